# Optimizing an MI355X kernel written in HIP

```python
import math
import jax
import jax.numpy as jnp
from jax import lax
import numpy as np

D_MODEL = 2048
BATCH = 2
SEQ = 8192
DEPTH = 2
DEC_BATCH = 16
DEC_SEQ = 16
PAST_LEN = 2048

CHUNK = 64
QBLOCK = 128
N_A_LAYERS = DEPTH // 2
N_B_LAYERS = DEPTH - N_A_LAYERS
GDN_HEAD_K = 128
GDN_HEAD_V = 128
GDN_K_HEADS = D_MODEL // 128
GDN_V_HEADS = 2 * GDN_K_HEADS
GDN_QK_W = GDN_K_HEADS * GDN_HEAD_K
GDN_V_W = GDN_V_HEADS * GDN_HEAD_V
GDN_QKV_W = 2 * GDN_QK_W + GDN_V_W
GDN_IN_W = GDN_QKV_W + GDN_V_W + 2 * GDN_V_HEADS
GDN_CONV = 4
DIFF_HEAD_DIM = 128
DIFF_HEADS = D_MODEL // 256
DIFF_QK_W = 2 * DIFF_HEADS * DIFF_HEAD_DIM
DIFF_V_W = DIFF_HEADS * 2 * DIFF_HEAD_DIM
DIFF_SUBLN_EPS = 1e-5
NUM_BUCKETS = 32
MAX_DISTANCE = 128
D_FF = 11 * D_MODEL // 4
FFN_CONV = 3
NORM_EPS = 1e-6
NEG_INF = -1e30

kernel_name = 'streaming_gdn_diffattn_yoco'


def _rmsnorm(x, g, eps=NORM_EPS):
    xf = x.astype(jnp.float32)
    y = xf * lax.rsqrt(jnp.mean(xf * xf, axis=-1, keepdims=True) + eps)
    return (y * g.astype(jnp.float32)).astype(x.dtype)


def _l2norm(x):
    return x * lax.rsqrt(jnp.sum(x * x, axis=-1, keepdims=True) + 1e-6)


def _causal_dwconv(x, w, buf):
    L = x.shape[1]
    width = w.shape[0]
    xp = jnp.concatenate([buf.astype(x.dtype), x], axis=1)
    y = xp[:, 0:L] * w[0]
    for i in range(1, width):
        y = y + xp[:, i:i + L] * w[i]
    return y, xp[:, xp.shape[1] - (width - 1):]


def _gated_delta_rule(q, k, v, g, beta, S0):
    B, L, H, DK = q.shape
    DV = v.shape[-1]
    c = min(CHUNK, L)
    n = L // c

    def blk(t):
        return jnp.moveaxis(t.reshape((B, n, c, H) + t.shape[3:]), 3, 2)

    q, k, v, g, beta = blk(q), blk(k), blk(v), blk(g), blk(beta)
    G = jnp.cumsum(g, axis=-1)
    idx = jnp.arange(c)
    incl = idx[:, None] >= idx[None, :]
    strict = idx[:, None] > idx[None, :]
    dec_incl = jnp.exp(jnp.where(incl, G[..., :, None] - G[..., None, :], -jnp.inf))
    dec_strict = jnp.where(strict, dec_incl, 0.0)
    A = beta[..., :, None] * jnp.einsum('bnhid,bnhjd->bnhij', k, k) * dec_strict
    eye = jnp.eye(c, dtype=jnp.float32)
    rhs = jnp.concatenate([beta[..., None] * v, (beta * jnp.exp(G))[..., None] * k], axis=-1)
    sol = lax.linalg.triangular_solve(A + eye, rhs, left_side=True, lower=True, unit_diagonal=True)
    u_v, w = sol[..., :DV], sol[..., DV:]
    P = jnp.einsum('bnhid,bnhjd->bnhij', q, k) * dec_incl
    q_g = q * jnp.exp(G)[..., None]
    k_d = k * jnp.exp(G[..., -1:] - G)[..., None]
    g_last = jnp.exp(G[..., -1])

    def step(S, xs):
        u_v_c, w_c, P_c, q_g_c, k_d_c, g_last_c = xs
        u = u_v_c - jnp.einsum('bhck,bhkv->bhcv', w_c, S)
        o = jnp.einsum('bhck,bhkv->bhcv', q_g_c, S) + jnp.einsum('bhij,bhjv->bhiv', P_c, u)
        S = g_last_c[..., None, None] * S + jnp.einsum('bhck,bhcv->bhkv', k_d_c, u)
        return S, o

    xs = tuple(jnp.moveaxis(t, 1, 0) for t in (u_v, w, P, q_g, k_d, g_last))
    S, o = lax.scan(step, S0, xs)
    o = jnp.transpose(o, (1, 0, 3, 2, 4)).reshape(B, L, H, DV)
    return o, S


def _gdn_mixer(xn, S0, conv_buf, w_in, w_conv, a_log, dt_bias, out_norm, w_out):
    B, L, _ = xn.shape
    proj = xn @ w_in
    o0 = GDN_QKV_W
    o1 = o0 + GDN_V_W
    o2 = o1 + GDN_V_HEADS
    qkv, z, b, a = proj[..., :o0], proj[..., o0:o1], proj[..., o1:o2], proj[..., o2:]
    qkv, new_buf = _causal_dwconv(qkv, w_conv, conv_buf)
    qkv = jax.nn.silu(qkv).astype(jnp.float32)
    rep = GDN_V_HEADS // GDN_K_HEADS
    q = _l2norm(qkv[..., :GDN_QK_W].reshape(B, L, GDN_K_HEADS, GDN_HEAD_K)) * (GDN_HEAD_K ** -0.5)
    k = _l2norm(qkv[..., GDN_QK_W:2 * GDN_QK_W].reshape(B, L, GDN_K_HEADS, GDN_HEAD_K))
    q = jnp.repeat(q, rep, axis=2)
    k = jnp.repeat(k, rep, axis=2)
    v = qkv[..., 2 * GDN_QK_W:].reshape(B, L, GDN_V_HEADS, GDN_HEAD_V)
    beta = jax.nn.sigmoid(b.astype(jnp.float32))
    g = -jnp.exp(a_log.astype(jnp.float32)) * jax.nn.softplus(a.astype(jnp.float32) + dt_bias.astype(jnp.float32))
    o, S = _gated_delta_rule(q, k, v, g, beta, S0.astype(jnp.float32))
    o = _rmsnorm(o, out_norm) * jax.nn.silu(z.astype(jnp.float32)).reshape(B, L, GDN_V_HEADS, GDN_HEAD_V)
    y = o.reshape(B, L, GDN_V_W).astype(xn.dtype) @ w_out
    return y, S.astype(xn.dtype), new_buf


def _conv_ffn(xn, buf, w_up, w_conv, b_conv, w_down):
    u, new_buf = _causal_dwconv(xn @ w_up, w_conv, buf)
    u = u + b_conv
    gate, val = u[..., :D_FF], u[..., D_FF:]
    return (jax.nn.silu(gate) * val) @ w_down, new_buf


def _t5_bucket(rel):
    half = NUM_BUCKETS // 2
    exact = half // 2
    n = jnp.abs(rel)
    large = exact + (jnp.log(jnp.maximum(n, 1).astype(jnp.float32) / exact)
                     / math.log(MAX_DISTANCE / exact) * (half - exact)).astype(jnp.int32)
    large = jnp.minimum(large, half - 1)
    return jnp.where(rel > 0, half, 0) + jnp.where(n < exact, n, large)


def _diff_core(q, k, v, q_pos, k_pos, rel_bias, lam):
    logits = jnp.einsum('bqhmd,bkhmd->bhmqk', q, k, preferred_element_type=jnp.float32) * (DIFF_HEAD_DIM ** -0.5)
    bias = rel_bias[_t5_bucket(k_pos[None, :] - q_pos[:, None])].astype(jnp.float32)
    bias = jnp.transpose(bias, (2, 0, 1))[None, :, None]
    visible = (k_pos[None, :] // CHUNK) <= (q_pos[:, None] // CHUNK)
    p = jax.nn.softmax(jnp.where(visible, logits + bias, NEG_INF), axis=-1)
    wts = p[:, :, 0] - lam * p[:, :, 1]
    return jnp.einsum('bhqk,bkhe->bqhe', wts.astype(v.dtype), v)


def _attend_blocks(q, k, v, q_pos, k_pos, rel_bias, lam):
    B, L = q.shape[:2]
    nb = L // QBLOCK
    qb = jnp.swapaxes(q.reshape((B, nb, QBLOCK) + q.shape[2:]), 0, 1)
    pb = q_pos.reshape(nb, QBLOCK)
    ob = lax.map(lambda t: _diff_core(t[0], k, v, t[1], k_pos, rel_bias, lam), (qb, pb))
    return jnp.swapaxes(ob, 0, 1).reshape((B, L) + ob.shape[3:])


def _diff_mixer(xn, k_all, v_all, q_pos, k_pos, w_q, lq1, lk1, lq2, lk2, sub_norm, w_o, rel_bias, lam_init, sweep):
    B, L, _ = xn.shape
    q = (xn @ w_q).reshape(B, L, DIFF_HEADS, 2, DIFF_HEAD_DIM)
    k = k_all.reshape(B, k_all.shape[1], DIFF_HEADS, 2, DIFF_HEAD_DIM)
    f32 = jnp.float32
    lam = (jnp.exp(jnp.sum(lq1.astype(f32) * lk1.astype(f32)))
           - jnp.exp(jnp.sum(lq2.astype(f32) * lk2.astype(f32))) + lam_init)
    if sweep:
        o = _attend_blocks(q, k, v_all, q_pos, k_pos, rel_bias, lam)
    else:
        o = _diff_core(q, k, v_all, q_pos, k_pos, rel_bias, lam)
    o = _rmsnorm(o, sub_norm, eps=DIFF_SUBLN_EPS) * (1.0 - lam_init)
    return o.reshape(B, L, DIFF_V_W) @ w_o


def _trunk(x, pos0, st_gdn, st_gdn_conv, st_ffn_conv, cache_k, cache_v, p):
    B, L, _ = x.shape
    fresh = cache_k is None
    q_pos = pos0 + jnp.arange(L, dtype=jnp.int32)
    new_S, new_gconv, new_fconv = [], [], []
    k_sh = None
    v_sh = None
    h = x
    for layer in range(DEPTH):
        if layer < N_A_LAYERS:
            i = layer
            S0 = jnp.zeros((B, GDN_V_HEADS, GDN_HEAD_K, GDN_HEAD_V), x.dtype) if fresh else st_gdn[i]
            cb = jnp.zeros((B, GDN_CONV - 1, GDN_QKV_W), x.dtype) if fresh else st_gdn_conv[i]
            o, S, cb_new = _gdn_mixer(_rmsnorm(h, p['a_norm'][i]), S0, cb, p['a_w_in'][i], p['a_w_conv'][i],
                                      p['a_log'][i], p['a_dt_bias'][i], p['a_out_norm'][i], p['a_w_out'][i])
            h = h + o
            new_S.append(S)
            new_gconv.append(cb_new)
        else:
            j = layer - N_A_LAYERS
            lam_init = 0.8 - 0.6 * math.exp(-0.3 * layer)
            if fresh:
                k_all, v_all, k_pos = k_sh, v_sh, q_pos
            else:
                k_all = jnp.concatenate([cache_k, k_sh], axis=1)
                v_all = jnp.concatenate([cache_v, v_sh], axis=1)
                k_pos = jnp.arange(cache_k.shape[1] + L, dtype=jnp.int32)
            o = _diff_mixer(_rmsnorm(h, p['b_norm'][j]), k_all, v_all, q_pos, k_pos, p['b_w_q'][j],
                            p['b_lam_q1'][j], p['b_lam_k1'][j], p['b_lam_q2'][j], p['b_lam_k2'][j],
                            p['b_sub_norm'][j], p['b_w_o'][j], p['rel_bias'], lam_init, fresh)
            h = h + o
        fb = jnp.zeros((B, FFN_CONV - 1, 2 * D_FF), x.dtype) if fresh else st_ffn_conv[layer]
        o, fb_new = _conv_ffn(_rmsnorm(h, p['f_norm'][layer]), fb, p['f_w_up'][layer], p['f_w_conv'][layer],
                              p['f_b_conv'][layer], p['f_w_down'][layer])
        h = h + o
        new_fconv.append(fb_new)
        if layer == N_A_LAYERS - 1:
            kv = _rmsnorm(h, p['kv_norm']) @ p['w_kv']
            k_sh = kv[..., :DIFF_QK_W].reshape(B, L, 2 * DIFF_HEADS, DIFF_HEAD_DIM)
            v_sh = kv[..., DIFF_QK_W:].reshape(B, L, DIFF_HEADS, 2 * DIFF_HEAD_DIM)
    y = _rmsnorm(h, p['final_norm'])
    return y, jnp.stack(new_S), jnp.stack(new_gconv), jnp.stack(new_fconv), k_sh, v_sh


def setup_inputs(seed: int = 0) -> dict:
    key = jax.random.key(seed)
    ks = iter(list(jax.random.split(key, 48)))
    f32 = jnp.float32

    def nrm(shape, scale):
        return scale * jax.random.normal(next(ks), shape, f32)

    def gain(shape):
        return 1.0 + 0.01 * jax.random.normal(next(ks), shape, f32)

    dt = jnp.exp(jax.random.uniform(next(ks), (N_A_LAYERS, GDN_V_HEADS), f32,
                                    minval=math.log(1e-3), maxval=math.log(0.1)))
    return {
        'x_prompt': nrm((BATCH, SEQ, D_MODEL), 1.0),
        'x_sample': nrm((DEC_BATCH, DEC_SEQ, D_MODEL), 1.0),
        'state_gdn': nrm((N_A_LAYERS, DEC_BATCH, GDN_V_HEADS, GDN_HEAD_K, GDN_HEAD_V), 0.1),
        'state_gdn_conv': nrm((N_A_LAYERS, DEC_BATCH, GDN_CONV - 1, GDN_QKV_W), 1.0),
        'state_ffn_conv': nrm((DEPTH, DEC_BATCH, FFN_CONV - 1, 2 * D_FF), 1.0),
        'cache_k': nrm((DEC_BATCH, PAST_LEN, 2 * DIFF_HEADS, DIFF_HEAD_DIM), 1.0),
        'cache_v': nrm((DEC_BATCH, PAST_LEN, DIFF_HEADS, 2 * DIFF_HEAD_DIM), 1.0),
        'a_norm': gain((N_A_LAYERS, D_MODEL)),
        'a_w_in': nrm((N_A_LAYERS, D_MODEL, GDN_IN_W), D_MODEL ** -0.5),
        'a_w_conv': nrm((N_A_LAYERS, GDN_CONV, GDN_QKV_W), 0.5),
        'a_log': jnp.log(jax.random.uniform(next(ks), (N_A_LAYERS, GDN_V_HEADS), f32, minval=1.0, maxval=16.0)),
        'a_dt_bias': dt + jnp.log(-jnp.expm1(-dt)),
        'a_out_norm': gain((N_A_LAYERS, GDN_HEAD_V)),
        'a_w_out': nrm((N_A_LAYERS, GDN_V_W, D_MODEL), GDN_V_W ** -0.5),
        'kv_norm': gain((D_MODEL,)),
        'w_kv': nrm((D_MODEL, DIFF_QK_W + DIFF_V_W), D_MODEL ** -0.5),
        'b_norm': gain((N_B_LAYERS, D_MODEL)),
        'b_w_q': nrm((N_B_LAYERS, D_MODEL, DIFF_QK_W), D_MODEL ** -0.5),
        'b_lam_q1': nrm((N_B_LAYERS, DIFF_HEAD_DIM), 0.1),
        'b_lam_k1': nrm((N_B_LAYERS, DIFF_HEAD_DIM), 0.1),
        'b_lam_q2': nrm((N_B_LAYERS, DIFF_HEAD_DIM), 0.1),
        'b_lam_k2': nrm((N_B_LAYERS, DIFF_HEAD_DIM), 0.1),
        'b_sub_norm': gain((N_B_LAYERS, 2 * DIFF_HEAD_DIM)),
        'b_w_o': nrm((N_B_LAYERS, DIFF_V_W, D_MODEL), DIFF_V_W ** -0.5),
        'rel_bias': nrm((NUM_BUCKETS, DIFF_HEADS), 0.5),
        'f_norm': gain((DEPTH, D_MODEL)),
        'f_w_up': nrm((DEPTH, D_MODEL, 2 * D_FF), D_MODEL ** -0.5),
        'f_w_conv': nrm((DEPTH, FFN_CONV, 2 * D_FF), FFN_CONV ** -0.5),
        'f_b_conv': nrm((DEPTH, 2 * D_FF), 0.02),
        'f_w_down': nrm((DEPTH, D_FF, D_MODEL), D_FF ** -0.5),
        'final_norm': gain((D_MODEL,)),
    }


def reference(x_prompt, x_sample, state_gdn, state_gdn_conv, state_ffn_conv, cache_k, cache_v,
              a_norm, a_w_in, a_w_conv, a_log, a_dt_bias, a_out_norm, a_w_out,
              kv_norm, w_kv, b_norm, b_w_q, b_lam_q1, b_lam_k1, b_lam_q2, b_lam_k2, b_sub_norm, b_w_o,
              rel_bias, f_norm, f_w_up, f_w_conv, f_b_conv, f_w_down, final_norm):
    p = {
        'a_norm': a_norm, 'a_w_in': a_w_in, 'a_w_conv': a_w_conv, 'a_log': a_log,
        'a_dt_bias': a_dt_bias, 'a_out_norm': a_out_norm, 'a_w_out': a_w_out,
        'kv_norm': kv_norm, 'w_kv': w_kv,
        'b_norm': b_norm, 'b_w_q': b_w_q, 'b_lam_q1': b_lam_q1, 'b_lam_k1': b_lam_k1,
        'b_lam_q2': b_lam_q2, 'b_lam_k2': b_lam_k2, 'b_sub_norm': b_sub_norm, 'b_w_o': b_w_o,
        'rel_bias': rel_bias,
        'f_norm': f_norm, 'f_w_up': f_w_up, 'f_w_conv': f_w_conv, 'f_b_conv': f_b_conv,
        'f_w_down': f_w_down, 'final_norm': final_norm,
    }
    y_prompt, p_gdn, p_gdn_conv, p_ffn_conv, p_k, p_v = _trunk(
        x_prompt, 0, None, None, None, None, None, p)
    y_sample, s_gdn, s_gdn_conv, s_ffn_conv, s_k, s_v = _trunk(
        x_sample, cache_k.shape[1], state_gdn, state_gdn_conv, state_ffn_conv, cache_k, cache_v, p)
    return (y_prompt, y_sample, p_gdn, p_gdn_conv, p_ffn_conv, p_k, p_v,
            s_gdn, s_gdn_conv, s_ffn_conv, s_k, s_v)
```

```cpp
#include <hip/hip_runtime.h>
#include <cstdio>
#include <cstdint>

constexpr int DM = 2048;
constexpr int SEQ = 8192, NB = 2, MP = NB * SEQ;
constexpr int DECB = 16, DECS = 16, MS = DECB * DECS;
constexpr int PAST = 2048;
constexpr int M = MP + MS;
constexpr int QKVW = 8192, VW = 4096, INW = 12352, INWP = 12544;
constexpr int DFF = 5632, UPW = 11264;
constexpr int NITEM_P = NB * 128 * 32, NITEM = NITEM_P + DECB * 32;
constexpr size_t O_Y = 0, O_PGDN = 34078720, O_PGC = 35127296, O_PFC = 35176448, O_PK = 35266560, O_PV = 68820992,
                 O_SGDN = 102375424, O_SGC = 110764032, O_SFC = 111157248, O_SK = 111878144, O_SV = 112402432, O_END = 112926720;
namespace pg8 {
#define PG8_LAS __attribute__((address_space(3)))
typedef unsigned short bf16_t;
typedef short bf16x8 __attribute__((ext_vector_type(8)));
typedef float f32x4 __attribute__((ext_vector_type(4)));
typedef unsigned u32x4 __attribute__((ext_vector_type(4)));
constexpr int BM = 256, BK = 64, HALF = 128, HTB = HALF * BK * 2  , STAGE_BYTES = 8 * HTB, NXCD = 8, WGM = 8;

__host__ __device__ __forceinline__ int lds_byte(int r, int c) { const int st = (r >> 4) * 2 + (c >> 5), rr = r & 15, cc = c & 31, ob = rr * 64 + cc * 2; return st * 1024 + (ob ^ (((ob >> 9) & 1) << 5)); }
__host__ __device__ __forceinline__ void stage_rc(int b, int& R, int& C) { const int st = b / 1024, sb = b % 1024, swz = sb ^ (((sb >> 9) & 1) << 5); R = (st >> 1) * 16 + swz / 64; C = (st & 1) * 32 + (swz % 64) / 2; }
__host__ __device__ __forceinline__ int perm32(int rho) { const int n = rho >> 4, i = rho & 15; return 8 * (i >> 2) + 4 * n + (i & 3); }

struct Unit { int pm, pn; };
struct Gemm { const bf16_t* A; const bf16_t* Bt; int M, N, K; };

struct StaticOrder {
    int nM, nN, nwg, G, c;
    __host__ __device__ void init(int M, int N, int G_, int c_) { nM = M / BM; nN = N / BM; nwg = nM * nN; G = G_; c = c_; }
    __host__ __device__ bool next(int i, Unit& u) const {
        const long L = (long)i * G + c; if (L >= nwg) return false;
        int wgid = (int)L; { const int q = nwg / NXCD, r = nwg % NXCD, xcd = wgid % NXCD, off = wgid / NXCD; wgid = (xcd < r ? xcd * (q + 1) : r * (q + 1) + (xcd - r) * q) + off; }
        const int nig = WGM * nN, gid = wgid / nig, fm = gid * WGM, gsz = (nM - fm) < WGM ? (nM - fm) : WGM;
        u.pm = fm + ((wgid % nig) % gsz); u.pn = (wgid % nig) / gsz; return true;
    }
    __device__ __forceinline__ void a_ready(const Unit&) const {}
    __device__ __forceinline__ void done(const Unit&) const {}
};

typedef float f32x2 __attribute__((ext_vector_type(2)));
typedef __bf16 bf16v2 __attribute__((ext_vector_type(2)));
typedef unsigned u32x2 __attribute__((ext_vector_type(2)));
__device__ __forceinline__ unsigned cvt_pk_bf16(float lo, float hi) { const f32x2 v = {lo, hi}; return __builtin_bit_cast(unsigned, __builtin_convertvector(v, bf16v2)); }

__device__ __forceinline__ void row_rstd(const float* ssq, int row0, int fq, float (&rs)[2][4]) {
#pragma unroll
    for (int ai = 0; ai < 2; ++ai)
#pragma unroll
        for (int m = 0; m < 4; ++m) {
            const float* p = ssq + (size_t)(row0 + ai * HALF + m * 16) * 32 + fq * 8;
            const f32x4 a = *(const f32x4*)p, b = *(const f32x4*)(p + 4);
            float s = ((a[0] + a[1]) + (a[2] + a[3])) + ((b[0] + b[1]) + (b[2] + b[3]));
            s += __shfl_xor(s, 16); s += __shfl_xor(s, 32);
            rs[ai][m] = rsqrtf(s * (1.0f / 2048.0f) + 1e-6f);
        }
}
struct EpiBf {
    static constexpr bool PERM = true, AFTER_DRAIN = false;
    const float* ssq; bf16_t* O0; int ld0, nc0; bf16_t* O1; int ld1, nc1; float* F2; int ld2, nc2;
    __device__ __forceinline__ void operator()(const f32x4 (&acc)[2][2][4][2], const Unit& u, int wr, int wc, int fr, int fq) const {
        const int row0 = u.pm * BM + wr * 64 + fr; const int colt = u.pn * BM;
        float rs[2][4]; row_rstd(ssq, row0, fq, rs);
        if (colt < nc0 + nc1) {
            bf16_t* base; int ld;
            if (colt < nc0) { base = O0 + colt; ld = ld0; } else { base = O1 + (colt - nc0); ld = ld1; }
            const int col0 = wc * 32 + 8 * fq;
#pragma unroll
            for (int ai = 0; ai < 2; ++ai)
#pragma unroll
                for (int m = 0; m < 4; ++m) { bf16_t* rowp = base + (size_t)(row0 + ai * HALF + m * 16) * ld + col0; const float r = rs[ai][m];
#pragma unroll
                    for (int bj = 0; bj < 2; ++bj) { const f32x4 v0 = acc[ai][bj][m][0] * r, v1 = acc[ai][bj][m][1] * r;
                        u32x4 w; w.x = cvt_pk_bf16(v0[0], v0[1]); w.y = cvt_pk_bf16(v0[2], v0[3]); w.z = cvt_pk_bf16(v1[0], v1[1]); w.w = cvt_pk_bf16(v1[2], v1[3]);
                        *(u32x4*)(rowp + bj * HALF) = w; } }
        } else if (colt == nc0 + nc1 && F2 != nullptr && wc * 32 < nc2) {
#pragma unroll
            for (int ai = 0; ai < 2; ++ai)
#pragma unroll
                for (int m = 0; m < 4; ++m) { float* rowp = F2 + (size_t)(row0 + ai * HALF + m * 16) * ld2 + wc * 32 + 8 * fq; const float r = rs[ai][m];
                    *(f32x4*)(rowp) = acc[ai][0][m][0] * r; *(f32x4*)(rowp + 4) = acc[ai][0][m][1] * r; }
        }
    }
};
struct EpiRes {
    static constexpr bool PERM = false, AFTER_DRAIN = false;
    const float* base0; const float* base1; float* out; bf16_t* hb; float* ssq;
    __device__ __forceinline__ void operator()(const f32x4 (&acc)[2][2][4][2], const Unit& u, int wr, int wc, int fr, int fq) const {
        const int row0 = u.pm * BM + wr * 64 + fr, col0 = u.pn * BM + wc * 32 + 4 * fq;
        const float* bs = (u.pm * BM < MP) ? base0 : base1;
#pragma unroll
        for (int ai = 0; ai < 2; ++ai)
#pragma unroll
            for (int m = 0; m < 4; ++m) { const size_t off = (size_t)(row0 + ai * HALF + m * 16) * DM + col0; float ss = 0.f;
#pragma unroll
                for (int bj = 0; bj < 2; ++bj)
#pragma unroll
                    for (int n = 0; n < 2; ++n) { const size_t o2 = off + bj * HALF + n * 16; const f32x4 o = *(const f32x4*)(bs + o2) + acc[ai][bj][m][n];
                        *(f32x4*)(out + o2) = o; ss += (o[0] * o[0] + o[1] * o[1]) + (o[2] * o[2] + o[3] * o[3]);
                        if (hb) { u32x2 w; w.x = cvt_pk_bf16(o[0], o[1]); w.y = cvt_pk_bf16(o[2], o[3]); *(u32x2*)(hb + o2) = w; } }
                ss += __shfl_xor(ss, 16); ss += __shfl_xor(ss, 32);
                if (fq == 0) ssq[(size_t)(row0 + ai * HALF + m * 16) * 32 + u.pn * 4 + wc] = ss; }
    }
};
struct EpiKVQ {
    static constexpr bool PERM = false, AFTER_DRAIN = false;
    const float* ssq; float* dout; bf16_t* KB; size_t kvq_stride;
    __device__ __forceinline__ void operator()(const f32x4 (&acc)[2][2][4][2], const Unit& u, int wr, int wc, int fr, int fq) const {
        const int row0 = u.pm * BM + wr * 64 + fr; const int colt = u.pn * BM, which = colt >> 11, cb = (colt & 2047) + wc * 32 + 4 * fq;
        float rs[2][4]; row_rstd(ssq, row0, fq, rs);
        bf16_t* bb = KB + (size_t)which * kvq_stride;
        float* fo = nullptr;
        if (which < 2) fo = (u.pm * BM < MP) ? dout + O_PK + (size_t)which * (O_PV - O_PK) : dout + O_SK + (size_t)which * (O_SV - O_SK) - (size_t)MP * DM;
#pragma unroll
        for (int ai = 0; ai < 2; ++ai)
#pragma unroll
            for (int m = 0; m < 4; ++m) { const size_t off = (size_t)(row0 + ai * HALF + m * 16) * DM + cb; const float r = rs[ai][m];
#pragma unroll
                for (int bj = 0; bj < 2; ++bj)
#pragma unroll
                    for (int n = 0; n < 2; ++n) { const size_t o2 = off + bj * HALF + n * 16; const f32x4 o = acc[ai][bj][m][n] * r;
                        if (fo) *(f32x4*)(fo + o2) = o;
                        u32x2 w; w.x = cvt_pk_bf16(o[0], o[1]); w.y = cvt_pk_bf16(o[2], o[3]); *(u32x2*)(bb + o2) = w; } }
    }
};

template <class Epi, class Sched, bool ALIGN_EPI = false, bool SP2 = false>
__device__ __forceinline__ void gemm_phase(PG8_LAS unsigned char* lds, const Gemm g, const Sched& S, const Epi& E) {
    const int tid = threadIdx.x, wid = __builtin_amdgcn_readfirstlane(tid >> 6), lane = tid & 63, wr = wid >> 2, wc = wid & 3, fr = lane & 15, fq = lane >> 4;
    const int K = g.K, nt = K / BK;
    unsigned voffA[2], voffB[2];
#pragma unroll
    for (int i = 0; i < 2; ++i) { int R, C; stage_rc(tid * 16 + i * 8192, R, C); const int Rb = Epi::PERM ? ((R & ~31) + perm32(R & 31)) : R;
        voffA[i] = (unsigned)(R * K + C) * 2u; voffB[i] = (unsigned)(Rb * K + C) * 2u; }
    const size_t kstep = (size_t)(BK * 2);
    const size_t hstep = (size_t)HALF * K * 2;
    const size_t tstep = 2 * hstep;
    const unsigned ldsw = (unsigned)wid * 1024u;
    const int aoff = lds_byte(wr * 64 + fr, fq * 8), boff = lds_byte(wc * 32 + fr, fq * 8);
#define PG8_SA(b, h) (((b) * 2 + (h)) * HTB)
#define PG8_SB(b, h) ((4 + (b) * 2 + (h)) * HTB)
#define PG8_STAGE(bufoff, gbase, voff) do { _Pragma("unroll") for (int _i = 0; _i < 2; ++_i) \
        __builtin_amdgcn_global_load_lds((const unsigned*)((const char*)(gbase) + (voff)[_i]), (PG8_LAS unsigned*)(lds + (bufoff) + ldsw + _i * 8192), 16, 0, 0); } while (0)
#define PG8_LDA(dst, b, h) do { _Pragma("unroll") for (int m = 0; m < 4; ++m) _Pragma("unroll") for (int k = 0; k < 2; ++k) dst[m][k] = *(const PG8_LAS bf16x8*)(lds + PG8_SA(b, h) + aoff + m * 2048 + k * 1024); } while (0)
#define PG8_LDB(dst, b, h) do { _Pragma("unroll") for (int n = 0; n < 2; ++n) _Pragma("unroll") for (int k = 0; k < 2; ++k) dst[n][k] = *(const PG8_LAS bf16x8*)(lds + PG8_SB(b, h) + boff + n * 2048 + k * 1024); } while (0)
#define PG8_MMA(ai, bj, At, Bt) do { __builtin_amdgcn_s_setprio(1); _Pragma("unroll") for (int m = 0; m < 4; ++m) _Pragma("unroll") for (int n = 0; n < 2; ++n) _Pragma("unroll") for (int k = 0; k < 2; ++k) \
        acc[ai][bj][m][n] = __builtin_amdgcn_mfma_f32_16x16x32_bf16(Bt[n][k], At[m][k], acc[ai][bj][m][n], 0, 0, 0); __builtin_amdgcn_s_setprio(0); } while (0)
#define PG8_WAIT_V(n) asm volatile("s_waitcnt vmcnt(" #n ")" ::: "memory")
#define PG8_WAIT_L(n) asm volatile("s_waitcnt lgkmcnt(" #n ")" ::: "memory")
#define PG8_BAR __builtin_amdgcn_s_barrier()
#define PG8_SCHED __builtin_amdgcn_sched_barrier(0)
    Unit cur, nxt; int ui = 0;
    if (!S.next(0, cur)) return;
    f32x4 acc[2][2][4][2];
#pragma unroll
    for (int a = 0; a < 2; ++a)
#pragma unroll
        for (int b = 0; b < 2; ++b)
#pragma unroll
            for (int m = 0; m < 4; ++m)
#pragma unroll
                for (int n = 0; n < 2; ++n) acc[a][b][m][n] = (f32x4){0.f, 0.f, 0.f, 0.f};
    bf16x8 At[4][2], B0[2][2], B1[2][2];
    const char* cA = (const char*)g.A + (size_t)cur.pm * tstep; const char* cB = (const char*)g.Bt + (size_t)cur.pn * tstep;
    S.a_ready(cur);
    if constexpr (SP2) {
        PG8_STAGE(PG8_SB(0, 0), cB, voffB); PG8_STAGE(PG8_SB(0, 1), cB + hstep, voffB); PG8_STAGE(PG8_SA(0, 0), cA, voffA); PG8_STAGE(PG8_SA(0, 1), cA + hstep, voffA);
        if (wr == 1) PG8_BAR;
        PG8_WAIT_V(2); PG8_BAR;
        PG8_STAGE(PG8_SB(1, 0), cB + kstep, voffB); PG8_STAGE(PG8_SA(1, 0), cA + kstep, voffA); PG8_STAGE(PG8_SB(1, 1), cB + hstep + kstep, voffB);
        PG8_WAIT_V(6); PG8_BAR;
    } else {
        PG8_STAGE(PG8_SB(0, 0), cB, voffB); PG8_STAGE(PG8_SA(0, 0), cA, voffA); PG8_STAGE(PG8_SB(0, 1), cB + hstep, voffB); PG8_STAGE(PG8_SA(0, 1), cA + hstep, voffA);
        if (wr == 1) PG8_BAR;
        PG8_WAIT_V(4); PG8_BAR;
        PG8_STAGE(PG8_SB(1, 0), cB + kstep, voffB); PG8_STAGE(PG8_SA(1, 0), cA + kstep, voffA); PG8_STAGE(PG8_SB(1, 1), cB + hstep + kstep, voffB);
        PG8_WAIT_V(6); PG8_BAR;
    }
    for (;;) {
        const bool has_next = S.next(ui + 1, nxt);
        const char* nA = has_next ? (const char*)g.A + (size_t)nxt.pm * tstep : cA; const char* nB = has_next ? (const char*)g.Bt + (size_t)nxt.pn * tstep : cB;
        for (int t = 0; t < nt; t += 2) {
            const bool last = (t == nt - 2);
            const char* a1 = cA + (size_t)(t + 1) * kstep;
            const char* a2 = last ? nA : cA + (size_t)(t + 2) * kstep; const char* b2 = last ? nB : cB + (size_t)(t + 2) * kstep;
            const char* a3 = a2 + kstep; const char* b3 = b2 + kstep;
            if (last && has_next) S.a_ready(nxt);
            if constexpr (SP2) {
            PG8_LDB(B0, 0, 0); PG8_LDB(B1, 0, 1); PG8_SCHED; PG8_LDA(At, 0, 0); PG8_STAGE(PG8_SA(1, 1), a1 + hstep, voffA);
            PG8_WAIT_V(8); PG8_WAIT_L(0); PG8_BAR; PG8_MMA(0, 0, At, B0); PG8_MMA(0, 1, At, B1); PG8_BAR; PG8_SCHED;
            PG8_LDA(At, 0, 1); PG8_STAGE(PG8_SB(0, 0), b2, voffB); PG8_STAGE(PG8_SB(0, 1), b2 + hstep, voffB); PG8_STAGE(PG8_SA(0, 0), a2, voffA);
            PG8_WAIT_V(8); PG8_WAIT_L(0); PG8_BAR; PG8_MMA(1, 0, At, B0); PG8_MMA(1, 1, At, B1); PG8_BAR; PG8_SCHED;
            PG8_LDB(B0, 1, 0); PG8_LDB(B1, 1, 1); PG8_SCHED; PG8_LDA(At, 1, 0); PG8_STAGE(PG8_SA(0, 1), a2 + hstep, voffA);
            PG8_WAIT_V(8); PG8_WAIT_L(0); PG8_BAR; PG8_MMA(0, 0, At, B0); PG8_MMA(0, 1, At, B1); PG8_BAR; PG8_SCHED;
            PG8_LDA(At, 1, 1); PG8_STAGE(PG8_SB(1, 0), b3, voffB); PG8_STAGE(PG8_SB(1, 1), b3 + hstep, voffB); PG8_STAGE(PG8_SA(1, 0), a3, voffA);
            PG8_WAIT_V(8); PG8_WAIT_L(0); PG8_BAR; PG8_MMA(1, 0, At, B0); PG8_MMA(1, 1, At, B1); PG8_BAR; PG8_SCHED;
            } else {
            PG8_LDB(B0, 0, 0); PG8_SCHED; PG8_LDA(At, 0, 0); PG8_STAGE(PG8_SA(1, 1), a1 + hstep, voffA);
            PG8_WAIT_L(8); PG8_BAR; PG8_WAIT_L(0); PG8_MMA(0, 0, At, B0); PG8_BAR; PG8_SCHED;
            PG8_LDB(B1, 0, 1); PG8_STAGE(PG8_SB(0, 0), b2, voffB);
            PG8_BAR; PG8_WAIT_L(0); PG8_MMA(0, 1, At, B1); PG8_BAR;
            PG8_LDA(At, 0, 1); PG8_STAGE(PG8_SA(0, 0), a2, voffA);
            PG8_BAR; PG8_WAIT_L(0); PG8_MMA(1, 0, At, B0); PG8_BAR; PG8_SCHED;
            PG8_STAGE(PG8_SB(0, 1), b2 + hstep, voffB);
            PG8_WAIT_V(6); PG8_BAR; PG8_MMA(1, 1, At, B1); PG8_BAR;
            PG8_LDB(B0, 1, 0); PG8_SCHED; PG8_LDA(At, 1, 0); PG8_STAGE(PG8_SA(0, 1), a2 + hstep, voffA);
            PG8_WAIT_L(8); PG8_BAR; PG8_WAIT_L(0); PG8_MMA(0, 0, At, B0); PG8_BAR; PG8_SCHED;
            PG8_LDB(B1, 1, 1); PG8_STAGE(PG8_SB(1, 0), b3, voffB);
            PG8_BAR; PG8_WAIT_L(0); PG8_MMA(0, 1, At, B1); PG8_BAR;
            PG8_LDA(At, 1, 1); PG8_STAGE(PG8_SA(1, 0), a3, voffA);
            PG8_BAR; PG8_WAIT_L(0); PG8_MMA(1, 0, At, B0); PG8_BAR; PG8_SCHED;
            PG8_STAGE(PG8_SB(1, 1), b3 + hstep, voffB);
            PG8_WAIT_V(6); PG8_BAR; PG8_MMA(1, 1, At, B1); PG8_BAR;
            }
        }
        if constexpr (ALIGN_EPI) { if (wr == 0) PG8_BAR; }
        if constexpr (!Epi::AFTER_DRAIN) { E(acc, cur, wr, wc, fr, fq); S.done(cur); }
        if (!has_next) break;
#pragma unroll
        for (int a = 0; a < 2; ++a)
#pragma unroll
            for (int b = 0; b < 2; ++b)
#pragma unroll
                for (int m = 0; m < 4; ++m)
#pragma unroll
                    for (int n = 0; n < 2; ++n) acc[a][b][m][n] = (f32x4){0.f, 0.f, 0.f, 0.f};
        cur = nxt; cA = nA; cB = nB; ++ui;
        if constexpr (ALIGN_EPI) { if (wr == 1) PG8_BAR; }
    }
    PG8_WAIT_V(0);
    if constexpr (!ALIGN_EPI) { if (wr == 0) PG8_BAR; }
    PG8_BAR;
    if constexpr (Epi::AFTER_DRAIN) { E.fused(acc, cur, wr, wc, fr, fq, lds, wid, lane); S.done(cur); }
#undef PG8_SA
#undef PG8_SB
#undef PG8_STAGE
#undef PG8_LDA
#undef PG8_LDB
#undef PG8_MMA
#undef PG8_WAIT_V
#undef PG8_WAIT_L
#undef PG8_BAR
#undef PG8_SCHED
}
}
#ifndef PG8_SP2
#define PG8_SP2 true
#endif
#ifndef PG8_ALIGN
#define PG8_ALIGN true
#endif

constexpr size_t MiB = 1u << 20;
constexpr size_t WS_CTL = 0, CTL_ZERO_BYTES = 1 * MiB;
constexpr size_t WS_SSQ = 1 * MiB, SSQ_STRIDE = 2359296;
constexpr size_t WS_BA = 13 * MiB;
constexpr size_t WS_EG = 18 * MiB, WS_DL = 21 * MiB, WS_GL = 24 * MiB;
constexpr size_t WS_WIN = 32 * MiB, WS_WOUT = 81 * MiB, WS_WUP0 = 97 * MiB, WS_WDN0 = 141 * MiB, WS_WKVQ = 163 * MiB, WS_WO = 187 * MiB, WS_WUP1 = 195 * MiB, WS_WDN1 = 239 * MiB;
constexpr size_t WS_HB = 261 * MiB;
constexpr size_t WS_RA = 326 * MiB;
constexpr size_t WS_QKV = WS_RA, WS_Z = WS_RA + 260 * MiB, WS_UP = WS_RA;
constexpr size_t WS_RB = 716 * MiB;
constexpr size_t WS_QN = WS_RB, WS_KN = WS_RB + 65 * MiB, WS_VV = WS_RB + 130 * MiB, WS_TP = WS_RB + 260 * MiB, WS_PP = WS_RB + 328 * MiB;
constexpr size_t WS_ACT = WS_RB;
constexpr size_t WS_KB = WS_RB, WS_VB = WS_RB + 65 * MiB, WS_QB = WS_RB + 130 * MiB, WS_ATT = WS_RB + 195 * MiB;
constexpr size_t WS_END = 1112 * MiB;
static_assert((size_t)M * 32 * 4 <= SSQ_STRIDE && WS_SSQ + 5 * SSQ_STRIDE <= WS_BA && WS_BA + (size_t)M * 64 * 4 <= WS_EG && WS_EG + (size_t)NITEM * 256 <= WS_DL && WS_DL + (size_t)NITEM * 256 <= WS_GL && WS_GL + NITEM * 4 <= WS_WIN, "small buffers");
static_assert(WS_WIN + (size_t)INWP * DM * 2 <= WS_WOUT && WS_WDN1 + (size_t)DM * DFF * 2 <= WS_HB && WS_HB + (size_t)M * DM * 2 <= WS_RA, "weights / HB");
static_assert(WS_QKV + (size_t)M * QKVW * 2 <= WS_Z && WS_Z + (size_t)M * VW * 2 <= WS_RB && WS_UP + (size_t)M * UPW * 2 <= WS_RB, "region A");
static_assert(WS_QN + (size_t)M * DM * 2 <= WS_KN && WS_KN + (size_t)M * DM * 2 <= WS_VV && WS_VV + (size_t)M * VW * 2 <= WS_TP && WS_TP + (size_t)NITEM * 8192 <= WS_PP && WS_PP + (size_t)NITEM * 8192 <= WS_END, "region B (gdn)");
static_assert(WS_ACT + (size_t)M * DFF * 2 <= WS_END && WS_ATT + (size_t)M * DM * 2 <= WS_END, "region B");
static_assert((size_t)M * VW * 2 <= (O_SGDN - O_PK) * 4, "ON scratch");
constexpr int CW_BAR = 4096;

constexpr int LDS_BYTES = 159744;
constexpr int LDSCTL_OFF = 158720;
constexpr int NWAVES = 8;

#define GAS __attribute__((address_space(1)))
#define LAS __attribute__((address_space(3)))
#define DI __device__ __forceinline__
typedef unsigned short bf16;
typedef unsigned v4u __attribute__((ext_vector_type(4)));
typedef unsigned v2u __attribute__((ext_vector_type(2)));
typedef float f32x4 __attribute__((ext_vector_type(4)));
typedef float f32x16 __attribute__((ext_vector_type(16)));
typedef short bf16x8 __attribute__((ext_vector_type(8)));
typedef short bf16x4 __attribute__((ext_vector_type(4)));
#define LDS_WAIT() asm volatile("s_waitcnt lgkmcnt(0)" ::: "memory")
#define VM_WAIT() asm volatile("s_waitcnt vmcnt(0)" ::: "memory")
#define MFMA32(a, b, c) __builtin_amdgcn_mfma_f32_32x32x16_bf16((a), (b), (c), 0, 0, 0)
DI unsigned pk2(float lo, float hi) { return pg8::cvt_pk_bf16(lo, hi); }
DI float bf2f(unsigned short b) { return __builtin_bit_cast(float, ((unsigned)b) << 16); }
DI float bflo(unsigned w) { return __builtin_bit_cast(float, w << 16); }
DI float bfhi(unsigned w) { return __builtin_bit_cast(float, w & 0xffff0000u); }
DI void unpack8(const v4u w, float (&f)[8]) { f[0] = bflo(w.x); f[1] = bfhi(w.x); f[2] = bflo(w.y); f[3] = bfhi(w.y); f[4] = bflo(w.z); f[5] = bfhi(w.z); f[6] = bflo(w.w); f[7] = bfhi(w.w); }
DI v4u pack8(const float (&f)[8]) { v4u w; w.x = pk2(f[0], f[1]); w.y = pk2(f[2], f[3]); w.z = pk2(f[4], f[5]); w.w = pk2(f[6], f[7]); return w; }
DI int crow(int r, int hi) { return (r & 3) + 8 * (r >> 2) + 4 * hi; }
DI float wave_sum(float v) {
#pragma unroll
    for (int o = 1; o < 64; o <<= 1) v += __shfl_xor(v, o);
    return v;
}
DI float siluf(float x) { return x / (1.0f + __expf(-x)); }

#define XB_TMO      128
#define XB_XCNT(j)  (256  + 64 * (j))
#define XB_XSUB(j)  (1280 + 64 * (j))
#define XB_XGEN(j)  (2304 + 64 * (j))
#define XB_TOP      3328
#define XB_TOPGEN   3392
#define XCD_BAR_WORDS 3456
#define XB_SPIN_CAP (1u << 18)

__device__ __forceinline__ unsigned xb_ld(unsigned* p)              { return __hip_atomic_load(p, __ATOMIC_RELAXED, __HIP_MEMORY_SCOPE_AGENT); }
__device__ __forceinline__ unsigned xb_add(unsigned* p, unsigned v) { return __hip_atomic_fetch_add(p, v, __ATOMIC_RELAXED, __HIP_MEMORY_SCOPE_AGENT); }
__device__ __forceinline__ unsigned xb_xcc_id() { return (unsigned)__builtin_amdgcn_s_getreg((3 << 11) | 20) & 0xFu; }
#define XB_SPIN(cond, bar) do { unsigned _sp = 0; while (cond) { __builtin_amdgcn_s_sleep(1); \
    if ((++_sp & 255u) == 0u) { if (xb_ld(&(bar)[XB_TMO])) break; if (_sp > XB_SPIN_CAP) { atomicAdd(&(bar)[XB_TMO], 1u); break; } } } } while (0)

struct XcdBarrier {
    unsigned* bar; unsigned x;
    volatile LAS unsigned* st;
};

__device__ __forceinline__ XcdBarrier xcd_barrier_post(unsigned* bar, volatile LAS unsigned* st) {
    XcdBarrier b; b.bar = bar; b.x = xb_xcc_id(); b.st = st;
    if (threadIdx.x == 0) (void)xb_add(&bar[XB_XCNT(b.x)], 1u);
    return b;
}
__device__ __forceinline__ void xcd_barrier_complete(unsigned* bar, unsigned x, unsigned& nloc, unsigned& nx) {
    const unsigned G = gridDim.x * gridDim.y * gridDim.z;
    unsigned sum, cnt, mine, sp = 0u;
    for (;;) {
        sum = 0u; cnt = 0u; mine = 0u;
#pragma unroll
        for (unsigned j = 0; j < 16; ++j) { const unsigned c = xb_ld(&bar[XB_XCNT(j)]); sum += c; cnt += (c > 0u) ? 1u : 0u; mine = (j == x) ? c : mine; }
        if (sum == G) break;
        __builtin_amdgcn_s_sleep(1);
        if ((++sp & 255u) == 0u) { if (xb_ld(&bar[XB_TMO])) break; if (sp > XB_SPIN_CAP) { atomicAdd(&bar[XB_TMO], 1u); break; } }
    }
    nloc = mine > 0u ? mine : 1u; nx = cnt > 0u ? cnt : 1u;
}

__device__ __forceinline__ void xcd_barrier(const XcdBarrier& b) {
    asm volatile("s_waitcnt vmcnt(0)" ::: "memory");
    __syncthreads();
    if (threadIdx.x == 0) {
        unsigned* bar = b.bar;
        __builtin_amdgcn_s_waitcnt(0);
        unsigned nloc = b.st[0], nx = b.st[1];
        if (nloc == 0u) { xcd_barrier_complete(bar, b.x, nloc, nx); b.st[0] = nloc; b.st[1] = nx; }
        const unsigned old = xb_add(&bar[XB_XSUB(b.x)], 1u);
        const unsigned gen = old / nloc;
        if (old + 1u == (gen + 1u) * nloc) {
            __builtin_amdgcn_fence(__ATOMIC_RELEASE, "agent");
            asm volatile("s_waitcnt vmcnt(0)" ::: "memory");
            const unsigned og = xb_add(&bar[XB_TOP], 1u);
            const unsigned tg = og / nx;
            if (og + 1u == (tg + 1u) * nx) xb_add(&bar[XB_TOPGEN], 1u);
            else XB_SPIN(xb_ld(&bar[XB_TOPGEN]) == tg, bar);
            __builtin_amdgcn_fence(__ATOMIC_ACQUIRE, "agent");
            xb_add(&bar[XB_XGEN(b.x)], 1u);
            asm volatile("s_waitcnt vmcnt(0)" ::: "memory");
        } else {
            XB_SPIN(xb_ld(&bar[XB_XGEN(b.x)]) == gen, bar);
            __builtin_amdgcn_fence(__ATOMIC_ACQUIRE, "agent");
            asm volatile("s_waitcnt vmcnt(0)" ::: "memory");
        }
    }
    __syncthreads();
}
struct Frame {
    LAS unsigned char* lds;
    volatile LAS unsigned* MISC;
    unsigned* ctl;
    int tid, lane, wave;
    int vcu, G;
    const float* const* in;
    float* out; unsigned char* ws;
};
enum { I_XP = 0, I_XS, I_SGDN, I_SGC, I_SFC, I_CK, I_CV, I_ANORM, I_AWIN, I_AWCONV, I_ALOG, I_ADT, I_AONORM, I_AWOUT, I_KVNORM, I_WKV, I_BNORM, I_BWQ,
       I_LQ1, I_LK1, I_LQ2, I_LK2, I_SUBN, I_BWO, I_RELB, I_FNORM, I_FWUP, I_FWCONV, I_FBCONV, I_FWDN, I_FINAL, N_IN };

DI void p0_transpose_item(const float* W, const float* gain, int K, int N, bf16* WT, int row_off, LAS float* scr, int item, int lane) {
    const int nblk = N / 32, kb = item / nblk, nb = item % nblk, k0 = 64 * kb, n0 = 32 * nb;
#pragma unroll 8
    for (int i = 0; i < 32; ++i) { const int kk = 2 * i + (lane >> 5); const float gk = gain ? gain[k0 + kk] : 1.0f; scr[kk * 33 + (lane & 31)] = W[(size_t)(k0 + kk) * N + n0 + (lane & 31)] * gk; }
    LDS_WAIT(); asm volatile("" ::: "memory");
    const int c = lane & 7;
#pragma unroll
    for (int j = 0; j < 4; ++j) { const int n = (lane >> 3) + 8 * j; const LAS float* s = scr + (8 * c) * 33 + n;
        v4u o; o.x = pk2(s[0 * 33], s[1 * 33]); o.y = pk2(s[2 * 33], s[3 * 33]); o.z = pk2(s[4 * 33], s[5 * 33]); o.w = pk2(s[6 * 33], s[7 * 33]);
        *(v4u*)(WT + (size_t)(row_off + n0 + n) * K + k0 + 8 * c) = o; }
    LDS_WAIT(); asm volatile("" ::: "memory");
}
DI void p0_prologue(Frame& F) {
    LAS float* scr = (LAS float*)(F.lds + F.wave * 16384);
    const int gw = F.vcu * NWAVES + F.wave, NGW = F.G * NWAVES, lane = F.lane;
    unsigned char* ws = F.ws;
    constexpr int I_IN = (DM / 64) * (INW / 32), I_OUT = (VW / 64) * (DM / 32), I_UP = (DM / 64) * (UPW / 32), I_DN = (DFF / 64) * (DM / 32), I_KV = (DM / 64) * (4096 / 32), I_Q = (DM / 64) * (DM / 32), I_O = I_Q;
    constexpr int NITEMS = I_IN + I_OUT + 2 * I_UP + 2 * I_DN + I_KV + I_Q + I_O;
    for (int it = gw; it < NITEMS; it += NGW) {
        int r = it;
        if (r < I_IN) { p0_transpose_item(F.in[I_AWIN], F.in[I_ANORM], DM, INW, (bf16*)(ws + WS_WIN), 0, scr, r, lane); continue; } r -= I_IN;
        if (r < I_OUT) { p0_transpose_item(F.in[I_AWOUT], nullptr, VW, DM, (bf16*)(ws + WS_WOUT), 0, scr, r, lane); continue; } r -= I_OUT;
        if (r < I_UP) { p0_transpose_item(F.in[I_FWUP], F.in[I_FNORM], DM, UPW, (bf16*)(ws + WS_WUP0), 0, scr, r, lane); continue; } r -= I_UP;
        if (r < I_UP) { p0_transpose_item(F.in[I_FWUP] + (size_t)DM * UPW, F.in[I_FNORM] + DM, DM, UPW, (bf16*)(ws + WS_WUP1), 0, scr, r, lane); continue; } r -= I_UP;
        if (r < I_DN) { p0_transpose_item(F.in[I_FWDN], nullptr, DFF, DM, (bf16*)(ws + WS_WDN0), 0, scr, r, lane); continue; } r -= I_DN;
        if (r < I_DN) { p0_transpose_item(F.in[I_FWDN] + (size_t)DFF * DM, nullptr, DFF, DM, (bf16*)(ws + WS_WDN1), 0, scr, r, lane); continue; } r -= I_DN;
        if (r < I_KV) { p0_transpose_item(F.in[I_WKV], F.in[I_KVNORM], DM, 4096, (bf16*)(ws + WS_WKVQ), 0, scr, r, lane); continue; } r -= I_KV;
        if (r < I_Q) { p0_transpose_item(F.in[I_BWQ], F.in[I_BNORM], DM, DM, (bf16*)(ws + WS_WKVQ), 4096, scr, r, lane); continue; } r -= I_Q;
        p0_transpose_item(F.in[I_BWO], nullptr, DM, DM, (bf16*)(ws + WS_WO), 0, scr, r, lane);
    }
    { v4u* z = (v4u*)(ws + WS_WIN + (size_t)INW * DM * 2); const int nz = (INWP - INW) * DM * 2 / 16; const v4u zero = {0u, 0u, 0u, 0u};
      for (int i = gw * 64 + lane; i < nz; i += NGW * 64) z[i] = zero; }
    float* ssq0 = (float*)(ws + WS_SSQ);
    for (int m = gw; m < M; m += NGW) {
        const float* xr = (m < MP) ? F.in[I_XP] + (size_t)m * DM : F.in[I_XS] + (size_t)(m - MP) * DM;
        const f32x4* x4 = (const f32x4*)xr + lane; v2u* o8 = (v2u*)((bf16*)(ws + WS_HB) + (size_t)m * DM) + lane;
        float s = 0.f;
#pragma unroll
        for (int j = 0; j < 8; ++j) { const f32x4 v = x4[64 * j]; s += (v[0] * v[0] + v[1] * v[1]) + (v[2] * v[2] + v[3] * v[3]); v2u w; w.x = pk2(v[0], v[1]); w.y = pk2(v[2], v[3]); o8[64 * j] = w; }
        s = wave_sum(s);
        if (lane < 32) ssq0[(size_t)m * 32 + lane] = (lane == 0) ? s : 0.f;
    }
}
DI void p_gdnconv(Frame& F) {
    const int gw = F.vcu * NWAVES + F.wave, NGW = F.G * NWAVES, lane = F.lane;
    const bf16* QKV = (const bf16*)(F.ws + WS_QKV);
    bf16* QN = (bf16*)(F.ws + WS_QN); bf16* KN = (bf16*)(F.ws + WS_KN); bf16* VV = (bf16*)(F.ws + WS_VV);
    const float* wconv = F.in[I_AWCONV];
    constexpr int NTB = MP / 16 + DECB;
    for (int it = gw; it < NTB * 16; it += NGW) {
        const int tb = it >> 4, cc = it & 15, c0 = cc * 512 + lane * 8;
        const bool samp = tb >= MP / 16; const int b = samp ? tb - MP / 16 : tb >> 9; const int t0 = samp ? 0 : (tb & 511) * 16;
        const size_t mbase = samp ? (size_t)MP + b * 16 : (size_t)b * SEQ; const int L = samp ? DECS : SEQ;
        float w[4][8];
#pragma unroll
        for (int i = 0; i < 4; ++i) { const f32x4 a = *(const f32x4*)(wconv + i * QKVW + c0), bq = *(const f32x4*)(wconv + i * QKVW + c0 + 4);
            w[i][0] = a[0]; w[i][1] = a[1]; w[i][2] = a[2]; w[i][3] = a[3]; w[i][4] = bq[0]; w[i][5] = bq[1]; w[i][6] = bq[2]; w[i][7] = bq[3]; }
        float h[3][8];
#pragma unroll
        for (int j = 0; j < 3; ++j) { const int t = t0 - 3 + j;
            if (t >= 0) { unpack8(*(const v4u*)(QKV + (mbase + t) * QKVW + c0), h[j]); }
            else if (samp) { const float* sp = F.in[I_SGC] + (size_t)(b * 3 + (t + 3)) * QKVW + c0; const f32x4 a = *(const f32x4*)sp, bq = *(const f32x4*)(sp + 4);
                h[j][0] = a[0]; h[j][1] = a[1]; h[j][2] = a[2]; h[j][3] = a[3]; h[j][4] = bq[0]; h[j][5] = bq[1]; h[j][6] = bq[2]; h[j][7] = bq[3]; }
            else {
#pragma unroll
                for (int e = 0; e < 8; ++e) h[j][e] = 0.f; } }
#pragma unroll 4
        for (int tt = 0; tt < 16; ++tt) {
            const int t = t0 + tt; const size_t m = mbase + t;
            float cur[8]; unpack8(*(const v4u*)(QKV + m * QKVW + c0), cur);
            float y[8]; float ss = 0.f;
#pragma unroll
            for (int e = 0; e < 8; ++e) { const float a = h[0][e] * w[0][e] + h[1][e] * w[1][e] + h[2][e] * w[2][e] + cur[e] * w[3][e]; y[e] = siluf(a); ss += y[e] * y[e]; }
            if (cc < 8) {
                ss += __shfl_xor(ss, 1); ss += __shfl_xor(ss, 2); ss += __shfl_xor(ss, 4); ss += __shfl_xor(ss, 8);
                const float sc = rsqrtf(ss + 1e-6f) * (cc < 4 ? 0.08838834764831845f : 1.0f);
#pragma unroll
                for (int e = 0; e < 8; ++e) y[e] *= sc;
                bf16* dst = (cc < 4) ? QN + m * DM + c0 : KN + m * DM + (c0 - 2048);
                *(v4u*)dst = pack8(y);
            } else { *(v4u*)(VV + m * VW + (c0 - 4096)) = pack8(y); }
            if (t >= L - 3) {
                float* so = F.out + (samp ? O_SGC : O_PGC) + (size_t)(b * 3 + (t - (L - 3))) * QKVW + c0;
                *(f32x4*)so = (f32x4){cur[0], cur[1], cur[2], cur[3]}; *(f32x4*)(so + 4) = (f32x4){cur[4], cur[5], cur[6], cur[7]}; }
#pragma unroll
            for (int e = 0; e < 8; ++e) { h[0][e] = h[1][e]; h[1][e] = h[2][e]; h[2][e] = cur[e]; }
        }
    }
}
DI void p_prep(Frame& F) {
    const int gw = F.vcu * NWAVES + F.wave, NGW = F.G * NWAVES;
    LAS float* Al = (LAS float*)(F.lds + F.wave * 16384);
    const bf16* QN = (const bf16*)(F.ws + WS_QN); const bf16* KN = (const bf16*)(F.ws + WS_KN);
    const float* BA = (const float*)(F.ws + WS_BA);
    bf16* TP = (bf16*)(F.ws + WS_TP); bf16* PP = (bf16*)(F.ws + WS_PP);
    float* EG = (float*)(F.ws + WS_EG); float* DL = (float*)(F.ws + WS_DL); float* GL = (float*)(F.ws + WS_GL);
    for (int it = gw; it < NITEM; it += NGW) {
        int lane = F.lane; asm volatile("" : "+v"(lane));
        const int c = lane & 31, hh = lane >> 5;
        int h, nv; size_t m0;
        if (it < NITEM_P) { h = it & 31; const int bn = it >> 5; m0 = (size_t)(bn >> 7) * SEQ + (size_t)(bn & 127) * 64; nv = 64; }
        else { const int r = it - NITEM_P; h = r & 31; m0 = (size_t)MP + (size_t)(r >> 5) * 16; nv = 16; }
        const int kh = h >> 1;
        float gt = 0.f, bt = 0.f;
        if (lane < nv) { const float bb = BA[(m0 + lane) * 64 + h], aa = BA[(m0 + lane) * 64 + 32 + h];
            bt = 1.0f / (1.0f + __expf(-bb));
            const float xx = aa + F.in[I_ADT][h]; const float sp = fmaxf(xx, 0.f) + log1pf(__expf(-fabsf(xx)));
            gt = -__expf(F.in[I_ALOG][h]) * sp; }
        float G = gt;
#pragma unroll
        for (int o = 1; o < 64; o <<= 1) { const float y = __shfl_up(G, o); if (lane >= o) G += y; }
        const float Glast = __shfl(G, 63);
        bf16x8 kf[2][8];
#pragma unroll
        for (int ti = 0; ti < 2; ++ti)
#pragma unroll
            for (int s = 0; s < 8; ++s) { const int row = 32 * ti + c;
                kf[ti][s] = (row < nv) ? *(const bf16x8*)(KN + (m0 + row) * DM + kh * 128 + 16 * s + 8 * hh) : (bf16x8){0, 0, 0, 0, 0, 0, 0, 0}; }
        {
            f32x16 t00 = {}, t10 = {}, t11 = {};
#pragma unroll
            for (int s = 0; s < 8; ++s) { t00 = MFMA32(kf[0][s], kf[0][s], t00); t10 = MFMA32(kf[1][s], kf[0][s], t10); t11 = MFMA32(kf[1][s], kf[1][s], t11); }
#pragma unroll
            for (int i = 0; i < 16; ++i) {
                const int r0 = crow(i, hh), r1 = 32 + r0;
                const float G0 = __shfl(G, r0), G1 = __shfl(G, r1), b0 = __shfl(bt, r0), b1 = __shfl(bt, r1);
                const float Gc0 = __shfl(G, c), Gc1 = __shfl(G, 32 + c);
                Al[r0 * 64 + c] = (r0 > c) ? b0 * t00[i] * __expf(G0 - Gc0) : 0.f;
                Al[r1 * 64 + c] = b1 * t10[i] * __expf(G1 - Gc0);
                Al[r1 * 64 + 32 + c] = (r0 > c) ? b1 * t11[i] * __expf(G1 - Gc1) : 0.f;
            }
        }
        asm volatile("" ::: "memory");
        {
            bf16x8 qf[2][8];
#pragma unroll
            for (int ti = 0; ti < 2; ++ti)
#pragma unroll
                for (int s = 0; s < 8; ++s) { const int row = 32 * ti + c;
                    qf[ti][s] = (row < nv) ? *(const bf16x8*)(QN + (m0 + row) * DM + kh * 128 + 16 * s + 8 * hh) : (bf16x8){0, 0, 0, 0, 0, 0, 0, 0}; }
            f32x16 t00 = {}, t10 = {}, t11 = {};
#pragma unroll
            for (int s = 0; s < 8; ++s) { t00 = MFMA32(qf[0][s], kf[0][s], t00); t10 = MFMA32(qf[1][s], kf[0][s], t10); t11 = MFMA32(qf[1][s], kf[1][s], t11); }
            bf16* pp = PP + (size_t)it * 4096;
#pragma unroll
            for (int i = 0; i < 16; ++i) {
                const int r0 = crow(i, hh), r1 = 32 + r0;
                const float G0 = __shfl(G, r0), G1 = __shfl(G, r1);
                const float Gc0 = __shfl(G, c), Gc1 = __shfl(G, 32 + c);
                const float v00 = (r0 >= c) ? t00[i] * __expf(G0 - Gc0) : 0.f;
                const float v10 = t10[i] * __expf(G1 - Gc0);
                const float v11 = (r0 >= c) ? t11[i] * __expf(G1 - Gc1) : 0.f;
                pp[r0 * 64 + c] = (bf16)(pk2(v00, 0.f) & 0xffffu); pp[r0 * 64 + 32 + c] = 0;
                pp[r1 * 64 + c] = (bf16)(pk2(v10, 0.f) & 0xffffu); pp[r1 * 64 + 32 + c] = (bf16)(pk2(v11, 0.f) & 0xffffu);
            }
        }
        LDS_WAIT(); asm volatile("" ::: "memory");
        float T[64];
#pragma unroll
        for (int i = 0; i < 64; ++i) {
            float a = (lane == i) ? 1.0f : 0.f;
#pragma unroll
            for (int j = 0; j < i; ++j) a -= Al[i * 64 + j] * T[j];
            T[i] = a;
            asm volatile("" ::: "memory");
        }
        bf16* tp = TP + (size_t)it * 4096;
#pragma unroll
        for (int i = 0; i < 64; ++i) tp[i * 64 + lane] = (bf16)(pk2(T[i] * bt, 0.f) & 0xffffu);
        EG[(size_t)it * 64 + lane] = __expf(G); DL[(size_t)it * 64 + lane] = __expf(Glast - G);
        if (lane == 0) GL[it] = __expf(Glast);
        LDS_WAIT(); asm volatile("" ::: "memory");
    }
}
constexpr int SC_K = 0, SC_KDT = 17408, SC_Q = 35840, SC_RT = 53248, SC_TP = 71680, SC_P = 80896, SC_ST = 90112, SC_UT = 124928, SC_EG = 143360, SC_DL = 143616, SC_OS = SC_Q;
constexpr int LDK = 272, LDT = 144;
DI f32x16 mma_rows(f32x16 acc, const LAS unsigned char* arow, const LAS unsigned char* brow, int ksteps) {
    for (int s = 0; s < ksteps; ++s) acc = MFMA32(*(const LAS bf16x8*)(arow + 32 * s), *(const LAS bf16x8*)(brow + 32 * s), acc);
    return acc;
}
DI void scan_chain(Frame& F, const bool samp, const int b, const int h) {
    const int tid = F.tid, w = F.wave, lane = F.lane, c = lane & 31, hh = lane >> 5;
    LAS unsigned char* lds = F.lds;
    const bf16* QN = (const bf16*)(F.ws + WS_QN); const bf16* KN = (const bf16*)(F.ws + WS_KN); const bf16* VV = (const bf16*)(F.ws + WS_VV);
    const bf16* TP = (const bf16*)(F.ws + WS_TP); const bf16* PP = (const bf16*)(F.ws + WS_PP); const bf16* Z = (const bf16*)(F.ws + WS_Z);
    const float* EG = (const float*)(F.ws + WS_EG); const float* DL = (const float*)(F.ws + WS_DL); const float* GL = (const float*)(F.ws + WS_GL);
    bf16* ON = (bf16*)(F.out + O_PK);
    const int nsteps = samp ? 1 : 128, nv = samp ? 16 : 64, kh = h >> 1;
    const int dvt = w & 3, dk0 = (w >> 2) * 2;
    const int tt = w & 1, dt = w >> 1;
    f32x16 S[2];
#pragma unroll
    for (int q = 0; q < 2; ++q)
#pragma unroll
        for (int i = 0; i < 16; ++i) S[q][i] = samp ? F.in[I_SGDN][((size_t)(b * 32 + h) * 128 + 32 * (dk0 + q) + crow(i, hh)) * 128 + 32 * dvt + c] : 0.f;
    __syncthreads();
#define WRITE_ST() do { _Pragma("unroll") for (int q = 0; q < 2; ++q) _Pragma("unroll") for (int g4 = 0; g4 < 4; ++g4) { v2u pw; pw.x = pk2(S[q][4 * g4], S[q][4 * g4 + 1]); pw.y = pk2(S[q][4 * g4 + 2], S[q][4 * g4 + 3]); \
        *(LAS v2u*)(lds + SC_ST + (32 * dvt + c) * LDK + (32 * (dk0 + q) + 8 * g4 + 4 * hh) * 2) = pw; } } while (0)
    WRITE_ST();
    for (int n = 0; n < nsteps; ++n) {
        const int item = samp ? NITEM_P + b * 32 + h : (b * 128 + n) * 32 + h;
        const size_t m0 = samp ? (size_t)MP + b * 16 : (size_t)b * SEQ + (size_t)n * 64;
#pragma unroll
        for (int p2 = 0; p2 < 2; ++p2) { const int p = tid + 512 * p2, row = p >> 4, cc = p & 15;
            v4u kv = {0u, 0u, 0u, 0u}, qv = {0u, 0u, 0u, 0u}; float dl = 0.f;
            if (row < nv) { kv = *(const v4u*)(KN + (m0 + row) * DM + kh * 128 + cc * 8); qv = *(const v4u*)(QN + (m0 + row) * DM + kh * 128 + cc * 8); dl = DL[(size_t)item * 64 + row]; }
            *(LAS v4u*)(lds + SC_K + row * LDK + cc * 16) = kv; *(LAS v4u*)(lds + SC_Q + row * LDK + cc * 16) = qv;
            float kf[8]; unpack8(kv, kf);
#pragma unroll
            for (int e = 0; e < 8; ++e) *(LAS bf16*)(lds + SC_KDT + (cc * 8 + e) * LDT + row * 2) = (bf16)(pk2(kf[e] * dl, 0.f) & 0xffffu); }
        { const int row = tid >> 3, cc = tid & 7;
          *(LAS v4u*)(lds + SC_TP + row * LDT + cc * 16) = *(const v4u*)(TP + (size_t)item * 4096 + row * 64 + cc * 8);
          *(LAS v4u*)(lds + SC_P + row * LDT + cc * 16) = *(const v4u*)(PP + (size_t)item * 4096 + row * 64 + cc * 8); }
        if (tid < 64) *(LAS float*)(lds + SC_EG + tid * 4) = EG[(size_t)item * 64 + tid];
        const float gl = GL[item];
        __syncthreads();
        f32x16 ks = {}, qs = {};
        ks = mma_rows(ks, lds + SC_K + (32 * tt + c) * LDK + 16 * hh, lds + SC_ST + (32 * dt + c) * LDK + 16 * hh, 8);
        qs = mma_rows(qs, lds + SC_Q + (32 * tt + c) * LDK + 16 * hh, lds + SC_ST + (32 * dt + c) * LDK + 16 * hh, 8);
        float eg[16];
#pragma unroll
        for (int i = 0; i < 16; ++i) eg[i] = *(const LAS float*)(lds + SC_EG + (32 * tt + crow(i, hh)) * 4);
#pragma unroll
        for (int g4 = 0; g4 < 4; ++g4) { float r[4];
#pragma unroll
            for (int j = 0; j < 4; ++j) { const int i = 4 * g4 + j, tok = 32 * tt + crow(i, hh);
                const float vv = (tok < nv) ? bf2f(VV[(m0 + tok) * VW + h * 128 + 32 * dt + c]) : 0.f; r[j] = vv - eg[i] * ks[i]; }
            v2u pw; pw.x = pk2(r[0], r[1]); pw.y = pk2(r[2], r[3]);
            *(LAS v2u*)(lds + SC_RT + (32 * dt + c) * LDT + (32 * tt + 8 * g4 + 4 * hh) * 2) = pw; }
        __syncthreads();
        f32x16 u = {};
        u = mma_rows(u, lds + SC_TP + (32 * tt + c) * LDT + 16 * hh, lds + SC_RT + (32 * dt + c) * LDT + 16 * hh, 4);
#pragma unroll
        for (int g4 = 0; g4 < 4; ++g4) { v2u pw; pw.x = pk2(u[4 * g4], u[4 * g4 + 1]); pw.y = pk2(u[4 * g4 + 2], u[4 * g4 + 3]);
            *(LAS v2u*)(lds + SC_UT + (32 * dt + c) * LDT + (32 * tt + 8 * g4 + 4 * hh) * 2) = pw; }
        __syncthreads();
        f32x16 pu = {};
        pu = mma_rows(pu, lds + SC_P + (32 * tt + c) * LDT + 16 * hh, lds + SC_UT + (32 * dt + c) * LDT + 16 * hh, 4);
#pragma unroll
        for (int i = 0; i < 16; ++i) *(LAS float*)(lds + SC_OS + ((32 * tt + crow(i, hh)) * 132 + 32 * dt + c) * 4) = eg[i] * qs[i] + pu[i];
#pragma unroll
        for (int q = 0; q < 2; ++q) {
#pragma unroll
            for (int i = 0; i < 16; ++i) S[q][i] *= gl;
            S[q] = mma_rows(S[q], lds + SC_KDT + (32 * (dk0 + q) + c) * LDT + 16 * hh, lds + SC_UT + (32 * dvt + c) * LDT + 16 * hh, 4);
        }
        WRITE_ST();
        __syncthreads();
        { const int tok = tid >> 3, j8 = tid & 7; float ov[16]; float ss = 0.f;
#pragma unroll
          for (int e4 = 0; e4 < 4; ++e4) { const f32x4 x = *(const LAS f32x4*)(lds + SC_OS + (tok * 132 + j8 * 16 + e4 * 4) * 4); ov[4 * e4] = x[0]; ov[4 * e4 + 1] = x[1]; ov[4 * e4 + 2] = x[2]; ov[4 * e4 + 3] = x[3];
              ss += (x[0] * x[0] + x[1] * x[1]) + (x[2] * x[2] + x[3] * x[3]); }
          ss += __shfl_xor(ss, 1); ss += __shfl_xor(ss, 2); ss += __shfl_xor(ss, 4);
          const float rstd = rsqrtf(ss * (1.0f / 128.0f) + 1e-6f);
          if (tok < nv) { const size_t zo = (m0 + tok) * VW + h * 128 + j8 * 16; float zf[16];
              unpack8(*(const v4u*)(Z + zo), *(float(*)[8])&zf[0]); unpack8(*(const v4u*)(Z + zo + 8), *(float(*)[8])&zf[8]);
              float res[16];
#pragma unroll
              for (int e = 0; e < 16; ++e) res[e] = ov[e] * rstd * F.in[I_AONORM][j8 * 16 + e] * siluf(zf[e]);
              *(v4u*)(ON + zo) = pack8(*(float(*)[8])&res[0]); *(v4u*)(ON + zo + 8) = pack8(*(float(*)[8])&res[8]); } }
        __syncthreads();
    }
    float* so = F.out + (samp ? O_SGDN : O_PGDN) + (size_t)(b * 32 + h) * 16384;
#pragma unroll
    for (int q = 0; q < 2; ++q)
#pragma unroll
        for (int i = 0; i < 16; ++i) so[(32 * (dk0 + q) + crow(i, hh)) * 128 + 32 * dvt + c] = S[q][i];
#undef WRITE_ST
}
DI void p_scan(Frame& F) {
    const int nW = F.G, bx = blockIdx.x;
    for (int ch = bx; ch < NB * 32; ch += nW) scan_chain(F, false, ch >> 5, ch & 31);
    int start, stride;
    if (nW > NB * 32) { start = bx - NB * 32; stride = nW - NB * 32; } else { start = bx; stride = nW; }
    if (start >= 0) for (int ch = start; ch < DECB * 32; ch += stride) scan_chain(F, true, ch >> 5, ch & 31);
}
DI void p_ffnconv(Frame& F, const int layer) {
    const int gw = F.vcu * NWAVES + F.wave, NGW = F.G * NWAVES, lane = F.lane;
    const bf16* UP = (const bf16*)(F.ws + WS_UP); bf16* ACT = (bf16*)(F.ws + WS_ACT);
    const float* wconv = F.in[I_FWCONV] + (size_t)layer * 3 * UPW; const float* bconv = F.in[I_FBCONV] + (size_t)layer * UPW;
    constexpr int NTB = MP / 16 + DECB, NCC = DFF / 512;
    for (int it = gw; it < NTB * NCC; it += NGW) {
        const int tb = it / NCC, cc = it - tb * NCC, c0 = cc * 512 + lane * 8;
        const bool samp = tb >= MP / 16; const int b = samp ? tb - MP / 16 : tb >> 9; const int t0 = samp ? 0 : (tb & 511) * 16;
        const size_t mbase = samp ? (size_t)MP + b * 16 : (size_t)b * SEQ; const int L = samp ? DECS : SEQ;
        float wg[3][8], wv[3][8], bg[8], bv[8];
#pragma unroll
        for (int i = 0; i < 3; ++i)
#pragma unroll
            for (int e = 0; e < 8; ++e) { wg[i][e] = wconv[i * UPW + c0 + e]; wv[i][e] = wconv[i * UPW + DFF + c0 + e]; }
#pragma unroll
        for (int e = 0; e < 8; ++e) { bg[e] = bconv[c0 + e]; bv[e] = bconv[DFF + c0 + e]; }
        float hg[2][8], hv[2][8];
#pragma unroll
        for (int j = 0; j < 2; ++j) { const int t = t0 - 2 + j;
            if (t >= 0) { unpack8(*(const v4u*)(UP + (mbase + t) * UPW + c0), hg[j]); unpack8(*(const v4u*)(UP + (mbase + t) * UPW + DFF + c0), hv[j]); }
            else if (samp) { const float* sp = F.in[I_SFC] + ((size_t)(layer * DECB + b) * 2 + (t + 2)) * UPW + c0;
#pragma unroll
                for (int e = 0; e < 8; ++e) { hg[j][e] = sp[e]; hv[j][e] = sp[DFF + e]; } }
            else {
#pragma unroll
                for (int e = 0; e < 8; ++e) { hg[j][e] = 0.f; hv[j][e] = 0.f; } } }
#pragma unroll 4
        for (int tt = 0; tt < 16; ++tt) {
            const int t = t0 + tt; const size_t m = mbase + t;
            float cg[8], cv[8]; unpack8(*(const v4u*)(UP + m * UPW + c0), cg); unpack8(*(const v4u*)(UP + m * UPW + DFF + c0), cv);
            float y[8];
#pragma unroll
            for (int e = 0; e < 8; ++e) { const float g = hg[0][e] * wg[0][e] + hg[1][e] * wg[1][e] + cg[e] * wg[2][e] + bg[e];
                const float v = hv[0][e] * wv[0][e] + hv[1][e] * wv[1][e] + cv[e] * wv[2][e] + bv[e]; y[e] = siluf(g) * v; }
            *(v4u*)(ACT + m * DFF + c0) = pack8(y);
            if (t >= L - 2) {
                float* so = F.out + (samp ? O_SFC + ((size_t)(layer * DECB + b) * 2 + (t - (L - 2))) * UPW : O_PFC + ((size_t)(layer * NB + b) * 2 + (t - (L - 2))) * UPW) + c0;
#pragma unroll
                for (int e = 0; e < 8; ++e) { so[e] = cg[e]; so[DFF + e] = cv[e]; } }
#pragma unroll
            for (int e = 0; e < 8; ++e) { hg[0][e] = hg[1][e]; hg[1][e] = cg[e]; hv[0][e] = hv[1][e]; hv[1][e] = cv[e]; }
        }
    }
}
DI void p_final(Frame& F) {
    const int gw = F.vcu * NWAVES + F.wave, NGW = F.G * NWAVES, lane = F.lane;
    const float* ssq = (const float*)(F.ws + WS_SSQ + 4 * SSQ_STRIDE); const float* gain = F.in[I_FINAL];
    for (int m = gw; m < M; m += NGW) {
        float s = (lane < 32) ? ssq[(size_t)m * 32 + lane] : 0.f; s = wave_sum(s);
        const float rstd = rsqrtf(s * (1.0f / 2048.0f) + 1e-6f);
        f32x4* y4 = (f32x4*)(F.out + (size_t)m * DM) + lane; const f32x4* g4 = (const f32x4*)gain + lane;
#pragma unroll
        for (int j = 0; j < 8; ++j) { const f32x4 v = y4[64 * j]; y4[64 * j] = v * rstd * g4[64 * j]; }
    }
}
constexpr int AT_K0 = 0, AT_K1 = 17408, AT_VT = 34816, AT_BT = 71680;
constexpr float ATT_C = 0.08838834764831845f * 1.4426950408889634f;
constexpr float LAM_INIT = 0.35550906759718507f;
struct AttnUnit { int samp, b, h, nq, qpos0, nkeys; size_t mq0; };
DI int t5_bucket(int rel) { const int n = rel < 0 ? -rel : rel; int v; if (n < 8) v = n; else { v = 2 + (31 - __builtin_clz((unsigned)(n * n))); v = v > 15 ? 15 : v; } return (rel > 0 ? 16 : 0) + v; }
DI void attn_stage(Frame& F, const AttnUnit& U, const int kt, const bool withV, const int dvh) {
    int tid = F.tid; asm volatile("" : "+v"(tid));
    LAS unsigned char* lds = F.lds;
    const bf16* KB = (const bf16*)(F.ws + WS_KB); const bf16* VB = (const bf16*)(F.ws + WS_VB);
#pragma unroll
    for (int p4 = 0; p4 < 4; ++p4) {
        const int p = tid + 512 * p4, mm = p >> 10, key = (p >> 4) & 63, cc = p & 15, kg = kt * 64 + key;
        v4u kv = {0u, 0u, 0u, 0u};
        if (kg < U.nkeys) {
            if (!U.samp) kv = *(const v4u*)(KB + ((size_t)U.b * SEQ + kg) * DM + (2 * U.h + mm) * 128 + cc * 8);
            else if (kg >= PAST) kv = *(const v4u*)(KB + ((size_t)MP + U.b * 16 + (kg - PAST)) * DM + (2 * U.h + mm) * 128 + cc * 8);
            else { const float* sp = F.in[I_CK] + (((size_t)U.b * PAST + kg) * 16 + 2 * U.h + mm) * 128 + cc * 8; const f32x4 a = *(const f32x4*)sp, bq = *(const f32x4*)(sp + 4);
                kv.x = pk2(a[0], a[1]); kv.y = pk2(a[2], a[3]); kv.z = pk2(bq[0], bq[1]); kv.w = pk2(bq[2], bq[3]); }
        }
        *(LAS v4u*)(lds + (mm ? AT_K1 : AT_K0) + key * LDK + cc * 16) = kv;
    }
    if (withV) {
#pragma unroll
        for (int p4 = 0; p4 < 2; ++p4) {
            const int p = tid + 512 * p4, key = p & 63, cc = p >> 6, kg = kt * 64 + key, dv0 = dvh * 128 + cc * 8;
            float vf[8];
#pragma unroll
            for (int e = 0; e < 8; ++e) vf[e] = 0.f;
            if (kg < U.nkeys) {
                if (!U.samp) unpack8(*(const v4u*)(VB + ((size_t)U.b * SEQ + kg) * DM + U.h * 256 + dv0), vf);
                else if (kg >= PAST) unpack8(*(const v4u*)(VB + ((size_t)MP + U.b * 16 + (kg - PAST)) * DM + U.h * 256 + dv0), vf);
                else { const float* sp = F.in[I_CV] + (((size_t)U.b * PAST + kg) * 8 + U.h) * 256 + dv0; const f32x4 a = *(const f32x4*)sp, bq = *(const f32x4*)(sp + 4);
                    vf[0] = a[0]; vf[1] = a[1]; vf[2] = a[2]; vf[3] = a[3]; vf[4] = bq[0]; vf[5] = bq[1]; vf[6] = bq[2]; vf[7] = bq[3]; }
            }
#pragma unroll
            for (int e = 0; e < 8; ++e) *(LAS bf16*)(lds + AT_VT + (cc * 8 + e) * LDT + key * 2) = (bf16)(pk2(vf[e], 0.f) & 0xffffu);
        }
    }
}
DI void attn_scores1(Frame& F, const AttnUnit& U, const bf16x8 (&qfm)[8], const int koff, const int kt, const int half, const int qpos_lane, const bool far, f32x16& t1, const int c, const int hh) {
    LAS unsigned char* lds = F.lds;
    f32x16 a1 = {};
#pragma unroll
    for (int s = 0; s < 8; ++s) a1 = MFMA32(*(const LAS bf16x8*)(lds + koff + (32 * half + c) * LDK + 32 * s + 16 * hh), qfm[s], a1);
    const LAS float* bt = (const LAS float*)(lds + AT_BT);
    if (far) { const float bc = bt[0];
#pragma unroll
        for (int i = 0; i < 16; ++i) t1[i] = a1[i] * ATT_C + bc;
    } else {
#pragma unroll
        for (int i = 0; i < 16; ++i) { const int kg = kt * 64 + 32 * half + crow(i, hh); int rel = kg - qpos_lane; rel = rel < -256 ? -256 : rel; rel = rel > 255 ? 255 : rel;
            const float bc = bt[rel + 256]; t1[i] = (kg < U.nkeys) ? a1[i] * ATT_C + bc : -1e30f; }
    }
}
DI void attn_unit(Frame& F, const AttnUnit& U, const float lam) {
    const int tid = F.tid, w = F.wave, lane = F.lane, c = lane & 31, hh = lane >> 5;
    LAS unsigned char* lds = F.lds;
    const bf16* QB = (const bf16*)(F.ws + WS_QB); bf16* ATT = (bf16*)(F.ws + WS_ATT);
    __syncthreads();
    { const int rel = tid - 256; *(LAS float*)(lds + AT_BT + tid * 4) = F.in[I_RELB][t5_bucket(rel) * 8 + U.h] * 1.4426950408889634f; }
    const bool active = 32 * w < U.nq;
    const int qrow = 32 * w + c, qpos_lane = U.qpos0 + qrow, qchunk = (U.qpos0 + 32 * w) >> 6;
    bf16x8 qf[2][8];
#pragma unroll
    for (int mm = 0; mm < 2; ++mm)
#pragma unroll
        for (int s = 0; s < 8; ++s) qf[mm][s] = (qrow < U.nq) ? *(const bf16x8*)(QB + (U.mq0 + qrow) * DM + (2 * U.h + mm) * 128 + 16 * s + 8 * hh) : (bf16x8){0, 0, 0, 0, 0, 0, 0, 0};
    const int ntiles = (U.nkeys + 63) >> 6;
    float m1 = -1e30f, m2 = -1e30f, l1 = 0.f, l2 = 0.f;
    for (int kt = 0; kt < ntiles; ++kt) {
        __syncthreads();
        attn_stage(F, U, kt, false, 0);
        __syncthreads();
        if (active && kt <= qchunk) {
            const bool far = (kt * 64 + 63 - (U.qpos0 + 32 * w)) <= -91 && (kt * 64 + 63 < U.nkeys);
            int lv = lane; asm volatile("" : "+v"(lv)); const int c = lv & 31, hh = lv >> 5; const int qpos_lane = U.qpos0 + 32 * w + c;
#pragma unroll
            for (int half = 0; half < 2; ++half) {
                { f32x16 t1; attn_scores1(F, U, qf[0], AT_K0, kt, half, qpos_lane, far, t1, c, hh);
                  float x1 = t1[0];
#pragma unroll
                  for (int i = 1; i < 16; ++i) x1 = fmaxf(x1, t1[i]);
                  x1 = fmaxf(x1, __shfl_xor(x1, 32)); const float n1 = fmaxf(m1, x1); float s1 = 0.f;
#pragma unroll
                  for (int i = 0; i < 16; ++i) s1 += __builtin_amdgcn_exp2f(t1[i] - n1);
                  l1 = l1 * __builtin_amdgcn_exp2f(m1 - n1) + s1; m1 = n1; }
                { f32x16 t2; attn_scores1(F, U, qf[1], AT_K1, kt, half, qpos_lane, far, t2, c, hh);
                  float x2 = t2[0];
#pragma unroll
                  for (int i = 1; i < 16; ++i) x2 = fmaxf(x2, t2[i]);
                  x2 = fmaxf(x2, __shfl_xor(x2, 32)); const float n2 = fmaxf(m2, x2); float s2 = 0.f;
#pragma unroll
                  for (int i = 0; i < 16; ++i) s2 += __builtin_amdgcn_exp2f(t2[i] - n2);
                  l2 = l2 * __builtin_amdgcn_exp2f(m2 - n2) + s2; m2 = n2; }
            }
        }
    }
    l1 += __shfl_xor(l1, 32); l2 += __shfl_xor(l2, 32);
    const float il1 = 1.0f / l1, il2 = lam / l2;
    f32x16 O[4]; float sc[16];
    LAS float* ssl = (LAS float*)(lds + AT_BT + 2048) + w * 32;
    bf16* scr = (bf16*)(F.ws + WS_ATT);
#pragma unroll 1
    for (int dvh = 0; dvh < 2; ++dvh) {
#pragma unroll
        for (int d = 0; d < 4; ++d) O[d] = (f32x16){};
        for (int kt = 0; kt < ntiles; ++kt) {
            __syncthreads();
            attn_stage(F, U, kt, true, dvh);
            __syncthreads();
            if (active && kt <= qchunk) {
                const bool far = (kt * 64 + 63 - (U.qpos0 + 32 * w)) <= -91 && (kt * 64 + 63 < U.nkeys);
                int lv = lane; asm volatile("" : "+v"(lv)); const int c = lv & 31, hh = lv >> 5; const int qpos_lane = U.qpos0 + 32 * w + c;
#pragma unroll
                for (int half = 0; half < 2; ++half) {
                    float wv[16];
                    { f32x16 t1; attn_scores1(F, U, qf[0], AT_K0, kt, half, qpos_lane, far, t1, c, hh);
#pragma unroll
                      for (int i = 0; i < 16; ++i) wv[i] = __builtin_amdgcn_exp2f(t1[i] - m1) * il1; }
                    { f32x16 t2; attn_scores1(F, U, qf[1], AT_K1, kt, half, qpos_lane, far, t2, c, hh);
#pragma unroll
                      for (int i = 0; i < 16; ++i) wv[i] -= __builtin_amdgcn_exp2f(t2[i] - m2) * il2; }
#pragma unroll
                    for (int s2 = 0; s2 < 2; ++s2) {
                        v4u pw; pw.x = pk2(wv[8 * s2], wv[8 * s2 + 1]); pw.y = pk2(wv[8 * s2 + 2], wv[8 * s2 + 3]); pw.z = pk2(wv[8 * s2 + 4], wv[8 * s2 + 5]); pw.w = pk2(wv[8 * s2 + 6], wv[8 * s2 + 7]);
                        const bf16x8 wfrag = __builtin_bit_cast(bf16x8, pw);
                        const int key0 = 32 * half + 16 * s2 + 4 * hh;
#pragma unroll
                        for (int d = 0; d < 4; ++d) {
                            const LAS unsigned char* vp = lds + AT_VT + (32 * d + c) * LDT + key0 * 2;
                            const v2u lo = *(const LAS v2u*)vp, hi = *(const LAS v2u*)(vp + 16);
                            v4u vv; vv.x = lo.x; vv.y = lo.y; vv.z = hi.x; vv.w = hi.y;
                            O[d] = MFMA32(wfrag, __builtin_bit_cast(bf16x8, vv), O[d]);
                        }
                    }
                }
            }
        }
        if (active) {
#pragma unroll
            for (int i = 0; i < 16; ++i) { float a = 0.f;
#pragma unroll
                for (int d = 0; d < 4; ++d) a += O[d][i] * O[d][i];
                a += __shfl_xor(a, 1); a += __shfl_xor(a, 2); a += __shfl_xor(a, 4); a += __shfl_xor(a, 8); a += __shfl_xor(a, 16);
                if (dvh == 0) { if (c == 0) ssl[crow(i, hh)] = a; }
                else { LDS_WAIT(); sc[i] = rsqrtf((a + ssl[crow(i, hh)]) * (1.0f / 256.0f) + 1e-5f) * (1.0f - LAM_INIT); } }
            if (dvh == 0) {
                int lv = lane; asm volatile("" : "+v"(lv)); const int c = lv & 31, hh = lv >> 5;
#pragma unroll
                for (int d = 0; d < 4; ++d)
#pragma unroll
                    for (int i = 0; i < 16; ++i) { const int r = 32 * w + crow(i, hh);
                        if (r < U.nq) scr[(U.mq0 + r) * DM + U.h * 256 + 32 * d + c] = (bf16)(pk2(O[d][i], 0.f) & 0xffffu); }
            }
        }
    }
    if (active) {
        int lv = lane; asm volatile("" : "+v"(lv)); const int c = lv & 31, hh = lv >> 5;
#pragma unroll
        for (int d = 0; d < 4; ++d) { const float g0 = F.in[I_SUBN][32 * d + c], g1 = F.in[I_SUBN][128 + 32 * d + c];
#pragma unroll
            for (int i = 0; i < 16; ++i) { const int r = 32 * w + crow(i, hh);
                if (r < U.nq) { bf16* op = ATT + (U.mq0 + r) * DM + U.h * 256 + 32 * d + c;
                    const float o0 = bf2f(op[0]);
                    op[0] = (bf16)(pk2(o0 * sc[i] * g0, 0.f) & 0xffffu);
                    op[128] = (bf16)(pk2(O[d][i] * sc[i] * g1, 0.f) & 0xffffu); } } }
    }
}
DI void p_attn(Frame& F) {
    float d1 = 0.f, d2 = 0.f;
    for (int i = 0; i < 128; ++i) { d1 += F.in[I_LQ1][i] * F.in[I_LK1][i]; d2 += F.in[I_LQ2][i] * F.in[I_LK2][i]; }
    const float lam = __expf(d1) - __expf(d2) + LAM_INIT;
    const int nW = F.G, bx = blockIdx.x;
    for (int p = bx; p < 256 + DECB * 8; p += nW) {
        if (p < 256) { const int b = p >> 7, h = (p >> 4) & 7, j = p & 15;
#pragma unroll 1
            for (int k2 = 0; k2 < 2; ++k2) { const int qb = k2 ? 31 - j : j;
                AttnUnit U; U.samp = 0; U.b = b; U.h = h; U.nq = 256; U.qpos0 = qb * 256; U.nkeys = (qb + 1) * 256; U.mq0 = (size_t)b * SEQ + (size_t)qb * 256;
                attn_unit(F, U, lam); }
        } else { const int r = p - 256; AttnUnit U; U.samp = 1; U.b = r >> 3; U.h = r & 7; U.nq = DECS; U.qpos0 = PAST; U.nkeys = PAST + DECS; U.mq0 = (size_t)MP + (size_t)(r >> 3) * 16;
            attn_unit(F, U, lam); }
    }
}
#ifndef N_LAUNCH_MODE
#define N_LAUNCH_MODE 1
#endif
constexpr int N_PHASES = 16;
struct Args { const float* in[N_IN]; float* out; unsigned char* ws; int ph_lo, ph_hi; };
static_assert(sizeof(Args) == (N_IN + 2) * 8 + 8, "Args has no padding");
__global__ void __launch_bounds__(NWAVES * 64, 2) fwd(Args args) {
    extern __shared__ __attribute__((aligned(16))) unsigned char lds_raw[];
    Frame F;
    F.lds = (LAS unsigned char*)lds_raw;
    F.MISC = (volatile LAS unsigned*)(F.lds + LDSCTL_OFF);
    F.tid = threadIdx.x; F.lane = F.tid & 63; F.wave = __builtin_amdgcn_readfirstlane(F.tid >> 6);
    F.G = gridDim.x; { const int bx = blockIdx.x; F.vcu = (F.G % 8 == 0) ? (bx % 8) * (F.G / 8) + bx / 8 : bx; }
    F.in = args.in; F.out = args.out; F.ws = args.ws; F.ctl = (unsigned*)(args.ws + WS_CTL);
    for (int u = F.tid; u < (LDS_BYTES - LDSCTL_OFF) / 4; u += NWAVES * 64) ((LAS unsigned*)(F.lds + LDSCTL_OFF))[u] = 0u;
    __syncthreads();
    XcdBarrier bar; bar.bar = F.ctl + CW_BAR; bar.x = 0; bar.st = nullptr;
    if (N_LAUNCH_MODE == 1) bar = xcd_barrier_post(F.ctl + CW_BAR, F.MISC + 8);
    const int lo = args.ph_lo, hi = args.ph_hi;
#ifndef PHASE_MASK
#define PHASE_MASK 0xffff
#endif
#define IN(k) (((PHASE_MASK >> (k)) & 1) && lo <= (k) && (k) < hi)
#define SEAM(k) do { if (IN(k) && IN((k) + 1)) xcd_barrier(bar); } while (0)
    unsigned char* ws = args.ws;
    PG8_LAS unsigned char* ring = (PG8_LAS unsigned char*)F.lds;
    bf16* HB = (bf16*)(ws + WS_HB);
    float* H = args.out;
#define SSQP(i) ((float*)(ws + WS_SSQ + (size_t)(i) * SSQ_STRIDE))

    if (IN(0)) { p0_prologue(F); } SEAM(0);
    if (IN(1)) {
        pg8::Gemm g{HB, (const bf16*)(ws + WS_WIN), M, INWP, DM}; pg8::StaticOrder S; S.init(M, INWP, F.G, (int)blockIdx.x);
        pg8::EpiBf E{SSQP(0), (bf16*)(ws + WS_QKV), QKVW, QKVW, (bf16*)(ws + WS_Z), VW, VW, (float*)(ws + WS_BA), 64, 64};
        pg8::gemm_phase<pg8::EpiBf, pg8::StaticOrder, PG8_ALIGN, PG8_SP2>(ring, g, S, E);
    } SEAM(1);
    if (IN(2)) { p_gdnconv(F); } SEAM(2);
    if (IN(3)) { p_prep(F); } SEAM(3);
    if (IN(4)) { p_scan(F); } SEAM(4);
    if (IN(5)) {
        pg8::Gemm g{(const bf16*)(args.out + O_PK), (const bf16*)(ws + WS_WOUT), M, DM, VW}; pg8::StaticOrder S; S.init(M, DM, F.G, (int)blockIdx.x);
        pg8::EpiRes E{args.in[I_XP], args.in[I_XS] - (size_t)MP * DM, H, HB, SSQP(1)};
        pg8::gemm_phase<pg8::EpiRes, pg8::StaticOrder, PG8_ALIGN, PG8_SP2>(ring, g, S, E);
    } SEAM(5);
    if (IN(6)) {
        pg8::Gemm g{HB, (const bf16*)(ws + WS_WUP0), M, UPW, DM}; pg8::StaticOrder S; S.init(M, UPW, F.G, (int)blockIdx.x);
        pg8::EpiBf E{SSQP(1), (bf16*)(ws + WS_UP), UPW, UPW, nullptr, 0, 0, nullptr, 0, 0};
        pg8::gemm_phase<pg8::EpiBf, pg8::StaticOrder, PG8_ALIGN, PG8_SP2>(ring, g, S, E);
    } SEAM(6);
    if (IN(7)) { p_ffnconv(F, 0); } SEAM(7);
    if (IN(8)) {
        pg8::Gemm g{(const bf16*)(ws + WS_ACT), (const bf16*)(ws + WS_WDN0), M, DM, DFF}; pg8::StaticOrder S; S.init(M, DM, F.G, (int)blockIdx.x);
        pg8::EpiRes E{H, H, H, HB, SSQP(2)};
        pg8::gemm_phase<pg8::EpiRes, pg8::StaticOrder, PG8_ALIGN, PG8_SP2>(ring, g, S, E);
    } SEAM(8);
    if (IN(9)) {
        pg8::Gemm g{HB, (const bf16*)(ws + WS_WKVQ), M, 6144, DM}; pg8::StaticOrder S; S.init(M, 6144, F.G, (int)blockIdx.x);
        pg8::EpiKVQ E{SSQP(2), args.out, (bf16*)(ws + WS_KB), (WS_VB - WS_KB) / 2};
        static_assert(WS_QB - WS_VB == WS_VB - WS_KB, "K, V, Q bf16 buffers equally spaced");
        pg8::gemm_phase<pg8::EpiKVQ, pg8::StaticOrder, PG8_ALIGN, PG8_SP2>(ring, g, S, E);
    } SEAM(9);
    if (IN(10)) { p_attn(F); } SEAM(10);
    if (IN(11)) {
        pg8::Gemm g{(const bf16*)(ws + WS_ATT), (const bf16*)(ws + WS_WO), M, DM, DM}; pg8::StaticOrder S; S.init(M, DM, F.G, (int)blockIdx.x);
        pg8::EpiRes E{H, H, H, HB, SSQP(3)};
        pg8::gemm_phase<pg8::EpiRes, pg8::StaticOrder, PG8_ALIGN, PG8_SP2>(ring, g, S, E);
    } SEAM(11);
    if (IN(12)) {
        pg8::Gemm g{HB, (const bf16*)(ws + WS_WUP1), M, UPW, DM}; pg8::StaticOrder S; S.init(M, UPW, F.G, (int)blockIdx.x);
        pg8::EpiBf E{SSQP(3), (bf16*)(ws + WS_UP), UPW, UPW, nullptr, 0, 0, nullptr, 0, 0};
        pg8::gemm_phase<pg8::EpiBf, pg8::StaticOrder, PG8_ALIGN, PG8_SP2>(ring, g, S, E);
    } SEAM(12);
    if (IN(13)) { p_ffnconv(F, 1); } SEAM(13);
    if (IN(14)) {
        pg8::Gemm g{(const bf16*)(ws + WS_ACT), (const bf16*)(ws + WS_WDN1), M, DM, DFF}; pg8::StaticOrder S; S.init(M, DM, F.G, (int)blockIdx.x);
        pg8::EpiRes E{H, H, H, nullptr, SSQP(4)};
        pg8::gemm_phase<pg8::EpiRes, pg8::StaticOrder, PG8_ALIGN, PG8_SP2>(ring, g, S, E);
    } SEAM(14);
    if (IN(15)) { p_final(F); }
#undef IN
#undef SEAM
}

extern "C" void kernel_launch(void* const* d_in, const int* in_sizes, int n_in, void* d_out, int out_size, void* d_ws, size_t ws_size, hipStream_t stream) {
    static int grid = 0;
    if (grid == 0) {
        if (n_in != N_IN || (size_t)out_size != O_END || ws_size < WS_END) { fprintf(stderr, "kernel_launch: shape mismatch: n_in %d out %d ws %zu (need %zu)\n", n_in, out_size, ws_size, (size_t)WS_END); grid = -1; return; }
        int dev = 0, cus = 0;
        if (hipGetDevice(&dev) != hipSuccess || hipDeviceGetAttribute(&cus, hipDeviceAttributeMultiprocessorCount, dev) != hipSuccess) { grid = -1; return; }
        if (hipFuncSetAttribute((const void*)fwd, hipFuncAttributeMaxDynamicSharedMemorySize, LDS_BYTES) != hipSuccess) { fprintf(stderr, "kernel_launch: hipFuncSetAttribute failed\n"); grid = -1; return; }
        int per_cu = 0;
        if (hipOccupancyMaxActiveBlocksPerMultiprocessor(&per_cu, (const void*)fwd, NWAVES * 64, LDS_BYTES) != hipSuccess || per_cu < 1) fprintf(stderr, "kernel_launch: occupancy query reports %d\n", per_cu);
        (void)hipGetLastError();
        grid = cus;
    }
    if (grid < 0) return;
    (void)hipMemsetAsync((char*)d_ws + WS_CTL, 0, CTL_ZERO_BYTES, stream);
    Args a{};
    for (int i = 0; i < N_IN; ++i) a.in[i] = (const float*)d_in[i];
    a.out = (float*)d_out; a.ws = (unsigned char*)d_ws;
    if (N_LAUNCH_MODE == 1) { a.ph_lo = 0; a.ph_hi = N_PHASES; hipLaunchKernelGGL(fwd, dim3(grid), dim3(NWAVES * 64), LDS_BYTES, stream, a); }
    else for (int p = 0; p < N_PHASES; ++p) { a.ph_lo = p; a.ph_hi = p + 1; hipLaunchKernelGGL(fwd, dim3(grid), dim3(NWAVES * 64), LDS_BYTES, stream, a); }
    const hipError_t le = hipPeekAtLastError();
    if (le != hipSuccess) fprintf(stderr, "kernel_launch: launch failed: %s\n", hipGetErrorName(le));
}
```

```cpp
#include <hip/hip_runtime.h>
#include <cstdio>
#include <cstdint>

constexpr int DM = 2048;
constexpr int SEQ = 8192, NB = 2, MP = NB * SEQ;
constexpr int DECB = 16, DECS = 16, MS = DECB * DECS;
constexpr int PAST = 2048;
constexpr int M = MP + MS;
constexpr int QKVW = 8192, VW = 4096, INW = 12352, INWP = 12544;
constexpr int DFF = 5632, UPW = 11264;
constexpr int NITEM_P = NB * 128 * 32, NITEM = NITEM_P + DECB * 32;
constexpr size_t O_Y = 0, O_PGDN = 34078720, O_PGC = 35127296, O_PFC = 35176448, O_PK = 35266560, O_PV = 68820992,
                 O_SGDN = 102375424, O_SGC = 110764032, O_SFC = 111157248, O_SK = 111878144, O_SV = 112402432, O_END = 112926720;
namespace pg8 {
#define PG8_LAS __attribute__((address_space(3)))
typedef unsigned short bf16_t;
typedef short bf16x8 __attribute__((ext_vector_type(8)));
typedef float f32x4 __attribute__((ext_vector_type(4)));
typedef unsigned u32x4 __attribute__((ext_vector_type(4)));
constexpr int BM = 256, BK = 64, HALF = 128, HTB = HALF * BK * 2  , STAGE_BYTES = 8 * HTB, NXCD = 8, WGM = 8;

__host__ __device__ __forceinline__ int lds_byte(int r, int c) { const int st = (r >> 4) * 2 + (c >> 5), rr = r & 15, cc = c & 31, ob = rr * 64 + cc * 2; return st * 1024 + (ob ^ (((ob >> 9) & 1) << 5)); }
__host__ __device__ __forceinline__ void stage_rc(int b, int& R, int& C) { const int st = b / 1024, sb = b % 1024, swz = sb ^ (((sb >> 9) & 1) << 5); R = (st >> 1) * 16 + swz / 64; C = (st & 1) * 32 + (swz % 64) / 2; }
__host__ __device__ __forceinline__ int perm32(int rho) { const int n = rho >> 4, i = rho & 15; return 8 * (i >> 2) + 4 * n + (i & 3); }

struct Unit { int pm, pn; };
struct Gemm { const bf16_t* A; const bf16_t* Bt; int M, N, K; };

struct StaticOrder {
    int nM, nN, nwg, G, c;
    __host__ __device__ void init(int M, int N, int G_, int c_) { nM = M / BM; nN = N / BM; nwg = nM * nN; G = G_; c = c_; }
    __host__ __device__ bool next(int i, Unit& u) const {
        const long L = (long)i * G + c; if (L >= nwg) return false;
        int wgid = (int)L; { const int q = nwg / NXCD, r = nwg % NXCD, xcd = wgid % NXCD, off = wgid / NXCD; wgid = (xcd < r ? xcd * (q + 1) : r * (q + 1) + (xcd - r) * q) + off; }
        const int nig = WGM * nN, gid = wgid / nig, fm = gid * WGM, gsz = (nM - fm) < WGM ? (nM - fm) : WGM;
        u.pm = fm + ((wgid % nig) % gsz); u.pn = (wgid % nig) / gsz; return true;
    }
    __device__ __forceinline__ void a_ready(const Unit&) const {}
    __device__ __forceinline__ void done(const Unit&) const {}
};

typedef float f32x2 __attribute__((ext_vector_type(2)));
typedef __bf16 bf16v2 __attribute__((ext_vector_type(2)));
typedef unsigned u32x2 __attribute__((ext_vector_type(2)));
__device__ __forceinline__ unsigned cvt_pk_bf16(float lo, float hi) { const f32x2 v = {lo, hi}; return __builtin_bit_cast(unsigned, __builtin_convertvector(v, bf16v2)); }

__device__ __forceinline__ void row_rstd(const float* ssq, int row0, int fq, float (&rs)[2][4]) {
#pragma unroll
    for (int ai = 0; ai < 2; ++ai)
#pragma unroll
        for (int m = 0; m < 4; ++m) {
            const float* p = ssq + (size_t)(row0 + ai * HALF + m * 16) * 32 + fq * 8;
            const f32x4 a = *(const f32x4*)p, b = *(const f32x4*)(p + 4);
            float s = ((a[0] + a[1]) + (a[2] + a[3])) + ((b[0] + b[1]) + (b[2] + b[3]));
            s += __shfl_xor(s, 16); s += __shfl_xor(s, 32);
            rs[ai][m] = rsqrtf(s * (1.0f / 2048.0f) + 1e-6f);
        }
}
struct EpiBf {
    static constexpr bool PERM = true, AFTER_DRAIN = false;
    const float* ssq; bf16_t* O0; int ld0, nc0; bf16_t* O1; int ld1, nc1; float* F2; int ld2, nc2;
    __device__ __forceinline__ void operator()(const f32x4 (&acc)[2][2][4][2], const Unit& u, int wr, int wc, int fr, int fq) const {
        const int row0 = u.pm * BM + wr * 64 + fr; const int colt = u.pn * BM;
        float rs[2][4]; row_rstd(ssq, row0, fq, rs);
        if (colt < nc0 + nc1) {
            bf16_t* base; int ld;
            if (colt < nc0) { base = O0 + colt; ld = ld0; } else { base = O1 + (colt - nc0); ld = ld1; }
            const int col0 = wc * 32 + 8 * fq;
#pragma unroll
            for (int ai = 0; ai < 2; ++ai)
#pragma unroll
                for (int m = 0; m < 4; ++m) { bf16_t* rowp = base + (size_t)(row0 + ai * HALF + m * 16) * ld + col0; const float r = rs[ai][m];
#pragma unroll
                    for (int bj = 0; bj < 2; ++bj) { const f32x4 v0 = acc[ai][bj][m][0] * r, v1 = acc[ai][bj][m][1] * r;
                        u32x4 w; w.x = cvt_pk_bf16(v0[0], v0[1]); w.y = cvt_pk_bf16(v0[2], v0[3]); w.z = cvt_pk_bf16(v1[0], v1[1]); w.w = cvt_pk_bf16(v1[2], v1[3]);
                        *(u32x4*)(rowp + bj * HALF) = w; } }
        } else if (colt == nc0 + nc1 && F2 != nullptr && wc * 32 < nc2) {
#pragma unroll
            for (int ai = 0; ai < 2; ++ai)
#pragma unroll
                for (int m = 0; m < 4; ++m) { float* rowp = F2 + (size_t)(row0 + ai * HALF + m * 16) * ld2 + wc * 32 + 8 * fq; const float r = rs[ai][m];
                    *(f32x4*)(rowp) = acc[ai][0][m][0] * r; *(f32x4*)(rowp + 4) = acc[ai][0][m][1] * r; }
        }
    }
};
struct EpiRes {
    static constexpr bool PERM = false, AFTER_DRAIN = false;
    const float* base0; const float* base1; float* out; bf16_t* hb; float* ssq;
    __device__ __forceinline__ void operator()(const f32x4 (&acc)[2][2][4][2], const Unit& u, int wr, int wc, int fr, int fq) const {
        const int row0 = u.pm * BM + wr * 64 + fr, col0 = u.pn * BM + wc * 32 + 4 * fq;
        const float* bs = (u.pm * BM < MP) ? base0 : base1;
#pragma unroll
        for (int ai = 0; ai < 2; ++ai)
#pragma unroll
            for (int m = 0; m < 4; ++m) { const size_t off = (size_t)(row0 + ai * HALF + m * 16) * DM + col0; float ss = 0.f;
#pragma unroll
                for (int bj = 0; bj < 2; ++bj)
#pragma unroll
                    for (int n = 0; n < 2; ++n) { const size_t o2 = off + bj * HALF + n * 16; const f32x4 o = *(const f32x4*)(bs + o2) + acc[ai][bj][m][n];
                        *(f32x4*)(out + o2) = o; ss += (o[0] * o[0] + o[1] * o[1]) + (o[2] * o[2] + o[3] * o[3]);
                        if (hb) { u32x2 w; w.x = cvt_pk_bf16(o[0], o[1]); w.y = cvt_pk_bf16(o[2], o[3]); *(u32x2*)(hb + o2) = w; } }
                ss += __shfl_xor(ss, 16); ss += __shfl_xor(ss, 32);
                if (fq == 0) ssq[(size_t)(row0 + ai * HALF + m * 16) * 32 + u.pn * 4 + wc] = ss; }
    }
};
struct EpiKVQ {
    static constexpr bool PERM = false, AFTER_DRAIN = false;
    const float* ssq; float* dout; bf16_t* KB; size_t kvq_stride; bf16_t* KC; size_t kc_stride;
    __device__ __forceinline__ void operator()(const f32x4 (&acc)[2][2][4][2], const Unit& u, int wr, int wc, int fr, int fq) const {
        const int row0 = u.pm * BM + wr * 64 + fr; const int colt = u.pn * BM, which = colt >> 11, cb = (colt & 2047) + wc * 32 + 4 * fq;
        float rs[2][4]; row_rstd(ssq, row0, fq, rs);
        bf16_t* bb = KB + (size_t)which * kvq_stride;
        float* fo = nullptr;
        if (which < 2) fo = (u.pm * BM < MP) ? dout + O_PK + (size_t)which * (O_PV - O_PK) : dout + O_SK + (size_t)which * (O_SV - O_SK) - (size_t)MP * DM;
#pragma unroll
        for (int ai = 0; ai < 2; ++ai)
#pragma unroll
            for (int m = 0; m < 4; ++m) { const size_t off = (size_t)(row0 + ai * HALF + m * 16) * DM + cb; const float r = rs[ai][m];
#pragma unroll
                for (int bj = 0; bj < 2; ++bj)
#pragma unroll
                    for (int n = 0; n < 2; ++n) { const size_t o2 = off + bj * HALF + n * 16; const f32x4 o = acc[ai][bj][m][n] * r;
                        if (fo) *(f32x4*)(fo + o2) = o;
                        u32x2 w; w.x = cvt_pk_bf16(o[0], o[1]); w.y = cvt_pk_bf16(o[2], o[3]); *(u32x2*)(bb + o2) = w;
                        if (which < 2 && u.pm * BM >= MP) { const int ms = row0 + ai * HALF + m * 16 - MP;
                            *(u32x2*)(KC + (size_t)which * kc_stride + ((size_t)(ms >> 4) * (2048 + 16) + 2048 + (ms & 15)) * DM + cb + bj * HALF + n * 16) = w; } } }
    }
};

template <class Epi, class Sched, bool ALIGN_EPI = false, bool SP2 = false>
__device__ __forceinline__ void gemm_phase(PG8_LAS unsigned char* lds, const Gemm g, const Sched& S, const Epi& E) {
    const int tid = threadIdx.x, wid = __builtin_amdgcn_readfirstlane(tid >> 6), lane = tid & 63, wr = wid >> 2, wc = wid & 3, fr = lane & 15, fq = lane >> 4;
    const int K = g.K, nt = K / BK;
    unsigned voffA[2], voffB[2];
#pragma unroll
    for (int i = 0; i < 2; ++i) { int R, C; stage_rc(tid * 16 + i * 8192, R, C); const int Rb = Epi::PERM ? ((R & ~31) + perm32(R & 31)) : R;
        voffA[i] = (unsigned)(R * K + C) * 2u; voffB[i] = (unsigned)(Rb * K + C) * 2u; }
    const size_t kstep = (size_t)(BK * 2);
    const size_t hstep = (size_t)HALF * K * 2;
    const size_t tstep = 2 * hstep;
    const unsigned ldsw = (unsigned)wid * 1024u;
    const int aoff = lds_byte(wr * 64 + fr, fq * 8), boff = lds_byte(wc * 32 + fr, fq * 8);
#define PG8_SA(b, h) (((b) * 2 + (h)) * HTB)
#define PG8_SB(b, h) ((4 + (b) * 2 + (h)) * HTB)
#define PG8_STAGE(bufoff, gbase, voff) do { _Pragma("unroll") for (int _i = 0; _i < 2; ++_i) \
        __builtin_amdgcn_global_load_lds((const unsigned*)((const char*)(gbase) + (voff)[_i]), (PG8_LAS unsigned*)(lds + (bufoff) + ldsw + _i * 8192), 16, 0, 0); } while (0)
#define PG8_LDA(dst, b, h) do { _Pragma("unroll") for (int m = 0; m < 4; ++m) _Pragma("unroll") for (int k = 0; k < 2; ++k) dst[m][k] = *(const PG8_LAS bf16x8*)(lds + PG8_SA(b, h) + aoff + m * 2048 + k * 1024); } while (0)
#define PG8_LDB(dst, b, h) do { _Pragma("unroll") for (int n = 0; n < 2; ++n) _Pragma("unroll") for (int k = 0; k < 2; ++k) dst[n][k] = *(const PG8_LAS bf16x8*)(lds + PG8_SB(b, h) + boff + n * 2048 + k * 1024); } while (0)
#define PG8_MMA(ai, bj, At, Bt) do { __builtin_amdgcn_s_setprio(1); _Pragma("unroll") for (int m = 0; m < 4; ++m) _Pragma("unroll") for (int n = 0; n < 2; ++n) _Pragma("unroll") for (int k = 0; k < 2; ++k) \
        acc[ai][bj][m][n] = __builtin_amdgcn_mfma_f32_16x16x32_bf16(Bt[n][k], At[m][k], acc[ai][bj][m][n], 0, 0, 0); __builtin_amdgcn_s_setprio(0); } while (0)
#define PG8_WAIT_V(n) asm volatile("s_waitcnt vmcnt(" #n ")" ::: "memory")
#define PG8_WAIT_L(n) asm volatile("s_waitcnt lgkmcnt(" #n ")" ::: "memory")
#define PG8_BAR __builtin_amdgcn_s_barrier()
#define PG8_SCHED __builtin_amdgcn_sched_barrier(0)
    Unit cur, nxt; int ui = 0;
    if (!S.next(0, cur)) return;
    f32x4 acc[2][2][4][2];
#pragma unroll
    for (int a = 0; a < 2; ++a)
#pragma unroll
        for (int b = 0; b < 2; ++b)
#pragma unroll
            for (int m = 0; m < 4; ++m)
#pragma unroll
                for (int n = 0; n < 2; ++n) acc[a][b][m][n] = (f32x4){0.f, 0.f, 0.f, 0.f};
    bf16x8 At[4][2], B0[2][2], B1[2][2];
    const char* cA = (const char*)g.A + (size_t)cur.pm * tstep; const char* cB = (const char*)g.Bt + (size_t)cur.pn * tstep;
    S.a_ready(cur);
    if constexpr (SP2) {
        PG8_STAGE(PG8_SB(0, 0), cB, voffB); PG8_STAGE(PG8_SB(0, 1), cB + hstep, voffB); PG8_STAGE(PG8_SA(0, 0), cA, voffA); PG8_STAGE(PG8_SA(0, 1), cA + hstep, voffA);
        if (wr == 1) PG8_BAR;
        PG8_WAIT_V(2); PG8_BAR;
        PG8_STAGE(PG8_SB(1, 0), cB + kstep, voffB); PG8_STAGE(PG8_SA(1, 0), cA + kstep, voffA); PG8_STAGE(PG8_SB(1, 1), cB + hstep + kstep, voffB);
        PG8_WAIT_V(6); PG8_BAR;
    } else {
        PG8_STAGE(PG8_SB(0, 0), cB, voffB); PG8_STAGE(PG8_SA(0, 0), cA, voffA); PG8_STAGE(PG8_SB(0, 1), cB + hstep, voffB); PG8_STAGE(PG8_SA(0, 1), cA + hstep, voffA);
        if (wr == 1) PG8_BAR;
        PG8_WAIT_V(4); PG8_BAR;
        PG8_STAGE(PG8_SB(1, 0), cB + kstep, voffB); PG8_STAGE(PG8_SA(1, 0), cA + kstep, voffA); PG8_STAGE(PG8_SB(1, 1), cB + hstep + kstep, voffB);
        PG8_WAIT_V(6); PG8_BAR;
    }
    for (;;) {
        const bool has_next = S.next(ui + 1, nxt);
        const char* nA = has_next ? (const char*)g.A + (size_t)nxt.pm * tstep : cA; const char* nB = has_next ? (const char*)g.Bt + (size_t)nxt.pn * tstep : cB;
        for (int t = 0; t < nt; t += 2) {
            const bool last = (t == nt - 2);
            const char* a1 = cA + (size_t)(t + 1) * kstep;
            const char* a2 = last ? nA : cA + (size_t)(t + 2) * kstep; const char* b2 = last ? nB : cB + (size_t)(t + 2) * kstep;
            const char* a3 = a2 + kstep; const char* b3 = b2 + kstep;
            if (last && has_next) S.a_ready(nxt);
            if constexpr (SP2) {
            PG8_LDB(B0, 0, 0); PG8_LDB(B1, 0, 1); PG8_SCHED; PG8_LDA(At, 0, 0); PG8_STAGE(PG8_SA(1, 1), a1 + hstep, voffA);
            PG8_WAIT_V(8); PG8_WAIT_L(0); PG8_BAR; PG8_MMA(0, 0, At, B0); PG8_MMA(0, 1, At, B1); PG8_BAR; PG8_SCHED;
            PG8_LDA(At, 0, 1); PG8_STAGE(PG8_SB(0, 0), b2, voffB); PG8_STAGE(PG8_SB(0, 1), b2 + hstep, voffB); PG8_STAGE(PG8_SA(0, 0), a2, voffA);
            PG8_WAIT_V(8); PG8_WAIT_L(0); PG8_BAR; PG8_MMA(1, 0, At, B0); PG8_MMA(1, 1, At, B1); PG8_BAR; PG8_SCHED;
            PG8_LDB(B0, 1, 0); PG8_LDB(B1, 1, 1); PG8_SCHED; PG8_LDA(At, 1, 0); PG8_STAGE(PG8_SA(0, 1), a2 + hstep, voffA);
            PG8_WAIT_V(8); PG8_WAIT_L(0); PG8_BAR; PG8_MMA(0, 0, At, B0); PG8_MMA(0, 1, At, B1); PG8_BAR; PG8_SCHED;
            PG8_LDA(At, 1, 1); PG8_STAGE(PG8_SB(1, 0), b3, voffB); PG8_STAGE(PG8_SB(1, 1), b3 + hstep, voffB); PG8_STAGE(PG8_SA(1, 0), a3, voffA);
            PG8_WAIT_V(8); PG8_WAIT_L(0); PG8_BAR; PG8_MMA(1, 0, At, B0); PG8_MMA(1, 1, At, B1); PG8_BAR; PG8_SCHED;
            } else {
            PG8_LDB(B0, 0, 0); PG8_SCHED; PG8_LDA(At, 0, 0); PG8_STAGE(PG8_SA(1, 1), a1 + hstep, voffA);
            PG8_WAIT_L(8); PG8_BAR; PG8_WAIT_L(0); PG8_MMA(0, 0, At, B0); PG8_BAR; PG8_SCHED;
            PG8_LDB(B1, 0, 1); PG8_STAGE(PG8_SB(0, 0), b2, voffB);
            PG8_BAR; PG8_WAIT_L(0); PG8_MMA(0, 1, At, B1); PG8_BAR;
            PG8_LDA(At, 0, 1); PG8_STAGE(PG8_SA(0, 0), a2, voffA);
            PG8_BAR; PG8_WAIT_L(0); PG8_MMA(1, 0, At, B0); PG8_BAR; PG8_SCHED;
            PG8_STAGE(PG8_SB(0, 1), b2 + hstep, voffB);
            PG8_WAIT_V(6); PG8_BAR; PG8_MMA(1, 1, At, B1); PG8_BAR;
            PG8_LDB(B0, 1, 0); PG8_SCHED; PG8_LDA(At, 1, 0); PG8_STAGE(PG8_SA(0, 1), a2 + hstep, voffA);
            PG8_WAIT_L(8); PG8_BAR; PG8_WAIT_L(0); PG8_MMA(0, 0, At, B0); PG8_BAR; PG8_SCHED;
            PG8_LDB(B1, 1, 1); PG8_STAGE(PG8_SB(1, 0), b3, voffB);
            PG8_BAR; PG8_WAIT_L(0); PG8_MMA(0, 1, At, B1); PG8_BAR;
            PG8_LDA(At, 1, 1); PG8_STAGE(PG8_SA(1, 0), a3, voffA);
            PG8_BAR; PG8_WAIT_L(0); PG8_MMA(1, 0, At, B0); PG8_BAR; PG8_SCHED;
            PG8_STAGE(PG8_SB(1, 1), b3 + hstep, voffB);
            PG8_WAIT_V(6); PG8_BAR; PG8_MMA(1, 1, At, B1); PG8_BAR;
            }
        }
        if constexpr (ALIGN_EPI) { if (wr == 0) PG8_BAR; }
        if constexpr (!Epi::AFTER_DRAIN) { E(acc, cur, wr, wc, fr, fq); S.done(cur); }
        if (!has_next) break;
#pragma unroll
        for (int a = 0; a < 2; ++a)
#pragma unroll
            for (int b = 0; b < 2; ++b)
#pragma unroll
                for (int m = 0; m < 4; ++m)
#pragma unroll
                    for (int n = 0; n < 2; ++n) acc[a][b][m][n] = (f32x4){0.f, 0.f, 0.f, 0.f};
        cur = nxt; cA = nA; cB = nB; ++ui;
        if constexpr (ALIGN_EPI) { if (wr == 1) PG8_BAR; }
    }
    PG8_WAIT_V(0);
    if constexpr (!ALIGN_EPI) { if (wr == 0) PG8_BAR; }
    PG8_BAR;
    if constexpr (Epi::AFTER_DRAIN) { E.fused(acc, cur, wr, wc, fr, fq, lds, wid, lane); S.done(cur); }
#undef PG8_SA
#undef PG8_SB
#undef PG8_STAGE
#undef PG8_LDA
#undef PG8_LDB
#undef PG8_MMA
#undef PG8_WAIT_V
#undef PG8_WAIT_L
#undef PG8_BAR
#undef PG8_SCHED
}
}
#ifndef PG8_SP2
#define PG8_SP2 true
#endif
#ifndef PG8_ALIGN
#define PG8_ALIGN true
#endif

constexpr size_t MiB = 1u << 20;
constexpr size_t WS_CTL = 0, CTL_ZERO_BYTES = 1 * MiB;
constexpr size_t WS_SSQ = 1 * MiB, SSQ_STRIDE = 2359296;
constexpr size_t WS_BA = 13 * MiB;
constexpr size_t WS_EG = 18 * MiB, WS_DL = 21 * MiB, WS_GL = 24 * MiB;
constexpr size_t WS_WIN = 32 * MiB, WS_WOUT = 81 * MiB, WS_WUP0 = 97 * MiB, WS_WDN0 = 141 * MiB, WS_WKVQ = 163 * MiB, WS_WO = 187 * MiB, WS_WUP1 = 195 * MiB, WS_WDN1 = 239 * MiB;
constexpr size_t WS_HB = 261 * MiB;
constexpr size_t WS_RA = 326 * MiB;
constexpr size_t WS_QKV = WS_RA, WS_Z = WS_RA + 260 * MiB, WS_UP = WS_RA;
constexpr size_t WS_KC = WS_RA, WS_VC = WS_RA + 130 * MiB;
static_assert(WS_KC + (size_t)DECB * (PAST + DECS) * DM * 2 <= WS_VC && WS_VC + (size_t)DECB * (PAST + DECS) * DM * 2 <= WS_RA + 390 * MiB, "cache copies");
constexpr size_t WS_RB = 716 * MiB;
constexpr size_t WS_QN = WS_RB, WS_KN = WS_RB + 65 * MiB, WS_VV = WS_RB + 130 * MiB, WS_TP = WS_RB + 260 * MiB, WS_PP = WS_RB + 328 * MiB;
constexpr size_t WS_ACT = WS_RB;
constexpr size_t WS_KB = WS_RB, WS_VB = WS_RB + 65 * MiB, WS_QB = WS_RB + 130 * MiB, WS_ATT = WS_RB + 195 * MiB;
constexpr size_t WS_END = 1112 * MiB;
static_assert((size_t)M * 32 * 4 <= SSQ_STRIDE && WS_SSQ + 5 * SSQ_STRIDE <= WS_BA && WS_BA + (size_t)M * 64 * 4 <= WS_EG && WS_EG + (size_t)NITEM * 256 <= WS_DL && WS_DL + (size_t)NITEM * 256 <= WS_GL && WS_GL + NITEM * 4 <= WS_WIN, "small buffers");
static_assert(WS_WIN + (size_t)INWP * DM * 2 <= WS_WOUT && WS_WDN1 + (size_t)DM * DFF * 2 <= WS_HB && WS_HB + (size_t)M * DM * 2 <= WS_RA, "weights / HB");
static_assert(WS_QKV + (size_t)M * QKVW * 2 <= WS_Z && WS_Z + (size_t)M * VW * 2 <= WS_RB && WS_UP + (size_t)M * UPW * 2 <= WS_RB, "region A");
static_assert(WS_QN + (size_t)M * DM * 2 <= WS_KN && WS_KN + (size_t)M * DM * 2 <= WS_VV && WS_VV + (size_t)M * VW * 2 <= WS_TP && WS_TP + (size_t)NITEM * 8192 <= WS_PP && WS_PP + (size_t)NITEM * 8192 <= WS_END, "region B (gdn)");
static_assert(WS_ACT + (size_t)M * DFF * 2 <= WS_END && WS_ATT + (size_t)M * DM * 2 <= WS_END, "region B");
static_assert((size_t)M * VW * 2 <= (O_SGDN - O_PK) * 4, "ON scratch");
constexpr int CW_BAR = 4096;

constexpr int LDS_BYTES = 159744;
constexpr int LDSCTL_OFF = 158720;
constexpr int NWAVES = 8;

#define GAS __attribute__((address_space(1)))
#define LAS __attribute__((address_space(3)))
#define DI __device__ __forceinline__
typedef unsigned short bf16;
typedef unsigned v4u __attribute__((ext_vector_type(4)));
typedef unsigned v2u __attribute__((ext_vector_type(2)));
typedef float f32x4 __attribute__((ext_vector_type(4)));
typedef float f32x16 __attribute__((ext_vector_type(16)));
typedef short bf16x8 __attribute__((ext_vector_type(8)));
typedef short bf16x4 __attribute__((ext_vector_type(4)));
#define LDS_WAIT() asm volatile("s_waitcnt lgkmcnt(0)" ::: "memory")
#define VM_WAIT() asm volatile("s_waitcnt vmcnt(0)" ::: "memory")
#define MFMA32(a, b, c) __builtin_amdgcn_mfma_f32_32x32x16_bf16((a), (b), (c), 0, 0, 0)
DI unsigned pk2(float lo, float hi) { return pg8::cvt_pk_bf16(lo, hi); }
DI float bf2f(unsigned short b) { return __builtin_bit_cast(float, ((unsigned)b) << 16); }
DI float bflo(unsigned w) { return __builtin_bit_cast(float, w << 16); }
DI float bfhi(unsigned w) { return __builtin_bit_cast(float, w & 0xffff0000u); }
DI void unpack8(const v4u w, float (&f)[8]) { f[0] = bflo(w.x); f[1] = bfhi(w.x); f[2] = bflo(w.y); f[3] = bfhi(w.y); f[4] = bflo(w.z); f[5] = bfhi(w.z); f[6] = bflo(w.w); f[7] = bfhi(w.w); }
DI v4u pack8(const float (&f)[8]) { v4u w; w.x = pk2(f[0], f[1]); w.y = pk2(f[2], f[3]); w.z = pk2(f[4], f[5]); w.w = pk2(f[6], f[7]); return w; }
DI int crow(int r, int hi) { return (r & 3) + 8 * (r >> 2) + 4 * hi; }
DI float wave_sum(float v) {
#pragma unroll
    for (int o = 1; o < 64; o <<= 1) v += __shfl_xor(v, o);
    return v;
}
DI float siluf(float x) { return x / (1.0f + __expf(-x)); }

#define XB_TMO      128
#define XB_XCNT(j)  (256  + 64 * (j))
#define XB_XSUB(j)  (1280 + 64 * (j))
#define XB_XGEN(j)  (2304 + 64 * (j))
#define XB_TOP      3328
#define XB_TOPGEN   3392
#define XCD_BAR_WORDS 3456
#define XB_SPIN_CAP (1u << 18)

__device__ __forceinline__ unsigned xb_ld(unsigned* p)              { return __hip_atomic_load(p, __ATOMIC_RELAXED, __HIP_MEMORY_SCOPE_AGENT); }
__device__ __forceinline__ unsigned xb_add(unsigned* p, unsigned v) { return __hip_atomic_fetch_add(p, v, __ATOMIC_RELAXED, __HIP_MEMORY_SCOPE_AGENT); }
__device__ __forceinline__ unsigned xb_xcc_id() { return (unsigned)__builtin_amdgcn_s_getreg((3 << 11) | 20) & 0xFu; }
#define XB_SPIN(cond, bar) do { unsigned _sp = 0; while (cond) { __builtin_amdgcn_s_sleep(1); \
    if ((++_sp & 255u) == 0u) { if (xb_ld(&(bar)[XB_TMO])) break; if (_sp > XB_SPIN_CAP) { atomicAdd(&(bar)[XB_TMO], 1u); break; } } } } while (0)

struct XcdBarrier {
    unsigned* bar; unsigned x;
    volatile LAS unsigned* st;
};

__device__ __forceinline__ XcdBarrier xcd_barrier_post(unsigned* bar, volatile LAS unsigned* st) {
    XcdBarrier b; b.bar = bar; b.x = xb_xcc_id(); b.st = st;
    if (threadIdx.x == 0) (void)xb_add(&bar[XB_XCNT(b.x)], 1u);
    return b;
}
__device__ __forceinline__ void xcd_barrier_complete(unsigned* bar, unsigned x, unsigned& nloc, unsigned& nx) {
    const unsigned G = gridDim.x * gridDim.y * gridDim.z;
    unsigned sum, cnt, mine, sp = 0u;
    for (;;) {
        sum = 0u; cnt = 0u; mine = 0u;
#pragma unroll
        for (unsigned j = 0; j < 16; ++j) { const unsigned c = xb_ld(&bar[XB_XCNT(j)]); sum += c; cnt += (c > 0u) ? 1u : 0u; mine = (j == x) ? c : mine; }
        if (sum == G) break;
        __builtin_amdgcn_s_sleep(1);
        if ((++sp & 255u) == 0u) { if (xb_ld(&bar[XB_TMO])) break; if (sp > XB_SPIN_CAP) { atomicAdd(&bar[XB_TMO], 1u); break; } }
    }
    nloc = mine > 0u ? mine : 1u; nx = cnt > 0u ? cnt : 1u;
}

__device__ __forceinline__ void xcd_barrier(const XcdBarrier& b) {
    asm volatile("s_waitcnt vmcnt(0)" ::: "memory");
    __syncthreads();
    if (threadIdx.x == 0) {
        unsigned* bar = b.bar;
        __builtin_amdgcn_s_waitcnt(0);
        unsigned nloc = b.st[0], nx = b.st[1];
        if (nloc == 0u) { xcd_barrier_complete(bar, b.x, nloc, nx); b.st[0] = nloc; b.st[1] = nx; }
        const unsigned old = xb_add(&bar[XB_XSUB(b.x)], 1u);
        const unsigned gen = old / nloc;
        if (old + 1u == (gen + 1u) * nloc) {
            __builtin_amdgcn_fence(__ATOMIC_RELEASE, "agent");
            asm volatile("s_waitcnt vmcnt(0)" ::: "memory");
            const unsigned og = xb_add(&bar[XB_TOP], 1u);
            const unsigned tg = og / nx;
            if (og + 1u == (tg + 1u) * nx) xb_add(&bar[XB_TOPGEN], 1u);
            else XB_SPIN(xb_ld(&bar[XB_TOPGEN]) == tg, bar);
            __builtin_amdgcn_fence(__ATOMIC_ACQUIRE, "agent");
            xb_add(&bar[XB_XGEN(b.x)], 1u);
            asm volatile("s_waitcnt vmcnt(0)" ::: "memory");
        } else {
            XB_SPIN(xb_ld(&bar[XB_XGEN(b.x)]) == gen, bar);
            __builtin_amdgcn_fence(__ATOMIC_ACQUIRE, "agent");
            asm volatile("s_waitcnt vmcnt(0)" ::: "memory");
        }
    }
    __syncthreads();
}
struct Frame {
    LAS unsigned char* lds;
    volatile LAS unsigned* MISC;
    unsigned* ctl;
    int tid, lane, wave;
    int vcu, G;
    const float* const* in;
    float* out; unsigned char* ws;
};
enum { I_XP = 0, I_XS, I_SGDN, I_SGC, I_SFC, I_CK, I_CV, I_ANORM, I_AWIN, I_AWCONV, I_ALOG, I_ADT, I_AONORM, I_AWOUT, I_KVNORM, I_WKV, I_BNORM, I_BWQ,
       I_LQ1, I_LK1, I_LQ2, I_LK2, I_SUBN, I_BWO, I_RELB, I_FNORM, I_FWUP, I_FWCONV, I_FBCONV, I_FWDN, I_FINAL, N_IN };

DI void p0_transpose_item(const float* W, const float* gain, int K, int N, bf16* WT, int row_off, LAS float* scr, int item, int lane) {
    const int nblk = N / 32, kb = item / nblk, nb = item % nblk, k0 = 64 * kb, n0 = 32 * nb;
#pragma unroll 8
    for (int i = 0; i < 32; ++i) { const int kk = 2 * i + (lane >> 5); const float gk = gain ? gain[k0 + kk] : 1.0f; scr[kk * 33 + (lane & 31)] = W[(size_t)(k0 + kk) * N + n0 + (lane & 31)] * gk; }
    LDS_WAIT(); asm volatile("" ::: "memory");
    const int c = lane & 7;
#pragma unroll
    for (int j = 0; j < 4; ++j) { const int n = (lane >> 3) + 8 * j; const LAS float* s = scr + (8 * c) * 33 + n;
        v4u o; o.x = pk2(s[0 * 33], s[1 * 33]); o.y = pk2(s[2 * 33], s[3 * 33]); o.z = pk2(s[4 * 33], s[5 * 33]); o.w = pk2(s[6 * 33], s[7 * 33]);
        *(v4u*)(WT + (size_t)(row_off + n0 + n) * K + k0 + 8 * c) = o; }
    LDS_WAIT(); asm volatile("" ::: "memory");
}
DI void p0_prologue(Frame& F) {
    LAS float* scr = (LAS float*)(F.lds + F.wave * 16384);
    const int gw = F.vcu * NWAVES + F.wave, NGW = F.G * NWAVES, lane = F.lane;
    unsigned char* ws = F.ws;
    constexpr int I_IN = (DM / 64) * (INW / 32), I_OUT = (VW / 64) * (DM / 32), I_UP = (DM / 64) * (UPW / 32), I_DN = (DFF / 64) * (DM / 32), I_KV = (DM / 64) * (4096 / 32), I_Q = (DM / 64) * (DM / 32), I_O = I_Q;
    constexpr int NITEMS = I_IN + I_OUT + 2 * I_UP + 2 * I_DN + I_KV + I_Q + I_O;
    for (int it = gw; it < NITEMS; it += NGW) {
        int r = it;
        if (r < I_IN) { p0_transpose_item(F.in[I_AWIN], F.in[I_ANORM], DM, INW, (bf16*)(ws + WS_WIN), 0, scr, r, lane); continue; } r -= I_IN;
        if (r < I_OUT) { p0_transpose_item(F.in[I_AWOUT], nullptr, VW, DM, (bf16*)(ws + WS_WOUT), 0, scr, r, lane); continue; } r -= I_OUT;
        if (r < I_UP) { p0_transpose_item(F.in[I_FWUP], F.in[I_FNORM], DM, UPW, (bf16*)(ws + WS_WUP0), 0, scr, r, lane); continue; } r -= I_UP;
        if (r < I_UP) { p0_transpose_item(F.in[I_FWUP] + (size_t)DM * UPW, F.in[I_FNORM] + DM, DM, UPW, (bf16*)(ws + WS_WUP1), 0, scr, r, lane); continue; } r -= I_UP;
        if (r < I_DN) { p0_transpose_item(F.in[I_FWDN], nullptr, DFF, DM, (bf16*)(ws + WS_WDN0), 0, scr, r, lane); continue; } r -= I_DN;
        if (r < I_DN) { p0_transpose_item(F.in[I_FWDN] + (size_t)DFF * DM, nullptr, DFF, DM, (bf16*)(ws + WS_WDN1), 0, scr, r, lane); continue; } r -= I_DN;
        if (r < I_KV) { p0_transpose_item(F.in[I_WKV], F.in[I_KVNORM], DM, 4096, (bf16*)(ws + WS_WKVQ), 0, scr, r, lane); continue; } r -= I_KV;
        if (r < I_Q) { p0_transpose_item(F.in[I_BWQ], F.in[I_BNORM], DM, DM, (bf16*)(ws + WS_WKVQ), 4096, scr, r, lane); continue; } r -= I_Q;
        p0_transpose_item(F.in[I_BWO], nullptr, DM, DM, (bf16*)(ws + WS_WO), 0, scr, r, lane);
    }
    { v4u* z = (v4u*)(ws + WS_WIN + (size_t)INW * DM * 2); const int nz = (INWP - INW) * DM * 2 / 16; const v4u zero = {0u, 0u, 0u, 0u};
      for (int i = gw * 64 + lane; i < nz; i += NGW * 64) z[i] = zero; }
    float* ssq0 = (float*)(ws + WS_SSQ);
    for (int m = gw; m < M; m += NGW) {
        const float* xr = (m < MP) ? F.in[I_XP] + (size_t)m * DM : F.in[I_XS] + (size_t)(m - MP) * DM;
        const f32x4* x4 = (const f32x4*)xr + lane; v2u* o8 = (v2u*)((bf16*)(ws + WS_HB) + (size_t)m * DM) + lane;
        float s = 0.f;
#pragma unroll
        for (int j = 0; j < 8; ++j) { const f32x4 v = x4[64 * j]; s += (v[0] * v[0] + v[1] * v[1]) + (v[2] * v[2] + v[3] * v[3]); v2u w; w.x = pk2(v[0], v[1]); w.y = pk2(v[2], v[3]); o8[64 * j] = w; }
        s = wave_sum(s);
        if (lane < 32) ssq0[(size_t)m * 32 + lane] = (lane == 0) ? s : 0.f;
    }
}
DI void p_gdnconv(Frame& F) {
    const int gw = F.vcu * NWAVES + F.wave, NGW = F.G * NWAVES, lane = F.lane;
    const bf16* QKV = (const bf16*)(F.ws + WS_QKV);
    bf16* QN = (bf16*)(F.ws + WS_QN); bf16* KN = (bf16*)(F.ws + WS_KN); bf16* VV = (bf16*)(F.ws + WS_VV);
    const float* wconv = F.in[I_AWCONV];
    constexpr int NTB = MP / 16 + DECB;
    for (int it = gw; it < NTB * 16; it += NGW) {
        const int tb = it >> 4, cc = it & 15, c0 = cc * 512 + lane * 8;
        const bool samp = tb >= MP / 16; const int b = samp ? tb - MP / 16 : tb >> 9; const int t0 = samp ? 0 : (tb & 511) * 16;
        const size_t mbase = samp ? (size_t)MP + b * 16 : (size_t)b * SEQ; const int L = samp ? DECS : SEQ;
        float w[4][8];
#pragma unroll
        for (int i = 0; i < 4; ++i) { const f32x4 a = *(const f32x4*)(wconv + i * QKVW + c0), bq = *(const f32x4*)(wconv + i * QKVW + c0 + 4);
            w[i][0] = a[0]; w[i][1] = a[1]; w[i][2] = a[2]; w[i][3] = a[3]; w[i][4] = bq[0]; w[i][5] = bq[1]; w[i][6] = bq[2]; w[i][7] = bq[3]; }
        float h[3][8];
#pragma unroll
        for (int j = 0; j < 3; ++j) { const int t = t0 - 3 + j;
            if (t >= 0) { unpack8(*(const v4u*)(QKV + (mbase + t) * QKVW + c0), h[j]); }
            else if (samp) { const float* sp = F.in[I_SGC] + (size_t)(b * 3 + (t + 3)) * QKVW + c0; const f32x4 a = *(const f32x4*)sp, bq = *(const f32x4*)(sp + 4);
                h[j][0] = a[0]; h[j][1] = a[1]; h[j][2] = a[2]; h[j][3] = a[3]; h[j][4] = bq[0]; h[j][5] = bq[1]; h[j][6] = bq[2]; h[j][7] = bq[3]; }
            else {
#pragma unroll
                for (int e = 0; e < 8; ++e) h[j][e] = 0.f; } }
#pragma unroll 4
        for (int tt = 0; tt < 16; ++tt) {
            const int t = t0 + tt; const size_t m = mbase + t;
            float cur[8]; unpack8(*(const v4u*)(QKV + m * QKVW + c0), cur);
            float y[8]; float ss = 0.f;
#pragma unroll
            for (int e = 0; e < 8; ++e) { const float a = h[0][e] * w[0][e] + h[1][e] * w[1][e] + h[2][e] * w[2][e] + cur[e] * w[3][e]; y[e] = siluf(a); ss += y[e] * y[e]; }
            if (cc < 8) {
                ss += __shfl_xor(ss, 1); ss += __shfl_xor(ss, 2); ss += __shfl_xor(ss, 4); ss += __shfl_xor(ss, 8);
                const float sc = rsqrtf(ss + 1e-6f) * (cc < 4 ? 0.08838834764831845f : 1.0f);
#pragma unroll
                for (int e = 0; e < 8; ++e) y[e] *= sc;
                bf16* dst = (cc < 4) ? QN + m * DM + c0 : KN + m * DM + (c0 - 2048);
                *(v4u*)dst = pack8(y);
            } else { *(v4u*)(VV + m * VW + (c0 - 4096)) = pack8(y); }
            if (t >= L - 3) {
                float* so = F.out + (samp ? O_SGC : O_PGC) + (size_t)(b * 3 + (t - (L - 3))) * QKVW + c0;
                *(f32x4*)so = (f32x4){cur[0], cur[1], cur[2], cur[3]}; *(f32x4*)(so + 4) = (f32x4){cur[4], cur[5], cur[6], cur[7]}; }
#pragma unroll
            for (int e = 0; e < 8; ++e) { h[0][e] = h[1][e]; h[1][e] = h[2][e]; h[2][e] = cur[e]; }
        }
    }
}
DI void p_prep(Frame& F) {
    const int gw = F.vcu * NWAVES + F.wave, NGW = F.G * NWAVES;
    LAS float* Al = (LAS float*)(F.lds + F.wave * 16384);
    const bf16* QN = (const bf16*)(F.ws + WS_QN); const bf16* KN = (const bf16*)(F.ws + WS_KN);
    const float* BA = (const float*)(F.ws + WS_BA);
    bf16* TP = (bf16*)(F.ws + WS_TP); bf16* PP = (bf16*)(F.ws + WS_PP);
    float* EG = (float*)(F.ws + WS_EG); float* DL = (float*)(F.ws + WS_DL); float* GL = (float*)(F.ws + WS_GL);
    for (int it = gw; it < NITEM; it += NGW) {
        int lane = F.lane; asm volatile("" : "+v"(lane));
        const int c = lane & 31, hh = lane >> 5;
        int h, nv; size_t m0;
        if (it < NITEM_P) { h = it & 31; const int bn = it >> 5; m0 = (size_t)(bn >> 7) * SEQ + (size_t)(bn & 127) * 64; nv = 64; }
        else { const int r = it - NITEM_P; h = r & 31; m0 = (size_t)MP + (size_t)(r >> 5) * 16; nv = 16; }
        const int kh = h >> 1;
        float gt = 0.f, bt = 0.f;
        if (lane < nv) { const float bb = BA[(m0 + lane) * 64 + h], aa = BA[(m0 + lane) * 64 + 32 + h];
            bt = 1.0f / (1.0f + __expf(-bb));
            const float xx = aa + F.in[I_ADT][h]; const float sp = fmaxf(xx, 0.f) + log1pf(__expf(-fabsf(xx)));
            gt = -__expf(F.in[I_ALOG][h]) * sp; }
        float G = gt;
#pragma unroll
        for (int o = 1; o < 64; o <<= 1) { const float y = __shfl_up(G, o); if (lane >= o) G += y; }
        const float Glast = __shfl(G, 63);
        bf16x8 kf[2][8];
#pragma unroll
        for (int ti = 0; ti < 2; ++ti)
#pragma unroll
            for (int s = 0; s < 8; ++s) { const int row = 32 * ti + c;
                kf[ti][s] = (row < nv) ? *(const bf16x8*)(KN + (m0 + row) * DM + kh * 128 + 16 * s + 8 * hh) : (bf16x8){0, 0, 0, 0, 0, 0, 0, 0}; }
        {
            f32x16 t00 = {}, t10 = {}, t11 = {};
#pragma unroll
            for (int s = 0; s < 8; ++s) { t00 = MFMA32(kf[0][s], kf[0][s], t00); t10 = MFMA32(kf[1][s], kf[0][s], t10); t11 = MFMA32(kf[1][s], kf[1][s], t11); }
#pragma unroll
            for (int i = 0; i < 16; ++i) {
                const int r0 = crow(i, hh), r1 = 32 + r0;
                const float G0 = __shfl(G, r0), G1 = __shfl(G, r1), b0 = __shfl(bt, r0), b1 = __shfl(bt, r1);
                const float Gc0 = __shfl(G, c), Gc1 = __shfl(G, 32 + c);
                Al[r0 * 64 + c] = (r0 > c) ? b0 * t00[i] * __expf(G0 - Gc0) : 0.f;
                Al[r1 * 64 + c] = b1 * t10[i] * __expf(G1 - Gc0);
                Al[r1 * 64 + 32 + c] = (r0 > c) ? b1 * t11[i] * __expf(G1 - Gc1) : 0.f;
            }
        }
        asm volatile("" ::: "memory");
        {
            bf16x8 qf[2][8];
#pragma unroll
            for (int ti = 0; ti < 2; ++ti)
#pragma unroll
                for (int s = 0; s < 8; ++s) { const int row = 32 * ti + c;
                    qf[ti][s] = (row < nv) ? *(const bf16x8*)(QN + (m0 + row) * DM + kh * 128 + 16 * s + 8 * hh) : (bf16x8){0, 0, 0, 0, 0, 0, 0, 0}; }
            f32x16 t00 = {}, t10 = {}, t11 = {};
#pragma unroll
            for (int s = 0; s < 8; ++s) { t00 = MFMA32(qf[0][s], kf[0][s], t00); t10 = MFMA32(qf[1][s], kf[0][s], t10); t11 = MFMA32(qf[1][s], kf[1][s], t11); }
            bf16* pp = PP + (size_t)it * 4096;
#pragma unroll
            for (int i = 0; i < 16; ++i) {
                const int r0 = crow(i, hh), r1 = 32 + r0;
                const float G0 = __shfl(G, r0), G1 = __shfl(G, r1);
                const float Gc0 = __shfl(G, c), Gc1 = __shfl(G, 32 + c);
                const float v00 = (r0 >= c) ? t00[i] * __expf(G0 - Gc0) : 0.f;
                const float v10 = t10[i] * __expf(G1 - Gc0);
                const float v11 = (r0 >= c) ? t11[i] * __expf(G1 - Gc1) : 0.f;
                pp[r0 * 64 + c] = (bf16)(pk2(v00, 0.f) & 0xffffu); pp[r0 * 64 + 32 + c] = 0;
                pp[r1 * 64 + c] = (bf16)(pk2(v10, 0.f) & 0xffffu); pp[r1 * 64 + 32 + c] = (bf16)(pk2(v11, 0.f) & 0xffffu);
            }
        }
        LDS_WAIT(); asm volatile("" ::: "memory");
        float T[64];
#pragma unroll
        for (int i = 0; i < 64; ++i) {
            float a = (lane == i) ? 1.0f : 0.f;
#pragma unroll
            for (int j = 0; j < i; ++j) a -= Al[i * 64 + j] * T[j];
            T[i] = a;
            asm volatile("" ::: "memory");
        }
        bf16* tp = TP + (size_t)it * 4096;
#pragma unroll
        for (int i = 0; i < 64; ++i) tp[i * 64 + lane] = (bf16)(pk2(T[i] * bt, 0.f) & 0xffffu);
        EG[(size_t)it * 64 + lane] = __expf(G); DL[(size_t)it * 64 + lane] = __expf(Glast - G);
        if (lane == 0) GL[it] = __expf(Glast);
        LDS_WAIT(); asm volatile("" ::: "memory");
    }
}
constexpr int SC_K = 0, SC_KDT = 17408, SC_Q = 35840, SC_RT = 53248, SC_TP = 71680, SC_P = 80896, SC_ST = 90112, SC_UT = 124928, SC_EG = 143360, SC_DL = 143616, SC_OS = SC_Q;
constexpr int LDK = 272, LDT = 144;
DI f32x16 mma_rows(f32x16 acc, const LAS unsigned char* arow, const LAS unsigned char* brow, int ksteps) {
    for (int s = 0; s < ksteps; ++s) acc = MFMA32(*(const LAS bf16x8*)(arow + 32 * s), *(const LAS bf16x8*)(brow + 32 * s), acc);
    return acc;
}
DI void scan_chain(Frame& F, const bool samp, const int b, const int h) {
    const int tid = F.tid, w = F.wave, lane = F.lane, c = lane & 31, hh = lane >> 5;
    LAS unsigned char* lds = F.lds;
    const bf16* QN = (const bf16*)(F.ws + WS_QN); const bf16* KN = (const bf16*)(F.ws + WS_KN); const bf16* VV = (const bf16*)(F.ws + WS_VV);
    const bf16* TP = (const bf16*)(F.ws + WS_TP); const bf16* PP = (const bf16*)(F.ws + WS_PP); const bf16* Z = (const bf16*)(F.ws + WS_Z);
    const float* EG = (const float*)(F.ws + WS_EG); const float* DL = (const float*)(F.ws + WS_DL); const float* GL = (const float*)(F.ws + WS_GL);
    bf16* ON = (bf16*)(F.out + O_PK);
    const int nsteps = samp ? 1 : 128, nv = samp ? 16 : 64, kh = h >> 1;
    const int dvt = w & 3, dk0 = (w >> 2) * 2;
    const int tt = w & 1, dt = w >> 1;
    f32x16 S[2];
#pragma unroll
    for (int q = 0; q < 2; ++q)
#pragma unroll
        for (int i = 0; i < 16; ++i) S[q][i] = samp ? F.in[I_SGDN][((size_t)(b * 32 + h) * 128 + 32 * (dk0 + q) + crow(i, hh)) * 128 + 32 * dvt + c] : 0.f;
    __syncthreads();
#define WRITE_ST() do { _Pragma("unroll") for (int q = 0; q < 2; ++q) _Pragma("unroll") for (int g4 = 0; g4 < 4; ++g4) { v2u pw; pw.x = pk2(S[q][4 * g4], S[q][4 * g4 + 1]); pw.y = pk2(S[q][4 * g4 + 2], S[q][4 * g4 + 3]); \
        *(LAS v2u*)(lds + SC_ST + (32 * dvt + c) * LDK + (32 * (dk0 + q) + 8 * g4 + 4 * hh) * 2) = pw; } } while (0)
    WRITE_ST();
    for (int n = 0; n < nsteps; ++n) {
        const int item = samp ? NITEM_P + b * 32 + h : (b * 128 + n) * 32 + h;
        const size_t m0 = samp ? (size_t)MP + b * 16 : (size_t)b * SEQ + (size_t)n * 64;
#pragma unroll
        for (int p2 = 0; p2 < 2; ++p2) { const int p = tid + 512 * p2, row = p >> 4, cc = p & 15;
            v4u kv = {0u, 0u, 0u, 0u}, qv = {0u, 0u, 0u, 0u}; float dl = 0.f;
            if (row < nv) { kv = *(const v4u*)(KN + (m0 + row) * DM + kh * 128 + cc * 8); qv = *(const v4u*)(QN + (m0 + row) * DM + kh * 128 + cc * 8); dl = DL[(size_t)item * 64 + row]; }
            *(LAS v4u*)(lds + SC_K + row * LDK + cc * 16) = kv; *(LAS v4u*)(lds + SC_Q + row * LDK + cc * 16) = qv;
            float kf[8]; unpack8(kv, kf);
#pragma unroll
            for (int e = 0; e < 8; ++e) *(LAS bf16*)(lds + SC_KDT + (cc * 8 + e) * LDT + row * 2) = (bf16)(pk2(kf[e] * dl, 0.f) & 0xffffu); }
        { const int row = tid >> 3, cc = tid & 7;
          *(LAS v4u*)(lds + SC_TP + row * LDT + cc * 16) = *(const v4u*)(TP + (size_t)item * 4096 + row * 64 + cc * 8);
          *(LAS v4u*)(lds + SC_P + row * LDT + cc * 16) = *(const v4u*)(PP + (size_t)item * 4096 + row * 64 + cc * 8); }
        if (tid < 64) *(LAS float*)(lds + SC_EG + tid * 4) = EG[(size_t)item * 64 + tid];
        const float gl = GL[item];
        __syncthreads();
        f32x16 ks = {}, qs = {};
        ks = mma_rows(ks, lds + SC_K + (32 * tt + c) * LDK + 16 * hh, lds + SC_ST + (32 * dt + c) * LDK + 16 * hh, 8);
        qs = mma_rows(qs, lds + SC_Q + (32 * tt + c) * LDK + 16 * hh, lds + SC_ST + (32 * dt + c) * LDK + 16 * hh, 8);
        float eg[16];
#pragma unroll
        for (int i = 0; i < 16; ++i) eg[i] = *(const LAS float*)(lds + SC_EG + (32 * tt + crow(i, hh)) * 4);
#pragma unroll
        for (int g4 = 0; g4 < 4; ++g4) { float r[4];
#pragma unroll
            for (int j = 0; j < 4; ++j) { const int i = 4 * g4 + j, tok = 32 * tt + crow(i, hh);
                const float vv = (tok < nv) ? bf2f(VV[(m0 + tok) * VW + h * 128 + 32 * dt + c]) : 0.f; r[j] = vv - eg[i] * ks[i]; }
            v2u pw; pw.x = pk2(r[0], r[1]); pw.y = pk2(r[2], r[3]);
            *(LAS v2u*)(lds + SC_RT + (32 * dt + c) * LDT + (32 * tt + 8 * g4 + 4 * hh) * 2) = pw; }
        __syncthreads();
        f32x16 u = {};
        u = mma_rows(u, lds + SC_TP + (32 * tt + c) * LDT + 16 * hh, lds + SC_RT + (32 * dt + c) * LDT + 16 * hh, 4);
#pragma unroll
        for (int g4 = 0; g4 < 4; ++g4) { v2u pw; pw.x = pk2(u[4 * g4], u[4 * g4 + 1]); pw.y = pk2(u[4 * g4 + 2], u[4 * g4 + 3]);
            *(LAS v2u*)(lds + SC_UT + (32 * dt + c) * LDT + (32 * tt + 8 * g4 + 4 * hh) * 2) = pw; }
        __syncthreads();
        f32x16 pu = {};
        pu = mma_rows(pu, lds + SC_P + (32 * tt + c) * LDT + 16 * hh, lds + SC_UT + (32 * dt + c) * LDT + 16 * hh, 4);
#pragma unroll
        for (int i = 0; i < 16; ++i) *(LAS float*)(lds + SC_OS + ((32 * tt + crow(i, hh)) * 132 + 32 * dt + c) * 4) = eg[i] * qs[i] + pu[i];
#pragma unroll
        for (int q = 0; q < 2; ++q) {
#pragma unroll
            for (int i = 0; i < 16; ++i) S[q][i] *= gl;
            S[q] = mma_rows(S[q], lds + SC_KDT + (32 * (dk0 + q) + c) * LDT + 16 * hh, lds + SC_UT + (32 * dvt + c) * LDT + 16 * hh, 4);
        }
        WRITE_ST();
        __syncthreads();
        { const int tok = tid >> 3, j8 = tid & 7; float ov[16]; float ss = 0.f;
#pragma unroll
          for (int e4 = 0; e4 < 4; ++e4) { const f32x4 x = *(const LAS f32x4*)(lds + SC_OS + (tok * 132 + j8 * 16 + e4 * 4) * 4); ov[4 * e4] = x[0]; ov[4 * e4 + 1] = x[1]; ov[4 * e4 + 2] = x[2]; ov[4 * e4 + 3] = x[3];
              ss += (x[0] * x[0] + x[1] * x[1]) + (x[2] * x[2] + x[3] * x[3]); }
          ss += __shfl_xor(ss, 1); ss += __shfl_xor(ss, 2); ss += __shfl_xor(ss, 4);
          const float rstd = rsqrtf(ss * (1.0f / 128.0f) + 1e-6f);
          if (tok < nv) { const size_t zo = (m0 + tok) * VW + h * 128 + j8 * 16; float zf[16];
              unpack8(*(const v4u*)(Z + zo), *(float(*)[8])&zf[0]); unpack8(*(const v4u*)(Z + zo + 8), *(float(*)[8])&zf[8]);
              float res[16];
#pragma unroll
              for (int e = 0; e < 16; ++e) res[e] = ov[e] * rstd * F.in[I_AONORM][j8 * 16 + e] * siluf(zf[e]);
              *(v4u*)(ON + zo) = pack8(*(float(*)[8])&res[0]); *(v4u*)(ON + zo + 8) = pack8(*(float(*)[8])&res[8]); } }
        __syncthreads();
    }
    float* so = F.out + (samp ? O_SGDN : O_PGDN) + (size_t)(b * 32 + h) * 16384;
#pragma unroll
    for (int q = 0; q < 2; ++q)
#pragma unroll
        for (int i = 0; i < 16; ++i) so[(32 * (dk0 + q) + crow(i, hh)) * 128 + 32 * dvt + c] = S[q][i];
#undef WRITE_ST
}
DI void p_scan(Frame& F) {
    const int nW = F.G, bx = blockIdx.x;
    for (int ch = bx; ch < NB * 32; ch += nW) scan_chain(F, false, ch >> 5, ch & 31);
    int start, stride;
    if (nW > NB * 32) { start = bx - NB * 32; stride = nW - NB * 32; } else { start = bx; stride = nW; }
    if (start >= 0) for (int ch = start; ch < DECB * 32; ch += stride) scan_chain(F, true, ch >> 5, ch & 31);
}
DI void p_ffnconv(Frame& F, const int layer) {
    const int gw = F.vcu * NWAVES + F.wave, NGW = F.G * NWAVES, lane = F.lane;
    const bf16* UP = (const bf16*)(F.ws + WS_UP); bf16* ACT = (bf16*)(F.ws + WS_ACT);
    const float* wconv = F.in[I_FWCONV] + (size_t)layer * 3 * UPW; const float* bconv = F.in[I_FBCONV] + (size_t)layer * UPW;
    constexpr int NTB = MP / 16 + DECB, NCC = DFF / 512;
    for (int it = gw; it < NTB * NCC; it += NGW) {
        const int tb = it / NCC, cc = it - tb * NCC, c0 = cc * 512 + lane * 8;
        const bool samp = tb >= MP / 16; const int b = samp ? tb - MP / 16 : tb >> 9; const int t0 = samp ? 0 : (tb & 511) * 16;
        const size_t mbase = samp ? (size_t)MP + b * 16 : (size_t)b * SEQ; const int L = samp ? DECS : SEQ;
        float wg[3][8], wv[3][8], bg[8], bv[8];
#pragma unroll
        for (int i = 0; i < 3; ++i)
#pragma unroll
            for (int e = 0; e < 8; ++e) { wg[i][e] = wconv[i * UPW + c0 + e]; wv[i][e] = wconv[i * UPW + DFF + c0 + e]; }
#pragma unroll
        for (int e = 0; e < 8; ++e) { bg[e] = bconv[c0 + e]; bv[e] = bconv[DFF + c0 + e]; }
        float hg[2][8], hv[2][8];
#pragma unroll
        for (int j = 0; j < 2; ++j) { const int t = t0 - 2 + j;
            if (t >= 0) { unpack8(*(const v4u*)(UP + (mbase + t) * UPW + c0), hg[j]); unpack8(*(const v4u*)(UP + (mbase + t) * UPW + DFF + c0), hv[j]); }
            else if (samp) { const float* sp = F.in[I_SFC] + ((size_t)(layer * DECB + b) * 2 + (t + 2)) * UPW + c0;
#pragma unroll
                for (int e = 0; e < 8; ++e) { hg[j][e] = sp[e]; hv[j][e] = sp[DFF + e]; } }
            else {
#pragma unroll
                for (int e = 0; e < 8; ++e) { hg[j][e] = 0.f; hv[j][e] = 0.f; } } }
#pragma unroll 4
        for (int tt = 0; tt < 16; ++tt) {
            const int t = t0 + tt; const size_t m = mbase + t;
            float cg[8], cv[8]; unpack8(*(const v4u*)(UP + m * UPW + c0), cg); unpack8(*(const v4u*)(UP + m * UPW + DFF + c0), cv);
            float y[8];
#pragma unroll
            for (int e = 0; e < 8; ++e) { const float g = hg[0][e] * wg[0][e] + hg[1][e] * wg[1][e] + cg[e] * wg[2][e] + bg[e];
                const float v = hv[0][e] * wv[0][e] + hv[1][e] * wv[1][e] + cv[e] * wv[2][e] + bv[e]; y[e] = siluf(g) * v; }
            *(v4u*)(ACT + m * DFF + c0) = pack8(y);
            if (t >= L - 2) {
                float* so = F.out + (samp ? O_SFC + ((size_t)(layer * DECB + b) * 2 + (t - (L - 2))) * UPW : O_PFC + ((size_t)(layer * NB + b) * 2 + (t - (L - 2))) * UPW) + c0;
#pragma unroll
                for (int e = 0; e < 8; ++e) { so[e] = cg[e]; so[DFF + e] = cv[e]; } }
#pragma unroll
            for (int e = 0; e < 8; ++e) { hg[0][e] = hg[1][e]; hg[1][e] = cg[e]; hv[0][e] = hv[1][e]; hv[1][e] = cv[e]; }
        }
    }
}
DI void p_final(Frame& F) {
    const int gw = F.vcu * NWAVES + F.wave, NGW = F.G * NWAVES, lane = F.lane;
    const float* ssq = (const float*)(F.ws + WS_SSQ + 4 * SSQ_STRIDE); const float* gain = F.in[I_FINAL];
    for (int m = gw; m < M; m += NGW) {
        float s = (lane < 32) ? ssq[(size_t)m * 32 + lane] : 0.f; s = wave_sum(s);
        const float rstd = rsqrtf(s * (1.0f / 2048.0f) + 1e-6f);
        f32x4* y4 = (f32x4*)(F.out + (size_t)m * DM) + lane; const f32x4* g4 = (const f32x4*)gain + lane;
#pragma unroll
        for (int j = 0; j < 8; ++j) { const f32x4 v = y4[64 * j]; y4[64 * j] = v * rstd * g4[64 * j]; }
    }
}
DI void p_cacheconv(Frame& F, const float* src, bf16* dst) {
    const size_t nthr = (size_t)F.G * 512, t0 = (size_t)F.vcu * 512 + F.tid;
    constexpr size_t NP = (size_t)DECB * PAST * DM / 8;
    for (size_t p = t0; p < NP; p += nthr) {
        const size_t row = p >> 8, c8 = p & 255, b = row >> 11, key = row & 2047;
        const f32x4 a = *(const f32x4*)(src + p * 8), bq = *(const f32x4*)(src + p * 8 + 4);
        v4u o; o.x = pk2(a[0], a[1]); o.y = pk2(a[2], a[3]); o.z = pk2(bq[0], bq[1]); o.w = pk2(bq[2], bq[3]);
        *(v4u*)(dst + (b * (PAST + DECS) + key) * DM + c8 * 8) = o;
    }
}
constexpr int AT_K = 0, AT_V = 65536, AT_W = 131072, AT_BT = 147456, AT_X = 149504;
constexpr float ATT_C = 0.08838834764831845f * 1.4426950408889634f;
constexpr float LAM_INIT = 0.35550906759718507f;
constexpr int CW_ATTQ = 64;
struct AttnUnit { const bf16* Kp; const bf16* Vp; int h, nq, qpos0, nkeys; size_t mq0; };
DI int t5_bucket(int rel) { const int n = rel < 0 ? -rel : rel; int v; if (n < 8) v = n; else { v = 2 + (31 - __builtin_clz((unsigned)(n * n))); v = v > 15 ? 15 : v; } return (rel > 0 ? 16 : 0) + v; }
#define KSWZ(row, colB) ((row) * 256 + ((colB) ^ (((row) & 7) << 4)))
DI int v_st(int k, int c) { return ((k >> 3) * 8 + (c >> 5)) * 512 + ((k & 7) * 32 + (c & 31)) * 2; }
DI int v_rd_base(int lane) { return ((lane & 3) << 3) | (((lane >> 2) & 3) << 6) | (((lane >> 4) & 1) << 5) | (((lane >> 5) & 1) << 8); }
template <int OFF> DI bf16x4 tr_read(int vb) { bf16x4 r; asm volatile("ds_read_b64_tr_b16 %0, %1 offset:%2" : "=&v"(r) : "v"(vb), "i"(OFF) : "memory"); return r; }
struct AtStage { v4u k[4]; v4u v[4]; };
DI void at_load(AtStage& S, const AttnUnit& U, const int kt, const bool withV, int tid) {
    asm volatile("" : "+v"(tid));
#pragma unroll
    for (int i = 0; i < 4; ++i) { const int key = 32 * (i & 1) + (tid >> 4); int kg = kt * 64 + key; kg = kg < U.nkeys ? kg : U.nkeys - 1;
        S.k[i] = *(const v4u*)(U.Kp + (size_t)kg * DM + (2 * U.h + (i >> 1)) * 128 + (tid & 15) * 8); }
    if (withV) {
#pragma unroll
        for (int i = 0; i < 4; ++i) { const int g = (tid >> 6) + 8 * i, key = (g >> 2) * 8 + (tid & 7), cc = (g & 3) * 8 + ((tid >> 3) & 7); int kg = kt * 64 + key; kg = kg < U.nkeys ? kg : U.nkeys - 1;
            S.v[i] = *(const v4u*)(U.Vp + (size_t)kg * DM + U.h * 256 + cc * 8); }
    }
}
DI void at_store(const AtStage& S, LAS unsigned char* lds, const int buf, const bool withV, int tid) {
    asm volatile("" : "+v"(tid));
#pragma unroll
    for (int i = 0; i < 4; ++i) { const int key = 32 * (i & 1) + (tid >> 4);
        *(LAS v4u*)(lds + AT_K + buf * 32768 + (i >> 1) * 16384 + KSWZ(key, (tid & 15) * 16)) = S.k[i]; }
    if (withV) {
#pragma unroll
        for (int i = 0; i < 4; ++i) { const int g = (tid >> 6) + 8 * i, key = (g >> 2) * 8 + (tid & 7), cc = (g & 3) * 8 + ((tid >> 3) & 7);
            *(LAS v4u*)(lds + AT_V + buf * 32768 + v_st(key, cc * 8)) = S.v[i]; }
    }
}
template <int NBATCH> DI void at_scores2(LAS unsigned char* lds, const AttnUnit& U, const bf16x8 (&qf)[2][8], const int kbase, const int kt, const int pi, const int qpos_lane, const int mode, f32x16& t1, f32x16& t2, const int c, const int hh) {
    f32x16 a1 = {}, a2 = {};
#pragma unroll
    for (int s0 = 0; s0 < 8; s0 += NBATCH) {
        bf16x8 k0[NBATCH], k1[NBATCH];
#pragma unroll
        for (int s = 0; s < NBATCH; ++s) { k0[s] = *(const LAS bf16x8*)(lds + kbase + KSWZ(32 * pi + c, 32 * (s0 + s) + 16 * hh)); k1[s] = *(const LAS bf16x8*)(lds + kbase + 16384 + KSWZ(32 * pi + c, 32 * (s0 + s) + 16 * hh)); }
        __builtin_amdgcn_sched_barrier(0);
#pragma unroll
        for (int s = 0; s < NBATCH; ++s) { a1 = MFMA32(k0[s], qf[0][s0 + s], a1); a2 = MFMA32(k1[s], qf[1][s0 + s], a2); }
        __builtin_amdgcn_sched_barrier(0);
    }
    const LAS float* bt = (const LAS float*)(lds + AT_BT);
    if (mode == 0) { const float bc = bt[0];
#pragma unroll
        for (int i = 0; i < 16; ++i) { t1[i] = a1[i] * ATT_C + bc; t2[i] = a2[i] * ATT_C + bc; }
    } else {
        float bc[16];
#pragma unroll
        for (int i = 0; i < 16; ++i) { int rel = kt * 64 + 32 * pi + crow(i, hh) - qpos_lane; rel = rel < -256 ? -256 : rel; rel = rel > 255 ? 255 : rel; bc[i] = bt[rel + 256]; }
        if (mode == 2) {
#pragma unroll
            for (int i = 0; i < 16; ++i) bc[i] = (kt * 64 + 32 * pi + crow(i, hh) < U.nkeys) ? bc[i] : -1e30f;
        }
#pragma unroll
        for (int i = 0; i < 16; ++i) { t1[i] = a1[i] * ATT_C + bc[i]; t2[i] = a2[i] * ATT_C + bc[i]; }
    }
}
#define PK(L, H) (bf16x8){L[0], L[1], L[2], L[3], H[0], H[1], H[2], H[3]}
template <int D0> DI void at_pv_two(f32x16& oa, f32x16& ob, const int vb, const bf16x8 (&wf)[4]) {
    const bf16x4 l0 = tr_read<D0 * 512 + 0 * 8192>(vb), h0 = tr_read<D0 * 512 + 0 * 8192 + 4096>(vb), l1 = tr_read<D0 * 512 + 1 * 8192>(vb), h1 = tr_read<D0 * 512 + 1 * 8192 + 4096>(vb);
    const bf16x4 l2 = tr_read<D0 * 512 + 2 * 8192>(vb), h2 = tr_read<D0 * 512 + 2 * 8192 + 4096>(vb), l3 = tr_read<D0 * 512 + 3 * 8192>(vb), h3 = tr_read<D0 * 512 + 3 * 8192 + 4096>(vb);
    const bf16x4 m0 = tr_read<D0 * 512 + 512 + 0 * 8192>(vb), n0 = tr_read<D0 * 512 + 512 + 0 * 8192 + 4096>(vb), m1 = tr_read<D0 * 512 + 512 + 1 * 8192>(vb), n1 = tr_read<D0 * 512 + 512 + 1 * 8192 + 4096>(vb);
    const bf16x4 m2 = tr_read<D0 * 512 + 512 + 2 * 8192>(vb), n2 = tr_read<D0 * 512 + 512 + 2 * 8192 + 4096>(vb), m3 = tr_read<D0 * 512 + 512 + 3 * 8192>(vb), n3 = tr_read<D0 * 512 + 512 + 3 * 8192 + 4096>(vb);
    asm volatile("s_waitcnt lgkmcnt(0)" ::: "memory"); __builtin_amdgcn_sched_barrier(0);
    oa = MFMA32(wf[0], PK(l0, h0), oa); ob = MFMA32(wf[0], PK(m0, n0), ob); oa = MFMA32(wf[1], PK(l1, h1), oa); ob = MFMA32(wf[1], PK(m1, n1), ob);
    oa = MFMA32(wf[2], PK(l2, h2), oa); ob = MFMA32(wf[2], PK(m2, n2), ob); oa = MFMA32(wf[3], PK(l3, h3), oa); ob = MFMA32(wf[3], PK(m3, n3), ob);
}
#undef PK
DI void attn_unit(Frame& F, const AttnUnit& U, const float lam) {
    const int tid = F.tid, w = F.wave, lane = F.lane, rt = w >> 1, pi = w & 1;
    LAS unsigned char* lds = F.lds;
    const bf16* QB = (const bf16*)(F.ws + WS_QB); bf16* ATT = (bf16*)(F.ws + WS_ATT);
    __syncthreads();
    { const int rel = tid - 256; *(LAS float*)(lds + AT_BT + tid * 4) = F.in[I_RELB][t5_bucket(rel) * 8 + U.h] * 1.4426950408889634f; }
    const bool active = 32 * rt < U.nq;
    const int qchunk = (U.qpos0 + 32 * rt) >> 6;
    bf16x8 qf[2][8];
    { const int c = lane & 31, hh = lane >> 5, qrow = 32 * rt + c;
#pragma unroll
      for (int mm = 0; mm < 2; ++mm)
#pragma unroll
        for (int s = 0; s < 8; ++s) qf[mm][s] = (qrow < U.nq) ? *(const bf16x8*)(QB + (U.mq0 + qrow) * DM + (2 * U.h + mm) * 128 + 16 * s + 8 * hh) : (bf16x8){0, 0, 0, 0, 0, 0, 0, 0}; }
    const int ntiles = (U.nkeys + 63) >> 6;
    AtStage S;
    float m1 = -1e30f, m2 = -1e30f, l1 = 0.f, l2 = 0.f;
    at_load(S, U, 0, false, tid); at_store(S, lds, 0, false, tid);
    __syncthreads();
    for (int kt = 0; kt < ntiles; ++kt) {
        if (kt + 1 < ntiles) at_load(S, U, kt + 1, false, tid);
        if (active && kt <= qchunk) {
            const int mode = (kt * 64 + 63 >= U.nkeys) ? 2 : ((kt * 64 + 32 * pi + 31 - (U.qpos0 + 32 * rt)) <= -91 ? 0 : 1);
            int lv = lane; asm volatile("" : "+v"(lv)); const int c = lv & 31, hh = lv >> 5; const int qpos_lane = U.qpos0 + 32 * rt + c;
            f32x16 t1, t2; at_scores2<8>(lds, U, qf, AT_K + (kt & 1) * 32768, kt, pi, qpos_lane, mode, t1, t2, c, hh);
            float x1 = t1[0], x2 = t2[0];
#pragma unroll
            for (int i = 1; i < 16; ++i) { x1 = fmaxf(x1, t1[i]); x2 = fmaxf(x2, t2[i]); }
            x1 = fmaxf(x1, __shfl_xor(x1, 32)); x2 = fmaxf(x2, __shfl_xor(x2, 32));
            const float n1 = fmaxf(m1, x1), n2 = fmaxf(m2, x2); float s1 = 0.f, s2 = 0.f;
#pragma unroll
            for (int i = 0; i < 16; ++i) { s1 += __builtin_amdgcn_exp2f(t1[i] - n1); s2 += __builtin_amdgcn_exp2f(t2[i] - n2); }
            l1 = l1 * __builtin_amdgcn_exp2f(m1 - n1) + s1; m1 = n1; l2 = l2 * __builtin_amdgcn_exp2f(m2 - n2) + s2; m2 = n2;
        }
        if (kt + 1 < ntiles) at_store(S, lds, (kt + 1) & 1, false, tid);
        __syncthreads();
    }
    l1 += __shfl_xor(l1, 32); l2 += __shfl_xor(l2, 32);
    { LAS float* xs = (LAS float*)(lds + AT_X) + w * 128;
      if (lane < 32) { xs[lane] = m1; xs[32 + lane] = l1; xs[64 + lane] = m2; xs[96 + lane] = l2; }
      __syncthreads();
      const LAS float* xo = (const LAS float*)(lds + AT_X) + (w ^ 1) * 128; const int c = lane & 31;
      const float pm1 = xo[c], pl1 = xo[32 + c], pm2 = xo[64 + c], pl2 = xo[96 + c];
      const float M1 = fmaxf(m1, pm1), M2 = fmaxf(m2, pm2);
      l1 = l1 * __builtin_amdgcn_exp2f(m1 - M1) + pl1 * __builtin_amdgcn_exp2f(pm1 - M1); m1 = M1;
      l2 = l2 * __builtin_amdgcn_exp2f(m2 - M2) + pl2 * __builtin_amdgcn_exp2f(pm2 - M2); m2 = M2; }
    const float il1 = 1.0f / l1, il2 = lam / l2;
    f32x16 O[4];
#pragma unroll
    for (int d = 0; d < 4; ++d) O[d] = (f32x16){};
    at_load(S, U, 0, true, tid);
    __syncthreads();
    at_store(S, lds, 0, true, tid);
    __syncthreads();
    for (int kt = 0; kt < ntiles; ++kt) {
        if (kt + 1 < ntiles) at_load(S, U, kt + 1, true, tid);
        const bool vis = active && kt <= qchunk;
        if (vis) {
            const int mode = (kt * 64 + 63 >= U.nkeys) ? 2 : ((kt * 64 + 32 * pi + 31 - (U.qpos0 + 32 * rt)) <= -91 ? 0 : 1);
            int lv = lane; asm volatile("" : "+v"(lv)); const int c = lv & 31, hh = lv >> 5; const int qpos_lane = U.qpos0 + 32 * rt + c;
            float wv[16];
            { f32x16 t1, t2; at_scores2<4>(lds, U, qf, AT_K + (kt & 1) * 32768, kt, pi, qpos_lane, mode, t1, t2, c, hh);
#pragma unroll
              for (int i = 0; i < 16; ++i) wv[i] = __builtin_amdgcn_exp2f(t1[i] - m1) * il1 - __builtin_amdgcn_exp2f(t2[i] - m2) * il2; }
#pragma unroll
            for (int s2 = 0; s2 < 2; ++s2) { v4u pw; pw.x = pk2(wv[8 * s2], wv[8 * s2 + 1]); pw.y = pk2(wv[8 * s2 + 2], wv[8 * s2 + 3]); pw.z = pk2(wv[8 * s2 + 4], wv[8 * s2 + 5]); pw.w = pk2(wv[8 * s2 + 6], wv[8 * s2 + 7]);
                *(LAS v4u*)(lds + AT_W + ((rt * 4 + 2 * pi + s2) * 64 + lv) * 16) = pw; }
        }
        __syncthreads();
        if (vis) {
            int lv = lane; asm volatile("" : "+v"(lv));
            bf16x8 wf[4];
#pragma unroll
            for (int ks = 0; ks < 4; ++ks) wf[ks] = *(const LAS bf16x8*)(lds + AT_W + ((rt * 4 + ks) * 64 + lv) * 16);
            const int vb = (int)(unsigned)(size_t)(lds + AT_V + (kt & 1) * 32768 + pi * 2048) + v_rd_base(lv);
            at_pv_two<0>(O[0], O[1], vb, wf); at_pv_two<2>(O[2], O[3], vb, wf);
        }
        if (kt + 1 < ntiles) at_store(S, lds, (kt + 1) & 1, true, tid);
        __syncthreads();
    }
    {
        int lv = lane; asm volatile("" : "+v"(lv)); const int c = lv & 31, hh = lv >> 5;
        LAS float* xs = (LAS float*)(lds + AT_X) + w * 128;
        float ssa[16];
#pragma unroll
        for (int i = 0; i < 16; ++i) { float a = 0.f;
#pragma unroll
            for (int d = 0; d < 4; ++d) a += O[d][i] * O[d][i];
            a += __shfl_xor(a, 1); a += __shfl_xor(a, 2); a += __shfl_xor(a, 4); a += __shfl_xor(a, 8); a += __shfl_xor(a, 16);
            ssa[i] = a; if (c == 0) xs[crow(i, hh)] = a; }
        __syncthreads();
        const LAS float* xo = (const LAS float*)(lds + AT_X) + (w ^ 1) * 128;
        if (active) {
#pragma unroll
            for (int i = 0; i < 16; ++i) { const int r = 32 * rt + crow(i, hh);
                const float sc = rsqrtf((ssa[i] + xo[crow(i, hh)]) * (1.0f / 256.0f) + 1e-5f) * (1.0f - LAM_INIT);
                if (r < U.nq) { bf16* op = ATT + (U.mq0 + r) * DM + U.h * 256 + 128 * pi + c;
#pragma unroll
                    for (int d = 0; d < 4; ++d) op[32 * d] = (bf16)(pk2(O[d][i] * sc * F.in[I_SUBN][128 * pi + 32 * d + c], 0.f) & 0xffffu); } }
        }
    }
}
DI void p_attn(Frame& F) {
    float d1 = 0.f, d2 = 0.f;
    for (int i = 0; i < 128; ++i) { d1 += F.in[I_LQ1][i] * F.in[I_LK1][i]; d2 += F.in[I_LQ2][i] * F.in[I_LK2][i]; }
    const float lam = __expf(d1) - __expf(d2) + LAM_INIT;
    const bf16* KB = (const bf16*)(F.ws + WS_KB); const bf16* VB = (const bf16*)(F.ws + WS_VB);
    const bf16* KC = (const bf16*)(F.ws + WS_KC); const bf16* VC = (const bf16*)(F.ws + WS_VC);
    constexpr int NSU = DECB * 8, NPU = NB * 8 * 64;
    for (;;) {
        __syncthreads();
        if (F.tid == 0) F.MISC[16] = atomicAdd(F.ctl + CW_ATTQ, 1u);
        __syncthreads();
        const int p = (int)F.MISC[16];
        if (p >= NSU + NPU) break;
        AttnUnit U;
        if (p < NSU) { const int b = p >> 3; U.h = p & 7; U.Kp = KC + (size_t)b * (PAST + DECS) * DM; U.Vp = VC + (size_t)b * (PAST + DECS) * DM; U.nq = DECS; U.qpos0 = PAST; U.nkeys = PAST + DECS; U.mq0 = (size_t)MP + (size_t)b * DECS; }
        else { const int r = p - NSU, bh = r >> 6, u = 63 - (r & 63), b = bh >> 3; U.h = bh & 7; U.Kp = KB + (size_t)b * SEQ * DM; U.Vp = VB + (size_t)b * SEQ * DM; U.nq = 128; U.qpos0 = u * 128; U.nkeys = (u + 1) * 128; U.mq0 = (size_t)b * SEQ + (size_t)u * 128; }
        attn_unit(F, U, lam);
    }
}
#ifndef N_LAUNCH_MODE
#define N_LAUNCH_MODE 1
#endif
constexpr int N_PHASES = 16;
struct Args { const float* in[N_IN]; float* out; unsigned char* ws; int ph_lo, ph_hi; };
static_assert(sizeof(Args) == (N_IN + 2) * 8 + 8, "Args has no padding");
__global__ void __launch_bounds__(NWAVES * 64, 2) fwd(Args args) {
    extern __shared__ __attribute__((aligned(16))) unsigned char lds_raw[];
    Frame F;
    F.lds = (LAS unsigned char*)lds_raw;
    F.MISC = (volatile LAS unsigned*)(F.lds + LDSCTL_OFF);
    F.tid = threadIdx.x; F.lane = F.tid & 63; F.wave = __builtin_amdgcn_readfirstlane(F.tid >> 6);
    F.G = gridDim.x; { const int bx = blockIdx.x; F.vcu = (F.G % 8 == 0) ? (bx % 8) * (F.G / 8) + bx / 8 : bx; }
    F.in = args.in; F.out = args.out; F.ws = args.ws; F.ctl = (unsigned*)(args.ws + WS_CTL);
    for (int u = F.tid; u < (LDS_BYTES - LDSCTL_OFF) / 4; u += NWAVES * 64) ((LAS unsigned*)(F.lds + LDSCTL_OFF))[u] = 0u;
    __syncthreads();
    XcdBarrier bar; bar.bar = F.ctl + CW_BAR; bar.x = 0; bar.st = nullptr;
    if (N_LAUNCH_MODE == 1) bar = xcd_barrier_post(F.ctl + CW_BAR, F.MISC + 8);
    const int lo = args.ph_lo, hi = args.ph_hi;
#ifndef PHASE_MASK
#define PHASE_MASK 0xffff
#endif
#define IN(k) (((PHASE_MASK >> (k)) & 1) && lo <= (k) && (k) < hi)
#ifndef TWICE_MASK
#define TWICE_MASK 0
#endif
#define SEAM(k) do { if (IN(k) && IN((k) + 1)) xcd_barrier(bar); } while (0)
#define REP(k) for (int rep_ = 0; rep_ < (((TWICE_MASK >> (k)) & 1) ? 2 : 1); ++rep_, (((TWICE_MASK >> (k)) & 1) && rep_ == 1 ? xcd_barrier(bar) : (void)0))
    unsigned char* ws = args.ws;
    PG8_LAS unsigned char* ring = (PG8_LAS unsigned char*)F.lds;
    bf16* HB = (bf16*)(ws + WS_HB);
    float* H = args.out;
#define SSQP(i) ((float*)(ws + WS_SSQ + (size_t)(i) * SSQ_STRIDE))

    if (IN(0)) { REP(0) p0_prologue(F); } SEAM(0);
    if (IN(1)) {
        pg8::Gemm g{HB, (const bf16*)(ws + WS_WIN), M, INWP, DM}; pg8::StaticOrder S; S.init(M, INWP, F.G, (int)blockIdx.x);
        pg8::EpiBf E{SSQP(0), (bf16*)(ws + WS_QKV), QKVW, QKVW, (bf16*)(ws + WS_Z), VW, VW, (float*)(ws + WS_BA), 64, 64};
        pg8::gemm_phase<pg8::EpiBf, pg8::StaticOrder, PG8_ALIGN, PG8_SP2>(ring, g, S, E);
    } SEAM(1);
    if (IN(2)) { REP(2) p_gdnconv(F); } SEAM(2);
    if (IN(3)) { REP(3) p_prep(F); } SEAM(3);
    if (IN(4)) { REP(4) p_scan(F); } SEAM(4);
    if (IN(5)) {
        pg8::Gemm g{(const bf16*)(args.out + O_PK), (const bf16*)(ws + WS_WOUT), M, DM, VW}; pg8::StaticOrder S; S.init(M, DM, F.G, (int)blockIdx.x);
        pg8::EpiRes E{args.in[I_XP], args.in[I_XS] - (size_t)MP * DM, H, HB, SSQP(1)};
        pg8::gemm_phase<pg8::EpiRes, pg8::StaticOrder, PG8_ALIGN, PG8_SP2>(ring, g, S, E);
    } SEAM(5);
    if (IN(6)) {
        pg8::Gemm g{HB, (const bf16*)(ws + WS_WUP0), M, UPW, DM}; pg8::StaticOrder S; S.init(M, UPW, F.G, (int)blockIdx.x);
        pg8::EpiBf E{SSQP(1), (bf16*)(ws + WS_UP), UPW, UPW, nullptr, 0, 0, nullptr, 0, 0};
        pg8::gemm_phase<pg8::EpiBf, pg8::StaticOrder, PG8_ALIGN, PG8_SP2>(ring, g, S, E);
    } SEAM(6);
    if (IN(7)) { REP(7) p_ffnconv(F, 0); } SEAM(7);
    if (IN(8)) {
        pg8::Gemm g{(const bf16*)(ws + WS_ACT), (const bf16*)(ws + WS_WDN0), M, DM, DFF}; pg8::StaticOrder S; S.init(M, DM, F.G, (int)blockIdx.x);
        pg8::EpiRes E{H, H, H, HB, SSQP(2)};
        pg8::gemm_phase<pg8::EpiRes, pg8::StaticOrder, PG8_ALIGN, PG8_SP2>(ring, g, S, E);
        p_cacheconv(F, args.in[I_CK], (bf16*)(ws + WS_KC));
    } SEAM(8);
    if (IN(9)) {
        pg8::Gemm g{HB, (const bf16*)(ws + WS_WKVQ), M, 6144, DM}; pg8::StaticOrder S; S.init(M, 6144, F.G, (int)blockIdx.x);
        pg8::EpiKVQ E{SSQP(2), args.out, (bf16*)(ws + WS_KB), (WS_VB - WS_KB) / 2, (bf16*)(ws + WS_KC), (WS_VC - WS_KC) / 2};
        static_assert(WS_QB - WS_VB == WS_VB - WS_KB, "K, V, Q bf16 buffers equally spaced");
        pg8::gemm_phase<pg8::EpiKVQ, pg8::StaticOrder, PG8_ALIGN, PG8_SP2>(ring, g, S, E);
        p_cacheconv(F, args.in[I_CV], (bf16*)(ws + WS_VC));
    } SEAM(9);
    if (IN(10)) { REP(10) p_attn(F); } SEAM(10);
    if (IN(11)) {
        pg8::Gemm g{(const bf16*)(ws + WS_ATT), (const bf16*)(ws + WS_WO), M, DM, DM}; pg8::StaticOrder S; S.init(M, DM, F.G, (int)blockIdx.x);
        pg8::EpiRes E{H, H, H, HB, SSQP(3)};
        pg8::gemm_phase<pg8::EpiRes, pg8::StaticOrder, PG8_ALIGN, PG8_SP2>(ring, g, S, E);
    } SEAM(11);
    if (IN(12)) {
        pg8::Gemm g{HB, (const bf16*)(ws + WS_WUP1), M, UPW, DM}; pg8::StaticOrder S; S.init(M, UPW, F.G, (int)blockIdx.x);
        pg8::EpiBf E{SSQP(3), (bf16*)(ws + WS_UP), UPW, UPW, nullptr, 0, 0, nullptr, 0, 0};
        pg8::gemm_phase<pg8::EpiBf, pg8::StaticOrder, PG8_ALIGN, PG8_SP2>(ring, g, S, E);
    } SEAM(12);
    if (IN(13)) { p_ffnconv(F, 1); } SEAM(13);
    if (IN(14)) {
        pg8::Gemm g{(const bf16*)(ws + WS_ACT), (const bf16*)(ws + WS_WDN1), M, DM, DFF}; pg8::StaticOrder S; S.init(M, DM, F.G, (int)blockIdx.x);
        pg8::EpiRes E{H, H, H, nullptr, SSQP(4)};
        pg8::gemm_phase<pg8::EpiRes, pg8::StaticOrder, PG8_ALIGN, PG8_SP2>(ring, g, S, E);
    } SEAM(14);
    if (IN(15)) { p_final(F); }
#undef IN
#undef SEAM
}

extern "C" void kernel_launch(void* const* d_in, const int* in_sizes, int n_in, void* d_out, int out_size, void* d_ws, size_t ws_size, hipStream_t stream) {
    static int grid = 0;
    if (grid == 0) {
        if (n_in != N_IN || (size_t)out_size != O_END || ws_size < WS_END) { fprintf(stderr, "kernel_launch: shape mismatch: n_in %d out %d ws %zu (need %zu)\n", n_in, out_size, ws_size, (size_t)WS_END); grid = -1; return; }
        int dev = 0, cus = 0;
        if (hipGetDevice(&dev) != hipSuccess || hipDeviceGetAttribute(&cus, hipDeviceAttributeMultiprocessorCount, dev) != hipSuccess) { grid = -1; return; }
        if (hipFuncSetAttribute((const void*)fwd, hipFuncAttributeMaxDynamicSharedMemorySize, LDS_BYTES) != hipSuccess) { fprintf(stderr, "kernel_launch: hipFuncSetAttribute failed\n"); grid = -1; return; }
        int per_cu = 0;
        if (hipOccupancyMaxActiveBlocksPerMultiprocessor(&per_cu, (const void*)fwd, NWAVES * 64, LDS_BYTES) != hipSuccess || per_cu < 1) fprintf(stderr, "kernel_launch: occupancy query reports %d\n", per_cu);
        (void)hipGetLastError();
        grid = cus;
    }
    if (grid < 0) return;
    (void)hipMemsetAsync((char*)d_ws + WS_CTL, 0, CTL_ZERO_BYTES, stream);
    Args a{};
    for (int i = 0; i < N_IN; ++i) a.in[i] = (const float*)d_in[i];
    a.out = (float*)d_out; a.ws = (unsigned char*)d_ws;
    if (N_LAUNCH_MODE == 1) { a.ph_lo = 0; a.ph_hi = N_PHASES; hipLaunchKernelGGL(fwd, dim3(grid), dim3(NWAVES * 64), LDS_BYTES, stream, a); }
    else for (int p = 0; p < N_PHASES; ++p) { a.ph_lo = p; a.ph_hi = p + 1; hipLaunchKernelGGL(fwd, dim3(grid), dim3(NWAVES * 64), LDS_BYTES, stream, a); }
    const hipError_t le = hipPeekAtLastError();
    if (le != hipSuccess) fprintf(stderr, "kernel_launch: launch failed: %s\n", hipGetErrorName(le));
}
```

```cpp
#include <hip/hip_runtime.h>
#include <cstdio>
#include <cstdint>

constexpr int DM = 2048;
constexpr int SEQ = 8192, NB = 2, MP = NB * SEQ;
constexpr int DECB = 16, DECS = 16, MS = DECB * DECS;
constexpr int PAST = 2048;
constexpr int M = MP + MS;
constexpr int QKVW = 8192, VW = 4096, INW = 12352, INWP = 12544;
constexpr int DFF = 5632, UPW = 11264;
constexpr int NITEM_P = NB * 128 * 32, NITEM = NITEM_P + DECB * 32;
constexpr size_t O_Y = 0, O_PGDN = 34078720, O_PGC = 35127296, O_PFC = 35176448, O_PK = 35266560, O_PV = 68820992,
                 O_SGDN = 102375424, O_SGC = 110764032, O_SFC = 111157248, O_SK = 111878144, O_SV = 112402432, O_END = 112926720;
namespace pg8 {
#define PG8_LAS __attribute__((address_space(3)))
typedef unsigned short bf16_t;
typedef short bf16x8 __attribute__((ext_vector_type(8)));
typedef float f32x4 __attribute__((ext_vector_type(4)));
typedef unsigned u32x4 __attribute__((ext_vector_type(4)));
constexpr int BM = 256, BK = 64, HALF = 128, HTB = HALF * BK * 2  , STAGE_BYTES = 8 * HTB, NXCD = 8, WGM = 8;

__host__ __device__ __forceinline__ int lds_byte(int r, int c) { const int st = (r >> 4) * 2 + (c >> 5), rr = r & 15, cc = c & 31, ob = rr * 64 + cc * 2; return st * 1024 + (ob ^ (((ob >> 9) & 1) << 5)); }
__host__ __device__ __forceinline__ void stage_rc(int b, int& R, int& C) { const int st = b / 1024, sb = b % 1024, swz = sb ^ (((sb >> 9) & 1) << 5); R = (st >> 1) * 16 + swz / 64; C = (st & 1) * 32 + (swz % 64) / 2; }
__host__ __device__ __forceinline__ int perm32(int rho) { const int n = rho >> 4, i = rho & 15; return 8 * (i >> 2) + 4 * n + (i & 3); }

struct Unit { int pm, pn; };
struct Gemm { const bf16_t* A; const bf16_t* Bt; int M, N, K; };

struct StaticOrder {
    int nM, nN, nwg, G, c;
    __host__ __device__ void init(int M, int N, int G_, int c_) { nM = M / BM; nN = N / BM; nwg = nM * nN; G = G_; c = c_; }
    __host__ __device__ bool next(int i, Unit& u) const {
        const long L = (long)i * G + c; if (L >= nwg) return false;
        int wgid = (int)L; { const int q = nwg / NXCD, r = nwg % NXCD, xcd = wgid % NXCD, off = wgid / NXCD; wgid = (xcd < r ? xcd * (q + 1) : r * (q + 1) + (xcd - r) * q) + off; }
        const int nig = WGM * nN, gid = wgid / nig, fm = gid * WGM, gsz = (nM - fm) < WGM ? (nM - fm) : WGM;
        u.pm = fm + ((wgid % nig) % gsz); u.pn = (wgid % nig) / gsz; return true;
    }
    __device__ __forceinline__ void a_ready(const Unit&) const {}
    __device__ __forceinline__ void done(const Unit&) const {}
};

typedef float f32x2 __attribute__((ext_vector_type(2)));
typedef __bf16 bf16v2 __attribute__((ext_vector_type(2)));
typedef unsigned u32x2 __attribute__((ext_vector_type(2)));
__device__ __forceinline__ unsigned cvt_pk_bf16(float lo, float hi) { const f32x2 v = {lo, hi}; return __builtin_bit_cast(unsigned, __builtin_convertvector(v, bf16v2)); }

__device__ __forceinline__ void row_rstd(const float* ssq, int row0, int fq, float (&rs)[2][4]) {
#pragma unroll
    for (int ai = 0; ai < 2; ++ai)
#pragma unroll
        for (int m = 0; m < 4; ++m) {
            const float* p = ssq + (size_t)(row0 + ai * HALF + m * 16) * 32 + fq * 8;
            const f32x4 a = *(const f32x4*)p, b = *(const f32x4*)(p + 4);
            float s = ((a[0] + a[1]) + (a[2] + a[3])) + ((b[0] + b[1]) + (b[2] + b[3]));
            s += __shfl_xor(s, 16); s += __shfl_xor(s, 32);
            rs[ai][m] = rsqrtf(s * (1.0f / 2048.0f) + 1e-6f);
        }
}
struct EpiBf {
    static constexpr bool PERM = true, AFTER_DRAIN = false;
    const float* ssq; bf16_t* O0; int ld0, nc0; bf16_t* O1; int ld1, nc1; float* F2; int ld2, nc2;
    __device__ __forceinline__ void operator()(const f32x4 (&acc)[2][2][4][2], const Unit& u, int wr, int wc, int fr, int fq) const {
        const int row0 = u.pm * BM + wr * 64 + fr; const int colt = u.pn * BM;
        float rs[2][4]; row_rstd(ssq, row0, fq, rs);
        if (colt < nc0 + nc1) {
            bf16_t* base; int ld;
            if (colt < nc0) { base = O0 + colt; ld = ld0; } else { base = O1 + (colt - nc0); ld = ld1; }
            const int col0 = wc * 32 + 8 * fq;
#pragma unroll
            for (int ai = 0; ai < 2; ++ai)
#pragma unroll
                for (int m = 0; m < 4; ++m) { bf16_t* rowp = base + (size_t)(row0 + ai * HALF + m * 16) * ld + col0; const float r = rs[ai][m];
#pragma unroll
                    for (int bj = 0; bj < 2; ++bj) { const f32x4 v0 = acc[ai][bj][m][0] * r, v1 = acc[ai][bj][m][1] * r;
                        u32x4 w; w.x = cvt_pk_bf16(v0[0], v0[1]); w.y = cvt_pk_bf16(v0[2], v0[3]); w.z = cvt_pk_bf16(v1[0], v1[1]); w.w = cvt_pk_bf16(v1[2], v1[3]);
                        *(u32x4*)(rowp + bj * HALF) = w; } }
        } else if (colt == nc0 + nc1 && F2 != nullptr && wc * 32 < nc2) {
#pragma unroll
            for (int ai = 0; ai < 2; ++ai)
#pragma unroll
                for (int m = 0; m < 4; ++m) { float* rowp = F2 + (size_t)(row0 + ai * HALF + m * 16) * ld2 + wc * 32 + 8 * fq; const float r = rs[ai][m];
                    *(f32x4*)(rowp) = acc[ai][0][m][0] * r; *(f32x4*)(rowp + 4) = acc[ai][0][m][1] * r; }
        }
    }
};
struct EpiRes {
    static constexpr bool PERM = false, AFTER_DRAIN = false;
    const float* base0; const float* base1; float* out; bf16_t* hb; float* ssq;
    __device__ __forceinline__ void operator()(const f32x4 (&acc)[2][2][4][2], const Unit& u, int wr, int wc, int fr, int fq) const {
        const int row0 = u.pm * BM + wr * 64 + fr, col0 = u.pn * BM + wc * 32 + 4 * fq;
        const float* bs = (u.pm * BM < MP) ? base0 : base1;
#pragma unroll
        for (int ai = 0; ai < 2; ++ai)
#pragma unroll
            for (int m = 0; m < 4; ++m) { const size_t off = (size_t)(row0 + ai * HALF + m * 16) * DM + col0; float ss = 0.f;
#pragma unroll
                for (int bj = 0; bj < 2; ++bj)
#pragma unroll
                    for (int n = 0; n < 2; ++n) { const size_t o2 = off + bj * HALF + n * 16; const f32x4 o = *(const f32x4*)(bs + o2) + acc[ai][bj][m][n];
                        *(f32x4*)(out + o2) = o; ss += (o[0] * o[0] + o[1] * o[1]) + (o[2] * o[2] + o[3] * o[3]);
                        if (hb) { u32x2 w; w.x = cvt_pk_bf16(o[0], o[1]); w.y = cvt_pk_bf16(o[2], o[3]); *(u32x2*)(hb + o2) = w; } }
                ss += __shfl_xor(ss, 16); ss += __shfl_xor(ss, 32);
                if (fq == 0) ssq[(size_t)(row0 + ai * HALF + m * 16) * 32 + u.pn * 4 + wc] = ss; }
    }
};
struct EpiKVQ {
    static constexpr bool PERM = false, AFTER_DRAIN = false;
    const float* ssq; float* dout; bf16_t* KB; size_t kvq_stride; bf16_t* KC; size_t kc_stride;
    __device__ __forceinline__ void operator()(const f32x4 (&acc)[2][2][4][2], const Unit& u, int wr, int wc, int fr, int fq) const {
        const int row0 = u.pm * BM + wr * 64 + fr; const int colt = u.pn * BM, which = colt >> 11, cb = (colt & 2047) + wc * 32 + 4 * fq;
        float rs[2][4]; row_rstd(ssq, row0, fq, rs);
        bf16_t* bb = KB + (size_t)which * kvq_stride;
        float* fo = nullptr;
        if (which < 2) fo = (u.pm * BM < MP) ? dout + O_PK + (size_t)which * (O_PV - O_PK) : dout + O_SK + (size_t)which * (O_SV - O_SK) - (size_t)MP * DM;
#pragma unroll
        for (int ai = 0; ai < 2; ++ai)
#pragma unroll
            for (int m = 0; m < 4; ++m) { const size_t off = (size_t)(row0 + ai * HALF + m * 16) * DM + cb; const float r = rs[ai][m];
#pragma unroll
                for (int bj = 0; bj < 2; ++bj)
#pragma unroll
                    for (int n = 0; n < 2; ++n) { const size_t o2 = off + bj * HALF + n * 16; const f32x4 o = acc[ai][bj][m][n] * r;
                        if (fo) *(f32x4*)(fo + o2) = o;
                        u32x2 w; w.x = cvt_pk_bf16(o[0], o[1]); w.y = cvt_pk_bf16(o[2], o[3]); *(u32x2*)(bb + o2) = w;
                        if (which < 2 && u.pm * BM >= MP) { const int ms = row0 + ai * HALF + m * 16 - MP;
                            *(u32x2*)(KC + (size_t)which * kc_stride + ((size_t)(ms >> 4) * (2048 + 16) + 2048 + (ms & 15)) * DM + cb + bj * HALF + n * 16) = w; } } }
    }
};

template <class Epi, class Sched, bool ALIGN_EPI = false, bool SP2 = false>
__device__ __forceinline__ void gemm_phase(PG8_LAS unsigned char* lds, const Gemm g, const Sched& S, const Epi& E) {
    const int tid = threadIdx.x, wid = __builtin_amdgcn_readfirstlane(tid >> 6), lane = tid & 63, wr = wid >> 2, wc = wid & 3, fr = lane & 15, fq = lane >> 4;
    const int K = g.K, nt = K / BK;
    unsigned voffA[2], voffB[2];
#pragma unroll
    for (int i = 0; i < 2; ++i) { int R, C; stage_rc(tid * 16 + i * 8192, R, C); const int Rb = Epi::PERM ? ((R & ~31) + perm32(R & 31)) : R;
        voffA[i] = (unsigned)(R * K + C) * 2u; voffB[i] = (unsigned)(Rb * K + C) * 2u; }
    const size_t kstep = (size_t)(BK * 2);
    const size_t hstep = (size_t)HALF * K * 2;
    const size_t tstep = 2 * hstep;
    const unsigned ldsw = (unsigned)wid * 1024u;
    const int aoff = lds_byte(wr * 64 + fr, fq * 8), boff = lds_byte(wc * 32 + fr, fq * 8);
#define PG8_SA(b, h) (((b) * 2 + (h)) * HTB)
#define PG8_SB(b, h) ((4 + (b) * 2 + (h)) * HTB)
#define PG8_STAGE(bufoff, gbase, voff) do { _Pragma("unroll") for (int _i = 0; _i < 2; ++_i) \
        __builtin_amdgcn_global_load_lds((const unsigned*)((const char*)(gbase) + (voff)[_i]), (PG8_LAS unsigned*)(lds + (bufoff) + ldsw + _i * 8192), 16, 0, 0); } while (0)
#define PG8_LDA(dst, b, h) do { _Pragma("unroll") for (int m = 0; m < 4; ++m) _Pragma("unroll") for (int k = 0; k < 2; ++k) dst[m][k] = *(const PG8_LAS bf16x8*)(lds + PG8_SA(b, h) + aoff + m * 2048 + k * 1024); } while (0)
#define PG8_LDB(dst, b, h) do { _Pragma("unroll") for (int n = 0; n < 2; ++n) _Pragma("unroll") for (int k = 0; k < 2; ++k) dst[n][k] = *(const PG8_LAS bf16x8*)(lds + PG8_SB(b, h) + boff + n * 2048 + k * 1024); } while (0)
#define PG8_MMA(ai, bj, At, Bt) do { __builtin_amdgcn_s_setprio(1); _Pragma("unroll") for (int m = 0; m < 4; ++m) _Pragma("unroll") for (int n = 0; n < 2; ++n) _Pragma("unroll") for (int k = 0; k < 2; ++k) \
        acc[ai][bj][m][n] = __builtin_amdgcn_mfma_f32_16x16x32_bf16(Bt[n][k], At[m][k], acc[ai][bj][m][n], 0, 0, 0); __builtin_amdgcn_s_setprio(0); } while (0)
#define PG8_WAIT_V(n) asm volatile("s_waitcnt vmcnt(" #n ")" ::: "memory")
#define PG8_WAIT_L(n) asm volatile("s_waitcnt lgkmcnt(" #n ")" ::: "memory")
#define PG8_BAR __builtin_amdgcn_s_barrier()
#define PG8_SCHED __builtin_amdgcn_sched_barrier(0)
    Unit cur, nxt; int ui = 0;
    if (!S.next(0, cur)) return;
    f32x4 acc[2][2][4][2];
#pragma unroll
    for (int a = 0; a < 2; ++a)
#pragma unroll
        for (int b = 0; b < 2; ++b)
#pragma unroll
            for (int m = 0; m < 4; ++m)
#pragma unroll
                for (int n = 0; n < 2; ++n) acc[a][b][m][n] = (f32x4){0.f, 0.f, 0.f, 0.f};
    bf16x8 At[4][2], B0[2][2], B1[2][2];
    const char* cA = (const char*)g.A + (size_t)cur.pm * tstep; const char* cB = (const char*)g.Bt + (size_t)cur.pn * tstep;
    S.a_ready(cur);
    if constexpr (SP2) {
        PG8_STAGE(PG8_SB(0, 0), cB, voffB); PG8_STAGE(PG8_SB(0, 1), cB + hstep, voffB); PG8_STAGE(PG8_SA(0, 0), cA, voffA); PG8_STAGE(PG8_SA(0, 1), cA + hstep, voffA);
        if (wr == 1) PG8_BAR;
        PG8_WAIT_V(2); PG8_BAR;
        PG8_STAGE(PG8_SB(1, 0), cB + kstep, voffB); PG8_STAGE(PG8_SA(1, 0), cA + kstep, voffA); PG8_STAGE(PG8_SB(1, 1), cB + hstep + kstep, voffB);
        PG8_WAIT_V(6); PG8_BAR;
    } else {
        PG8_STAGE(PG8_SB(0, 0), cB, voffB); PG8_STAGE(PG8_SA(0, 0), cA, voffA); PG8_STAGE(PG8_SB(0, 1), cB + hstep, voffB); PG8_STAGE(PG8_SA(0, 1), cA + hstep, voffA);
        if (wr == 1) PG8_BAR;
        PG8_WAIT_V(4); PG8_BAR;
        PG8_STAGE(PG8_SB(1, 0), cB + kstep, voffB); PG8_STAGE(PG8_SA(1, 0), cA + kstep, voffA); PG8_STAGE(PG8_SB(1, 1), cB + hstep + kstep, voffB);
        PG8_WAIT_V(6); PG8_BAR;
    }
    for (;;) {
        const bool has_next = S.next(ui + 1, nxt);
        const char* nA = has_next ? (const char*)g.A + (size_t)nxt.pm * tstep : cA; const char* nB = has_next ? (const char*)g.Bt + (size_t)nxt.pn * tstep : cB;
        for (int t = 0; t < nt; t += 2) {
            const bool last = (t == nt - 2);
            const char* a1 = cA + (size_t)(t + 1) * kstep;
            const char* a2 = last ? nA : cA + (size_t)(t + 2) * kstep; const char* b2 = last ? nB : cB + (size_t)(t + 2) * kstep;
            const char* a3 = a2 + kstep; const char* b3 = b2 + kstep;
            if (last && has_next) S.a_ready(nxt);
            if constexpr (SP2) {
            PG8_LDB(B0, 0, 0); PG8_LDB(B1, 0, 1); PG8_SCHED; PG8_LDA(At, 0, 0); PG8_STAGE(PG8_SA(1, 1), a1 + hstep, voffA);
            PG8_WAIT_V(8); PG8_WAIT_L(0); PG8_BAR; PG8_MMA(0, 0, At, B0); PG8_MMA(0, 1, At, B1); PG8_BAR; PG8_SCHED;
            PG8_LDA(At, 0, 1); PG8_STAGE(PG8_SB(0, 0), b2, voffB); PG8_STAGE(PG8_SB(0, 1), b2 + hstep, voffB); PG8_STAGE(PG8_SA(0, 0), a2, voffA);
            PG8_WAIT_V(8); PG8_WAIT_L(0); PG8_BAR; PG8_MMA(1, 0, At, B0); PG8_MMA(1, 1, At, B1); PG8_BAR; PG8_SCHED;
            PG8_LDB(B0, 1, 0); PG8_LDB(B1, 1, 1); PG8_SCHED; PG8_LDA(At, 1, 0); PG8_STAGE(PG8_SA(0, 1), a2 + hstep, voffA);
            PG8_WAIT_V(8); PG8_WAIT_L(0); PG8_BAR; PG8_MMA(0, 0, At, B0); PG8_MMA(0, 1, At, B1); PG8_BAR; PG8_SCHED;
            PG8_LDA(At, 1, 1); PG8_STAGE(PG8_SB(1, 0), b3, voffB); PG8_STAGE(PG8_SB(1, 1), b3 + hstep, voffB); PG8_STAGE(PG8_SA(1, 0), a3, voffA);
            PG8_WAIT_V(8); PG8_WAIT_L(0); PG8_BAR; PG8_MMA(1, 0, At, B0); PG8_MMA(1, 1, At, B1); PG8_BAR; PG8_SCHED;
            } else {
            PG8_LDB(B0, 0, 0); PG8_SCHED; PG8_LDA(At, 0, 0); PG8_STAGE(PG8_SA(1, 1), a1 + hstep, voffA);
            PG8_WAIT_L(8); PG8_BAR; PG8_WAIT_L(0); PG8_MMA(0, 0, At, B0); PG8_BAR; PG8_SCHED;
            PG8_LDB(B1, 0, 1); PG8_STAGE(PG8_SB(0, 0), b2, voffB);
            PG8_BAR; PG8_WAIT_L(0); PG8_MMA(0, 1, At, B1); PG8_BAR;
            PG8_LDA(At, 0, 1); PG8_STAGE(PG8_SA(0, 0), a2, voffA);
            PG8_BAR; PG8_WAIT_L(0); PG8_MMA(1, 0, At, B0); PG8_BAR; PG8_SCHED;
            PG8_STAGE(PG8_SB(0, 1), b2 + hstep, voffB);
            PG8_WAIT_V(6); PG8_BAR; PG8_MMA(1, 1, At, B1); PG8_BAR;
            PG8_LDB(B0, 1, 0); PG8_SCHED; PG8_LDA(At, 1, 0); PG8_STAGE(PG8_SA(0, 1), a2 + hstep, voffA);
            PG8_WAIT_L(8); PG8_BAR; PG8_WAIT_L(0); PG8_MMA(0, 0, At, B0); PG8_BAR; PG8_SCHED;
            PG8_LDB(B1, 1, 1); PG8_STAGE(PG8_SB(1, 0), b3, voffB);
            PG8_BAR; PG8_WAIT_L(0); PG8_MMA(0, 1, At, B1); PG8_BAR;
            PG8_LDA(At, 1, 1); PG8_STAGE(PG8_SA(1, 0), a3, voffA);
            PG8_BAR; PG8_WAIT_L(0); PG8_MMA(1, 0, At, B0); PG8_BAR; PG8_SCHED;
            PG8_STAGE(PG8_SB(1, 1), b3 + hstep, voffB);
            PG8_WAIT_V(6); PG8_BAR; PG8_MMA(1, 1, At, B1); PG8_BAR;
            }
        }
        if constexpr (ALIGN_EPI) { if (wr == 0) PG8_BAR; }
        if constexpr (!Epi::AFTER_DRAIN) { E(acc, cur, wr, wc, fr, fq); S.done(cur); }
        if (!has_next) break;
#pragma unroll
        for (int a = 0; a < 2; ++a)
#pragma unroll
            for (int b = 0; b < 2; ++b)
#pragma unroll
                for (int m = 0; m < 4; ++m)
#pragma unroll
                    for (int n = 0; n < 2; ++n) acc[a][b][m][n] = (f32x4){0.f, 0.f, 0.f, 0.f};
        cur = nxt; cA = nA; cB = nB; ++ui;
        if constexpr (ALIGN_EPI) { if (wr == 1) PG8_BAR; }
    }
    PG8_WAIT_V(0);
    if constexpr (!ALIGN_EPI) { if (wr == 0) PG8_BAR; }
    PG8_BAR;
    if constexpr (Epi::AFTER_DRAIN) { E.fused(acc, cur, wr, wc, fr, fq, lds, wid, lane); S.done(cur); }
#undef PG8_SA
#undef PG8_SB
#undef PG8_STAGE
#undef PG8_LDA
#undef PG8_LDB
#undef PG8_MMA
#undef PG8_WAIT_V
#undef PG8_WAIT_L
#undef PG8_BAR
#undef PG8_SCHED
}
}
#ifndef PG8_SP2
#define PG8_SP2 true
#endif
#ifndef PG8_ALIGN
#define PG8_ALIGN true
#endif

constexpr size_t MiB = 1u << 20;
constexpr size_t WS_CTL = 0, CTL_ZERO_BYTES = 1 * MiB;
constexpr size_t WS_SSQ = 1 * MiB, SSQ_STRIDE = 2359296;
constexpr size_t WS_BA = 13 * MiB;
constexpr size_t WS_EG = 18 * MiB, WS_DL = 21 * MiB, WS_GL = 24 * MiB;
constexpr size_t WS_WIN = 32 * MiB, WS_WOUT = 81 * MiB, WS_WUP0 = 97 * MiB, WS_WDN0 = 141 * MiB, WS_WKVQ = 163 * MiB, WS_WO = 187 * MiB, WS_WUP1 = 195 * MiB, WS_WDN1 = 239 * MiB;
constexpr size_t WS_HB = 261 * MiB;
constexpr size_t WS_RA = 326 * MiB;
constexpr size_t WS_QKV = WS_RA, WS_Z = WS_RA + 260 * MiB, WS_UP = WS_RA;
constexpr size_t WS_KC = WS_RA, WS_VC = WS_RA + 130 * MiB;
static_assert(WS_KC + (size_t)DECB * (PAST + DECS) * DM * 2 <= WS_VC && WS_VC + (size_t)DECB * (PAST + DECS) * DM * 2 <= WS_RA + 390 * MiB, "cache copies");
constexpr size_t WS_RB = 716 * MiB;
constexpr size_t WS_QN = WS_RB, WS_KN = WS_RB + 65 * MiB, WS_VV = WS_RB + 130 * MiB, WS_TP = WS_RB + 260 * MiB, WS_PP = WS_RB + 328 * MiB;
constexpr size_t WS_ACT = WS_RB;
constexpr size_t WS_KB = WS_RB, WS_VB = WS_RB + 65 * MiB, WS_QB = WS_RB + 130 * MiB, WS_ATT = WS_RB + 195 * MiB;
constexpr size_t WS_END = 1112 * MiB;
static_assert((size_t)M * 32 * 4 <= SSQ_STRIDE && WS_SSQ + 5 * SSQ_STRIDE <= WS_BA && WS_BA + (size_t)M * 64 * 4 <= WS_EG && WS_EG + (size_t)NITEM * 256 <= WS_DL && WS_DL + (size_t)NITEM * 256 <= WS_GL && WS_GL + NITEM * 4 <= WS_WIN, "small buffers");
static_assert(WS_WIN + (size_t)INWP * DM * 2 <= WS_WOUT && WS_WDN1 + (size_t)DM * DFF * 2 <= WS_HB && WS_HB + (size_t)M * DM * 2 <= WS_RA, "weights / HB");
static_assert(WS_QKV + (size_t)M * QKVW * 2 <= WS_Z && WS_Z + (size_t)M * VW * 2 <= WS_RB && WS_UP + (size_t)M * UPW * 2 <= WS_RB, "region A");
static_assert(WS_QN + (size_t)M * DM * 2 <= WS_KN && WS_KN + (size_t)M * DM * 2 <= WS_VV && WS_VV + (size_t)M * VW * 2 <= WS_TP && WS_TP + (size_t)NITEM * 8192 <= WS_PP && WS_PP + (size_t)NITEM * 8192 <= WS_END, "region B (gdn)");
static_assert(WS_ACT + (size_t)M * DFF * 2 <= WS_END && WS_ATT + (size_t)M * DM * 2 <= WS_END, "region B");
static_assert((size_t)M * VW * 2 <= (O_SGDN - O_PK) * 4, "ON scratch");
constexpr int CW_BAR = 4096;

constexpr int LDS_BYTES = 159744;
constexpr int LDSCTL_OFF = 158720;
constexpr int NWAVES = 8;

#define GAS __attribute__((address_space(1)))
#define LAS __attribute__((address_space(3)))
#define DI __device__ __forceinline__
typedef unsigned short bf16;
typedef unsigned v4u __attribute__((ext_vector_type(4)));
typedef unsigned v2u __attribute__((ext_vector_type(2)));
typedef float f32x4 __attribute__((ext_vector_type(4)));
typedef float f32x16 __attribute__((ext_vector_type(16)));
typedef short bf16x8 __attribute__((ext_vector_type(8)));
typedef short bf16x4 __attribute__((ext_vector_type(4)));
#define LDS_WAIT() asm volatile("s_waitcnt lgkmcnt(0)" ::: "memory")
#define VM_WAIT() asm volatile("s_waitcnt vmcnt(0)" ::: "memory")
#define MFMA32(a, b, c) __builtin_amdgcn_mfma_f32_32x32x16_bf16((a), (b), (c), 0, 0, 0)
DI unsigned pk2(float lo, float hi) { return pg8::cvt_pk_bf16(lo, hi); }
DI float bf2f(unsigned short b) { return __builtin_bit_cast(float, ((unsigned)b) << 16); }
DI float bflo(unsigned w) { return __builtin_bit_cast(float, w << 16); }
DI float bfhi(unsigned w) { return __builtin_bit_cast(float, w & 0xffff0000u); }
DI void unpack8(const v4u w, float (&f)[8]) { f[0] = bflo(w.x); f[1] = bfhi(w.x); f[2] = bflo(w.y); f[3] = bfhi(w.y); f[4] = bflo(w.z); f[5] = bfhi(w.z); f[6] = bflo(w.w); f[7] = bfhi(w.w); }
DI v4u pack8(const float (&f)[8]) { v4u w; w.x = pk2(f[0], f[1]); w.y = pk2(f[2], f[3]); w.z = pk2(f[4], f[5]); w.w = pk2(f[6], f[7]); return w; }
DI int crow(int r, int hi) { return (r & 3) + 8 * (r >> 2) + 4 * hi; }
DI float wave_sum(float v) {
#pragma unroll
    for (int o = 1; o < 64; o <<= 1) v += __shfl_xor(v, o);
    return v;
}
DI float siluf(float x) { return x * __builtin_amdgcn_rcpf(1.0f + __expf(-x)); }

template <int OFF> DI bf16x4 tr_read(int vb) { bf16x4 r; asm volatile("ds_read_b64_tr_b16 %0, %1 offset:%2" : "=&v"(r) : "v"(vb), "i"(OFF) : "memory"); return r; }
#define XB_TMO      128
#define XB_XCNT(j)  (256  + 64 * (j))
#define XB_XSUB(j)  (1280 + 64 * (j))
#define XB_XGEN(j)  (2304 + 64 * (j))
#define XB_TOP      3328
#define XB_TOPGEN   3392
#define XCD_BAR_WORDS 3456
#define XB_SPIN_CAP (1u << 18)

__device__ __forceinline__ unsigned xb_ld(unsigned* p)              { return __hip_atomic_load(p, __ATOMIC_RELAXED, __HIP_MEMORY_SCOPE_AGENT); }
__device__ __forceinline__ unsigned xb_add(unsigned* p, unsigned v) { return __hip_atomic_fetch_add(p, v, __ATOMIC_RELAXED, __HIP_MEMORY_SCOPE_AGENT); }
__device__ __forceinline__ unsigned xb_xcc_id() { return (unsigned)__builtin_amdgcn_s_getreg((3 << 11) | 20) & 0xFu; }
#define XB_SPIN(cond, bar) do { unsigned _sp = 0; while (cond) { __builtin_amdgcn_s_sleep(1); \
    if ((++_sp & 255u) == 0u) { if (xb_ld(&(bar)[XB_TMO])) break; if (_sp > XB_SPIN_CAP) { atomicAdd(&(bar)[XB_TMO], 1u); break; } } } } while (0)

struct XcdBarrier {
    unsigned* bar; unsigned x;
    volatile LAS unsigned* st;
};

__device__ __forceinline__ XcdBarrier xcd_barrier_post(unsigned* bar, volatile LAS unsigned* st) {
    XcdBarrier b; b.bar = bar; b.x = xb_xcc_id(); b.st = st;
    if (threadIdx.x == 0) (void)xb_add(&bar[XB_XCNT(b.x)], 1u);
    return b;
}
__device__ __forceinline__ void xcd_barrier_complete(unsigned* bar, unsigned x, unsigned& nloc, unsigned& nx) {
    const unsigned G = gridDim.x * gridDim.y * gridDim.z;
    unsigned sum, cnt, mine, sp = 0u;
    for (;;) {
        sum = 0u; cnt = 0u; mine = 0u;
#pragma unroll
        for (unsigned j = 0; j < 16; ++j) { const unsigned c = xb_ld(&bar[XB_XCNT(j)]); sum += c; cnt += (c > 0u) ? 1u : 0u; mine = (j == x) ? c : mine; }
        if (sum == G) break;
        __builtin_amdgcn_s_sleep(1);
        if ((++sp & 255u) == 0u) { if (xb_ld(&bar[XB_TMO])) break; if (sp > XB_SPIN_CAP) { atomicAdd(&bar[XB_TMO], 1u); break; } }
    }
    nloc = mine > 0u ? mine : 1u; nx = cnt > 0u ? cnt : 1u;
}

__device__ __forceinline__ void xcd_barrier(const XcdBarrier& b) {
    asm volatile("s_waitcnt vmcnt(0)" ::: "memory");
    __syncthreads();
    if (threadIdx.x == 0) {
        unsigned* bar = b.bar;
        __builtin_amdgcn_s_waitcnt(0);
        unsigned nloc = b.st[0], nx = b.st[1];
        if (nloc == 0u) { xcd_barrier_complete(bar, b.x, nloc, nx); b.st[0] = nloc; b.st[1] = nx; }
        const unsigned old = xb_add(&bar[XB_XSUB(b.x)], 1u);
        const unsigned gen = old / nloc;
        if (old + 1u == (gen + 1u) * nloc) {
            __builtin_amdgcn_fence(__ATOMIC_RELEASE, "agent");
            asm volatile("s_waitcnt vmcnt(0)" ::: "memory");
            const unsigned og = xb_add(&bar[XB_TOP], 1u);
            const unsigned tg = og / nx;
            if (og + 1u == (tg + 1u) * nx) xb_add(&bar[XB_TOPGEN], 1u);
            else XB_SPIN(xb_ld(&bar[XB_TOPGEN]) == tg, bar);
            __builtin_amdgcn_fence(__ATOMIC_ACQUIRE, "agent");
            xb_add(&bar[XB_XGEN(b.x)], 1u);
            asm volatile("s_waitcnt vmcnt(0)" ::: "memory");
        } else {
            XB_SPIN(xb_ld(&bar[XB_XGEN(b.x)]) == gen, bar);
            __builtin_amdgcn_fence(__ATOMIC_ACQUIRE, "agent");
            asm volatile("s_waitcnt vmcnt(0)" ::: "memory");
        }
    }
    __syncthreads();
}
struct Frame {
    LAS unsigned char* lds;
    volatile LAS unsigned* MISC;
    unsigned* ctl;
    int tid, lane, wave;
    int vcu, G;
    const float* const* in;
    float* out; unsigned char* ws;
};
enum { I_XP = 0, I_XS, I_SGDN, I_SGC, I_SFC, I_CK, I_CV, I_ANORM, I_AWIN, I_AWCONV, I_ALOG, I_ADT, I_AONORM, I_AWOUT, I_KVNORM, I_WKV, I_BNORM, I_BWQ,
       I_LQ1, I_LK1, I_LQ2, I_LK2, I_SUBN, I_BWO, I_RELB, I_FNORM, I_FWUP, I_FWCONV, I_FBCONV, I_FWDN, I_FINAL, N_IN };

DI void p0_transpose_item(const float* W, const float* gain, int K, int N, bf16* WT, int row_off, LAS float* scr, int item, int lane) {
    const int nblk = N / 32, kb = item / nblk, nb = item % nblk, k0 = 64 * kb, n0 = 32 * nb;
#pragma unroll 8
    for (int i = 0; i < 32; ++i) { const int kk = 2 * i + (lane >> 5); const float gk = gain ? gain[k0 + kk] : 1.0f; scr[kk * 33 + (lane & 31)] = W[(size_t)(k0 + kk) * N + n0 + (lane & 31)] * gk; }
    LDS_WAIT(); asm volatile("" ::: "memory");
    const int c = lane & 7;
#pragma unroll
    for (int j = 0; j < 4; ++j) { const int n = (lane >> 3) + 8 * j; const LAS float* s = scr + (8 * c) * 33 + n;
        v4u o; o.x = pk2(s[0 * 33], s[1 * 33]); o.y = pk2(s[2 * 33], s[3 * 33]); o.z = pk2(s[4 * 33], s[5 * 33]); o.w = pk2(s[6 * 33], s[7 * 33]);
        *(v4u*)(WT + (size_t)(row_off + n0 + n) * K + k0 + 8 * c) = o; }
    LDS_WAIT(); asm volatile("" ::: "memory");
}
DI void p0_prologue(Frame& F) {
    LAS float* scr = (LAS float*)(F.lds + F.wave * 16384);
    const int gw = F.vcu * NWAVES + F.wave, NGW = F.G * NWAVES, lane = F.lane;
    unsigned char* ws = F.ws;
    constexpr int I_IN = (DM / 64) * (INW / 32), I_OUT = (VW / 64) * (DM / 32), I_UP = (DM / 64) * (UPW / 32), I_DN = (DFF / 64) * (DM / 32), I_KV = (DM / 64) * (4096 / 32), I_Q = (DM / 64) * (DM / 32), I_O = I_Q;
    constexpr int NITEMS = I_IN + I_OUT + 2 * I_UP + 2 * I_DN + I_KV + I_Q + I_O;
    for (int it = gw; it < NITEMS; it += NGW) {
        int r = it;
        if (r < I_IN) { p0_transpose_item(F.in[I_AWIN], F.in[I_ANORM], DM, INW, (bf16*)(ws + WS_WIN), 0, scr, r, lane); continue; } r -= I_IN;
        if (r < I_OUT) { p0_transpose_item(F.in[I_AWOUT], nullptr, VW, DM, (bf16*)(ws + WS_WOUT), 0, scr, r, lane); continue; } r -= I_OUT;
        if (r < I_UP) { p0_transpose_item(F.in[I_FWUP], F.in[I_FNORM], DM, UPW, (bf16*)(ws + WS_WUP0), 0, scr, r, lane); continue; } r -= I_UP;
        if (r < I_UP) { p0_transpose_item(F.in[I_FWUP] + (size_t)DM * UPW, F.in[I_FNORM] + DM, DM, UPW, (bf16*)(ws + WS_WUP1), 0, scr, r, lane); continue; } r -= I_UP;
        if (r < I_DN) { p0_transpose_item(F.in[I_FWDN], nullptr, DFF, DM, (bf16*)(ws + WS_WDN0), 0, scr, r, lane); continue; } r -= I_DN;
        if (r < I_DN) { p0_transpose_item(F.in[I_FWDN] + (size_t)DFF * DM, nullptr, DFF, DM, (bf16*)(ws + WS_WDN1), 0, scr, r, lane); continue; } r -= I_DN;
        if (r < I_KV) { p0_transpose_item(F.in[I_WKV], F.in[I_KVNORM], DM, 4096, (bf16*)(ws + WS_WKVQ), 0, scr, r, lane); continue; } r -= I_KV;
        if (r < I_Q) { p0_transpose_item(F.in[I_BWQ], F.in[I_BNORM], DM, DM, (bf16*)(ws + WS_WKVQ), 4096, scr, r, lane); continue; } r -= I_Q;
        p0_transpose_item(F.in[I_BWO], nullptr, DM, DM, (bf16*)(ws + WS_WO), 0, scr, r, lane);
    }
    { v4u* z = (v4u*)(ws + WS_WIN + (size_t)INW * DM * 2); const int nz = (INWP - INW) * DM * 2 / 16; const v4u zero = {0u, 0u, 0u, 0u};
      for (int i = gw * 64 + lane; i < nz; i += NGW * 64) z[i] = zero; }
    float* ssq0 = (float*)(ws + WS_SSQ);
    for (int m = gw; m < M; m += NGW) {
        const float* xr = (m < MP) ? F.in[I_XP] + (size_t)m * DM : F.in[I_XS] + (size_t)(m - MP) * DM;
        const f32x4* x4 = (const f32x4*)xr + lane; v2u* o8 = (v2u*)((bf16*)(ws + WS_HB) + (size_t)m * DM) + lane;
        float s = 0.f;
#pragma unroll
        for (int j = 0; j < 8; ++j) { const f32x4 v = x4[64 * j]; s += (v[0] * v[0] + v[1] * v[1]) + (v[2] * v[2] + v[3] * v[3]); v2u w; w.x = pk2(v[0], v[1]); w.y = pk2(v[2], v[3]); o8[64 * j] = w; }
        s = wave_sum(s);
        if (lane < 32) ssq0[(size_t)m * 32 + lane] = (lane == 0) ? s : 0.f;
    }
}
DI void p_gdnconv(Frame& F) {
    const int gw = F.vcu * NWAVES + F.wave, NGW = F.G * NWAVES, lane = F.lane;
    const bf16* QKV = (const bf16*)(F.ws + WS_QKV);
    bf16* QN = (bf16*)(F.ws + WS_QN); bf16* KN = (bf16*)(F.ws + WS_KN); bf16* VV = (bf16*)(F.ws + WS_VV);
    const float* wconv = F.in[I_AWCONV];
    constexpr int NTB = MP / 16 + DECB;
    for (int it = gw; it < NTB * 16; it += NGW) {
        const int tb = it >> 4, cc = it & 15, c0 = cc * 512 + lane * 8;
        const bool samp = tb >= MP / 16; const int b = samp ? tb - MP / 16 : tb >> 9; const int t0 = samp ? 0 : (tb & 511) * 16;
        const size_t mbase = samp ? (size_t)MP + b * 16 : (size_t)b * SEQ; const int L = samp ? DECS : SEQ;
        float w[4][8];
#pragma unroll
        for (int i = 0; i < 4; ++i) { const f32x4 a = *(const f32x4*)(wconv + i * QKVW + c0), bq = *(const f32x4*)(wconv + i * QKVW + c0 + 4);
            w[i][0] = a[0]; w[i][1] = a[1]; w[i][2] = a[2]; w[i][3] = a[3]; w[i][4] = bq[0]; w[i][5] = bq[1]; w[i][6] = bq[2]; w[i][7] = bq[3]; }
        float h[3][8];
#pragma unroll
        for (int j = 0; j < 3; ++j) { const int t = t0 - 3 + j;
            if (t >= 0) { unpack8(*(const v4u*)(QKV + (mbase + t) * QKVW + c0), h[j]); }
            else if (samp) { const float* sp = F.in[I_SGC] + (size_t)(b * 3 + (t + 3)) * QKVW + c0; const f32x4 a = *(const f32x4*)sp, bq = *(const f32x4*)(sp + 4);
                h[j][0] = a[0]; h[j][1] = a[1]; h[j][2] = a[2]; h[j][3] = a[3]; h[j][4] = bq[0]; h[j][5] = bq[1]; h[j][6] = bq[2]; h[j][7] = bq[3]; }
            else {
#pragma unroll
                for (int e = 0; e < 8; ++e) h[j][e] = 0.f; } }
#pragma unroll 4
        for (int tt = 0; tt < 16; ++tt) {
            const int t = t0 + tt; const size_t m = mbase + t;
            float cur[8]; unpack8(*(const v4u*)(QKV + m * QKVW + c0), cur);
            float y[8]; float ss = 0.f;
#pragma unroll
            for (int e = 0; e < 8; ++e) { const float a = h[0][e] * w[0][e] + h[1][e] * w[1][e] + h[2][e] * w[2][e] + cur[e] * w[3][e]; y[e] = siluf(a); ss += y[e] * y[e]; }
            if (cc < 8) {
                ss += __shfl_xor(ss, 1); ss += __shfl_xor(ss, 2); ss += __shfl_xor(ss, 4); ss += __shfl_xor(ss, 8);
                const float sc = rsqrtf(ss + 1e-6f) * (cc < 4 ? 0.08838834764831845f : 1.0f);
#pragma unroll
                for (int e = 0; e < 8; ++e) y[e] *= sc;
                bf16* dst = (cc < 4) ? QN + m * DM + c0 : KN + m * DM + (c0 - 2048);
                *(v4u*)dst = pack8(y);
            } else { *(v4u*)(VV + m * VW + (c0 - 4096)) = pack8(y); }
            if (t >= L - 3) {
                float* so = F.out + (samp ? O_SGC : O_PGC) + (size_t)(b * 3 + (t - (L - 3))) * QKVW + c0;
                *(f32x4*)so = (f32x4){cur[0], cur[1], cur[2], cur[3]}; *(f32x4*)(so + 4) = (f32x4){cur[4], cur[5], cur[6], cur[7]}; }
#pragma unroll
            for (int e = 0; e < 8; ++e) { h[0][e] = h[1][e]; h[1][e] = h[2][e]; h[2][e] = cur[e]; }
        }
    }
}
DI void p_prep(Frame& F) {
    const int gw = F.vcu * NWAVES + F.wave, NGW = F.G * NWAVES;
    LAS float* Al = (LAS float*)(F.lds + F.wave * 16384);
    const bf16* QN = (const bf16*)(F.ws + WS_QN); const bf16* KN = (const bf16*)(F.ws + WS_KN);
    const float* BA = (const float*)(F.ws + WS_BA);
    bf16* TP = (bf16*)(F.ws + WS_TP); bf16* PP = (bf16*)(F.ws + WS_PP);
    float* EG = (float*)(F.ws + WS_EG); float* DL = (float*)(F.ws + WS_DL); float* GL = (float*)(F.ws + WS_GL);
    for (int it = gw; it < NITEM; it += NGW) {
        int lane = F.lane; asm volatile("" : "+v"(lane));
        const int c = lane & 31, hh = lane >> 5;
        int h, nv; size_t m0;
        if (it < NITEM_P) { h = it & 31; const int bn = it >> 5; m0 = (size_t)(bn >> 7) * SEQ + (size_t)(bn & 127) * 64; nv = 64; }
        else { const int r = it - NITEM_P; h = r & 31; m0 = (size_t)MP + (size_t)(r >> 5) * 16; nv = 16; }
        const int kh = h >> 1;
        float gt = 0.f, bt = 0.f;
        if (lane < nv) { const float bb = BA[(m0 + lane) * 64 + h], aa = BA[(m0 + lane) * 64 + 32 + h];
            bt = 1.0f / (1.0f + __expf(-bb));
            const float xx = aa + F.in[I_ADT][h]; const float sp = fmaxf(xx, 0.f) + log1pf(__expf(-fabsf(xx)));
            gt = -__expf(F.in[I_ALOG][h]) * sp; }
        float G = gt;
#pragma unroll
        for (int o = 1; o < 64; o <<= 1) { const float y = __shfl_up(G, o); if (lane >= o) G += y; }
        const float Glast = __shfl(G, 63);
        bf16x8 kf[2][8];
#pragma unroll
        for (int ti = 0; ti < 2; ++ti)
#pragma unroll
            for (int s = 0; s < 8; ++s) { const int row = 32 * ti + c;
                kf[ti][s] = (row < nv) ? *(const bf16x8*)(KN + (m0 + row) * DM + kh * 128 + 16 * s + 8 * hh) : (bf16x8){0, 0, 0, 0, 0, 0, 0, 0}; }
        {
            f32x16 t00 = {}, t10 = {}, t11 = {};
#pragma unroll
            for (int s = 0; s < 8; ++s) { t00 = MFMA32(kf[0][s], kf[0][s], t00); t10 = MFMA32(kf[1][s], kf[0][s], t10); t11 = MFMA32(kf[1][s], kf[1][s], t11); }
#pragma unroll
            for (int i = 0; i < 16; ++i) {
                const int r0 = crow(i, hh), r1 = 32 + r0;
                const float G0 = __shfl(G, r0), G1 = __shfl(G, r1), b0 = __shfl(bt, r0), b1 = __shfl(bt, r1);
                const float Gc0 = __shfl(G, c), Gc1 = __shfl(G, 32 + c);
                Al[r0 * 64 + c] = (r0 > c) ? b0 * t00[i] * __expf(G0 - Gc0) : 0.f;
                Al[r1 * 64 + c] = b1 * t10[i] * __expf(G1 - Gc0);
                Al[r1 * 64 + 32 + c] = (r0 > c) ? b1 * t11[i] * __expf(G1 - Gc1) : 0.f;
            }
        }
        asm volatile("" ::: "memory");
        {
            bf16x8 qf[2][8];
#pragma unroll
            for (int ti = 0; ti < 2; ++ti)
#pragma unroll
                for (int s = 0; s < 8; ++s) { const int row = 32 * ti + c;
                    qf[ti][s] = (row < nv) ? *(const bf16x8*)(QN + (m0 + row) * DM + kh * 128 + 16 * s + 8 * hh) : (bf16x8){0, 0, 0, 0, 0, 0, 0, 0}; }
            f32x16 t00 = {}, t10 = {}, t11 = {};
#pragma unroll
            for (int s = 0; s < 8; ++s) { t00 = MFMA32(qf[0][s], kf[0][s], t00); t10 = MFMA32(qf[1][s], kf[0][s], t10); t11 = MFMA32(qf[1][s], kf[1][s], t11); }
            bf16* pp = PP + (size_t)it * 4096;
#pragma unroll
            for (int i = 0; i < 16; ++i) {
                const int r0 = crow(i, hh), r1 = 32 + r0;
                const float G0 = __shfl(G, r0), G1 = __shfl(G, r1);
                const float Gc0 = __shfl(G, c), Gc1 = __shfl(G, 32 + c);
                const float v00 = (r0 >= c) ? t00[i] * __expf(G0 - Gc0) : 0.f;
                const float v10 = t10[i] * __expf(G1 - Gc0);
                const float v11 = (r0 >= c) ? t11[i] * __expf(G1 - Gc1) : 0.f;
                pp[r0 * 64 + c] = (bf16)(pk2(v00, 0.f) & 0xffffu); pp[r0 * 64 + 32 + c] = 0;
                pp[r1 * 64 + c] = (bf16)(pk2(v10, 0.f) & 0xffffu); pp[r1 * 64 + 32 + c] = (bf16)(pk2(v11, 0.f) & 0xffffu);
            }
        }
        LDS_WAIT(); asm volatile("" ::: "memory");
        float T[64];
#pragma unroll
        for (int i = 0; i < 64; ++i) {
            float a = (lane == i) ? 1.0f : 0.f;
#pragma unroll
            for (int j = 0; j < i; ++j) a -= Al[i * 64 + j] * T[j];
            T[i] = a;
            asm volatile("" ::: "memory");
        }
        bf16* tp = TP + (size_t)it * 4096;
#pragma unroll
        for (int i = 0; i < 64; ++i) tp[i * 64 + lane] = (bf16)(pk2(T[i] * bt, 0.f) & 0xffffu);
        EG[(size_t)it * 64 + lane] = __expf(G); DL[(size_t)it * 64 + lane] = __expf(Glast - G);
        if (lane == 0) GL[it] = __expf(Glast);
        LDS_WAIT(); asm volatile("" ::: "memory");
    }
}
constexpr int SB_K = 0, SB_Q = 17408, SB_V = 34816, SB_TP = 52224, SB_PP = 61440, SB_SIZE = 70656, SB_EG = 2 * SB_SIZE;
constexpr int LDK = 272, LDT = 144;
DI bf16x8 frag_perm(const LAS unsigned char* p) {
    const v2u lo = *(const LAS v2u*)p, hi = *(const LAS v2u*)(p + 16); const v4u x = {lo.x, lo.y, hi.x, hi.y}; return __builtin_bit_cast(bf16x8, x); }
DI bf16x8 pack_acc(const f32x16& a, const int s2) {
    v4u x; x.x = pk2(a[8 * s2], a[8 * s2 + 1]); x.y = pk2(a[8 * s2 + 2], a[8 * s2 + 3]); x.z = pk2(a[8 * s2 + 4], a[8 * s2 + 5]); x.w = pk2(a[8 * s2 + 6], a[8 * s2 + 7]); return __builtin_bit_cast(bf16x8, x); }
struct ScanLd { v4u k[4], q[4], v[4], tp[2], pp[2]; float e0, e1; };
DI void scan_issue(ScanLd& L, Frame& F, const int lt, const int item, const size_t m0, const int nv, const int h) {
    const bf16* QN = (const bf16*)(F.ws + WS_QN); const bf16* KN = (const bf16*)(F.ws + WS_KN); const bf16* VV = (const bf16*)(F.ws + WS_VV);
    const bf16* TP = (const bf16*)(F.ws + WS_TP); const bf16* PP = (const bf16*)(F.ws + WS_PP);
    const float* EG = (const float*)(F.ws + WS_EG); const float* DL = (const float*)(F.ws + WS_DL); const float* GL = (const float*)(F.ws + WS_GL);
    const int kh = h >> 1;
#pragma unroll
    for (int i = 0; i < 4; ++i) { const int p = lt + 256 * i, row = p >> 4, cc = p & 15; const v4u z4 = {0u, 0u, 0u, 0u};
        L.k[i] = (row < nv) ? *(const v4u*)(KN + (m0 + row) * DM + kh * 128 + cc * 8) : z4;
        L.q[i] = (row < nv) ? *(const v4u*)(QN + (m0 + row) * DM + kh * 128 + cc * 8) : z4;
        L.v[i] = (row < nv) ? *(const v4u*)(VV + (m0 + row) * VW + h * 128 + cc * 8) : z4; }
#pragma unroll
    for (int i = 0; i < 2; ++i) { const int p = lt + 256 * i, row = p >> 3, cc = p & 7;
        L.tp[i] = *(const v4u*)(TP + (size_t)item * 4096 + row * 64 + cc * 8); L.pp[i] = *(const v4u*)(PP + (size_t)item * 4096 + row * 64 + cc * 8); }
    L.e0 = (lt < 64) ? EG[(size_t)item * 64 + lt] : ((lt < 128) ? DL[(size_t)item * 64 + lt - 64] : GL[item]);
}
DI void st_perm(LAS unsigned char* rowbase, const int cc, const v4u x) {
    LAS unsigned char* g = rowbase + (cc >> 1) * 32 + (cc & 1) * 8;
    *(LAS v2u*)g = (v2u){x.x, x.y}; *(LAS v2u*)(g + 16) = (v2u){x.z, x.w};
}
DI void scan_write(const ScanLd& L, LAS unsigned char* lds, const int buf, const int lt) {
    LAS unsigned char* B = lds + buf * SB_SIZE;
#pragma unroll
    for (int i = 0; i < 4; ++i) { const int p = lt + 256 * i, row = p >> 4, cc = p & 15;
        *(LAS v4u*)(B + SB_K + row * LDK + cc * 16) = L.k[i]; st_perm(B + SB_Q + row * LDK, cc, L.q[i]);
        *(LAS v4u*)(B + SB_V + row * LDK + cc * 16) = L.v[i]; }
#pragma unroll
    for (int i = 0; i < 2; ++i) { const int p = lt + 256 * i, row = p >> 3, cc = p & 7;
        st_perm(B + SB_TP + row * LDT, cc, L.tp[i]); st_perm(B + SB_PP + row * LDT, cc, L.pp[i]); }
    if (lt <= 128) *(LAS float*)(lds + SB_EG + buf * 1024 + lt * 4) = L.e0;
}
struct ScanNm { v4u o[4], z[4]; };
DI void scan_norm_load(ScanNm& N, Frame& F, const int lt, const size_t m0, const int nv, const int h) {
    const bf16* ON = (const bf16*)(F.out + O_PK); const bf16* Z = (const bf16*)(F.ws + WS_Z);
    const int tok = lt >> 2, qd = lt & 3; const size_t off = (m0 + (tok < nv ? tok : 0)) * VW + h * 128 + qd * 32;
#pragma unroll
    for (int i = 0; i < 4; ++i) { N.o[i] = *(const v4u*)(ON + off + 8 * i); N.z[i] = *(const v4u*)(Z + off + 8 * i); }
}
DI void scan_norm_finish(const ScanNm& N, Frame& F, const int lt, const size_t m0, const int nv, const int h) {
    bf16* ON = (bf16*)(F.out + O_PK); const LAS float* gn = (const LAS float*)(F.lds + SB_EG + 2048);
    const int tok = lt >> 2, qd = lt & 3; const size_t off = (m0 + tok) * VW + h * 128 + qd * 32;
    float ss = 0.f;
#pragma unroll
    for (int i = 0; i < 4; ++i) { float o8[8]; unpack8(N.o[i], o8);
#pragma unroll
        for (int e = 0; e < 8; ++e) ss += o8[e] * o8[e]; }
    ss += __shfl_xor(ss, 1); ss += __shfl_xor(ss, 2);
    const float rstd = rsqrtf(ss * (1.0f / 128.0f) + 1e-6f);
    if (tok < nv) {
#pragma unroll
        for (int i = 0; i < 4; ++i) { float o8[8], z8[8]; unpack8(N.o[i], o8); unpack8(N.z[i], z8);
            const f32x4 g0 = *(const LAS f32x4*)(gn + qd * 32 + 8 * i), g1 = *(const LAS f32x4*)(gn + qd * 32 + 8 * i + 4);
#pragma unroll
            for (int e = 0; e < 8; ++e) o8[e] = o8[e] * rstd * (e < 4 ? g0[e & 3] : g1[e & 3]) * siluf(z8[e]);
            *(v4u*)(ON + off + 8 * i) = pack8(o8); }
    }
}
DI void scan_chain(Frame& F, const bool samp, const int b, const int h) {
    const int tid = F.tid, w = F.wave;
    LAS unsigned char* lds = F.lds;
    bf16* ON = (bf16*)(F.out + O_PK);
    const int nsteps = samp ? 1 : 128, nv = samp ? 16 : 64;
    const bool loader = w >= 4; const int lt = tid - 256;
#define SC_ITEM(n) (samp ? NITEM_P + b * 32 + h : (b * 128 + (n)) * 32 + h)
#define SC_M0(n) (samp ? (size_t)MP + b * 16 : (size_t)b * SEQ + (size_t)(n) * 64)
    f32x16 S[4];
    __syncthreads();
    if (tid < 128) *(LAS float*)(lds + SB_EG + 2048 + tid * 4) = F.in[I_AONORM][tid];
    if (samp) {
        const float* s0 = F.in[I_SGDN] + (size_t)(b * 32 + h) * 16384;
#pragma unroll
        for (int i = 0; i < 8; ++i) *(LAS f32x4*)(lds + (tid + 512 * i) * 16) = *(const f32x4*)(s0 + (tid + 512 * i) * 4);
        __syncthreads();
        if (!loader) { const int lane = F.lane, c = lane & 31, hh = lane >> 5, dvb = 32 * w;
#pragma unroll
            for (int i4 = 0; i4 < 4; ++i4)
#pragma unroll
                for (int i = 0; i < 16; ++i) S[i4][i] = *(const LAS float*)(lds + ((32 * i4 + crow(i, hh)) * 128 + dvb + c) * 4); }
        __syncthreads();
    } else {
#pragma unroll
        for (int i4 = 0; i4 < 4; ++i4)
#pragma unroll
            for (int i = 0; i < 16; ++i) S[i4][i] = 0.f;
    }
    if (loader) {
        ScanLd L; ScanNm N;
        { int lv = lt; asm volatile("" : "+v"(lv)); scan_issue(L, F, lv, SC_ITEM(0), SC_M0(0), nv, h); scan_write(L, lds, 0, lv); if (nsteps > 1) scan_issue(L, F, lv, SC_ITEM(1), SC_M0(1), nv, h); }
        __syncthreads();
        for (int n = 0; n < nsteps; ++n) {
            int lv = lt; asm volatile("" : "+v"(lv));
            if (n >= 3) scan_norm_finish(N, F, lv, SC_M0(n - 3), nv, h);
            if (n + 1 < nsteps) scan_write(L, lds, (n + 1) & 1, lv);
            if (n >= 2) scan_norm_load(N, F, lv, SC_M0(n - 2), nv, h);
            if (n + 2 < nsteps) scan_issue(L, F, lv, SC_ITEM(n + 2), SC_M0(n + 2), nv, h);
            __syncthreads();
        }
        __syncthreads();
        { int lv = lt; asm volatile("" : "+v"(lv));
          if (nsteps >= 3) scan_norm_finish(N, F, lv, SC_M0(nsteps - 3), nv, h);
          if (nsteps >= 2) { scan_norm_load(N, F, lv, SC_M0(nsteps - 2), nv, h); scan_norm_finish(N, F, lv, SC_M0(nsteps - 2), nv, h); }
          scan_norm_load(N, F, lv, SC_M0(nsteps - 1), nv, h); scan_norm_finish(N, F, lv, SC_M0(nsteps - 1), nv, h); }
    } else {
        __syncthreads();
        for (int n = 0; n < nsteps; ++n) {
            int lane = F.lane; asm volatile("" : "+v"(lane));
            const int c = lane & 31, hh = lane >> 5, dvb = 32 * w;
            const LAS unsigned char* B = lds + (n & 1) * SB_SIZE; const LAS float* egp = (const LAS float*)(lds + SB_EG + (n & 1) * 1024);
            const size_t m0 = SC_M0(n);
            bf16x8 Sb[8];
#pragma unroll
            for (int i4 = 0; i4 < 4; ++i4) { Sb[2 * i4] = pack_acc(S[i4], 0); Sb[2 * i4 + 1] = pack_acc(S[i4], 1); }
            f32x16 ks[2] = {{}, {}}, qs[2] = {{}, {}};
            const LAS unsigned char* pk0 = B + SB_K + c * LDK + 8 * hh; const LAS unsigned char* pq1 = B + SB_Q + c * LDK + 16 * hh;
            bf16x8 fa[4], fb[4], tf[8];
#define LDKQ(dst, s8) do { dst[0] = frag_perm(pk0 + 32 * (s8)); dst[1] = frag_perm(pk0 + 32 * LDK + 32 * (s8)); dst[2] = *(const LAS bf16x8*)(pq1 + 32 * (s8)); dst[3] = *(const LAS bf16x8*)(pq1 + 32 * LDK + 32 * (s8)); } while (0)
#define MMKQ(src, s8) do { ks[0] = MFMA32(src[0], Sb[s8], ks[0]); ks[1] = MFMA32(src[1], Sb[s8], ks[1]); qs[0] = MFMA32(src[2], Sb[s8], qs[0]); qs[1] = MFMA32(src[3], Sb[s8], qs[1]); } while (0)
#define SBAR() __builtin_amdgcn_sched_barrier(0)
            LDKQ(fa, 0); SBAR();
            LDKQ(fb, 1); SBAR(); MMKQ(fa, 0); SBAR();
            LDKQ(fa, 2); SBAR(); MMKQ(fb, 1); SBAR();
            LDKQ(fb, 3); SBAR(); MMKQ(fa, 2); SBAR();
            LDKQ(fa, 4); SBAR(); MMKQ(fb, 3); SBAR();
            LDKQ(fb, 5); SBAR(); MMKQ(fa, 4); SBAR();
            LDKQ(fa, 6); SBAR(); MMKQ(fb, 5); SBAR();
            LDKQ(fb, 7); SBAR(); MMKQ(fa, 6); SBAR();
#pragma unroll
            for (int s4 = 0; s4 < 4; ++s4) { tf[2 * s4] = *(const LAS bf16x8*)(B + SB_TP + c * LDT + 32 * s4 + 16 * hh); tf[2 * s4 + 1] = *(const LAS bf16x8*)(B + SB_TP + (32 + c) * LDT + 32 * s4 + 16 * hh); }
            SBAR(); MMKQ(fb, 7); SBAR();
#undef LDKQ
#undef MMKQ
            bf16x8 rf[4];
            { const int vbv = (int)(unsigned)(size_t)(B + SB_V) + (4 * hh + ((lane >> 2) & 3)) * LDK + ((lane >> 4) & 1) * 32 + (lane & 3) * 8 + dvb * 2;
              const bf16x4 v00 = tr_read<0 * LDK>(vbv), v01 = tr_read<8 * LDK>(vbv), v02 = tr_read<16 * LDK>(vbv), v03 = tr_read<24 * LDK>(vbv);
              const bf16x4 v10 = tr_read<32 * LDK>(vbv), v11 = tr_read<40 * LDK>(vbv), v12 = tr_read<48 * LDK>(vbv), v13 = tr_read<56 * LDK>(vbv);
              asm volatile("s_waitcnt lgkmcnt(0)" ::: "memory"); SBAR();
#define RROW(tt, g4, V) do { const f32x4 e4 = *(const LAS f32x4*)(egp + 32 * (tt) + 8 * (g4) + 4 * hh); \
                  r[4 * (g4)] = bf2f((bf16)V[0]) - e4[0] * ks[tt][4 * (g4)]; r[4 * (g4) + 1] = bf2f((bf16)V[1]) - e4[1] * ks[tt][4 * (g4) + 1]; \
                  r[4 * (g4) + 2] = bf2f((bf16)V[2]) - e4[2] * ks[tt][4 * (g4) + 2]; r[4 * (g4) + 3] = bf2f((bf16)V[3]) - e4[3] * ks[tt][4 * (g4) + 3]; } while (0)
              { f32x16 r; RROW(0, 0, v00); RROW(0, 1, v01); RROW(0, 2, v02); RROW(0, 3, v03); rf[0] = pack_acc(r, 0); rf[1] = pack_acc(r, 1); }
              { f32x16 r; RROW(1, 0, v10); RROW(1, 1, v11); RROW(1, 2, v12); RROW(1, 3, v13); rf[2] = pack_acc(r, 0); rf[3] = pack_acc(r, 1); }
#undef RROW
            }
            SBAR();
            f32x16 u[2] = {{}, {}};
#pragma unroll
            for (int s4 = 0; s4 < 4; ++s4) { u[0] = MFMA32(tf[2 * s4], rf[s4], u[0]); u[1] = MFMA32(tf[2 * s4 + 1], rf[s4], u[1]); }
            SBAR();
            bf16x8 pf[8];
#pragma unroll
            for (int s4 = 0; s4 < 4; ++s4) { pf[2 * s4] = *(const LAS bf16x8*)(B + SB_PP + c * LDT + 32 * s4 + 16 * hh); pf[2 * s4 + 1] = *(const LAS bf16x8*)(B + SB_PP + (32 + c) * LDT + 32 * s4 + 16 * hh); }
            const float gl = egp[128];
            SBAR();
            bf16x8 uf[4], upf[4];
#pragma unroll
            for (int tt = 0; tt < 2; ++tt) { uf[2 * tt] = pack_acc(u[tt], 0); uf[2 * tt + 1] = pack_acc(u[tt], 1); f32x16 up;
#pragma unroll
                for (int g4 = 0; g4 < 4; ++g4) { const f32x4 d4 = *(const LAS f32x4*)(egp + 64 + 32 * tt + 8 * g4 + 4 * hh);
                    up[4 * g4] = u[tt][4 * g4] * d4[0]; up[4 * g4 + 1] = u[tt][4 * g4 + 1] * d4[1]; up[4 * g4 + 2] = u[tt][4 * g4 + 2] * d4[2]; up[4 * g4 + 3] = u[tt][4 * g4 + 3] * d4[3]; }
                upf[2 * tt] = pack_acc(up, 0); upf[2 * tt + 1] = pack_acc(up, 1); }
            f32x16 pu[2] = {{}, {}};
#pragma unroll
            for (int s4 = 0; s4 < 4; ++s4) { pu[0] = MFMA32(pf[2 * s4], uf[s4], pu[0]); pu[1] = MFMA32(pf[2 * s4 + 1], uf[s4], pu[1]); }
            SBAR();
            { const int vb = (int)(unsigned)(size_t)(B + SB_K) + (4 * hh + ((lane >> 2) & 3)) * LDK + ((lane >> 4) & 1) * 32 + (lane & 3) * 8;
#pragma unroll
              for (int i4 = 0; i4 < 4; ++i4) {
#pragma unroll
                  for (int i = 0; i < 16; ++i) S[i4][i] *= gl; }
#define KTPK(L, H) (bf16x8){L[0], L[1], L[2], L[3], H[0], H[1], H[2], H[3]}
#define KTLD(P, s4) const bf16x4 P##l0 = tr_read<16 * (s4) * LDK>(vb), P##h0 = tr_read<(16 * (s4) + 8) * LDK>(vb), P##l1 = tr_read<16 * (s4) * LDK + 64>(vb), P##h1 = tr_read<(16 * (s4) + 8) * LDK + 64>(vb), \
                  P##l2 = tr_read<16 * (s4) * LDK + 128>(vb), P##h2 = tr_read<(16 * (s4) + 8) * LDK + 128>(vb), P##l3 = tr_read<16 * (s4) * LDK + 192>(vb), P##h3 = tr_read<(16 * (s4) + 8) * LDK + 192>(vb)
#define KTMM(P, s4) do { S[0] = MFMA32(KTPK(P##l0, P##h0), upf[s4], S[0]); S[1] = MFMA32(KTPK(P##l1, P##h1), upf[s4], S[1]); S[2] = MFMA32(KTPK(P##l2, P##h2), upf[s4], S[2]); S[3] = MFMA32(KTPK(P##l3, P##h3), upf[s4], S[3]); } while (0)
              KTLD(a, 0); KTLD(b, 1);
              asm volatile("s_waitcnt lgkmcnt(0)" ::: "memory"); SBAR();
              KTMM(a, 0); KTMM(b, 1); SBAR();
              KTLD(d, 2); KTLD(e, 3);
              asm volatile("s_waitcnt lgkmcnt(0)" ::: "memory"); SBAR();
              KTMM(d, 2); KTMM(e, 3); SBAR();
#undef KTLD
#undef KTMM
#undef KTPK
            }
#undef SBAR
            { LAS unsigned char* ob = lds + (n & 1) * SB_SIZE + SB_V + dvb * 2;
#pragma unroll
              for (int ti = 0; ti < 2; ++ti)
#pragma unroll
                for (int g4 = 0; g4 < 4; ++g4) { const int tk = 32 * ti + 8 * g4 + 4 * hh; const f32x4 e4 = *(const LAS f32x4*)(egp + tk);
#pragma unroll
                    for (int j = 0; j < 4; ++j) *(LAS bf16*)(ob + (tk + j) * LDK + c * 2) = (bf16)(pk2(e4[j] * qs[ti][4 * g4 + j] + pu[ti][4 * g4 + j], 0.f) & 0xffffu); }
              LDS_WAIT();
#pragma unroll
              for (int j = 0; j < 4; ++j) { const int p = lane + 64 * j, tok = p >> 2, part = p & 3;
                const v4u x = *(const LAS v4u*)(ob + tok * LDK + part * 16);
                if (tok < nv) *(v4u*)(ON + (m0 + tok) * VW + h * 128 + dvb + part * 8) = x; } }
            asm volatile("s_waitcnt vmcnt(4)" ::: "memory");
            __syncthreads();
        }
        asm volatile("s_waitcnt vmcnt(0)" ::: "memory");
        __syncthreads();
        {
            const int lane = F.lane, c = lane & 31, hh = lane >> 5, dvb = 32 * w;
#pragma unroll
            for (int i4 = 0; i4 < 4; ++i4)
#pragma unroll
                for (int i = 0; i < 16; ++i) *(LAS float*)(lds + ((32 * i4 + crow(i, hh)) * 128 + dvb + c) * 4) = S[i4][i];
        }
    }
    __syncthreads();
    { float* so = F.out + (samp ? O_SGDN : O_PGDN) + (size_t)(b * 32 + h) * 16384;
#pragma unroll
      for (int i = 0; i < 8; ++i) *(f32x4*)(so + (tid + 512 * i) * 4) = *(const LAS f32x4*)(lds + (tid + 512 * i) * 16); }
#undef SC_ITEM
#undef SC_M0
}
DI void p_scan(Frame& F) {
    const int nW = F.G, bx = blockIdx.x;
    for (int ch = bx; ch < NB * 32; ch += nW) scan_chain(F, false, ch >> 5, ch & 31);
    int start, stride;
    if (nW > NB * 32) { start = bx - NB * 32; stride = nW - NB * 32; } else { start = bx; stride = nW; }
    if (start >= 0) for (int ch = start; ch < DECB * 32; ch += stride) scan_chain(F, true, ch >> 5, ch & 31);
}
DI void p_ffnconv(Frame& F, const int layer) {
    const int gw = F.vcu * NWAVES + F.wave, NGW = F.G * NWAVES, lane = F.lane;
    const bf16* UP = (const bf16*)(F.ws + WS_UP); bf16* ACT = (bf16*)(F.ws + WS_ACT);
    const float* wconv = F.in[I_FWCONV] + (size_t)layer * 3 * UPW; const float* bconv = F.in[I_FBCONV] + (size_t)layer * UPW;
    constexpr int NTB = MP / 16 + DECB, NCC = DFF / 512;
    for (int it = gw; it < NTB * NCC; it += NGW) {
        const int tb = it / NCC, cc = it - tb * NCC, c0 = cc * 512 + lane * 8;
        const bool samp = tb >= MP / 16; const int b = samp ? tb - MP / 16 : tb >> 9; const int t0 = samp ? 0 : (tb & 511) * 16;
        const size_t mbase = samp ? (size_t)MP + b * 16 : (size_t)b * SEQ; const int L = samp ? DECS : SEQ;
        float wg[3][8], wv[3][8], bg[8], bv[8];
#pragma unroll
        for (int i = 0; i < 3; ++i)
#pragma unroll
            for (int e = 0; e < 8; ++e) { wg[i][e] = wconv[i * UPW + c0 + e]; wv[i][e] = wconv[i * UPW + DFF + c0 + e]; }
#pragma unroll
        for (int e = 0; e < 8; ++e) { bg[e] = bconv[c0 + e]; bv[e] = bconv[DFF + c0 + e]; }
        float hg[2][8], hv[2][8];
#pragma unroll
        for (int j = 0; j < 2; ++j) { const int t = t0 - 2 + j;
            if (t >= 0) { unpack8(*(const v4u*)(UP + (mbase + t) * UPW + c0), hg[j]); unpack8(*(const v4u*)(UP + (mbase + t) * UPW + DFF + c0), hv[j]); }
            else if (samp) { const float* sp = F.in[I_SFC] + ((size_t)(layer * DECB + b) * 2 + (t + 2)) * UPW + c0;
#pragma unroll
                for (int e = 0; e < 8; ++e) { hg[j][e] = sp[e]; hv[j][e] = sp[DFF + e]; } }
            else {
#pragma unroll
                for (int e = 0; e < 8; ++e) { hg[j][e] = 0.f; hv[j][e] = 0.f; } } }
#pragma unroll 4
        for (int tt = 0; tt < 16; ++tt) {
            const int t = t0 + tt; const size_t m = mbase + t;
            float cg[8], cv[8]; unpack8(*(const v4u*)(UP + m * UPW + c0), cg); unpack8(*(const v4u*)(UP + m * UPW + DFF + c0), cv);
            float y[8];
#pragma unroll
            for (int e = 0; e < 8; ++e) { const float g = hg[0][e] * wg[0][e] + hg[1][e] * wg[1][e] + cg[e] * wg[2][e] + bg[e];
                const float v = hv[0][e] * wv[0][e] + hv[1][e] * wv[1][e] + cv[e] * wv[2][e] + bv[e]; y[e] = siluf(g) * v; }
            *(v4u*)(ACT + m * DFF + c0) = pack8(y);
            if (t >= L - 2) {
                float* so = F.out + (samp ? O_SFC + ((size_t)(layer * DECB + b) * 2 + (t - (L - 2))) * UPW : O_PFC + ((size_t)(layer * NB + b) * 2 + (t - (L - 2))) * UPW) + c0;
#pragma unroll
                for (int e = 0; e < 8; ++e) { so[e] = cg[e]; so[DFF + e] = cv[e]; } }
#pragma unroll
            for (int e = 0; e < 8; ++e) { hg[0][e] = hg[1][e]; hg[1][e] = cg[e]; hv[0][e] = hv[1][e]; hv[1][e] = cv[e]; }
        }
    }
}
DI void p_final(Frame& F) {
    const int gw = F.vcu * NWAVES + F.wave, NGW = F.G * NWAVES, lane = F.lane;
    const float* ssq = (const float*)(F.ws + WS_SSQ + 4 * SSQ_STRIDE); const float* gain = F.in[I_FINAL];
    for (int m = gw; m < M; m += NGW) {
        float s = (lane < 32) ? ssq[(size_t)m * 32 + lane] : 0.f; s = wave_sum(s);
        const float rstd = rsqrtf(s * (1.0f / 2048.0f) + 1e-6f);
        f32x4* y4 = (f32x4*)(F.out + (size_t)m * DM) + lane; const f32x4* g4 = (const f32x4*)gain + lane;
#pragma unroll
        for (int j = 0; j < 8; ++j) { const f32x4 v = y4[64 * j]; y4[64 * j] = v * rstd * g4[64 * j]; }
    }
}
DI void p_cacheconv(Frame& F, const float* src, bf16* dst) {
    const size_t nthr = (size_t)F.G * 512, t0 = (size_t)F.vcu * 512 + F.tid;
    constexpr size_t NP = (size_t)DECB * PAST * DM / 8;
    for (size_t p = t0; p < NP; p += nthr) {
        const size_t row = p >> 8, c8 = p & 255, b = row >> 11, key = row & 2047;
        const f32x4 a = *(const f32x4*)(src + p * 8), bq = *(const f32x4*)(src + p * 8 + 4);
        v4u o; o.x = pk2(a[0], a[1]); o.y = pk2(a[2], a[3]); o.z = pk2(bq[0], bq[1]); o.w = pk2(bq[2], bq[3]);
        *(v4u*)(dst + (b * (PAST + DECS) + key) * DM + c8 * 8) = o;
    }
}
constexpr int AT_K = 0, AT_V = 65536, AT_W = 131072, AT_BT = 147456, AT_X = 149504;
constexpr float ATT_C = 0.08838834764831845f * 1.4426950408889634f;
constexpr float LAM_INIT = 0.35550906759718507f;
constexpr int CW_ATTQ = 64;
struct AttnUnit { const bf16* Kp; const bf16* Vp; int h, nq, qpos0, nkeys; size_t mq0; };
DI int t5_bucket(int rel) { const int n = rel < 0 ? -rel : rel; int v; if (n < 8) v = n; else { v = 2 + (31 - __builtin_clz((unsigned)(n * n))); v = v > 15 ? 15 : v; } return (rel > 0 ? 16 : 0) + v; }
#define KSWZ(row, colB) ((row) * 256 + ((colB) ^ (((row) & 7) << 4)))
DI int v_st(int k, int c) { return ((k >> 3) * 8 + (c >> 5)) * 512 + ((k & 7) * 32 + (c & 31)) * 2; }
DI int v_rd_base(int lane) { return ((lane & 3) << 3) | (((lane >> 2) & 3) << 6) | (((lane >> 4) & 1) << 5) | (((lane >> 5) & 1) << 8); }
struct AtStage { v4u k[4]; v4u v[4]; };
DI void at_load(AtStage& S, const AttnUnit& U, const int kt, const bool withV, int tid) {
    asm volatile("" : "+v"(tid));
#pragma unroll
    for (int i = 0; i < 4; ++i) { const int key = 32 * (i & 1) + (tid >> 4); int kg = kt * 64 + key; kg = kg < U.nkeys ? kg : U.nkeys - 1;
        S.k[i] = *(const v4u*)(U.Kp + (size_t)kg * DM + (2 * U.h + (i >> 1)) * 128 + (tid & 15) * 8); }
    if (withV) {
#pragma unroll
        for (int i = 0; i < 4; ++i) { const int g = (tid >> 6) + 8 * i, key = (g >> 2) * 8 + (tid & 7), cc = (g & 3) * 8 + ((tid >> 3) & 7); int kg = kt * 64 + key; kg = kg < U.nkeys ? kg : U.nkeys - 1;
            S.v[i] = *(const v4u*)(U.Vp + (size_t)kg * DM + U.h * 256 + cc * 8); }
    }
}
DI void at_store(const AtStage& S, LAS unsigned char* lds, const int buf, const bool withV, int tid) {
    asm volatile("" : "+v"(tid));
#pragma unroll
    for (int i = 0; i < 4; ++i) { const int key = 32 * (i & 1) + (tid >> 4);
        *(LAS v4u*)(lds + AT_K + buf * 32768 + (i >> 1) * 16384 + KSWZ(key, (tid & 15) * 16)) = S.k[i]; }
    if (withV) {
#pragma unroll
        for (int i = 0; i < 4; ++i) { const int g = (tid >> 6) + 8 * i, key = (g >> 2) * 8 + (tid & 7), cc = (g & 3) * 8 + ((tid >> 3) & 7);
            *(LAS v4u*)(lds + AT_V + buf * 32768 + v_st(key, cc * 8)) = S.v[i]; }
    }
}
template <int NBATCH> DI void at_scores2(LAS unsigned char* lds, const AttnUnit& U, const bf16x8 (&qf)[2][8], const int kbase, const int kt, const int pi, const int qpos_lane, const int mode, f32x16& t1, f32x16& t2, const int c, const int hh) {
    f32x16 a1 = {}, a2 = {};
#pragma unroll
    for (int s0 = 0; s0 < 8; s0 += NBATCH) {
        bf16x8 k0[NBATCH], k1[NBATCH];
#pragma unroll
        for (int s = 0; s < NBATCH; ++s) { k0[s] = *(const LAS bf16x8*)(lds + kbase + KSWZ(32 * pi + c, 32 * (s0 + s) + 16 * hh)); k1[s] = *(const LAS bf16x8*)(lds + kbase + 16384 + KSWZ(32 * pi + c, 32 * (s0 + s) + 16 * hh)); }
        __builtin_amdgcn_sched_barrier(0);
#pragma unroll
        for (int s = 0; s < NBATCH; ++s) { a1 = MFMA32(k0[s], qf[0][s0 + s], a1); a2 = MFMA32(k1[s], qf[1][s0 + s], a2); }
        __builtin_amdgcn_sched_barrier(0);
    }
    const LAS float* bt = (const LAS float*)(lds + AT_BT);
    if (mode == 0) { const float bc = bt[0];
#pragma unroll
        for (int i = 0; i < 16; ++i) { t1[i] = a1[i] * ATT_C + bc; t2[i] = a2[i] * ATT_C + bc; }
    } else {
        float bc[16];
#pragma unroll
        for (int i = 0; i < 16; ++i) { int rel = kt * 64 + 32 * pi + crow(i, hh) - qpos_lane; rel = rel < -256 ? -256 : rel; rel = rel > 255 ? 255 : rel; bc[i] = bt[rel + 256]; }
        if (mode == 2) {
#pragma unroll
            for (int i = 0; i < 16; ++i) bc[i] = (kt * 64 + 32 * pi + crow(i, hh) < U.nkeys) ? bc[i] : -1e30f;
        }
#pragma unroll
        for (int i = 0; i < 16; ++i) { t1[i] = a1[i] * ATT_C + bc[i]; t2[i] = a2[i] * ATT_C + bc[i]; }
    }
}
#define PK(L, H) (bf16x8){L[0], L[1], L[2], L[3], H[0], H[1], H[2], H[3]}
template <int D0> DI void at_pv_two(f32x16& oa, f32x16& ob, const int vb, const bf16x8 (&wf)[4]) {
    const bf16x4 l0 = tr_read<D0 * 512 + 0 * 8192>(vb), h0 = tr_read<D0 * 512 + 0 * 8192 + 4096>(vb), l1 = tr_read<D0 * 512 + 1 * 8192>(vb), h1 = tr_read<D0 * 512 + 1 * 8192 + 4096>(vb);
    const bf16x4 l2 = tr_read<D0 * 512 + 2 * 8192>(vb), h2 = tr_read<D0 * 512 + 2 * 8192 + 4096>(vb), l3 = tr_read<D0 * 512 + 3 * 8192>(vb), h3 = tr_read<D0 * 512 + 3 * 8192 + 4096>(vb);
    const bf16x4 m0 = tr_read<D0 * 512 + 512 + 0 * 8192>(vb), n0 = tr_read<D0 * 512 + 512 + 0 * 8192 + 4096>(vb), m1 = tr_read<D0 * 512 + 512 + 1 * 8192>(vb), n1 = tr_read<D0 * 512 + 512 + 1 * 8192 + 4096>(vb);
    const bf16x4 m2 = tr_read<D0 * 512 + 512 + 2 * 8192>(vb), n2 = tr_read<D0 * 512 + 512 + 2 * 8192 + 4096>(vb), m3 = tr_read<D0 * 512 + 512 + 3 * 8192>(vb), n3 = tr_read<D0 * 512 + 512 + 3 * 8192 + 4096>(vb);
    asm volatile("s_waitcnt lgkmcnt(0)" ::: "memory"); __builtin_amdgcn_sched_barrier(0);
    oa = MFMA32(wf[0], PK(l0, h0), oa); ob = MFMA32(wf[0], PK(m0, n0), ob); oa = MFMA32(wf[1], PK(l1, h1), oa); ob = MFMA32(wf[1], PK(m1, n1), ob);
    oa = MFMA32(wf[2], PK(l2, h2), oa); ob = MFMA32(wf[2], PK(m2, n2), ob); oa = MFMA32(wf[3], PK(l3, h3), oa); ob = MFMA32(wf[3], PK(m3, n3), ob);
}
#undef PK
DI void attn_unit(Frame& F, const AttnUnit& U, const float lam) {
    const int tid = F.tid, w = F.wave, lane = F.lane, rt = w >> 1, pi = w & 1;
    LAS unsigned char* lds = F.lds;
    const bf16* QB = (const bf16*)(F.ws + WS_QB); bf16* ATT = (bf16*)(F.ws + WS_ATT);
    __syncthreads();
    { const int rel = tid - 256; *(LAS float*)(lds + AT_BT + tid * 4) = F.in[I_RELB][t5_bucket(rel) * 8 + U.h] * 1.4426950408889634f; }
    const bool active = 32 * rt < U.nq;
    const int qchunk = (U.qpos0 + 32 * rt) >> 6;
    bf16x8 qf[2][8];
    { const int c = lane & 31, hh = lane >> 5, qrow = 32 * rt + c;
#pragma unroll
      for (int mm = 0; mm < 2; ++mm)
#pragma unroll
        for (int s = 0; s < 8; ++s) qf[mm][s] = (qrow < U.nq) ? *(const bf16x8*)(QB + (U.mq0 + qrow) * DM + (2 * U.h + mm) * 128 + 16 * s + 8 * hh) : (bf16x8){0, 0, 0, 0, 0, 0, 0, 0}; }
    const int ntiles = (U.nkeys + 63) >> 6;
    AtStage S;
    float m1 = -1e30f, m2 = -1e30f, l1 = 0.f, l2 = 0.f;
    at_load(S, U, 0, false, tid); at_store(S, lds, 0, false, tid);
    __syncthreads();
    for (int kt = 0; kt < ntiles; ++kt) {
        if (kt + 1 < ntiles) at_load(S, U, kt + 1, false, tid);
        if (active && kt <= qchunk) {
            const int mode = (kt * 64 + 63 >= U.nkeys) ? 2 : ((kt * 64 + 32 * pi + 31 - (U.qpos0 + 32 * rt)) <= -91 ? 0 : 1);
            int lv = lane; asm volatile("" : "+v"(lv)); const int c = lv & 31, hh = lv >> 5; const int qpos_lane = U.qpos0 + 32 * rt + c;
            f32x16 t1, t2; at_scores2<8>(lds, U, qf, AT_K + (kt & 1) * 32768, kt, pi, qpos_lane, mode, t1, t2, c, hh);
            float x1 = t1[0], x2 = t2[0];
#pragma unroll
            for (int i = 1; i < 16; ++i) { x1 = fmaxf(x1, t1[i]); x2 = fmaxf(x2, t2[i]); }
            x1 = fmaxf(x1, __shfl_xor(x1, 32)); x2 = fmaxf(x2, __shfl_xor(x2, 32));
            const float n1 = fmaxf(m1, x1), n2 = fmaxf(m2, x2); float s1 = 0.f, s2 = 0.f;
#pragma unroll
            for (int i = 0; i < 16; ++i) { s1 += __builtin_amdgcn_exp2f(t1[i] - n1); s2 += __builtin_amdgcn_exp2f(t2[i] - n2); }
            l1 = l1 * __builtin_amdgcn_exp2f(m1 - n1) + s1; m1 = n1; l2 = l2 * __builtin_amdgcn_exp2f(m2 - n2) + s2; m2 = n2;
        }
        if (kt + 1 < ntiles) at_store(S, lds, (kt + 1) & 1, false, tid);
        __syncthreads();
    }
    l1 += __shfl_xor(l1, 32); l2 += __shfl_xor(l2, 32);
    { LAS float* xs = (LAS float*)(lds + AT_X) + w * 128;
      if (lane < 32) { xs[lane] = m1; xs[32 + lane] = l1; xs[64 + lane] = m2; xs[96 + lane] = l2; }
      __syncthreads();
      const LAS float* xo = (const LAS float*)(lds + AT_X) + (w ^ 1) * 128; const int c = lane & 31;
      const float pm1 = xo[c], pl1 = xo[32 + c], pm2 = xo[64 + c], pl2 = xo[96 + c];
      const float M1 = fmaxf(m1, pm1), M2 = fmaxf(m2, pm2);
      l1 = l1 * __builtin_amdgcn_exp2f(m1 - M1) + pl1 * __builtin_amdgcn_exp2f(pm1 - M1); m1 = M1;
      l2 = l2 * __builtin_amdgcn_exp2f(m2 - M2) + pl2 * __builtin_amdgcn_exp2f(pm2 - M2); m2 = M2; }
    const float il1 = 1.0f / l1, il2 = lam / l2;
    f32x16 O[4];
#pragma unroll
    for (int d = 0; d < 4; ++d) O[d] = (f32x16){};
    at_load(S, U, 0, true, tid);
    __syncthreads();
    at_store(S, lds, 0, true, tid);
    __syncthreads();
    for (int kt = 0; kt < ntiles; ++kt) {
        if (kt + 1 < ntiles) at_load(S, U, kt + 1, true, tid);
        const bool vis = active && kt <= qchunk;
        if (vis) {
            const int mode = (kt * 64 + 63 >= U.nkeys) ? 2 : ((kt * 64 + 32 * pi + 31 - (U.qpos0 + 32 * rt)) <= -91 ? 0 : 1);
            int lv = lane; asm volatile("" : "+v"(lv)); const int c = lv & 31, hh = lv >> 5; const int qpos_lane = U.qpos0 + 32 * rt + c;
            float wv[16];
            { f32x16 t1, t2; at_scores2<4>(lds, U, qf, AT_K + (kt & 1) * 32768, kt, pi, qpos_lane, mode, t1, t2, c, hh);
#pragma unroll
              for (int i = 0; i < 16; ++i) wv[i] = __builtin_amdgcn_exp2f(t1[i] - m1) * il1 - __builtin_amdgcn_exp2f(t2[i] - m2) * il2; }
#pragma unroll
            for (int s2 = 0; s2 < 2; ++s2) { v4u pw; pw.x = pk2(wv[8 * s2], wv[8 * s2 + 1]); pw.y = pk2(wv[8 * s2 + 2], wv[8 * s2 + 3]); pw.z = pk2(wv[8 * s2 + 4], wv[8 * s2 + 5]); pw.w = pk2(wv[8 * s2 + 6], wv[8 * s2 + 7]);
                *(LAS v4u*)(lds + AT_W + ((rt * 4 + 2 * pi + s2) * 64 + lv) * 16) = pw; }
        }
        __syncthreads();
        if (vis) {
            int lv = lane; asm volatile("" : "+v"(lv));
            bf16x8 wf[4];
#pragma unroll
            for (int ks = 0; ks < 4; ++ks) wf[ks] = *(const LAS bf16x8*)(lds + AT_W + ((rt * 4 + ks) * 64 + lv) * 16);
            const int vb = (int)(unsigned)(size_t)(lds + AT_V + (kt & 1) * 32768 + pi * 2048) + v_rd_base(lv);
            at_pv_two<0>(O[0], O[1], vb, wf); at_pv_two<2>(O[2], O[3], vb, wf);
        }
        if (kt + 1 < ntiles) at_store(S, lds, (kt + 1) & 1, true, tid);
        __syncthreads();
    }
    {
        int lv = lane; asm volatile("" : "+v"(lv)); const int c = lv & 31, hh = lv >> 5;
        LAS float* xs = (LAS float*)(lds + AT_X) + w * 128;
        float ssa[16];
#pragma unroll
        for (int i = 0; i < 16; ++i) { float a = 0.f;
#pragma unroll
            for (int d = 0; d < 4; ++d) a += O[d][i] * O[d][i];
            a += __shfl_xor(a, 1); a += __shfl_xor(a, 2); a += __shfl_xor(a, 4); a += __shfl_xor(a, 8); a += __shfl_xor(a, 16);
            ssa[i] = a; if (c == 0) xs[crow(i, hh)] = a; }
        __syncthreads();
        const LAS float* xo = (const LAS float*)(lds + AT_X) + (w ^ 1) * 128;
        if (active) {
#pragma unroll
            for (int i = 0; i < 16; ++i) { const int r = 32 * rt + crow(i, hh);
                const float sc = rsqrtf((ssa[i] + xo[crow(i, hh)]) * (1.0f / 256.0f) + 1e-5f) * (1.0f - LAM_INIT);
                if (r < U.nq) { bf16* op = ATT + (U.mq0 + r) * DM + U.h * 256 + 128 * pi + c;
#pragma unroll
                    for (int d = 0; d < 4; ++d) op[32 * d] = (bf16)(pk2(O[d][i] * sc * F.in[I_SUBN][128 * pi + 32 * d + c], 0.f) & 0xffffu); } }
        }
    }
}
DI void p_attn(Frame& F) {
    float d1 = 0.f, d2 = 0.f;
    for (int i = 0; i < 128; ++i) { d1 += F.in[I_LQ1][i] * F.in[I_LK1][i]; d2 += F.in[I_LQ2][i] * F.in[I_LK2][i]; }
    const float lam = __expf(d1) - __expf(d2) + LAM_INIT;
    const bf16* KB = (const bf16*)(F.ws + WS_KB); const bf16* VB = (const bf16*)(F.ws + WS_VB);
    const bf16* KC = (const bf16*)(F.ws + WS_KC); const bf16* VC = (const bf16*)(F.ws + WS_VC);
    constexpr int NSU = DECB * 8, NPU = NB * 8 * 64;
    for (;;) {
        __syncthreads();
        if (F.tid == 0) F.MISC[16] = atomicAdd(F.ctl + CW_ATTQ, 1u);
        __syncthreads();
        const int p = (int)F.MISC[16];
        if (p >= NSU + NPU) break;
        AttnUnit U;
        if (p < NSU) { const int b = p >> 3; U.h = p & 7; U.Kp = KC + (size_t)b * (PAST + DECS) * DM; U.Vp = VC + (size_t)b * (PAST + DECS) * DM; U.nq = DECS; U.qpos0 = PAST; U.nkeys = PAST + DECS; U.mq0 = (size_t)MP + (size_t)b * DECS; }
        else { const int r = p - NSU, bh = r >> 6, u = 63 - (r & 63), b = bh >> 3; U.h = bh & 7; U.Kp = KB + (size_t)b * SEQ * DM; U.Vp = VB + (size_t)b * SEQ * DM; U.nq = 128; U.qpos0 = u * 128; U.nkeys = (u + 1) * 128; U.mq0 = (size_t)b * SEQ + (size_t)u * 128; }
        attn_unit(F, U, lam);
    }
}
#ifndef N_LAUNCH_MODE
#define N_LAUNCH_MODE 1
#endif
constexpr int N_PHASES = 16;
struct Args { const float* in[N_IN]; float* out; unsigned char* ws; int ph_lo, ph_hi; };
static_assert(sizeof(Args) == (N_IN + 2) * 8 + 8, "Args has no padding");
__global__ void __launch_bounds__(NWAVES * 64, 2) fwd(Args args) {
    extern __shared__ __attribute__((aligned(16))) unsigned char lds_raw[];
    Frame F;
    F.lds = (LAS unsigned char*)lds_raw;
    F.MISC = (volatile LAS unsigned*)(F.lds + LDSCTL_OFF);
    F.tid = threadIdx.x; F.lane = F.tid & 63; F.wave = __builtin_amdgcn_readfirstlane(F.tid >> 6);
    F.G = gridDim.x; { const int bx = blockIdx.x; F.vcu = (F.G % 8 == 0) ? (bx % 8) * (F.G / 8) + bx / 8 : bx; }
    F.in = args.in; F.out = args.out; F.ws = args.ws; F.ctl = (unsigned*)(args.ws + WS_CTL);
    for (int u = F.tid; u < (LDS_BYTES - LDSCTL_OFF) / 4; u += NWAVES * 64) ((LAS unsigned*)(F.lds + LDSCTL_OFF))[u] = 0u;
    __syncthreads();
    XcdBarrier bar; bar.bar = F.ctl + CW_BAR; bar.x = 0; bar.st = nullptr;
    if (N_LAUNCH_MODE == 1) bar = xcd_barrier_post(F.ctl + CW_BAR, F.MISC + 8);
    const int lo = args.ph_lo, hi = args.ph_hi;
#ifndef PHASE_MASK
#define PHASE_MASK 0xffff
#endif
#define IN(k) (((PHASE_MASK >> (k)) & 1) && lo <= (k) && (k) < hi)
#ifndef TWICE_MASK
#define TWICE_MASK 0
#endif
#define SEAM(k) do { if (IN(k) && IN((k) + 1)) xcd_barrier(bar); } while (0)
#define REP(k) for (int rep_ = 0; rep_ < (((TWICE_MASK >> (k)) & 1) ? 2 : 1); ++rep_, (((TWICE_MASK >> (k)) & 1) && rep_ == 1 ? xcd_barrier(bar) : (void)0))
    unsigned char* ws = args.ws;
    PG8_LAS unsigned char* ring = (PG8_LAS unsigned char*)F.lds;
    bf16* HB = (bf16*)(ws + WS_HB);
    float* H = args.out;
#define SSQP(i) ((float*)(ws + WS_SSQ + (size_t)(i) * SSQ_STRIDE))

    if (IN(0)) { REP(0) p0_prologue(F); } SEAM(0);
    if (IN(1)) {
        pg8::Gemm g{HB, (const bf16*)(ws + WS_WIN), M, INWP, DM}; pg8::StaticOrder S; S.init(M, INWP, F.G, (int)blockIdx.x);
        pg8::EpiBf E{SSQP(0), (bf16*)(ws + WS_QKV), QKVW, QKVW, (bf16*)(ws + WS_Z), VW, VW, (float*)(ws + WS_BA), 64, 64};
        pg8::gemm_phase<pg8::EpiBf, pg8::StaticOrder, PG8_ALIGN, PG8_SP2>(ring, g, S, E);
    } SEAM(1);
    if (IN(2)) { REP(2) p_gdnconv(F); } SEAM(2);
    if (IN(3)) { REP(3) p_prep(F); } SEAM(3);
    if (IN(4)) { REP(4) p_scan(F); } SEAM(4);
    if (IN(5)) {
        pg8::Gemm g{(const bf16*)(args.out + O_PK), (const bf16*)(ws + WS_WOUT), M, DM, VW}; pg8::StaticOrder S; S.init(M, DM, F.G, (int)blockIdx.x);
        pg8::EpiRes E{args.in[I_XP], args.in[I_XS] - (size_t)MP * DM, H, HB, SSQP(1)};
        pg8::gemm_phase<pg8::EpiRes, pg8::StaticOrder, PG8_ALIGN, PG8_SP2>(ring, g, S, E);
    } SEAM(5);
    if (IN(6)) {
        pg8::Gemm g{HB, (const bf16*)(ws + WS_WUP0), M, UPW, DM}; pg8::StaticOrder S; S.init(M, UPW, F.G, (int)blockIdx.x);
        pg8::EpiBf E{SSQP(1), (bf16*)(ws + WS_UP), UPW, UPW, nullptr, 0, 0, nullptr, 0, 0};
        pg8::gemm_phase<pg8::EpiBf, pg8::StaticOrder, PG8_ALIGN, PG8_SP2>(ring, g, S, E);
    } SEAM(6);
    if (IN(7)) { REP(7) p_ffnconv(F, 0); } SEAM(7);
    if (IN(8)) {
        pg8::Gemm g{(const bf16*)(ws + WS_ACT), (const bf16*)(ws + WS_WDN0), M, DM, DFF}; pg8::StaticOrder S; S.init(M, DM, F.G, (int)blockIdx.x);
        pg8::EpiRes E{H, H, H, HB, SSQP(2)};
        pg8::gemm_phase<pg8::EpiRes, pg8::StaticOrder, PG8_ALIGN, PG8_SP2>(ring, g, S, E);
        p_cacheconv(F, args.in[I_CK], (bf16*)(ws + WS_KC));
    } SEAM(8);
    if (IN(9)) {
        pg8::Gemm g{HB, (const bf16*)(ws + WS_WKVQ), M, 6144, DM}; pg8::StaticOrder S; S.init(M, 6144, F.G, (int)blockIdx.x);
        pg8::EpiKVQ E{SSQP(2), args.out, (bf16*)(ws + WS_KB), (WS_VB - WS_KB) / 2, (bf16*)(ws + WS_KC), (WS_VC - WS_KC) / 2};
        static_assert(WS_QB - WS_VB == WS_VB - WS_KB, "K, V, Q bf16 buffers equally spaced");
        pg8::gemm_phase<pg8::EpiKVQ, pg8::StaticOrder, PG8_ALIGN, PG8_SP2>(ring, g, S, E);
        p_cacheconv(F, args.in[I_CV], (bf16*)(ws + WS_VC));
    } SEAM(9);
    if (IN(10)) { REP(10) p_attn(F); } SEAM(10);
    if (IN(11)) {
        pg8::Gemm g{(const bf16*)(ws + WS_ATT), (const bf16*)(ws + WS_WO), M, DM, DM}; pg8::StaticOrder S; S.init(M, DM, F.G, (int)blockIdx.x);
        pg8::EpiRes E{H, H, H, HB, SSQP(3)};
        pg8::gemm_phase<pg8::EpiRes, pg8::StaticOrder, PG8_ALIGN, PG8_SP2>(ring, g, S, E);
    } SEAM(11);
    if (IN(12)) {
        pg8::Gemm g{HB, (const bf16*)(ws + WS_WUP1), M, UPW, DM}; pg8::StaticOrder S; S.init(M, UPW, F.G, (int)blockIdx.x);
        pg8::EpiBf E{SSQP(3), (bf16*)(ws + WS_UP), UPW, UPW, nullptr, 0, 0, nullptr, 0, 0};
        pg8::gemm_phase<pg8::EpiBf, pg8::StaticOrder, PG8_ALIGN, PG8_SP2>(ring, g, S, E);
    } SEAM(12);
    if (IN(13)) { p_ffnconv(F, 1); } SEAM(13);
    if (IN(14)) {
        pg8::Gemm g{(const bf16*)(ws + WS_ACT), (const bf16*)(ws + WS_WDN1), M, DM, DFF}; pg8::StaticOrder S; S.init(M, DM, F.G, (int)blockIdx.x);
        pg8::EpiRes E{H, H, H, nullptr, SSQP(4)};
        pg8::gemm_phase<pg8::EpiRes, pg8::StaticOrder, PG8_ALIGN, PG8_SP2>(ring, g, S, E);
    } SEAM(14);
    if (IN(15)) { p_final(F); }
#undef IN
#undef SEAM
}

extern "C" void kernel_launch(void* const* d_in, const int* in_sizes, int n_in, void* d_out, int out_size, void* d_ws, size_t ws_size, hipStream_t stream) {
    static int grid = 0;
    if (grid == 0) {
        if (n_in != N_IN || (size_t)out_size != O_END || ws_size < WS_END) { fprintf(stderr, "kernel_launch: shape mismatch: n_in %d out %d ws %zu (need %zu)\n", n_in, out_size, ws_size, (size_t)WS_END); grid = -1; return; }
        int dev = 0, cus = 0;
        if (hipGetDevice(&dev) != hipSuccess || hipDeviceGetAttribute(&cus, hipDeviceAttributeMultiprocessorCount, dev) != hipSuccess) { grid = -1; return; }
        if (hipFuncSetAttribute((const void*)fwd, hipFuncAttributeMaxDynamicSharedMemorySize, LDS_BYTES) != hipSuccess) { fprintf(stderr, "kernel_launch: hipFuncSetAttribute failed\n"); grid = -1; return; }
        int per_cu = 0;
        if (hipOccupancyMaxActiveBlocksPerMultiprocessor(&per_cu, (const void*)fwd, NWAVES * 64, LDS_BYTES) != hipSuccess || per_cu < 1) fprintf(stderr, "kernel_launch: occupancy query reports %d\n", per_cu);
        (void)hipGetLastError();
        grid = cus;
    }
    if (grid < 0) return;
    (void)hipMemsetAsync((char*)d_ws + WS_CTL, 0, CTL_ZERO_BYTES, stream);
    Args a{};
    for (int i = 0; i < N_IN; ++i) a.in[i] = (const float*)d_in[i];
    a.out = (float*)d_out; a.ws = (unsigned char*)d_ws;
    if (N_LAUNCH_MODE == 1) { a.ph_lo = 0; a.ph_hi = N_PHASES; hipLaunchKernelGGL(fwd, dim3(grid), dim3(NWAVES * 64), LDS_BYTES, stream, a); }
    else for (int p = 0; p < N_PHASES; ++p) { a.ph_lo = p; a.ph_hi = p + 1; hipLaunchKernelGGL(fwd, dim3(grid), dim3(NWAVES * 64), LDS_BYTES, stream, a); }
    const hipError_t le = hipPeekAtLastError();
    if (le != hipSuccess) fprintf(stderr, "kernel_launch: launch failed: %s\n", hipGetErrorName(le));
}
```

```cpp
#include <hip/hip_runtime.h>
#include <cstdio>
#include <cstdint>

constexpr int DM = 2048;
constexpr int SEQ = 8192, NB = 2, MP = NB * SEQ;
constexpr int DECB = 16, DECS = 16, MS = DECB * DECS;
constexpr int PAST = 2048;
constexpr int M = MP + MS;
constexpr int QKVW = 8192, VW = 4096, INW = 12352, INWP = 12544;
constexpr int DFF = 5632, UPW = 11264;
constexpr int NITEM_P = NB * 128 * 32, NITEM = NITEM_P + DECB * 32;
constexpr size_t O_Y = 0, O_PGDN = 34078720, O_PGC = 35127296, O_PFC = 35176448, O_PK = 35266560, O_PV = 68820992,
                 O_SGDN = 102375424, O_SGC = 110764032, O_SFC = 111157248, O_SK = 111878144, O_SV = 112402432, O_END = 112926720;
namespace pg8 {
#define PG8_LAS __attribute__((address_space(3)))
typedef unsigned short bf16_t;
typedef short bf16x8 __attribute__((ext_vector_type(8)));
typedef float f32x4 __attribute__((ext_vector_type(4)));
typedef unsigned u32x4 __attribute__((ext_vector_type(4)));
constexpr int BM = 256, BK = 64, HALF = 128, HTB = HALF * BK * 2  , STAGE_BYTES = 8 * HTB, NXCD = 8, WGM = 4;

__host__ __device__ __forceinline__ int lds_byte(int r, int c) { const int st = (r >> 4) * 2 + (c >> 5), rr = r & 15, cc = c & 31, ob = rr * 64 + cc * 2; return st * 1024 + (ob ^ (((ob >> 9) & 1) << 5)); }
__host__ __device__ __forceinline__ void stage_rc(int b, int& R, int& C) { const int st = b / 1024, sb = b % 1024, swz = sb ^ (((sb >> 9) & 1) << 5); R = (st >> 1) * 16 + swz / 64; C = (st & 1) * 32 + (swz % 64) / 2; }
__host__ __device__ __forceinline__ int perm32(int rho) { const int n = rho >> 4, i = rho & 15; return 8 * (i >> 2) + 4 * n + (i & 3); }

struct Unit { int pm, pn; };
struct Gemm { const bf16_t* A; const bf16_t* Bt; int M, N, K; };

struct StaticOrder {
    int nM, nN, nwg, G, c, wgm;
    __host__ __device__ void init(int M, int N, int G_, int c_, int wgm_ = WGM) { nM = M / BM; nN = N / BM; nwg = nM * nN; G = G_; c = c_; wgm = wgm_; }
    __host__ __device__ bool next(int i, Unit& u) const {
        const long L = (long)i * G + c; if (L >= nwg) return false;
        int wgid = (int)L; { const int q = nwg / NXCD, r = nwg % NXCD, xcd = wgid % NXCD, off = wgid / NXCD; wgid = (xcd < r ? xcd * (q + 1) : r * (q + 1) + (xcd - r) * q) + off; }
        const int nig = wgm * nN, gid = wgid / nig, fm = gid * wgm, gsz = (nM - fm) < wgm ? (nM - fm) : wgm;
        u.pm = fm + ((wgid % nig) % gsz); u.pn = (wgid % nig) / gsz; return true;
    }
    __device__ __forceinline__ void a_ready(const Unit&) const {}
    __device__ __forceinline__ void done(const Unit&) const {}
};

typedef float f32x2 __attribute__((ext_vector_type(2)));
typedef __bf16 bf16v2 __attribute__((ext_vector_type(2)));
typedef unsigned u32x2 __attribute__((ext_vector_type(2)));
__device__ __forceinline__ unsigned cvt_pk_bf16(float lo, float hi) { const f32x2 v = {lo, hi}; return __builtin_bit_cast(unsigned, __builtin_convertvector(v, bf16v2)); }

__device__ __forceinline__ void row_rstd(const float* ssq, int row0, int fq, float (&rs)[2][4]) {
    asm volatile("" : "+v"(row0), "+v"(fq));
#pragma unroll
    for (int ai = 0; ai < 2; ++ai)
#pragma unroll
        for (int m = 0; m < 4; ++m) {
            const float* p = ssq + (size_t)(row0 + ai * HALF + m * 16) * 32 + fq * 8;
            const f32x4 a = *(const f32x4*)p, b = *(const f32x4*)(p + 4);
            float s = ((a[0] + a[1]) + (a[2] + a[3])) + ((b[0] + b[1]) + (b[2] + b[3]));
            s += __shfl_xor(s, 16); s += __shfl_xor(s, 32);
            rs[ai][m] = rsqrtf(s * (1.0f / 2048.0f) + 1e-6f);
        }
}
struct EpiBf {
    static constexpr bool PERM = true, AFTER_DRAIN = false;
    const float* ssq; bf16_t* O0; int ld0, nc0; bf16_t* O1; int ld1, nc1; float* F2; int ld2, nc2;
    __device__ __forceinline__ void operator()(const f32x4 (&acc)[2][2][4][2], const Unit& u, int wr, int wc, int fr, int fq) const {
        asm volatile("" : "+v"(fr), "+v"(fq));
        const int row0 = u.pm * BM + wr * 64 + fr; const int colt = u.pn * BM;
        float rs[2][4]; row_rstd(ssq, row0, fq, rs);
        if (colt < nc0 + nc1) {
            bf16_t* base; int ld;
            if (colt < nc0) { base = O0 + colt; ld = ld0; } else { base = O1 + (colt - nc0); ld = ld1; }
            const int col0 = wc * 32 + 8 * fq;
#pragma unroll
            for (int ai = 0; ai < 2; ++ai)
#pragma unroll
                for (int m = 0; m < 4; ++m) { bf16_t* rowp = base + (size_t)(row0 + ai * HALF + m * 16) * ld + col0; const float r = rs[ai][m];
#pragma unroll
                    for (int bj = 0; bj < 2; ++bj) { const f32x4 v0 = acc[ai][bj][m][0] * r, v1 = acc[ai][bj][m][1] * r;
                        u32x4 w; w.x = cvt_pk_bf16(v0[0], v0[1]); w.y = cvt_pk_bf16(v0[2], v0[3]); w.z = cvt_pk_bf16(v1[0], v1[1]); w.w = cvt_pk_bf16(v1[2], v1[3]);
                        __builtin_nontemporal_store(w, (u32x4*)(rowp + bj * HALF)); } }
        } else if (colt == nc0 + nc1 && F2 != nullptr && wc * 32 < nc2) {
#pragma unroll
            for (int ai = 0; ai < 2; ++ai)
#pragma unroll
                for (int m = 0; m < 4; ++m) { float* rowp = F2 + (size_t)(row0 + ai * HALF + m * 16) * ld2 + wc * 32 + 8 * fq; const float r = rs[ai][m];
                    *(f32x4*)(rowp) = acc[ai][0][m][0] * r; *(f32x4*)(rowp + 4) = acc[ai][0][m][1] * r; }
        }
    }
};
struct EpiRes {
    static constexpr bool PERM = false, AFTER_DRAIN = false;
    const float* base0; const float* base1; float* out; bf16_t* hb; float* ssq;
    __device__ __forceinline__ void operator()(const f32x4 (&acc)[2][2][4][2], const Unit& u, int wr, int wc, int fr, int fq) const {
        asm volatile("" : "+v"(fr), "+v"(fq));
        const int row0 = u.pm * BM + wr * 64 + fr, col0 = u.pn * BM + wc * 32 + 4 * fq;
        const float* bs = (u.pm * BM < MP) ? base0 : base1;
#pragma unroll
        for (int ai = 0; ai < 2; ++ai)
#pragma unroll
            for (int m = 0; m < 4; ++m) { const size_t off = (size_t)(row0 + ai * HALF + m * 16) * DM + col0; float ss = 0.f;
#pragma unroll
                for (int bj = 0; bj < 2; ++bj)
#pragma unroll
                    for (int n = 0; n < 2; ++n) { const size_t o2 = off + bj * HALF + n * 16; const f32x4 o = __builtin_nontemporal_load((const f32x4*)(bs + o2)) + acc[ai][bj][m][n];
                        __builtin_nontemporal_store(o, (f32x4*)(out + o2)); ss += (o[0] * o[0] + o[1] * o[1]) + (o[2] * o[2] + o[3] * o[3]);
                        if (hb) { u32x2 w; w.x = cvt_pk_bf16(o[0], o[1]); w.y = cvt_pk_bf16(o[2], o[3]); *(u32x2*)(hb + o2) = w; } }
                ss += __shfl_xor(ss, 16); ss += __shfl_xor(ss, 32);
                if (fq == 0) ssq[(size_t)(row0 + ai * HALF + m * 16) * 32 + u.pn * 4 + wc] = ss; }
    }
};
struct EpiKVQ {
    static constexpr bool PERM = false, AFTER_DRAIN = false;
    const float* ssq; float* dout; bf16_t* KB; size_t kvq_stride; bf16_t* KC; size_t kc_stride;
    __device__ __forceinline__ void operator()(const f32x4 (&acc)[2][2][4][2], const Unit& u, int wr, int wc, int fr, int fq) const {
        asm volatile("" : "+v"(fr), "+v"(fq));
        const int row0 = u.pm * BM + wr * 64 + fr; const int colt = u.pn * BM, which = colt >> 11, cb = (colt & 2047) + wc * 32 + 4 * fq;
        float rs[2][4]; row_rstd(ssq, row0, fq, rs);
        bf16_t* bb = KB + (size_t)which * kvq_stride;
        float* fo = nullptr;
        if (which < 2) fo = (u.pm * BM < MP) ? dout + O_PK + (size_t)which * (O_PV - O_PK) : dout + O_SK + (size_t)which * (O_SV - O_SK) - (size_t)MP * DM;
#pragma unroll
        for (int ai = 0; ai < 2; ++ai)
#pragma unroll
            for (int m = 0; m < 4; ++m) { const size_t off = (size_t)(row0 + ai * HALF + m * 16) * DM + cb; const float r = rs[ai][m];
#pragma unroll
                for (int bj = 0; bj < 2; ++bj)
#pragma unroll
                    for (int n = 0; n < 2; ++n) { const size_t o2 = off + bj * HALF + n * 16; const f32x4 o = acc[ai][bj][m][n] * r;
                        if (fo) __builtin_nontemporal_store(o, (f32x4*)(fo + o2));
                        u32x2 w; w.x = cvt_pk_bf16(o[0], o[1]); w.y = cvt_pk_bf16(o[2], o[3]); *(u32x2*)(bb + o2) = w;
                        if (which < 2 && u.pm * BM >= MP) { const int ms = row0 + ai * HALF + m * 16 - MP;
                            *(u32x2*)(KC + (size_t)which * kc_stride + ((size_t)(ms >> 4) * (2048 + 16) + 2048 + (ms & 15)) * DM + cb + bj * HALF + n * 16) = w; } } }
    }
};

struct EpiKVQs {
    static constexpr bool PERM = false, AFTER_DRAIN = false;
    const float* ssq; float* dout; bf16_t* KC; size_t kc_stride; bf16_t* Qs;
    __device__ __forceinline__ void operator()(const f32x4 (&acc)[2][2][4][2], const Unit& u, int wr, int wc, int fr, int fq) const {
        asm volatile("" : "+v"(fr), "+v"(fq));
        const int row0 = u.pm * BM + wr * 64 + fr; const int colt = u.pn * BM, which = colt >> 11, cb = (colt & 2047) + wc * 32 + 4 * fq;
        float rs[2][4]; row_rstd(ssq, row0, fq, rs);
        float* fo = (which < 2) ? dout + O_SK + (size_t)which * (O_SV - O_SK) - (size_t)MP * DM : nullptr;
#pragma unroll
        for (int ai = 0; ai < 2; ++ai)
#pragma unroll
            for (int m = 0; m < 4; ++m) { const int row = row0 + ai * HALF + m * 16, ms = row - MP; const size_t off = (size_t)row * DM + cb; const float r = rs[ai][m];
#pragma unroll
                for (int bj = 0; bj < 2; ++bj)
#pragma unroll
                    for (int n = 0; n < 2; ++n) { const size_t o2 = off + bj * HALF + n * 16; const f32x4 o = acc[ai][bj][m][n] * r;
                        u32x2 w; w.x = cvt_pk_bf16(o[0], o[1]); w.y = cvt_pk_bf16(o[2], o[3]);
                        if (which < 2) { *(f32x4*)(fo + o2) = o; *(u32x2*)(KC + (size_t)which * kc_stride + ((size_t)(ms >> 4) * (2048 + 16) + 2048 + (ms & 15)) * DM + cb + bj * HALF + n * 16) = w; }
                        else *(u32x2*)(Qs + o2) = w; } }
    }
};
struct EpiPart {
    static constexpr bool PERM = false, AFTER_DRAIN = false;
    float* part;
    __device__ __forceinline__ void operator()(const f32x4 (&acc)[2][2][4][2], const Unit& u, int wr, int wc, int fr, int fq) const {
        asm volatile("" : "+v"(fr), "+v"(fq));
        const int row0 = u.pm * BM + wr * 64 + fr, col0 = (u.pn & 7) * BM + wc * 32 + 4 * fq;
#pragma unroll
        for (int ai = 0; ai < 2; ++ai)
#pragma unroll
            for (int m = 0; m < 4; ++m) { const size_t off = (size_t)(row0 + ai * HALF + m * 16) * DM + col0;
#pragma unroll
                for (int bj = 0; bj < 2; ++bj)
#pragma unroll
                    for (int n = 0; n < 2; ++n) __builtin_nontemporal_store(acc[ai][bj][m][n], (f32x4*)(part + off + bj * HALF + n * 16)); }
    }
};
struct SplitOrder {
    int G, c;
    __host__ __device__ bool next(int i, Unit& u) const { const int L = i * G + c; if (L >= 16) return false; u.pm = L >> 3; u.pn = L; return true; }
    __device__ __forceinline__ void a_ready(const Unit&) const {}
    __device__ __forceinline__ void done(const Unit&) const {}
};
struct SubOrder {
    int pm, nN, G, c;
    __host__ __device__ bool next(int i, Unit& u) const { const int L = i * G + c; if (L >= nN) return false; u.pm = pm; u.pn = L; return true; }
    __device__ __forceinline__ void a_ready(const Unit&) const {}
    __device__ __forceinline__ void done(const Unit&) const {}
};
template <class Epi, class Sched, bool ALIGN_EPI = false, bool SP2 = false>
__device__ __forceinline__ void gemm_phase(PG8_LAS unsigned char* lds, const Gemm g, const Sched& S, const Epi& E, int tid) {
    asm volatile("" : "+v"(tid));
    const int wid = __builtin_amdgcn_readfirstlane(tid >> 6), lane = tid & 63, wr = wid >> 2, wc = wid & 3, fr = lane & 15, fq = lane >> 4;
    const int K = g.K, nt = K / BK;
    unsigned voffA[2], voffB[2];
#pragma unroll
    for (int i = 0; i < 2; ++i) { int R, C; stage_rc(tid * 16 + i * 8192, R, C); const int Rb = Epi::PERM ? ((R & ~31) + perm32(R & 31)) : R;
        voffA[i] = (unsigned)(R * K + C) * 2u; voffB[i] = (unsigned)(Rb * K + C) * 2u; }
    const size_t kstep = (size_t)(BK * 2);
    const size_t hstep = (size_t)HALF * K * 2;
    const size_t tstep = 2 * hstep;
    const unsigned ldsw = (unsigned)wid * 1024u;
    const int aoff = lds_byte(wr * 64 + fr, fq * 8), boff = lds_byte(wc * 32 + fr, fq * 8);
#define PG8_SA(b, h) (((b) * 2 + (h)) * HTB)
#define PG8_SB(b, h) ((4 + (b) * 2 + (h)) * HTB)
#define PG8_STAGE(bufoff, gbase, voff) do { _Pragma("unroll") for (int _i = 0; _i < 2; ++_i) \
        __builtin_amdgcn_global_load_lds((const unsigned*)((const char*)(gbase) + (voff)[_i]), (PG8_LAS unsigned*)(lds + (bufoff) + ldsw + _i * 8192), 16, 0, 0); } while (0)
#define PG8_LDA(dst, b, h) do { _Pragma("unroll") for (int m = 0; m < 4; ++m) _Pragma("unroll") for (int k = 0; k < 2; ++k) dst[m][k] = *(const PG8_LAS bf16x8*)(lds + PG8_SA(b, h) + aoff + m * 2048 + k * 1024); } while (0)
#define PG8_LDB(dst, b, h) do { _Pragma("unroll") for (int n = 0; n < 2; ++n) _Pragma("unroll") for (int k = 0; k < 2; ++k) dst[n][k] = *(const PG8_LAS bf16x8*)(lds + PG8_SB(b, h) + boff + n * 2048 + k * 1024); } while (0)
#define PG8_MMA(ai, bj, At, Bt) do { __builtin_amdgcn_s_setprio(1); _Pragma("unroll") for (int m = 0; m < 4; ++m) _Pragma("unroll") for (int n = 0; n < 2; ++n) _Pragma("unroll") for (int k = 0; k < 2; ++k) \
        acc[ai][bj][m][n] = __builtin_amdgcn_mfma_f32_16x16x32_bf16(Bt[n][k], At[m][k], acc[ai][bj][m][n], 0, 0, 0); __builtin_amdgcn_s_setprio(0); } while (0)
#define PG8_WAIT_V(n) asm volatile("s_waitcnt vmcnt(" #n ")" ::: "memory")
#define PG8_WAIT_L(n) asm volatile("s_waitcnt lgkmcnt(" #n ")" ::: "memory")
#define PG8_BAR __builtin_amdgcn_s_barrier()
#define PG8_SCHED __builtin_amdgcn_sched_barrier(0)
    Unit cur, nxt; int ui = 0;
    if (!S.next(0, cur)) return;
    f32x4 acc[2][2][4][2];
#pragma unroll
    for (int a = 0; a < 2; ++a)
#pragma unroll
        for (int b = 0; b < 2; ++b)
#pragma unroll
            for (int m = 0; m < 4; ++m)
#pragma unroll
                for (int n = 0; n < 2; ++n) acc[a][b][m][n] = (f32x4){0.f, 0.f, 0.f, 0.f};
    bf16x8 At[4][2], B0[2][2], B1[2][2];
    const char* cA = (const char*)g.A + (size_t)cur.pm * tstep; const char* cB = (const char*)g.Bt + (size_t)cur.pn * tstep;
    S.a_ready(cur);
    if constexpr (SP2) {
        PG8_STAGE(PG8_SB(0, 0), cB, voffB); PG8_STAGE(PG8_SB(0, 1), cB + hstep, voffB); PG8_STAGE(PG8_SA(0, 0), cA, voffA); PG8_STAGE(PG8_SA(0, 1), cA + hstep, voffA);
        if (wr == 1) PG8_BAR;
        PG8_WAIT_V(2); PG8_BAR;
        PG8_STAGE(PG8_SB(1, 0), cB + kstep, voffB); PG8_STAGE(PG8_SA(1, 0), cA + kstep, voffA); PG8_STAGE(PG8_SB(1, 1), cB + hstep + kstep, voffB);
        PG8_WAIT_V(6); PG8_BAR;
    } else {
        PG8_STAGE(PG8_SB(0, 0), cB, voffB); PG8_STAGE(PG8_SA(0, 0), cA, voffA); PG8_STAGE(PG8_SB(0, 1), cB + hstep, voffB); PG8_STAGE(PG8_SA(0, 1), cA + hstep, voffA);
        if (wr == 1) PG8_BAR;
        PG8_WAIT_V(4); PG8_BAR;
        PG8_STAGE(PG8_SB(1, 0), cB + kstep, voffB); PG8_STAGE(PG8_SA(1, 0), cA + kstep, voffA); PG8_STAGE(PG8_SB(1, 1), cB + hstep + kstep, voffB);
        PG8_WAIT_V(6); PG8_BAR;
    }
    for (;;) {
        const bool has_next = S.next(ui + 1, nxt);
        const char* nA = has_next ? (const char*)g.A + (size_t)nxt.pm * tstep : cA; const char* nB = has_next ? (const char*)g.Bt + (size_t)nxt.pn * tstep : cB;
        for (int t = 0; t < nt; t += 2) {
            const bool last = (t == nt - 2);
            const char* a1 = cA + (size_t)(t + 1) * kstep;
            const char* a2 = last ? nA : cA + (size_t)(t + 2) * kstep; const char* b2 = last ? nB : cB + (size_t)(t + 2) * kstep;
            const char* a3 = a2 + kstep; const char* b3 = b2 + kstep;
            if (last && has_next) S.a_ready(nxt);
            if constexpr (SP2) {
            PG8_LDB(B0, 0, 0); PG8_LDB(B1, 0, 1); PG8_SCHED; PG8_LDA(At, 0, 0); PG8_STAGE(PG8_SA(1, 1), a1 + hstep, voffA);
            PG8_WAIT_V(8); PG8_WAIT_L(0); PG8_BAR; PG8_MMA(0, 0, At, B0); PG8_MMA(0, 1, At, B1); PG8_BAR; PG8_SCHED;
            PG8_LDA(At, 0, 1); PG8_STAGE(PG8_SB(0, 0), b2, voffB); PG8_STAGE(PG8_SB(0, 1), b2 + hstep, voffB); PG8_STAGE(PG8_SA(0, 0), a2, voffA);
            PG8_WAIT_V(8); PG8_WAIT_L(0); PG8_BAR; PG8_MMA(1, 0, At, B0); PG8_MMA(1, 1, At, B1); PG8_BAR; PG8_SCHED;
            PG8_LDB(B0, 1, 0); PG8_LDB(B1, 1, 1); PG8_SCHED; PG8_LDA(At, 1, 0); PG8_STAGE(PG8_SA(0, 1), a2 + hstep, voffA);
            PG8_WAIT_V(8); PG8_WAIT_L(0); PG8_BAR; PG8_MMA(0, 0, At, B0); PG8_MMA(0, 1, At, B1); PG8_BAR; PG8_SCHED;
            PG8_LDA(At, 1, 1); PG8_STAGE(PG8_SB(1, 0), b3, voffB); PG8_STAGE(PG8_SB(1, 1), b3 + hstep, voffB); PG8_STAGE(PG8_SA(1, 0), a3, voffA);
            PG8_WAIT_V(8); PG8_WAIT_L(0); PG8_BAR; PG8_MMA(1, 0, At, B0); PG8_MMA(1, 1, At, B1); PG8_BAR; PG8_SCHED;
            } else {
            PG8_LDB(B0, 0, 0); PG8_SCHED; PG8_LDA(At, 0, 0); PG8_STAGE(PG8_SA(1, 1), a1 + hstep, voffA);
            PG8_WAIT_L(8); PG8_BAR; PG8_WAIT_L(0); PG8_MMA(0, 0, At, B0); PG8_BAR; PG8_SCHED;
            PG8_LDB(B1, 0, 1); PG8_STAGE(PG8_SB(0, 0), b2, voffB);
            PG8_BAR; PG8_WAIT_L(0); PG8_MMA(0, 1, At, B1); PG8_BAR;
            PG8_LDA(At, 0, 1); PG8_STAGE(PG8_SA(0, 0), a2, voffA);
            PG8_BAR; PG8_WAIT_L(0); PG8_MMA(1, 0, At, B0); PG8_BAR; PG8_SCHED;
            PG8_STAGE(PG8_SB(0, 1), b2 + hstep, voffB);
            PG8_WAIT_V(6); PG8_BAR; PG8_MMA(1, 1, At, B1); PG8_BAR;
            PG8_LDB(B0, 1, 0); PG8_SCHED; PG8_LDA(At, 1, 0); PG8_STAGE(PG8_SA(0, 1), a2 + hstep, voffA);
            PG8_WAIT_L(8); PG8_BAR; PG8_WAIT_L(0); PG8_MMA(0, 0, At, B0); PG8_BAR; PG8_SCHED;
            PG8_LDB(B1, 1, 1); PG8_STAGE(PG8_SB(1, 0), b3, voffB);
            PG8_BAR; PG8_WAIT_L(0); PG8_MMA(0, 1, At, B1); PG8_BAR;
            PG8_LDA(At, 1, 1); PG8_STAGE(PG8_SA(1, 0), a3, voffA);
            PG8_BAR; PG8_WAIT_L(0); PG8_MMA(1, 0, At, B0); PG8_BAR; PG8_SCHED;
            PG8_STAGE(PG8_SB(1, 1), b3 + hstep, voffB);
            PG8_WAIT_V(6); PG8_BAR; PG8_MMA(1, 1, At, B1); PG8_BAR;
            }
        }
        if constexpr (ALIGN_EPI) { if (wr == 0) PG8_BAR; }
        if constexpr (!Epi::AFTER_DRAIN) { E(acc, cur, wr, wc, fr, fq); S.done(cur); }
        if (!has_next) break;
#pragma unroll
        for (int a = 0; a < 2; ++a)
#pragma unroll
            for (int b = 0; b < 2; ++b)
#pragma unroll
                for (int m = 0; m < 4; ++m)
#pragma unroll
                    for (int n = 0; n < 2; ++n) acc[a][b][m][n] = (f32x4){0.f, 0.f, 0.f, 0.f};
        cur = nxt; cA = nA; cB = nB; ++ui;
        if constexpr (ALIGN_EPI) { if (wr == 1) PG8_BAR; }
    }
    PG8_WAIT_V(0);
    if constexpr (!ALIGN_EPI) { if (wr == 0) PG8_BAR; }
    PG8_BAR;
    if constexpr (Epi::AFTER_DRAIN) { E.fused(acc, cur, wr, wc, fr, fq, lds, wid, lane); S.done(cur); }
#undef PG8_SA
#undef PG8_SB
#undef PG8_STAGE
#undef PG8_LDA
#undef PG8_LDB
#undef PG8_MMA
#undef PG8_WAIT_V
#undef PG8_WAIT_L
#undef PG8_BAR
#undef PG8_SCHED
}
}
#ifndef PG8_SP2
#define PG8_SP2 true
#endif
#ifndef PG8_ALIGN
#define PG8_ALIGN true
#endif

constexpr size_t MiB = 1u << 20;
constexpr size_t WS_CTL = 0, CTL_ZERO_BYTES = 1 * MiB;
constexpr size_t WS_SSQ = 1 * MiB, SSQ_STRIDE = 2359296;
constexpr size_t WS_BA = 13 * MiB;
constexpr size_t WS_EG = 18 * MiB, WS_DL = 21 * MiB, WS_GL = 24 * MiB;
constexpr size_t WS_WIN = 32 * MiB, WS_WOUT = 81 * MiB, WS_WUP0 = 97 * MiB, WS_WDN0 = 141 * MiB, WS_WKVQ = 163 * MiB, WS_WO = 187 * MiB, WS_WUP1 = 195 * MiB, WS_WDN1 = 239 * MiB;
constexpr size_t WS_HB = 261 * MiB;
constexpr size_t WS_RA = 326 * MiB;
constexpr size_t WS_QKV = WS_RA, WS_Z = WS_RA + 260 * MiB, WS_UP = WS_RA;
constexpr size_t WS_KC = WS_RA, WS_VC = WS_RA + 130 * MiB;
static_assert(WS_KC + (size_t)DECB * (PAST + DECS) * DM * 2 <= WS_VC && WS_VC + (size_t)DECB * (PAST + DECS) * DM * 2 <= WS_RA + 390 * MiB, "cache copies");
constexpr size_t WS_RB = 716 * MiB;
constexpr size_t WS_QN = WS_RB, WS_KN = WS_RB + 65 * MiB, WS_VV = WS_RB + 130 * MiB, WS_TP = WS_RB + 260 * MiB, WS_PP = WS_RB + 328 * MiB;
constexpr size_t WS_ACT = WS_RB;
constexpr size_t WS_KB = WS_RB, WS_VB = WS_RB + 65 * MiB, WS_QB = WS_RB + 130 * MiB, WS_ATT = WS_RB + 195 * MiB;
constexpr size_t WS_SUP = 1112 * MiB, WS_SACT = 1118 * MiB, WS_SQB = 1121 * MiB, WS_SATT = 1122 * MiB;
constexpr size_t WS_END = 1123 * MiB;
static_assert(WS_SUP + (size_t)MS * UPW * 2 <= WS_SACT && WS_SACT + (size_t)MS * DFF * 2 <= WS_SQB && WS_SQB + (size_t)MS * DM * 2 <= WS_SATT && WS_SATT + (size_t)MS * DM * 2 <= WS_END, "sample buffers");
static_assert((size_t)M * 32 * 4 <= SSQ_STRIDE && WS_SSQ + 5 * SSQ_STRIDE <= WS_BA && WS_BA + (size_t)M * 64 * 4 <= WS_EG && WS_EG + (size_t)NITEM * 256 <= WS_DL && WS_DL + (size_t)NITEM * 256 <= WS_GL && WS_GL + NITEM * 4 <= WS_WIN, "small buffers");
static_assert(WS_WIN + (size_t)INWP * DM * 2 <= WS_WOUT && WS_WDN1 + (size_t)DM * DFF * 2 <= WS_HB && WS_HB + (size_t)M * DM * 2 <= WS_RA, "weights / HB");
static_assert(WS_QKV + (size_t)M * QKVW * 2 <= WS_Z && WS_Z + (size_t)M * VW * 2 <= WS_RB && WS_UP + (size_t)M * UPW * 2 <= WS_RB, "region A");
static_assert(WS_QN + (size_t)M * DM * 2 <= WS_KN && WS_KN + (size_t)M * DM * 2 <= WS_VV && WS_VV + (size_t)M * VW * 2 <= WS_TP && WS_TP + (size_t)NITEM * 8192 <= WS_PP && WS_PP + (size_t)NITEM * 8192 <= WS_END, "region B (gdn)");
static_assert(WS_ACT + (size_t)M * DFF * 2 <= WS_END && WS_ATT + (size_t)M * DM * 2 <= WS_END, "region B");
static_assert((size_t)M * VW * 2 <= (O_SGDN - O_PK) * 4, "ON scratch");
constexpr int CW_BAR = 4096, CW_BAR2 = 8192, CW_BAR3 = 12288;

constexpr int LDS_BYTES = 159744;
constexpr int LDSCTL_OFF = 158720;
constexpr int NWAVES = 8;

#define GAS __attribute__((address_space(1)))
#define LAS __attribute__((address_space(3)))
#define DI __device__ __forceinline__
typedef unsigned short bf16;
typedef unsigned v4u __attribute__((ext_vector_type(4)));
typedef unsigned v2u __attribute__((ext_vector_type(2)));
typedef float f32x4 __attribute__((ext_vector_type(4)));
typedef float f32x16 __attribute__((ext_vector_type(16)));
typedef short bf16x8 __attribute__((ext_vector_type(8)));
typedef short bf16x4 __attribute__((ext_vector_type(4)));
#define LDS_WAIT() asm volatile("s_waitcnt lgkmcnt(0)" ::: "memory")
#define VM_WAIT() asm volatile("s_waitcnt vmcnt(0)" ::: "memory")
#define MFMA32(a, b, c) __builtin_amdgcn_mfma_f32_32x32x16_bf16((a), (b), (c), 0, 0, 0)
DI unsigned pk2(float lo, float hi) { return pg8::cvt_pk_bf16(lo, hi); }
DI float bf2f(unsigned short b) { return __builtin_bit_cast(float, ((unsigned)b) << 16); }
DI float bflo(unsigned w) { return __builtin_bit_cast(float, w << 16); }
DI float bfhi(unsigned w) { return __builtin_bit_cast(float, w & 0xffff0000u); }
DI void unpack8(const v4u w, float (&f)[8]) { f[0] = bflo(w.x); f[1] = bfhi(w.x); f[2] = bflo(w.y); f[3] = bfhi(w.y); f[4] = bflo(w.z); f[5] = bfhi(w.z); f[6] = bflo(w.w); f[7] = bfhi(w.w); }
DI v4u pack8(const float (&f)[8]) { v4u w; w.x = pk2(f[0], f[1]); w.y = pk2(f[2], f[3]); w.z = pk2(f[4], f[5]); w.w = pk2(f[6], f[7]); return w; }
DI int crow(int r, int hi) { return (r & 3) + 8 * (r >> 2) + 4 * hi; }
DI float wave_sum(float v) {
#pragma unroll
    for (int o = 1; o < 64; o <<= 1) v += __shfl_xor(v, o);
    return v;
}
DI float siluf(float x) { return x * __builtin_amdgcn_rcpf(1.0f + __expf(-x)); }

template <int OFF> DI bf16x4 tr_read(int vb) { bf16x4 r; asm volatile("ds_read_b64_tr_b16 %0, %1 offset:%2" : "=&v"(r) : "v"(vb), "i"(OFF) : "memory"); return r; }
#define XB_TMO      128
#define XB_XCNT(j)  (256  + 64 * (j))
#define XB_XSUB(j)  (1280 + 64 * (j))
#define XB_XGEN(j)  (2304 + 64 * (j))
#define XB_TOP      3328
#define XB_TOPGEN   3392
#define XCD_BAR_WORDS 3456
#define XB_SPIN_CAP (1u << 18)

__device__ __forceinline__ unsigned xb_ld(unsigned* p)              { return __hip_atomic_load(p, __ATOMIC_RELAXED, __HIP_MEMORY_SCOPE_AGENT); }
__device__ __forceinline__ unsigned xb_add(unsigned* p, unsigned v) { return __hip_atomic_fetch_add(p, v, __ATOMIC_RELAXED, __HIP_MEMORY_SCOPE_AGENT); }
__device__ __forceinline__ unsigned xb_xcc_id() { return (unsigned)__builtin_amdgcn_s_getreg((3 << 11) | 20) & 0xFu; }
#define XB_SPIN(cond, bar) do { unsigned _sp = 0; while (cond) { __builtin_amdgcn_s_sleep(1); \
    if ((++_sp & 255u) == 0u) { if (xb_ld(&(bar)[XB_TMO])) break; if (_sp > XB_SPIN_CAP) { atomicAdd(&(bar)[XB_TMO], 1u); break; } } } } while (0)

struct XcdBarrier {
    unsigned* bar; unsigned x;
    volatile LAS unsigned* st;
};

__device__ __forceinline__ XcdBarrier xcd_barrier_post(unsigned* bar, volatile LAS unsigned* st) {
    XcdBarrier b; b.bar = bar; b.x = xb_xcc_id(); b.st = st;
    if (threadIdx.x == 0) (void)xb_add(&bar[XB_XCNT(b.x)], 1u);
    return b;
}
__device__ __forceinline__ void xcd_barrier_complete(unsigned* bar, unsigned x, unsigned& nloc, unsigned& nx) {
    const unsigned G = gridDim.x * gridDim.y * gridDim.z;
    unsigned sum, cnt, mine, sp = 0u;
    for (;;) {
        sum = 0u; cnt = 0u; mine = 0u;
#pragma unroll
        for (unsigned j = 0; j < 16; ++j) { const unsigned c = xb_ld(&bar[XB_XCNT(j)]); sum += c; cnt += (c > 0u) ? 1u : 0u; mine = (j == x) ? c : mine; }
        if (sum == G) break;
        __builtin_amdgcn_s_sleep(1);
        if ((++sp & 255u) == 0u) { if (xb_ld(&bar[XB_TMO])) break; if (sp > XB_SPIN_CAP) { atomicAdd(&bar[XB_TMO], 1u); break; } }
    }
    nloc = mine > 0u ? mine : 1u; nx = cnt > 0u ? cnt : 1u;
}

__device__ __forceinline__ void xcd_barrier(const XcdBarrier& b) {
    asm volatile("s_waitcnt vmcnt(0)" ::: "memory");
    __syncthreads();
    if (threadIdx.x == 0) {
        unsigned* bar = b.bar;
        __builtin_amdgcn_s_waitcnt(0);
        unsigned nloc = b.st[0], nx = b.st[1];
        if (nloc == 0u) { xcd_barrier_complete(bar, b.x, nloc, nx); b.st[0] = nloc; b.st[1] = nx; }
        const unsigned old = xb_add(&bar[XB_XSUB(b.x)], 1u);
        const unsigned gen = old / nloc;
        if (old + 1u == (gen + 1u) * nloc) {
            __builtin_amdgcn_fence(__ATOMIC_RELEASE, "agent");
            asm volatile("s_waitcnt vmcnt(0)" ::: "memory");
            const unsigned og = xb_add(&bar[XB_TOP], 1u);
            const unsigned tg = og / nx;
            if (og + 1u == (tg + 1u) * nx) xb_add(&bar[XB_TOPGEN], 1u);
            else XB_SPIN(xb_ld(&bar[XB_TOPGEN]) == tg, bar);
            __builtin_amdgcn_fence(__ATOMIC_ACQUIRE, "agent");
            xb_add(&bar[XB_XGEN(b.x)], 1u);
            asm volatile("s_waitcnt vmcnt(0)" ::: "memory");
        } else {
            XB_SPIN(xb_ld(&bar[XB_XGEN(b.x)]) == gen, bar);
            __builtin_amdgcn_fence(__ATOMIC_ACQUIRE, "agent");
            asm volatile("s_waitcnt vmcnt(0)" ::: "memory");
        }
    }
    __syncthreads();
}
__device__ __forceinline__ void sub_barrier_complete(unsigned* bar, unsigned x, unsigned& nloc, unsigned& nx, const unsigned expect) {
    unsigned sum, cnt, mine, sp = 0u;
    for (;;) {
        sum = 0u; cnt = 0u; mine = 0u;
#pragma unroll
        for (unsigned j = 0; j < 16; ++j) { const unsigned c = xb_ld(&bar[XB_XCNT(j)]); sum += c; cnt += (c > 0u) ? 1u : 0u; mine = (j == x) ? c : mine; }
        if (sum == expect) break;
        __builtin_amdgcn_s_sleep(1);
        if ((++sp & 255u) == 0u) { if (xb_ld(&bar[XB_TMO])) break; if (sp > XB_SPIN_CAP) { atomicAdd(&bar[XB_TMO], 1u); break; } }
    }
    nloc = mine > 0u ? mine : 1u; nx = cnt > 0u ? cnt : 1u;
}
__device__ __forceinline__ void sub_barrier(const XcdBarrier& b, const unsigned expect) {
    asm volatile("s_waitcnt vmcnt(0)" ::: "memory");
    __syncthreads();
    if (threadIdx.x == 0) {
        unsigned* bar = b.bar;
        __builtin_amdgcn_s_waitcnt(0);
        unsigned nloc = b.st[0], nx = b.st[1];
        if (nloc == 0u) { sub_barrier_complete(bar, b.x, nloc, nx, expect); b.st[0] = nloc; b.st[1] = nx; }
        const unsigned old = xb_add(&bar[XB_XSUB(b.x)], 1u);
        const unsigned gen = old / nloc;
        if (old + 1u == (gen + 1u) * nloc) {
            __builtin_amdgcn_fence(__ATOMIC_RELEASE, "agent");
            asm volatile("s_waitcnt vmcnt(0)" ::: "memory");
            const unsigned og = xb_add(&bar[XB_TOP], 1u);
            const unsigned tg = og / nx;
            if (og + 1u == (tg + 1u) * nx) xb_add(&bar[XB_TOPGEN], 1u);
            else XB_SPIN(xb_ld(&bar[XB_TOPGEN]) == tg, bar);
            __builtin_amdgcn_fence(__ATOMIC_ACQUIRE, "agent");
            xb_add(&bar[XB_XGEN(b.x)], 1u);
            asm volatile("s_waitcnt vmcnt(0)" ::: "memory");
        } else {
            XB_SPIN(xb_ld(&bar[XB_XGEN(b.x)]) == gen, bar);
            __builtin_amdgcn_fence(__ATOMIC_ACQUIRE, "agent");
            asm volatile("s_waitcnt vmcnt(0)" ::: "memory");
        }
    }
    __syncthreads();
}
struct Frame {
    LAS unsigned char* lds;
    volatile LAS unsigned* MISC;
    unsigned* ctl;
    int tid, lane, wave;
    int vcu, G;
    const float* const* in;
    float* out; unsigned char* ws;
};
enum { I_XP = 0, I_XS, I_SGDN, I_SGC, I_SFC, I_CK, I_CV, I_ANORM, I_AWIN, I_AWCONV, I_ALOG, I_ADT, I_AONORM, I_AWOUT, I_KVNORM, I_WKV, I_BNORM, I_BWQ,
       I_LQ1, I_LK1, I_LQ2, I_LK2, I_SUBN, I_BWO, I_RELB, I_FNORM, I_FWUP, I_FWCONV, I_FBCONV, I_FWDN, I_FINAL, N_IN };

constexpr int TR_LDS = 16896;
DI void p0_transpose_item(const float* W, const float* gain, int K, int N, bf16* WT, int row_off, LAS float* scr, int item, int lane) {
    const int nblk = N / 64, kb = item / nblk, nb = item % nblk, k0 = 64 * kb, n0 = 64 * nb;
    const int n4 = lane & 15;
#pragma unroll 8
    for (int i = 0; i < 16; ++i) { const int kk = 4 * i + (lane >> 4); const float gk = gain ? gain[k0 + kk] : 1.0f;
        const f32x4 v = __builtin_nontemporal_load((const f32x4*)(W + (size_t)(k0 + kk) * N + n0 + 4 * n4));
        LAS float* d = scr + kk * 65 + 4 * n4; d[0] = v[0] * gk; d[1] = v[1] * gk; d[2] = v[2] * gk; d[3] = v[3] * gk; }
    LDS_WAIT(); asm volatile("" ::: "memory");
    const int c = lane & 7;
#pragma unroll
    for (int j = 0; j < 8; ++j) { const int n = (lane >> 3) + 8 * j; const LAS float* s = scr + (8 * c) * 65 + n;
        v4u o; o.x = pk2(s[0 * 65], s[1 * 65]); o.y = pk2(s[2 * 65], s[3 * 65]); o.z = pk2(s[4 * 65], s[5 * 65]); o.w = pk2(s[6 * 65], s[7 * 65]);
        *(v4u*)(WT + (size_t)(row_off + n0 + n) * K + k0 + 8 * c) = o; }
    LDS_WAIT(); asm volatile("" ::: "memory");
}
DI void conv_mat(Frame& F, const float* W, const float* gain, const int K, const int N, bf16* WT, const int row_off, const int gw, const int NGW) {
    LAS float* scr = (LAS float*)(F.lds + F.wave * TR_LDS);
    const int nit = (K / 64) * (N / 64);
    for (int it = gw; it < nit; it += NGW) p0_transpose_item(W, gain, K, N, WT, row_off, scr, it, F.lane);
}
enum { CJ_WOUT = 0, CJ_WUP0, CJ_WDN0, CJ_WKVQ, CJ_WO, CJ_WUP1, CJ_WDN1, CJ_WDN0S };
DI void conv_job(Frame& F, const int job, const int gw, const int NGW) {
    unsigned char* ws = F.ws;
    if (job == CJ_WDN0S) {
        for (int h = 0; h < 2; ++h) conv_mat(F, F.in[I_FWDN] + (size_t)h * (DFF / 2) * DM, nullptr, DFF / 2, DM, (bf16*)(ws + WS_WIN) + (size_t)h * DM * (DFF / 2), 0, gw, NGW); }
    else if (job == CJ_WOUT) conv_mat(F, F.in[I_AWOUT], nullptr, VW, DM, (bf16*)(ws + WS_WOUT), 0, gw, NGW);
    else if (job == CJ_WUP0) conv_mat(F, F.in[I_FWUP], F.in[I_FNORM], DM, UPW, (bf16*)(ws + WS_WUP0), 0, gw, NGW);
    else if (job == CJ_WDN0) conv_mat(F, F.in[I_FWDN], nullptr, DFF, DM, (bf16*)(ws + WS_WDN0), 0, gw, NGW);
    else if (job == CJ_WKVQ) { conv_mat(F, F.in[I_WKV], F.in[I_KVNORM], DM, 4096, (bf16*)(ws + WS_WKVQ), 0, gw, NGW); conv_mat(F, F.in[I_BWQ], F.in[I_BNORM], DM, DM, (bf16*)(ws + WS_WKVQ), 4096, gw, NGW); }
    else if (job == CJ_WO) conv_mat(F, F.in[I_BWO], nullptr, DM, DM, (bf16*)(ws + WS_WO), 0, gw, NGW);
    else if (job == CJ_WUP1) conv_mat(F, F.in[I_FWUP] + (size_t)DM * UPW, F.in[I_FNORM] + DM, DM, UPW, (bf16*)(ws + WS_WUP1), 0, gw, NGW);
    else conv_mat(F, F.in[I_FWDN] + (size_t)DFF * DM, nullptr, DFF, DM, (bf16*)(ws + WS_WDN1), 0, gw, NGW);
}
DI void p0_prologue(Frame& F) {
    LAS float* scr = (LAS float*)(F.lds + F.wave * TR_LDS);
    const int gw = F.vcu * NWAVES + F.wave, NGW = F.G * NWAVES, lane = F.lane;
    unsigned char* ws = F.ws;
    constexpr int I_IN = (DM / 64) * (INW / 64);
    for (int it = F.wave * F.G + F.vcu; it < I_IN; it += NGW) p0_transpose_item(F.in[I_AWIN], F.in[I_ANORM], DM, INW, (bf16*)(ws + WS_WIN), 0, scr, it, lane);
    { v4u* z = (v4u*)(ws + WS_WIN + (size_t)INW * DM * 2); const int nz = (INWP - INW) * DM * 2 / 16; const v4u zero = {0u, 0u, 0u, 0u};
      for (int i = gw * 64 + lane; i < nz; i += NGW * 64) z[i] = zero; }
    float* ssq0 = (float*)(ws + WS_SSQ);
    for (int m0 = NGW - 1 - (F.wave * F.G + F.vcu); m0 < M; m0 += 2 * NGW) {
        const int m1 = m0 + NGW; const bool two = m1 < M; const int mb = two ? m1 : m0;
        const float* xa = (m0 < MP) ? F.in[I_XP] + (size_t)m0 * DM : F.in[I_XS] + (size_t)(m0 - MP) * DM;
        const float* xb = (mb < MP) ? F.in[I_XP] + (size_t)mb * DM : F.in[I_XS] + (size_t)(mb - MP) * DM;
        const f32x4* a4 = (const f32x4*)xa + lane; const f32x4* b4 = (const f32x4*)xb + lane;
        v2u* oa = (v2u*)((bf16*)(ws + WS_HB) + (size_t)m0 * DM) + lane; v2u* ob = (v2u*)((bf16*)(ws + WS_HB) + (size_t)mb * DM) + lane;
        f32x4 va[8], vb[8];
#pragma unroll
        for (int j = 0; j < 8; ++j) va[j] = __builtin_nontemporal_load(a4 + 64 * j);
#pragma unroll
        for (int j = 0; j < 8; ++j) vb[j] = __builtin_nontemporal_load(b4 + 64 * j);
        float sa = 0.f, sb = 0.f;
#pragma unroll
        for (int j = 0; j < 8; ++j) { const f32x4 v = va[j]; sa += (v[0] * v[0] + v[1] * v[1]) + (v[2] * v[2] + v[3] * v[3]); v2u w; w.x = pk2(v[0], v[1]); w.y = pk2(v[2], v[3]); oa[64 * j] = w; }
        sa = wave_sum(sa);
        if (lane < 32) ssq0[(size_t)m0 * 32 + lane] = (lane == 0) ? sa : 0.f;
        if (two) {
#pragma unroll
            for (int j = 0; j < 8; ++j) { const f32x4 v = vb[j]; sb += (v[0] * v[0] + v[1] * v[1]) + (v[2] * v[2] + v[3] * v[3]); v2u w; w.x = pk2(v[0], v[1]); w.y = pk2(v[2], v[3]); ob[64 * j] = w; }
            sb = wave_sum(sb);
            if (lane < 32) ssq0[(size_t)m1 * 32 + lane] = (lane == 0) ? sb : 0.f;
        }
    }
}
#define GC_LOAD(TB, R, H) { const int tb_ = (TB); const int b_ = tb_ >> 9; const int t0_ = (tb_ & 511) * 16; \
        const bf16* p_ = QKV + ((size_t)b_ * SEQ + t0_) * QKVW + c0; \
        _Pragma("unroll") for (int j_ = 0; j_ < 3; ++j_) { if (t0_ > 0) H[j_] = *(const v4u*)(p_ - (3 - j_) * QKVW); else H[j_] = (v4u){0u, 0u, 0u, 0u}; } \
        _Pragma("unroll") for (int tt_ = 0; tt_ < 16; ++tt_) R[tt_] = __builtin_nontemporal_load((const v4u*)(p_ + tt_ * QKVW)); }
#define GC_ROW(ROW, T, MROW, SAMP, B, LEN) { \
            const int t = (T); const size_t m = (MROW); \
            float cur[8]; unpack8(ROW, cur); \
            float y[8]; float ss = 0.f; \
            _Pragma("unroll") for (int e = 0; e < 8; ++e) { const float a = h[0][e] * w[0][e] + h[1][e] * w[1][e] + h[2][e] * w[2][e] + cur[e] * w[3][e]; y[e] = siluf(a); ss += y[e] * y[e]; } \
            if (cc < 8) {     \
                ss += __shfl_xor(ss, 1); ss += __shfl_xor(ss, 2); ss += __shfl_xor(ss, 4); ss += __shfl_xor(ss, 8); \
                const float sc = rsqrtf(ss + 1e-6f) * (cc < 4 ? 0.08838834764831845f : 1.0f); \
                _Pragma("unroll") for (int e = 0; e < 8; ++e) y[e] *= sc; \
                bf16* dst = (cc < 4) ? QN + m * DM + c0 : KN + m * DM + (c0 - 2048); \
                *(v4u*)dst = pack8(y); \
            } else { *(v4u*)(VV + m * VW + (c0 - 4096)) = pack8(y); } \
            if (t >= (LEN) - 3) {     \
                float* so = F.out + ((SAMP) ? O_SGC : O_PGC) + (size_t)((B) * 3 + (t - ((LEN) - 3))) * QKVW + c0; \
                *(f32x4*)so = (f32x4){cur[0], cur[1], cur[2], cur[3]}; *(f32x4*)(so + 4) = (f32x4){cur[4], cur[5], cur[6], cur[7]}; } \
            _Pragma("unroll") for (int e = 0; e < 8; ++e) { h[0][e] = h[1][e]; h[1][e] = h[2][e]; h[2][e] = cur[e]; } }
DI void p_gdnconv(Frame& F) {
    const int gw = F.vcu * NWAVES + F.wave, NGW = F.G * NWAVES, lane = F.lane;
    const bf16* QKV = (const bf16*)(F.ws + WS_QKV);
    bf16* QN = (bf16*)(F.ws + WS_QN); bf16* KN = (bf16*)(F.ws + WS_KN); bf16* VV = (bf16*)(F.ws + WS_VV);
    const float* wconv = F.in[I_AWCONV];
    constexpr int NTBP = MP / 16;
    const int TBS = NGW >> 4;
    const bool act = gw < TBS * 16;
    const int cc = gw & 15, c0 = cc * 512 + lane * 8;
    float w[4][8];
#pragma unroll
    for (int i = 0; i < 4; ++i) { const f32x4 a = *(const f32x4*)(wconv + i * QKVW + c0), bq = *(const f32x4*)(wconv + i * QKVW + c0 + 4);
        w[i][0] = a[0]; w[i][1] = a[1]; w[i][2] = a[2]; w[i][3] = a[3]; w[i][4] = bq[0]; w[i][5] = bq[1]; w[i][6] = bq[2]; w[i][7] = bq[3]; }
    int tb = act ? gw >> 4 : NTBP;
    v4u rows[16], hp[3];
    if (tb < NTBP) GC_LOAD(tb, rows, hp)
    for (; tb < NTBP; tb += TBS) {
        v4u rn[16], hn[3];
#pragma unroll
        for (int tt = 0; tt < 16; ++tt) rn[tt] = rows[tt];
#pragma unroll
        for (int j = 0; j < 3; ++j) hn[j] = hp[j];
        if (tb + TBS < NTBP) GC_LOAD(tb + TBS, rn, hn)
        const int b = tb >> 9; const int t0 = (tb & 511) * 16;
        const size_t mbase = (size_t)b * SEQ;
        float h[3][8];
#pragma unroll
        for (int j = 0; j < 3; ++j) unpack8(hp[j], h[j]);
#pragma unroll
        for (int tt = 0; tt < 16; ++tt) GC_ROW(rows[tt], t0 + tt, mbase + t0 + tt, false, b, SEQ)
#pragma unroll
        for (int tt = 0; tt < 16; ++tt) rows[tt] = rn[tt];
#pragma unroll
        for (int j = 0; j < 3; ++j) hp[j] = hn[j];
    }
    if (act) for (int pc = gw >> 4; pc < DECB * 4; pc += TBS) {
        const int b = pc >> 2, ta = (pc & 3) * 4; const size_t mbase = (size_t)MP + b * 16;
        v4u r4[4];
#pragma unroll
        for (int tt = 0; tt < 4; ++tt) r4[tt] = __builtin_nontemporal_load((const v4u*)(QKV + (mbase + ta + tt) * QKVW + c0));
        float h[3][8];
        if (ta == 0) {
#pragma unroll
            for (int j = 0; j < 3; ++j) { const float* sp = F.in[I_SGC] + (size_t)(b * 3 + j) * QKVW + c0; const f32x4 a = *(const f32x4*)sp, bq = *(const f32x4*)(sp + 4);
                h[j][0] = a[0]; h[j][1] = a[1]; h[j][2] = a[2]; h[j][3] = a[3]; h[j][4] = bq[0]; h[j][5] = bq[1]; h[j][6] = bq[2]; h[j][7] = bq[3]; }
        } else {
#pragma unroll
            for (int j = 0; j < 3; ++j) unpack8(*(const v4u*)(QKV + (mbase + ta - 3 + j) * QKVW + c0), h[j]);
        }
#pragma unroll
        for (int tt = 0; tt < 4; ++tt) GC_ROW(r4[tt], ta + tt, mbase + ta + tt, true, b, DECS)
    }
}
DI void p_prep(Frame& F) {
    const int gw = F.vcu * NWAVES + F.wave, NGW = F.G * NWAVES;
    LAS float* Al = (LAS float*)(F.lds + F.wave * 16384);
    const bf16* QN = (const bf16*)(F.ws + WS_QN); const bf16* KN = (const bf16*)(F.ws + WS_KN);
    const float* BA = (const float*)(F.ws + WS_BA);
    bf16* TP = (bf16*)(F.ws + WS_TP); bf16* PP = (bf16*)(F.ws + WS_PP);
    float* EG = (float*)(F.ws + WS_EG); float* DL = (float*)(F.ws + WS_DL); float* GL = (float*)(F.ws + WS_GL);
    const int gw2 = F.wave * F.G + F.vcu;
    const int npr = (gw < NITEM_P) ? (NITEM_P - gw + NGW - 1) / NGW : 0, nsm = (gw2 < NITEM - NITEM_P) ? (NITEM - NITEM_P - gw2 + NGW - 1) / NGW : 0;
    for (int k = 0; k < npr + nsm; ++k) {
        const int it = (k < npr) ? gw + k * NGW : NITEM_P + gw2 + (k - npr) * NGW;
        int lane = F.lane; asm volatile("" : "+v"(lane));
        const int c = lane & 31, hh = lane >> 5;
        int h, nv; size_t m0;
        if (it < NITEM_P) { h = it & 31; const int bn = it >> 5; m0 = (size_t)(bn >> 7) * SEQ + (size_t)(bn & 127) * 64; nv = 64; }
        else { const int r = it - NITEM_P; h = r & 31; m0 = (size_t)MP + (size_t)(r >> 5) * 16; nv = 16; }
        const int kh = h >> 1;
        float gt = 0.f, bt = 0.f;
        if (lane < nv) { const float bb = BA[(m0 + lane) * 64 + h], aa = BA[(m0 + lane) * 64 + 32 + h];
            bt = 1.0f / (1.0f + __expf(-bb));
            const float xx = aa + F.in[I_ADT][h]; const float sp = fmaxf(xx, 0.f) + log1pf(__expf(-fabsf(xx)));
            gt = -__expf(F.in[I_ALOG][h]) * sp; }
        float G = gt;
#pragma unroll
        for (int o = 1; o < 64; o <<= 1) { const float y = __shfl_up(G, o); if (lane >= o) G += y; }
        const float Glast = __shfl(G, 63);
        if (nv == 64) {
        bf16x8 kf[2][8];
#pragma unroll
        for (int ti = 0; ti < 2; ++ti)
#pragma unroll
            for (int s = 0; s < 8; ++s) { const int row = 32 * ti + c;
                kf[ti][s] = (row < nv) ? *(const bf16x8*)(KN + (m0 + row) * DM + kh * 128 + 16 * s + 8 * hh) : (bf16x8){0, 0, 0, 0, 0, 0, 0, 0}; }
        {
            f32x16 t00 = {}, t10 = {}, t11 = {};
#pragma unroll
            for (int s = 0; s < 8; ++s) { t00 = MFMA32(kf[0][s], kf[0][s], t00); t10 = MFMA32(kf[1][s], kf[0][s], t10); t11 = MFMA32(kf[1][s], kf[1][s], t11); }
#pragma unroll
            for (int i = 0; i < 16; ++i) {
                const int r0 = crow(i, hh), r1 = 32 + r0;
                const float G0 = __shfl(G, r0), G1 = __shfl(G, r1), b0 = __shfl(bt, r0), b1 = __shfl(bt, r1);
                const float Gc0 = __shfl(G, c), Gc1 = __shfl(G, 32 + c);
                Al[r0 * 64 + c] = (r0 > c) ? b0 * t00[i] * __expf(G0 - Gc0) : 0.f;
                Al[r1 * 64 + c] = b1 * t10[i] * __expf(G1 - Gc0);
                Al[r1 * 64 + 32 + c] = (r0 > c) ? b1 * t11[i] * __expf(G1 - Gc1) : 0.f;
            }
        }
        asm volatile("" ::: "memory");
        {
            bf16x8 qf[2][8];
#pragma unroll
            for (int ti = 0; ti < 2; ++ti)
#pragma unroll
                for (int s = 0; s < 8; ++s) { const int row = 32 * ti + c;
                    qf[ti][s] = (row < nv) ? *(const bf16x8*)(QN + (m0 + row) * DM + kh * 128 + 16 * s + 8 * hh) : (bf16x8){0, 0, 0, 0, 0, 0, 0, 0}; }
            f32x16 t00 = {}, t10 = {}, t11 = {};
#pragma unroll
            for (int s = 0; s < 8; ++s) { t00 = MFMA32(qf[0][s], kf[0][s], t00); t10 = MFMA32(qf[1][s], kf[0][s], t10); t11 = MFMA32(qf[1][s], kf[1][s], t11); }
            bf16* pp = PP + (size_t)it * 4096;
#pragma unroll
            for (int i = 0; i < 16; ++i) {
                const int r0 = crow(i, hh), r1 = 32 + r0;
                const float G0 = __shfl(G, r0), G1 = __shfl(G, r1);
                const float Gc0 = __shfl(G, c), Gc1 = __shfl(G, 32 + c);
                const float v00 = (r0 >= c) ? t00[i] * __expf(G0 - Gc0) : 0.f;
                const float v10 = t10[i] * __expf(G1 - Gc0);
                const float v11 = (r0 >= c) ? t11[i] * __expf(G1 - Gc1) : 0.f;
                pp[r0 * 64 + c] = (bf16)(pk2(v00, 0.f) & 0xffffu); pp[r0 * 64 + 32 + c] = 0;
                pp[r1 * 64 + c] = (bf16)(pk2(v10, 0.f) & 0xffffu); pp[r1 * 64 + 32 + c] = (bf16)(pk2(v11, 0.f) & 0xffffu);
            }
        }
        LDS_WAIT(); asm volatile("" ::: "memory");
        float T[64];
#pragma unroll
        for (int i = 0; i < 64; ++i) {
            float a = (lane == i) ? 1.0f : 0.f;
#pragma unroll
            for (int j = 0; j < i; ++j) a -= Al[i * 64 + j] * T[j];
            T[i] = a;
            asm volatile("" ::: "memory");
        }
        bf16* tp = TP + (size_t)it * 4096;
#pragma unroll
        for (int i = 0; i < 64; ++i) tp[i * 64 + lane] = (bf16)(pk2(T[i] * bt, 0.f) & 0xffffu);
        } else {
        bf16x8 kf0[8], qf0[8];
#pragma unroll
        for (int s = 0; s < 8; ++s) { kf0[s] = (c < nv) ? *(const bf16x8*)(KN + (m0 + c) * DM + kh * 128 + 16 * s + 8 * hh) : (bf16x8){0, 0, 0, 0, 0, 0, 0, 0};
            qf0[s] = (c < nv) ? *(const bf16x8*)(QN + (m0 + c) * DM + kh * 128 + 16 * s + 8 * hh) : (bf16x8){0, 0, 0, 0, 0, 0, 0, 0}; }
        f32x16 tk = {}, tq = {};
#pragma unroll
        for (int s = 0; s < 8; ++s) { tk = MFMA32(kf0[s], kf0[s], tk); tq = MFMA32(qf0[s], kf0[s], tq); }
        bf16* pp = PP + (size_t)it * 4096;
#pragma unroll
        for (int i = 0; i < 16; ++i) {
            const int r0 = crow(i, hh), r1 = 32 + r0;
            const float G0 = __shfl(G, r0), b0 = __shfl(bt, r0), Gc0 = __shfl(G, c);
            const float dec = __expf(G0 - Gc0);
            Al[r0 * 64 + c] = (r0 > c) ? b0 * tk[i] * dec : 0.f;
            const float v00 = (r0 >= c) ? tq[i] * dec : 0.f;
            pp[r0 * 64 + c] = (bf16)(pk2(v00, 0.f) & 0xffffu); pp[r0 * 64 + 32 + c] = 0;
            pp[r1 * 64 + c] = 0; pp[r1 * 64 + 32 + c] = 0;
        }
        LDS_WAIT(); asm volatile("" ::: "memory");
        float T[16];
#pragma unroll
        for (int i = 0; i < 16; ++i) {
            float a = (lane == i) ? 1.0f : 0.f;
#pragma unroll
            for (int j = 0; j < i; ++j) a -= Al[i * 64 + j] * T[j];
            T[i] = a;
            asm volatile("" ::: "memory");
        }
        bf16* tp = TP + (size_t)it * 4096;
#pragma unroll
        for (int i = 0; i < 16; ++i) tp[i * 64 + lane] = (bf16)(pk2(T[i] * bt, 0.f) & 0xffffu);
#pragma unroll
        for (int i = 16; i < 64; ++i) tp[i * 64 + lane] = 0;
        }
        EG[(size_t)it * 64 + lane] = __expf(G); DL[(size_t)it * 64 + lane] = __expf(Glast - G);
        if (lane == 0) GL[it] = __expf(Glast);
        LDS_WAIT(); asm volatile("" ::: "memory");
    }
}
constexpr int SB_K = 0, SB_Q = 17408, SB_V = 34816, SB_TP = 52224, SB_PP = 61440, SB_SIZE = 70656, SB_EG = 2 * SB_SIZE;
constexpr int LDK = 272, LDT = 144;
DI bf16x8 frag_perm(const LAS unsigned char* p) {
    const v2u lo = *(const LAS v2u*)p, hi = *(const LAS v2u*)(p + 16); const v4u x = {lo.x, lo.y, hi.x, hi.y}; return __builtin_bit_cast(bf16x8, x); }
DI bf16x8 pack_acc(const f32x16& a, const int s2) {
    v4u x; x.x = pk2(a[8 * s2], a[8 * s2 + 1]); x.y = pk2(a[8 * s2 + 2], a[8 * s2 + 3]); x.z = pk2(a[8 * s2 + 4], a[8 * s2 + 5]); x.w = pk2(a[8 * s2 + 6], a[8 * s2 + 7]); return __builtin_bit_cast(bf16x8, x); }
struct ScanLd { v4u k[4], q[4], v[4], tp[2], pp[2]; float e0, e1; };
DI void scan_issue(ScanLd& L, Frame& F, const int lt, const int item, const size_t m0, const int nv, const int h) {
    const bf16* QN = (const bf16*)(F.ws + WS_QN); const bf16* KN = (const bf16*)(F.ws + WS_KN); const bf16* VV = (const bf16*)(F.ws + WS_VV);
    const bf16* TP = (const bf16*)(F.ws + WS_TP); const bf16* PP = (const bf16*)(F.ws + WS_PP);
    const float* EG = (const float*)(F.ws + WS_EG); const float* DL = (const float*)(F.ws + WS_DL); const float* GL = (const float*)(F.ws + WS_GL);
    const int kh = h >> 1;
#pragma unroll
    for (int i = 0; i < 4; ++i) { const int p = lt + 256 * i, row = p >> 4, cc = p & 15; const v4u z4 = {0u, 0u, 0u, 0u};
        L.k[i] = (row < nv) ? *(const v4u*)(KN + (m0 + row) * DM + kh * 128 + cc * 8) : z4;
        L.q[i] = (row < nv) ? *(const v4u*)(QN + (m0 + row) * DM + kh * 128 + cc * 8) : z4;
        const int vrow = lt >> 2, vcc = (lt & 3) * 4 + i; L.v[i] = (vrow < nv) ? *(const v4u*)(VV + (m0 + vrow) * VW + h * 128 + vcc * 8) : z4; }
#pragma unroll
    for (int i = 0; i < 2; ++i) { const int p = lt + 256 * i, row = p >> 3, cc = p & 7;
        L.tp[i] = *(const v4u*)(TP + (size_t)item * 4096 + row * 64 + cc * 8); L.pp[i] = *(const v4u*)(PP + (size_t)item * 4096 + row * 64 + cc * 8); }
    L.e0 = (lt < 64) ? EG[(size_t)item * 64 + lt] : ((lt < 128) ? DL[(size_t)item * 64 + lt - 64] : GL[item]);
}
DI void st_perm(LAS unsigned char* rowbase, const int cc, const v4u x) {
    LAS unsigned char* g = rowbase + (cc >> 1) * 32 + (cc & 1) * 8;
    *(LAS v2u*)g = (v2u){x.x, x.y}; *(LAS v2u*)(g + 16) = (v2u){x.z, x.w};
}
DI void scan_write(const ScanLd& L, LAS unsigned char* lds, const int buf, const int lt) {
    LAS unsigned char* B = lds + buf * SB_SIZE;
#pragma unroll
    for (int i = 0; i < 4; ++i) { const int p = lt + 256 * i, row = p >> 4, cc = p & 15;
        *(LAS v4u*)(B + SB_K + row * LDK + cc * 16) = L.k[i]; st_perm(B + SB_Q + row * LDK, cc, L.q[i]);
        *(LAS v4u*)(B + SB_V + (lt >> 2) * LDK + ((lt & 3) * 4 + i) * 16) = L.v[i]; }
#pragma unroll
    for (int i = 0; i < 2; ++i) { const int p = lt + 256 * i, row = p >> 3, cc = p & 7;
        st_perm(B + SB_TP + row * LDT, cc, L.tp[i]); st_perm(B + SB_PP + row * LDT, cc, L.pp[i]); }
    if (lt <= 128) *(LAS float*)(lds + SB_EG + buf * 1024 + lt * 4) = L.e0;
}
struct ScanZ { v4u z[4]; };
DI void scan_z_load(ScanZ& N, Frame& F, const int lt, const size_t m0, const int nv, const int h) {
    const bf16* Z = (const bf16*)(F.ws + WS_Z); const int tok = lt >> 2, qd = lt & 3; const size_t off = (m0 + (tok < nv ? tok : 0)) * VW + h * 128 + qd * 32;
#pragma unroll
    for (int i = 0; i < 4; ++i) N.z[i] = *(const v4u*)(Z + off + 8 * i);
}
DI void scan_norm_lds(const ScanZ& N, Frame& F, const int buf, const int lt, const size_t m0, const int nv, const int h) {
    bf16* ON = (bf16*)(F.out + O_PK); const LAS float* gn = (const LAS float*)(F.lds + SB_EG + 2048);
    const int tok = lt >> 2, qd = lt & 3; const size_t off = (m0 + tok) * VW + h * 128 + qd * 32;
    const LAS unsigned char* op = F.lds + buf * SB_SIZE + SB_V + tok * LDK + qd * 64;
    v4u o4[4]; float ss = 0.f;
#pragma unroll
    for (int i = 0; i < 4; ++i) { o4[i] = *(const LAS v4u*)(op + 16 * i); float o8[8]; unpack8(o4[i], o8);
#pragma unroll
        for (int e = 0; e < 8; ++e) ss += o8[e] * o8[e]; }
    ss += __shfl_xor(ss, 1); ss += __shfl_xor(ss, 2);
    const float rstd = rsqrtf(ss * (1.0f / 128.0f) + 1e-6f);
    if (tok < nv) {
#pragma unroll
        for (int i = 0; i < 4; ++i) { float o8[8], z8[8]; unpack8(o4[i], o8); unpack8(N.z[i], z8);
            const f32x4 g0 = *(const LAS f32x4*)(gn + qd * 32 + 8 * i), g1 = *(const LAS f32x4*)(gn + qd * 32 + 8 * i + 4);
#pragma unroll
            for (int e = 0; e < 8; ++e) o8[e] = o8[e] * rstd * (e < 4 ? g0[e & 3] : g1[e & 3]) * siluf(z8[e]);
            *(v4u*)(ON + off + 8 * i) = pack8(o8); }
    }
}
DI void scan_chain(Frame& F, const bool samp, const int b, const int h) {
    const int tid = F.tid, w = F.wave;
    LAS unsigned char* lds = F.lds;
    bf16* ON = (bf16*)(F.out + O_PK);
    const int nsteps = samp ? 1 : 128, nv = samp ? 16 : 64;
    const bool loader = w >= 4; const int lt = tid - 256;
#define SC_ITEM(n) (samp ? NITEM_P + b * 32 + h : (b * 128 + (n)) * 32 + h)
#define SC_M0(n) (samp ? (size_t)MP + b * 16 : (size_t)b * SEQ + (size_t)(n) * 64)
    f32x16 S[4];
    __syncthreads();
    if (tid < 128) *(LAS float*)(lds + SB_EG + 2048 + tid * 4) = F.in[I_AONORM][tid];
    if (samp) {
        const float* s0 = F.in[I_SGDN] + (size_t)(b * 32 + h) * 16384;
#pragma unroll
        for (int i = 0; i < 8; ++i) *(LAS f32x4*)(lds + (tid + 512 * i) * 16) = *(const f32x4*)(s0 + (tid + 512 * i) * 4);
        __syncthreads();
        if (!loader) { const int lane = F.lane, c = lane & 31, hh = lane >> 5, dvb = 32 * w;
#pragma unroll
            for (int i4 = 0; i4 < 4; ++i4)
#pragma unroll
                for (int i = 0; i < 16; ++i) S[i4][i] = *(const LAS float*)(lds + ((32 * i4 + crow(i, hh)) * 128 + dvb + c) * 4); }
        __syncthreads();
    } else {
#pragma unroll
        for (int i4 = 0; i4 < 4; ++i4)
#pragma unroll
            for (int i = 0; i < 16; ++i) S[i4][i] = 0.f;
    }
    if (loader) {
        ScanLd L0, L1; ScanZ Z0;
        { int lv = lt; asm volatile("" : "+v"(lv)); scan_issue(L0, F, lv, SC_ITEM(0), SC_M0(0), nv, h); scan_write(L0, lds, 0, lv);
          if (nsteps > 1) scan_issue(L1, F, lv, SC_ITEM(1), SC_M0(1), nv, h); if (nsteps > 2) scan_issue(L0, F, lv, SC_ITEM(2), SC_M0(2), nv, h);
          scan_z_load(Z0, F, lv, SC_M0(0), nv, h); }
        __syncthreads();
        for (int n = 0; n < nsteps; n += 2) {
            {
                int lv = lt; asm volatile("" : "+v"(lv));
                if (n >= 1) { scan_norm_lds(Z0, F, 1, lv, SC_M0(n - 1), nv, h); scan_z_load(Z0, F, lv, SC_M0(n), nv, h); }
                if (n + 1 < nsteps) scan_write(L1, lds, 1, lv);
                if (n + 3 < nsteps) scan_issue(L1, F, lv, SC_ITEM(n + 3), SC_M0(n + 3), nv, h);
                __syncthreads();
            }
            if (n + 1 < nsteps) {
                int lv = lt; asm volatile("" : "+v"(lv));
                scan_norm_lds(Z0, F, 0, lv, SC_M0(n), nv, h); scan_z_load(Z0, F, lv, SC_M0(n + 1), nv, h);
                if (n + 2 < nsteps) scan_write(L0, lds, 0, lv);
                if (n + 4 < nsteps) scan_issue(L0, F, lv, SC_ITEM(n + 4), SC_M0(n + 4), nv, h);
                __syncthreads();
            }
        }
        __syncthreads();
        { int lv = lt; asm volatile("" : "+v"(lv));
          scan_norm_lds(Z0, F, (nsteps - 1) & 1, lv, SC_M0(nsteps - 1), nv, h); }
        __syncthreads();
    } else {
        __syncthreads();
        for (int n = 0; n < nsteps; ++n) {
            int lane = F.lane; asm volatile("" : "+v"(lane));
            const int c = lane & 31, hh = lane >> 5, dvb = 32 * w;
            const LAS unsigned char* B = lds + (n & 1) * SB_SIZE; const LAS float* egp = (const LAS float*)(lds + SB_EG + (n & 1) * 1024);
            const size_t m0 = SC_M0(n);
            bf16x8 Sb[8];
#pragma unroll
            for (int i4 = 0; i4 < 4; ++i4) { Sb[2 * i4] = pack_acc(S[i4], 0); Sb[2 * i4 + 1] = pack_acc(S[i4], 1); }
            f32x16 ks[2] = {{}, {}}, qs[2] = {{}, {}};
            const LAS unsigned char* pk0 = B + SB_K + c * LDK + 8 * hh; const LAS unsigned char* pq1 = B + SB_Q + c * LDK + 16 * hh;
            bf16x8 fa[4], fb[4], tf[8];
#define LDKQ(dst, s8) do { dst[0] = frag_perm(pk0 + 32 * (s8)); dst[1] = frag_perm(pk0 + 32 * LDK + 32 * (s8)); dst[2] = *(const LAS bf16x8*)(pq1 + 32 * (s8)); dst[3] = *(const LAS bf16x8*)(pq1 + 32 * LDK + 32 * (s8)); } while (0)
#define MMKQ(src, s8) do { ks[0] = MFMA32(src[0], Sb[s8], ks[0]); ks[1] = MFMA32(src[1], Sb[s8], ks[1]); qs[0] = MFMA32(src[2], Sb[s8], qs[0]); qs[1] = MFMA32(src[3], Sb[s8], qs[1]); } while (0)
#define SBAR() __builtin_amdgcn_sched_barrier(0)
            LDKQ(fa, 0); SBAR();
            LDKQ(fb, 1); SBAR(); MMKQ(fa, 0); SBAR();
            LDKQ(fa, 2); SBAR(); MMKQ(fb, 1); SBAR();
            LDKQ(fb, 3); SBAR(); MMKQ(fa, 2); SBAR();
            LDKQ(fa, 4); SBAR(); MMKQ(fb, 3); SBAR();
            LDKQ(fb, 5); SBAR(); MMKQ(fa, 4); SBAR();
            LDKQ(fa, 6); SBAR(); MMKQ(fb, 5); SBAR();
            LDKQ(fb, 7); SBAR(); MMKQ(fa, 6); SBAR();
#pragma unroll
            for (int s4 = 0; s4 < 4; ++s4) { tf[2 * s4] = *(const LAS bf16x8*)(B + SB_TP + c * LDT + 32 * s4 + 16 * hh); tf[2 * s4 + 1] = *(const LAS bf16x8*)(B + SB_TP + (32 + c) * LDT + 32 * s4 + 16 * hh); }
            SBAR(); MMKQ(fb, 7); SBAR();
#undef LDKQ
#undef MMKQ
            bf16x8 rf[4];
            { const int vbv = (int)(unsigned)(size_t)(B + SB_V) + (4 * hh + ((lane >> 2) & 3)) * LDK + ((lane >> 4) & 1) * 32 + (lane & 3) * 8 + dvb * 2;
              const bf16x4 v00 = tr_read<0 * LDK>(vbv), v01 = tr_read<8 * LDK>(vbv), v02 = tr_read<16 * LDK>(vbv), v03 = tr_read<24 * LDK>(vbv);
              const bf16x4 v10 = tr_read<32 * LDK>(vbv), v11 = tr_read<40 * LDK>(vbv), v12 = tr_read<48 * LDK>(vbv), v13 = tr_read<56 * LDK>(vbv);
              asm volatile("s_waitcnt lgkmcnt(0)" ::: "memory"); SBAR();
#define RROW(tt, g4, V) do { const f32x4 e4 = *(const LAS f32x4*)(egp + 32 * (tt) + 8 * (g4) + 4 * hh); \
                  r[4 * (g4)] = bf2f((bf16)V[0]) - e4[0] * ks[tt][4 * (g4)]; r[4 * (g4) + 1] = bf2f((bf16)V[1]) - e4[1] * ks[tt][4 * (g4) + 1]; \
                  r[4 * (g4) + 2] = bf2f((bf16)V[2]) - e4[2] * ks[tt][4 * (g4) + 2]; r[4 * (g4) + 3] = bf2f((bf16)V[3]) - e4[3] * ks[tt][4 * (g4) + 3]; } while (0)
              { f32x16 r; RROW(0, 0, v00); RROW(0, 1, v01); RROW(0, 2, v02); RROW(0, 3, v03); rf[0] = pack_acc(r, 0); rf[1] = pack_acc(r, 1); }
              { f32x16 r; RROW(1, 0, v10); RROW(1, 1, v11); RROW(1, 2, v12); RROW(1, 3, v13); rf[2] = pack_acc(r, 0); rf[3] = pack_acc(r, 1); }
#undef RROW
            }
            SBAR();
            f32x16 u[2] = {{}, {}};
#pragma unroll
            for (int s4 = 0; s4 < 4; ++s4) { u[0] = MFMA32(tf[2 * s4], rf[s4], u[0]); u[1] = MFMA32(tf[2 * s4 + 1], rf[s4], u[1]); }
            SBAR();
            bf16x8 pf[8];
#pragma unroll
            for (int s4 = 0; s4 < 4; ++s4) { pf[2 * s4] = *(const LAS bf16x8*)(B + SB_PP + c * LDT + 32 * s4 + 16 * hh); pf[2 * s4 + 1] = *(const LAS bf16x8*)(B + SB_PP + (32 + c) * LDT + 32 * s4 + 16 * hh); }
            const float gl = egp[128];
            SBAR();
            bf16x8 uf[4], upf[4];
#pragma unroll
            for (int tt = 0; tt < 2; ++tt) { uf[2 * tt] = pack_acc(u[tt], 0); uf[2 * tt + 1] = pack_acc(u[tt], 1); f32x16 up;
#pragma unroll
                for (int g4 = 0; g4 < 4; ++g4) { const f32x4 d4 = *(const LAS f32x4*)(egp + 64 + 32 * tt + 8 * g4 + 4 * hh);
                    up[4 * g4] = u[tt][4 * g4] * d4[0]; up[4 * g4 + 1] = u[tt][4 * g4 + 1] * d4[1]; up[4 * g4 + 2] = u[tt][4 * g4 + 2] * d4[2]; up[4 * g4 + 3] = u[tt][4 * g4 + 3] * d4[3]; }
                upf[2 * tt] = pack_acc(up, 0); upf[2 * tt + 1] = pack_acc(up, 1); }
            f32x16 pu[2] = {{}, {}};
#pragma unroll
            for (int s4 = 0; s4 < 4; ++s4) { pu[0] = MFMA32(pf[2 * s4], uf[s4], pu[0]); pu[1] = MFMA32(pf[2 * s4 + 1], uf[s4], pu[1]); }
            SBAR();
            { const int vb = (int)(unsigned)(size_t)(B + SB_K) + (4 * hh + ((lane >> 2) & 3)) * LDK + ((lane >> 4) & 1) * 32 + (lane & 3) * 8;
#pragma unroll
              for (int i4 = 0; i4 < 4; ++i4) {
#pragma unroll
                  for (int i = 0; i < 16; ++i) S[i4][i] *= gl; }
#define KTPK(L, H) (bf16x8){L[0], L[1], L[2], L[3], H[0], H[1], H[2], H[3]}
#define KTLD(P, s4) const bf16x4 P##l0 = tr_read<16 * (s4) * LDK>(vb), P##h0 = tr_read<(16 * (s4) + 8) * LDK>(vb), P##l1 = tr_read<16 * (s4) * LDK + 64>(vb), P##h1 = tr_read<(16 * (s4) + 8) * LDK + 64>(vb), \
                  P##l2 = tr_read<16 * (s4) * LDK + 128>(vb), P##h2 = tr_read<(16 * (s4) + 8) * LDK + 128>(vb), P##l3 = tr_read<16 * (s4) * LDK + 192>(vb), P##h3 = tr_read<(16 * (s4) + 8) * LDK + 192>(vb)
#define KTMM(P, s4) do { S[0] = MFMA32(KTPK(P##l0, P##h0), upf[s4], S[0]); S[1] = MFMA32(KTPK(P##l1, P##h1), upf[s4], S[1]); S[2] = MFMA32(KTPK(P##l2, P##h2), upf[s4], S[2]); S[3] = MFMA32(KTPK(P##l3, P##h3), upf[s4], S[3]); } while (0)
              KTLD(a, 0); KTLD(b, 1);
              asm volatile("s_waitcnt lgkmcnt(0)" ::: "memory"); SBAR();
              KTMM(a, 0); KTMM(b, 1); SBAR();
              KTLD(d, 2); KTLD(e, 3);
              asm volatile("s_waitcnt lgkmcnt(0)" ::: "memory"); SBAR();
              KTMM(d, 2); KTMM(e, 3); SBAR();
#undef KTLD
#undef KTMM
#undef KTPK
            }
#undef SBAR
            { LAS unsigned char* ob = lds + (n & 1) * SB_SIZE + SB_V + dvb * 2;
#pragma unroll
              for (int ti = 0; ti < 2; ++ti)
#pragma unroll
                for (int g4 = 0; g4 < 4; ++g4) { const int tk = 32 * ti + 8 * g4 + 4 * hh; const f32x4 e4 = *(const LAS f32x4*)(egp + tk);
#pragma unroll
                    for (int j = 0; j < 4; ++j) *(LAS bf16*)(ob + (tk + j) * LDK + c * 2) = (bf16)(pk2(e4[j] * qs[ti][4 * g4 + j] + pu[ti][4 * g4 + j], 0.f) & 0xffffu); }
              LDS_WAIT(); }
            __syncthreads();
        }
        __syncthreads();
        __syncthreads();
        {
            const int lane = F.lane, c = lane & 31, hh = lane >> 5, dvb = 32 * w;
#pragma unroll
            for (int i4 = 0; i4 < 4; ++i4)
#pragma unroll
                for (int i = 0; i < 16; ++i) *(LAS float*)(lds + ((32 * i4 + crow(i, hh)) * 128 + dvb + c) * 4) = S[i4][i];
        }
    }
    __syncthreads();
    { float* so = F.out + (samp ? O_SGDN : O_PGDN) + (size_t)(b * 32 + h) * 16384;
#pragma unroll
      for (int i = 0; i < 8; ++i) *(f32x4*)(so + (tid + 512 * i) * 4) = *(const LAS f32x4*)(lds + (tid + 512 * i) * 16); }
#undef SC_ITEM
#undef SC_M0
}
DI void p_scan(Frame& F) {
    const int nW = F.G, bx = blockIdx.x;
    for (int ch = bx; ch < NB * 32; ch += nW) { const int x = ch & 7, y = (ch >> 3) & 7, kh = x + 8 * (y >> 1);
        scan_chain(F, false, kh >> 4, 2 * (kh & 15) + (y & 1)); }
    int start, stride;
    if (nW > NB * 32) { start = bx - NB * 32; stride = nW - NB * 32; } else { start = bx; stride = nW; }
    if (start >= 0) for (int ch = start; ch < DECB * 32; ch += stride) scan_chain(F, true, ch >> 5, ch & 31);
}
DI void p_ffnconv(Frame& F, const int layer, const int tb_lo, const int tb_hi, const int gw, const int NGW, const bf16* UP, bf16* ACT, bf16* ACTS = nullptr) {
    const int lane = F.lane;
    const float* wconv = F.in[I_FWCONV] + (size_t)layer * 3 * UPW; const float* bconv = F.in[I_FBCONV] + (size_t)layer * UPW;
    constexpr int NCC = DFF / 512;
    const int NI = (tb_hi - tb_lo) * NCC, R = NI / NGW, rem = NI - R * NGW; const bool halves = 2 * rem <= NGW;
    const int npiece = R + ((halves ? gw < 2 * rem : gw < rem) ? 1 : 0);
    for (int k = 0; k < npiece; ++k) {
        const bool tail = k >= R;
        const int it = !tail ? gw + k * NGW : R * NGW + (halves ? gw >> 1 : gw);
        const int th_lo = (tail && halves) ? (gw & 1) : 0, th_hi = (tail && halves) ? th_lo + 1 : 2;
        const int tb = tb_lo + it / NCC, cc = it % NCC, c0 = cc * 512 + lane * 8;
        const bool samp = tb >= MP / 16; const int b = samp ? tb - MP / 16 : tb >> 9; const int t0 = samp ? 0 : (tb & 511) * 16;
        const size_t mbase = samp ? (size_t)MP + b * 16 : (size_t)b * SEQ; const int L = samp ? DECS : SEQ;
        float wg[3][8], wv[3][8], bg[8], bv[8];
#pragma unroll
        for (int i = 0; i < 3; ++i)
#pragma unroll
            for (int e = 0; e < 8; ++e) { wg[i][e] = wconv[i * UPW + c0 + e]; wv[i][e] = wconv[i * UPW + DFF + c0 + e]; }
#pragma unroll
        for (int e = 0; e < 8; ++e) { bg[e] = bconv[c0 + e]; bv[e] = bconv[DFF + c0 + e]; }
        float hg[2][8], hv[2][8];
#pragma unroll
        for (int j = 0; j < 2; ++j) { const int t = t0 + 8 * th_lo - 2 + j;
            if (t >= 0) { unpack8(*(const v4u*)(UP + (mbase + t) * UPW + c0), hg[j]); unpack8(*(const v4u*)(UP + (mbase + t) * UPW + DFF + c0), hv[j]); }
            else if (samp) { const float* sp = F.in[I_SFC] + ((size_t)(layer * DECB + b) * 2 + (t + 2)) * UPW + c0;
#pragma unroll
                for (int e = 0; e < 8; ++e) { hg[j][e] = sp[e]; hv[j][e] = sp[DFF + e]; } }
            else {
#pragma unroll
                for (int e = 0; e < 8; ++e) { hg[j][e] = 0.f; hv[j][e] = 0.f; } } }
        for (int th = th_lo; th < th_hi; ++th) {
        v4u rg[8], rv[8];
#pragma unroll
        for (int tt = 0; tt < 8; ++tt) { rg[tt] = __builtin_nontemporal_load((const v4u*)(UP + (mbase + t0 + 8 * th + tt) * UPW + c0)); rv[tt] = __builtin_nontemporal_load((const v4u*)(UP + (mbase + t0 + 8 * th + tt) * UPW + DFF + c0)); }
#pragma unroll
        for (int t8 = 0; t8 < 8; ++t8) {
            const int tt = 8 * th + t8; const int t = t0 + tt; const size_t m = mbase + t;
            float cg[8], cv[8]; unpack8(rg[t8], cg); unpack8(rv[t8], cv);
            float y[8];
#pragma unroll
            for (int e = 0; e < 8; ++e) { const float g = hg[0][e] * wg[0][e] + hg[1][e] * wg[1][e] + cg[e] * wg[2][e] + bg[e];
                const float v = hv[0][e] * wv[0][e] + hv[1][e] * wv[1][e] + cv[e] * wv[2][e] + bv[e]; y[e] = siluf(g) * v; }
            if (ACTS) { const int hs = c0 >= DFF / 2 ? 1 : 0; *(v4u*)(ACTS + ((size_t)(hs * MS + (int)(m - MP)) * (DFF / 2) + (c0 - hs * (DFF / 2)))) = pack8(y); }
            else *(v4u*)(ACT + m * DFF + c0) = pack8(y);
            if (t >= L - 2) {
                float* so = F.out + (samp ? O_SFC + ((size_t)(layer * DECB + b) * 2 + (t - (L - 2))) * UPW : O_PFC + ((size_t)(layer * NB + b) * 2 + (t - (L - 2))) * UPW) + c0;
#pragma unroll
                for (int e = 0; e < 8; ++e) { so[e] = cg[e]; so[DFF + e] = cv[e]; } }
#pragma unroll
            for (int e = 0; e < 8; ++e) { hg[0][e] = hg[1][e]; hg[1][e] = cg[e]; hv[0][e] = hv[1][e]; hv[1][e] = cv[e]; }
        }
        }
    }
}
DI void p_splitk_reduce(Frame& F, float* H, bf16* HB, float* ssq, const int gw, const int NGW) {
    const float* P = (const float*)(F.ws + WS_SUP); const int lane = F.lane;
    for (int r = gw; r < MS; r += NGW) {
        const size_t m = (size_t)MP + r; float s = 0.f;
#pragma unroll
        for (int j = 0; j < 8; ++j) { const int c = 4 * lane + 256 * j;
            const f32x4 o = *(const f32x4*)(H + m * DM + c) + *(const f32x4*)(P + (size_t)r * DM + c) + *(const f32x4*)(P + (size_t)(MS + r) * DM + c);
            *(f32x4*)(H + m * DM + c) = o; s += (o[0] * o[0] + o[1] * o[1]) + (o[2] * o[2] + o[3] * o[3]);
            v2u w; w.x = pk2(o[0], o[1]); w.y = pk2(o[2], o[3]); *(v2u*)(HB + m * DM + c) = w; }
        s = wave_sum(s);
        if (lane < 32) ssq[m * 32 + lane] = (lane == 0) ? s : 0.f;
    }
}
DI void p_final(Frame& F, const int m_lo, const int m_hi, const int gw, const int NGW) {
    const int lane = F.lane;
    const float* ssq = (const float*)(F.ws + WS_SSQ + 4 * SSQ_STRIDE); const float* gain = F.in[I_FINAL];
    for (int m0 = m_lo + gw; m0 < m_hi; m0 += 2 * NGW) {
        const int m1 = m0 + NGW; const bool two = m1 < m_hi; const int mb = two ? m1 : m0;
        float s0 = (lane < 32) ? ssq[(size_t)m0 * 32 + lane] : 0.f; float s1 = (lane < 32) ? ssq[(size_t)mb * 32 + lane] : 0.f;
        f32x4* ya = (f32x4*)(F.out + (size_t)m0 * DM) + lane; f32x4* yb = (f32x4*)(F.out + (size_t)mb * DM) + lane; const f32x4* g4 = (const f32x4*)gain + lane;
        f32x4 va[8], vb[8];
#pragma unroll
        for (int j = 0; j < 8; ++j) va[j] = __builtin_nontemporal_load(ya + 64 * j);
#pragma unroll
        for (int j = 0; j < 8; ++j) vb[j] = __builtin_nontemporal_load(yb + 64 * j);
        s0 = wave_sum(s0); s1 = wave_sum(s1);
        const float r0 = rsqrtf(s0 * (1.0f / 2048.0f) + 1e-6f), r1 = rsqrtf(s1 * (1.0f / 2048.0f) + 1e-6f);
#pragma unroll
        for (int j = 0; j < 8; ++j) __builtin_nontemporal_store(va[j] * r0 * g4[64 * j], ya + 64 * j);
        if (two) {
#pragma unroll
            for (int j = 0; j < 8; ++j) __builtin_nontemporal_store(vb[j] * r1 * g4[64 * j], yb + 64 * j);
        }
    }
}
DI void p_cacheconv(Frame& F, const float* src, bf16* dst, const size_t t0, const size_t nthr, const int f_lo = 0, const int f_hi = 20) {
    constexpr size_t NP = (size_t)DECB * PAST * DM / 8;
    const size_t p_hi = NP * (size_t)f_hi / 20;
    for (size_t p = NP * (size_t)f_lo / 20 + t0; p < p_hi; p += nthr) {
        const size_t row = p >> 8, c8 = p & 255, b = row >> 11, key = row & 2047;
        const f32x4 a = __builtin_nontemporal_load((const f32x4*)(src + p * 8)), bq = __builtin_nontemporal_load((const f32x4*)(src + p * 8 + 4));
        v4u o; o.x = pk2(a[0], a[1]); o.y = pk2(a[2], a[3]); o.z = pk2(bq[0], bq[1]); o.w = pk2(bq[2], bq[3]);
        *(v4u*)(dst + (b * (PAST + DECS) + key) * DM + c8 * 8) = o;
    }
}
#ifndef ATT_SKEW
#define ATT_SKEW 0
#endif
constexpr int AT_K = 0, AT_V = 65536, AT_BT = 131072;
constexpr float ATT_C = 0.08838834764831845f * 1.4426950408889634f;
constexpr float LAM_INIT = 0.35550906759718507f;
constexpr float ATT_THR = 6.0f;
constexpr int CW_ATTQ = 64;
struct AttnUnit { const bf16* Kp; const bf16* Vp; const bf16* Qp; bf16* Op; int h, nq, qpos0, nkeys; size_t mq0; };
DI int t5_bucket(int rel) { const int n = rel < 0 ? -rel : rel; int v; if (n < 8) v = n; else { v = 2 + (31 - __builtin_clz((unsigned)(n * n))); v = v > 15 ? 15 : v; } return (rel > 0 ? 16 : 0) + v; }
#define KSWZ(row, colB) ((row) * 256 + ((colB) ^ (((row) & 7) << 4)))
DI int v_st(int k, int c) { return ((k >> 3) * 8 + (c >> 5)) * 512 + ((k & 7) * 32 + (c & 31)) * 2; }
DI int v_rd_base(int lane) { return ((lane & 3) << 3) | (((lane >> 2) & 3) << 6) | (((lane >> 4) & 1) << 5) | (((lane >> 5) & 1) << 8); }
DI void at_dma(LAS unsigned char* lds, const AttnUnit& U, const int kt, const int buf, const int w, int lane) {
    asm volatile("" : "+v"(lane));
#pragma unroll
    for (int i = 0; i < 4; ++i) {
        const int ch = 4 * w + i, map = ch >> 4, row = 4 * (ch & 15) + (lane >> 4), cc = (lane & 15) ^ (row & 7); int kg = kt * 64 + row; kg = kg < U.nkeys ? kg : U.nkeys - 1;
        __builtin_amdgcn_global_load_lds((const unsigned*)(U.Kp + (size_t)kg * DM + (2 * U.h + map) * 128 + cc * 8), (LAS unsigned*)(lds + AT_K + buf * 32768 + ch * 1024), 16, 0, 0); }
#pragma unroll
    for (int i = 0; i < 4; ++i) {
        const int ch = 4 * w + i, key = 8 * (ch >> 2) + ((lane & 31) >> 2), col = 32 * (2 * (ch & 3) + (lane >> 5)) + 8 * (lane & 3); int kg = kt * 64 + key; kg = kg < U.nkeys ? kg : U.nkeys - 1;
        __builtin_amdgcn_global_load_lds((const unsigned*)(U.Vp + (size_t)kg * DM + U.h * 256 + col), (LAS unsigned*)(lds + AT_V + buf * 32768 + ch * 1024), 16, 0, 0); }
}
#define PK(L, H) (bf16x8){L[0], L[1], L[2], L[3], H[0], H[1], H[2], H[3]}
#define VRD(P, D0) const bf16x4 P##l0 = tr_read<(D0) * 512 + 0 * 8192>(vb), P##h0 = tr_read<(D0) * 512 + 0 * 8192 + 4096>(vb), P##l1 = tr_read<(D0) * 512 + 1 * 8192>(vb), P##h1 = tr_read<(D0) * 512 + 1 * 8192 + 4096>(vb), \
    P##l2 = tr_read<(D0) * 512 + 2 * 8192>(vb), P##h2 = tr_read<(D0) * 512 + 2 * 8192 + 4096>(vb), P##l3 = tr_read<(D0) * 512 + 3 * 8192>(vb), P##h3 = tr_read<(D0) * 512 + 3 * 8192 + 4096>(vb)
#define VMM(P, D0) do { O[D0] = MFMA32(pf[0], PK(P##l0, P##h0), O[D0]); O[D0] = MFMA32(pf[1], PK(P##l1, P##h1), O[D0]); O[D0] = MFMA32(pf[2], PK(P##l2, P##h2), O[D0]); O[D0] = MFMA32(pf[3], PK(P##l3, P##h3), O[D0]); } while (0)
#define VW8() do { asm volatile("s_waitcnt lgkmcnt(8)" ::: "memory"); __builtin_amdgcn_sched_barrier(0); } while (0)
DI void at_pv_all(f32x16 (&O)[8], const int vb, const bf16x8 (&pf)[4]) {
    VRD(a, 0); __builtin_amdgcn_sched_barrier(0);
    VRD(b, 1); VW8(); VMM(a, 0); __builtin_amdgcn_sched_barrier(0);
    VRD(c, 2); VW8(); VMM(b, 1); __builtin_amdgcn_sched_barrier(0);
    VRD(d, 3); VW8(); VMM(c, 2); __builtin_amdgcn_sched_barrier(0);
    VRD(e, 4); VW8(); VMM(d, 3); __builtin_amdgcn_sched_barrier(0);
    VRD(f, 5); VW8(); VMM(e, 4); __builtin_amdgcn_sched_barrier(0);
    VRD(g, 6); VW8(); VMM(f, 5); __builtin_amdgcn_sched_barrier(0);
    VRD(h, 7); VW8(); VMM(g, 6); __builtin_amdgcn_sched_barrier(0);
    asm volatile("s_waitcnt lgkmcnt(0)" ::: "memory"); __builtin_amdgcn_sched_barrier(0); VMM(h, 7); __builtin_amdgcn_sched_barrier(0);
}
#undef VRD
#undef VMM
#undef VW8
#undef PK
DI void attn_unit(Frame& F, const AttnUnit& U, const float lam) {
    const int tid = F.tid, w = F.wave, lane = F.lane, rt = w >> 1, mm = w & 1;
    LAS unsigned char* lds = F.lds;
    const bf16* QB = U.Qp; bf16* ATT = U.Op;
    __syncthreads();
    { int tv = tid; asm volatile("" : "+v"(tv)); const int rel = tv - 256; *(LAS float*)(lds + AT_BT + tv * 4) = F.in[I_RELB][t5_bucket(rel) * 8 + U.h] * 1.4426950408889634f; }
    const bool active = 32 * rt < U.nq;
    const int qchunk = (U.qpos0 + 32 * rt) >> 6;
    bf16x8 qf[8];
    { int lq = lane; asm volatile("" : "+v"(lq)); const int c = lq & 31, hh = lq >> 5, qrow = 32 * rt + c;
#pragma unroll
      for (int s = 0; s < 8; ++s) qf[s] = (qrow < U.nq) ? *(const bf16x8*)(QB + (U.mq0 + qrow) * DM + (2 * U.h + mm) * 128 + 16 * s + 8 * hh) : (bf16x8){0, 0, 0, 0, 0, 0, 0, 0}; }
    const int ntiles = (U.nkeys + 63) >> 6;
    float m_run = -1e30f, l_run = 0.f;
    f32x16 O[8];
#pragma unroll
    for (int d = 0; d < 8; ++d) O[d] = (f32x16){};
    at_dma(lds, U, 0, 0, w, lane);
    asm volatile("s_waitcnt vmcnt(0)" ::: "memory");
    __syncthreads();
    for (int kt = 0; kt < ntiles; ++kt) {
        const bool vis = active && kt <= qchunk;
        if (!vis && kt + 1 < ntiles) at_dma(lds, U, kt + 1, (kt + 1) & 1, w, lane);
        if (vis) {
#if ATT_SKEW
            if (w >= 4) __builtin_amdgcn_s_sleep(ATT_SKEW);
#endif
            int lv = lane; asm volatile("" : "+v"(lv)); const int c = lv & 31, hh = lv >> 5; const int qpos_lane = U.qpos0 + 32 * rt + c;
            const int kbase = AT_K + (kt & 1) * 32768 + mm * 16384;
            f32x16 t0 = {}, t1 = {};
            {
                bf16x8 ka[3], kb[3];
#define LDKF(buf, s0) do { ka[buf] = *(const LAS bf16x8*)(lds + kbase + KSWZ(c, 32 * (s0) + 16 * hh)); kb[buf] = *(const LAS bf16x8*)(lds + kbase + KSWZ(32 + c, 32 * (s0) + 16 * hh)); } while (0)
#define MMKF(buf, s0) do { t0 = MFMA32(ka[buf], qf[s0], t0); t1 = MFMA32(kb[buf], qf[s0], t1); } while (0)
#define SB_() __builtin_amdgcn_sched_barrier(0)
                LDKF(0, 0); LDKF(1, 1); SB_();
                LDKF(2, 2); SB_(); MMKF(0, 0); SB_();
                LDKF(0, 3); SB_(); MMKF(1, 1); SB_();
                LDKF(1, 4); SB_(); MMKF(2, 2); SB_();
                LDKF(2, 5); SB_(); MMKF(0, 3); SB_();
                LDKF(0, 6); SB_(); MMKF(1, 4); SB_();
                LDKF(1, 7); SB_(); MMKF(2, 5); SB_();
                MMKF(0, 6); SB_(); MMKF(1, 7); SB_();
#undef SB_
#undef LDKF
#undef MMKF
            }
            const LAS float* bt = (const LAS float*)(lds + AT_BT);
            float mx, bc0 = 0.f; bool far = false;
            if (kt * 64 + 63 - (U.qpos0 + 32 * rt) <= -91 && kt * 64 + 63 < U.nkeys) {
                far = true; bc0 = bt[0];
                float r0 = fmaxf(t0[0], t1[0]);
#pragma unroll
                for (int i = 1; i < 16; i += 1) r0 = __builtin_fmaxf(__builtin_fmaxf(r0, t0[i]), t1[i]);
                mx = r0 * ATT_C + bc0;
            } else {
                const bool part = kt * 64 + 63 >= U.nkeys;
#pragma unroll
                for (int i = 0; i < 16; ++i) { const int kg = kt * 64 + crow(i, hh); int r0 = kg - qpos_lane, r1 = r0 + 32;
                    r0 = r0 < -256 ? -256 : r0; r0 = r0 > 255 ? 255 : r0; r1 = r1 < -256 ? -256 : r1; r1 = r1 > 255 ? 255 : r1;
                    float b0 = bt[r0 + 256], b1 = bt[r1 + 256];
                    if (part) { b0 = (kg < U.nkeys) ? b0 : -1e30f; b1 = (kg + 32 < U.nkeys) ? b1 : -1e30f; }
                    t0[i] = t0[i] * ATT_C + b0; t1[i] = t1[i] * ATT_C + b1; }
                mx = fmaxf(t0[0], t1[0]);
#pragma unroll
                for (int i = 1; i < 16; ++i) mx = __builtin_fmaxf(__builtin_fmaxf(mx, t0[i]), t1[i]);
            }
            mx = fmaxf(mx, __shfl_xor(mx, 32));
            if (__any(mx - m_run > ATT_THR)) {
                const float mn = fmaxf(m_run, mx), al = __builtin_amdgcn_exp2f(m_run - mn);
#pragma unroll
                for (int i = 0; i < 16; ++i) { const float ai = __shfl(al, crow(i, hh));
#pragma unroll
                    for (int d = 0; d < 8; ++d) O[d][i] *= ai; }
                l_run *= al; m_run = mn;
            }
            float ps = 0.f;
            if (far) { const float off = bc0 - m_run;
#pragma unroll
                for (int i = 0; i < 16; ++i) { t0[i] = __builtin_amdgcn_exp2f(__builtin_fmaf(t0[i], ATT_C, off)); t1[i] = __builtin_amdgcn_exp2f(__builtin_fmaf(t1[i], ATT_C, off)); ps += t0[i] + t1[i]; }
            } else {
#pragma unroll
                for (int i = 0; i < 16; ++i) { t0[i] = __builtin_amdgcn_exp2f(t0[i] - m_run); t1[i] = __builtin_amdgcn_exp2f(t1[i] - m_run); ps += t0[i] + t1[i]; }
            }
            l_run += ps;
            bf16x8 pf[4];
            pf[0] = pack_acc(t0, 0); pf[1] = pack_acc(t0, 1); pf[2] = pack_acc(t1, 0); pf[3] = pack_acc(t1, 1);
            if (kt + 1 < ntiles) at_dma(lds, U, kt + 1, (kt + 1) & 1, w, lane);
            const int vb = (int)(unsigned)(size_t)(lds + AT_V + (kt & 1) * 32768) + v_rd_base(lv);
            asm volatile("s_waitcnt lgkmcnt(0)" ::: "memory"); at_pv_all(O, vb, pf);
        }
        asm volatile("s_waitcnt vmcnt(0)" ::: "memory");
        __syncthreads();
    }
    {
        int lv = lane; asm volatile("" : "+v"(lv)); const int c = lv & 31, hh = lv >> 5;
        l_run += __shfl_xor(l_run, 32);
        const float sc_own = (mm ? lam : 1.0f) / l_run;
        LAS float* xo = (LAS float*)lds + rt * 8192;
        if (mm == 1) {
#pragma unroll
            for (int i = 0; i < 16; ++i) { const float si = __shfl(sc_own, crow(i, hh));
#pragma unroll
                for (int d = 0; d < 8; ++d) xo[crow(i, hh) * 256 + 32 * d + c] = O[d][i] * si; }
        }
        __syncthreads();
        if (mm == 0 && active) {
            float ssa[16];
#pragma unroll
            for (int i = 0; i < 16; ++i) { const float si = __shfl(sc_own, crow(i, hh)); float a = 0.f;
#pragma unroll
                for (int d = 0; d < 8; ++d) { const float o = O[d][i] * si - xo[crow(i, hh) * 256 + 32 * d + c]; O[d][i] = o; a += o * o; }
                a += __shfl_xor(a, 1); a += __shfl_xor(a, 2); a += __shfl_xor(a, 4); a += __shfl_xor(a, 8); a += __shfl_xor(a, 16);
                ssa[i] = rsqrtf(a * (1.0f / 256.0f) + 1e-5f) * (1.0f - LAM_INIT); }
#pragma unroll
            for (int d = 0; d < 8; ++d) { const float gn = F.in[I_SUBN][32 * d + c];
#pragma unroll
                for (int i = 0; i < 16; ++i) { const int r = 32 * rt + crow(i, hh);
                    if (r < U.nq) ATT[(U.mq0 + r) * DM + U.h * 256 + 32 * d + c] = (bf16)(pk2(O[d][i] * ssa[i] * gn, 0.f) & 0xffffu); } }
        }
    }
}
DI float attn_lambda(Frame& F) {
    float d1 = 0.f, d2 = 0.f;
    for (int i = 0; i < 128; ++i) { d1 += F.in[I_LQ1][i] * F.in[I_LK1][i]; d2 += F.in[I_LQ2][i] * F.in[I_LK2][i]; }
    return __expf(d1) - __expf(d2) + LAM_INIT;
}
DI void p_attn(Frame& F) {
    const float lam = attn_lambda(F);
    const bf16* KB = (const bf16*)(F.ws + WS_KB); const bf16* VB = (const bf16*)(F.ws + WS_VB);
    constexpr int NPQ = NB * 8 * 64 / 8;
    const int xcc = (int)(xb_xcc_id() & 7u);
    for (int e = 0; e < 8; ++e) {
        const int q = (xcc + e) & 7;
        for (;;) {
            __syncthreads();
            if (F.tid == 0) F.MISC[16] = atomicAdd(F.ctl + CW_ATTQ + 32 * q, 1u);
            __syncthreads();
            const int r = __builtin_amdgcn_readfirstlane((int)F.MISC[16]);
            if (r >= NPQ) break;
            AttnUnit U; const int bh = 2 * q + (r & 1), u = 63 - (r >> 1), b = bh >> 3;
            U.h = bh & 7; U.Kp = KB + (size_t)b * SEQ * DM; U.Vp = VB + (size_t)b * SEQ * DM; U.Qp = (const bf16*)(F.ws + WS_QB); U.Op = (bf16*)(F.ws + WS_ATT);
            U.nq = 128; U.qpos0 = u * 128; U.nkeys = (u + 1) * 128; U.mq0 = (size_t)b * SEQ + (size_t)u * 128;
            attn_unit(F, U, lam);
        }
    }
}
DI void p_attn_sample(Frame& F, const int sw, const int nsw) {
    const float lam = attn_lambda(F);
    const bf16* KC = (const bf16*)(F.ws + WS_KC); const bf16* VC = (const bf16*)(F.ws + WS_VC);
    for (int p = sw; p < DECB * 8; p += nsw) {
        AttnUnit U; const int b = p >> 3; U.h = p & 7; U.Kp = KC + (size_t)b * (PAST + DECS) * DM; U.Vp = VC + (size_t)b * (PAST + DECS) * DM;
        U.Qp = (const bf16*)(F.ws + WS_SQB) - (size_t)MP * DM; U.Op = (bf16*)(F.ws + WS_SATT) - (size_t)MP * DM;
        U.nq = DECS; U.qpos0 = PAST; U.nkeys = PAST + DECS; U.mq0 = (size_t)MP + (size_t)b * DECS;
        attn_unit(F, U, lam);
    }
}
#ifndef WGM_SMALLN
#define WGM_SMALLN 4
#endif
#ifndef WGM_BIGN
#define WGM_BIGN 4
#endif
#ifndef N_LAUNCH_MODE
#define N_LAUNCH_MODE 1
#endif
constexpr int N_PHASES = 16;
struct Args { const float* in[N_IN]; float* out; unsigned char* ws; int ph_lo, ph_hi; };
static_assert(sizeof(Args) == (N_IN + 2) * 8 + 8, "Args has no padding");
__global__ void __launch_bounds__(NWAVES * 64, 2) fwd(Args args) {
    extern __shared__ __attribute__((aligned(16))) unsigned char lds_raw[];
    Frame F;
    F.lds = (LAS unsigned char*)lds_raw;
    F.MISC = (volatile LAS unsigned*)(F.lds + LDSCTL_OFF);
    F.tid = threadIdx.x; F.lane = F.tid & 63; F.wave = __builtin_amdgcn_readfirstlane(F.tid >> 6);
    F.G = gridDim.x; { const int bx = blockIdx.x; F.vcu = (F.G % 8 == 0) ? (bx % 8) * (F.G / 8) + bx / 8 : bx; }
    F.in = args.in; F.out = args.out; F.ws = args.ws; F.ctl = (unsigned*)(args.ws + WS_CTL);
    for (int u = F.tid; u < (LDS_BYTES - LDSCTL_OFF) / 4; u += NWAVES * 64) ((LAS unsigned*)(F.lds + LDSCTL_OFF))[u] = 0u;
    __syncthreads();
    XcdBarrier bar; bar.bar = F.ctl + CW_BAR; bar.x = 0; bar.st = nullptr;
    if (N_LAUNCH_MODE == 1) bar = xcd_barrier_post(F.ctl + CW_BAR, F.MISC + 8);
    const int lo = args.ph_lo, hi = args.ph_hi;
#ifndef PHASE_MASK
#define PHASE_MASK 0xffff
#endif
#define IN(k) (((PHASE_MASK >> (k)) & 1) && lo <= (k) && (k) < hi)
#ifndef TWICE_MASK
#define TWICE_MASK 0
#endif
#ifndef NREP
#define NREP 2
#endif
#ifndef SPIN_MASK
#define SPIN_MASK 0
#endif
#define SEAM(k) do { if (((SPIN_MASK >> (k)) & 1) && IN(k)) { const unsigned long long t1_ = __builtin_amdgcn_s_memrealtime(); while (__builtin_amdgcn_s_memrealtime() - t1_ < t1_ - tph_) __builtin_amdgcn_s_sleep(8); } \
    if (IN(k) && IN((k) + 1)) xcd_barrier(bar); if (SPIN_MASK) tph_ = __builtin_amdgcn_s_memrealtime(); } while (0)
#define REP(k) for (int rep_ = 0; rep_ < (((TWICE_MASK >> (k)) & 1) ? NREP : 1); ++rep_, (((TWICE_MASK >> (k)) & 1) && rep_ < NREP ? xcd_barrier(bar) : (void)0))
    unsigned long long tph_ = SPIN_MASK ? __builtin_amdgcn_s_memrealtime() : 0ull; (void)tph_;
    unsigned char* ws = args.ws;
    PG8_LAS unsigned char* ring = (PG8_LAS unsigned char*)F.lds;
    bf16* HB = (bf16*)(ws + WS_HB);
    float* H = args.out;
#define SSQP(i) ((float*)(ws + WS_SSQ + (size_t)(i) * SSQ_STRIDE))

    const int gwA = F.vcu * NWAVES + F.wave, NGWA = F.G * NWAVES;
    const bf16* UPm = (const bf16*)(ws + WS_UP); bf16* ACTm = (bf16*)(ws + WS_ACT);
    if (IN(0)) { REP(0) p0_prologue(F); } SEAM(0);
    if (IN(1)) {
        pg8::Gemm g{HB, (const bf16*)(ws + WS_WIN), M, INWP, DM}; pg8::StaticOrder S; S.init(M, INWP, F.G, (int)blockIdx.x, WGM_BIGN);
        pg8::EpiBf E{SSQP(0), (bf16*)(ws + WS_QKV), QKVW, QKVW, (bf16*)(ws + WS_Z), VW, VW, (float*)(ws + WS_BA), 64, 64};
        pg8::gemm_phase<pg8::EpiBf, pg8::StaticOrder, PG8_ALIGN, PG8_SP2>(ring, g, S, E, F.tid);
    } SEAM(1);
#ifdef GDN_REP5
    if (IN(2)) { p_gdnconv(F); p_gdnconv(F); p_gdnconv(F); p_gdnconv(F); p_gdnconv(F); } SEAM(2);
#else
    if (IN(2)) { REP(2) p_gdnconv(F); } SEAM(2);
#endif
    if (IN(3)) { REP(3) p_prep(F); } SEAM(3);
    if (IN(4)) {
        p_scan(F);
        const int nW = F.G, bx = blockIdx.x;
        const bool sub = (nW > NB * 32) ? (bx >= NB * 32) : true;
        const int sw = (nW > NB * 32) ? bx - NB * 32 : bx, nsw = (nW > NB * 32) ? nW - NB * 32 : nW;
        if (sub) {
#ifndef SUBSPIN
#define SUBSPIN 0
#endif
            unsigned long long tst_ = SUBSPIN ? __builtin_amdgcn_s_memrealtime() : 0ull; (void)tst_;
#define STG0() do { if (SUBSPIN) tst_ = __builtin_amdgcn_s_memrealtime(); } while (0)
#define STG(i) do { if ((SUBSPIN >> (i)) & 1) { const unsigned long long t1_ = __builtin_amdgcn_s_memrealtime(); while (__builtin_amdgcn_s_memrealtime() - t1_ < t1_ - tst_) __builtin_amdgcn_s_sleep(8); } } while (0)
            XcdBarrier sb = xcd_barrier_post(F.ctl + CW_BAR2, F.MISC + 12);
            const unsigned ne = (unsigned)nsw; const int gwS = sw * NWAVES + F.wave, NGWS = nsw * NWAVES;
#define UPs_ ((bf16*)(ws + WS_SUP) - (size_t)MP * UPW)
#define ACTs_ ((bf16*)(ws + WS_SACT) - (size_t)MP * DFF)
#define QBs_ ((bf16*)(ws + WS_SQB) - (size_t)MP * DM)
#define ATTs_ ((bf16*)(ws + WS_SATT) - (size_t)MP * DM)
            const int spm = MP / 256;
#define IDLE(n) (sw >= (n) && nsw > (n))
#define IGW(n) ((sw - (n)) * NWAVES + F.wave)
#define INGW(n) ((nsw - (n)) * NWAVES)
            __syncthreads();
            conv_job(F, CJ_WOUT, gwS, NGWS);
            if (nsw <= 44) { conv_job(F, CJ_WUP0, gwS, NGWS); conv_job(F, CJ_WDN0, gwS, NGWS); conv_job(F, CJ_WKVQ, gwS, NGWS); conv_job(F, CJ_WO, gwS, NGWS); conv_job(F, CJ_WUP1, gwS, NGWS); conv_job(F, CJ_WDN1, gwS, NGWS);
                p_cacheconv(F, args.in[I_CK], (bf16*)(ws + WS_KC), (size_t)sw * 512 + F.tid, (size_t)nsw * 512); p_cacheconv(F, args.in[I_CV], (bf16*)(ws + WS_VC), (size_t)sw * 512 + F.tid, (size_t)nsw * 512); }
            const bool spread = nsw > 44;
            STG(0); sub_barrier(sb, ne); asm volatile("" : "+v"(F.tid), "+v"(F.lane)); STG0();
            {
                pg8::Gemm g{(const bf16*)(args.out + O_PK), (const bf16*)(ws + WS_WOUT), M, DM, VW}; pg8::SubOrder S{spm, DM / 256, nsw, sw};
                pg8::EpiRes E{args.in[I_XS] - (size_t)MP * DM, args.in[I_XS] - (size_t)MP * DM, H, HB, SSQP(1)};
                pg8::gemm_phase<pg8::EpiRes, pg8::SubOrder, PG8_ALIGN, PG8_SP2>(ring, g, S, E, F.tid); }
            if (spread && IDLE(8)) { __syncthreads(); conv_job(F, CJ_WUP0, IGW(8), INGW(8)); conv_job(F, CJ_WDN0S, IGW(8), INGW(8)); p_cacheconv(F, args.in[I_CK], (bf16*)(ws + WS_KC), (size_t)(sw - 8) * 512 + F.tid, (size_t)(nsw - 8) * 512, 0, 6); }
            STG(1); sub_barrier(sb, ne); asm volatile("" : "+v"(F.tid), "+v"(F.lane)); STG0();
            {
                pg8::Gemm g{HB, (const bf16*)(ws + WS_WUP0), M, UPW, DM}; pg8::SubOrder S{spm, UPW / 256, nsw, sw};
                pg8::EpiBf E{SSQP(1), UPs_, UPW, UPW, nullptr, 0, 0, nullptr, 0, 0};
                pg8::gemm_phase<pg8::EpiBf, pg8::SubOrder, PG8_ALIGN, PG8_SP2>(ring, g, S, E, F.tid); }
            if (spread && IDLE(44)) { __syncthreads(); conv_job(F, CJ_WDN0, IGW(44), INGW(44)); conv_job(F, CJ_WKVQ, IGW(44), INGW(44)); }
            STG(2); sub_barrier(sb, ne); asm volatile("" : "+v"(F.tid), "+v"(F.lane)); STG0();
            p_ffnconv(F, 0, MP / 16, MP / 16 + DECB, gwS, NGWS, UPs_, ACTs_, spread ? (bf16*)(ws + WS_SACT) : nullptr);
            STG(3); sub_barrier(sb, ne); asm volatile("" : "+v"(F.tid), "+v"(F.lane)); STG0();
            if (spread) {
                pg8::Gemm g{(const bf16*)(ws + WS_SACT), (const bf16*)(ws + WS_WIN), 2 * MS, 2 * DM, DFF / 2}; pg8::SplitOrder S{nsw, sw};
                pg8::EpiPart E{(float*)(ws + WS_SUP)};
                pg8::gemm_phase<pg8::EpiPart, pg8::SplitOrder, PG8_ALIGN, PG8_SP2>(ring, g, S, E, F.tid);
                if (IDLE(16)) p_cacheconv(F, args.in[I_CK], (bf16*)(ws + WS_KC), (size_t)(sw - 16) * 512 + F.tid, (size_t)(nsw - 16) * 512, 6, 20);
                sub_barrier(sb, ne); asm volatile("" : "+v"(F.tid), "+v"(F.lane));
                p_splitk_reduce(F, H, HB, SSQP(2), gwS, NGWS);
            } else {
                pg8::Gemm g{ACTs_, (const bf16*)(ws + WS_WDN0), M, DM, DFF}; pg8::SubOrder S{spm, DM / 256, nsw, sw};
                pg8::EpiRes E{H, H, H, HB, SSQP(2)};
                pg8::gemm_phase<pg8::EpiRes, pg8::SubOrder, PG8_ALIGN, PG8_SP2>(ring, g, S, E, F.tid); }
            STG(4); sub_barrier(sb, ne); asm volatile("" : "+v"(F.tid), "+v"(F.lane)); STG0();
            {
                pg8::Gemm g{HB, (const bf16*)(ws + WS_WKVQ), M, 6144, DM}; pg8::SubOrder S{spm, 6144 / 256, nsw, sw};
                pg8::EpiKVQs E{SSQP(2), args.out, (bf16*)(ws + WS_KC), (WS_VC - WS_KC) / 2, QBs_};
                pg8::gemm_phase<pg8::EpiKVQs, pg8::SubOrder, PG8_ALIGN, PG8_SP2>(ring, g, S, E, F.tid); }
            if (spread && IDLE(24)) p_cacheconv(F, args.in[I_CV], (bf16*)(ws + WS_VC), (size_t)(sw - 24) * 512 + F.tid, (size_t)(nsw - 24) * 512);
            STG(5); sub_barrier(sb, ne); asm volatile("" : "+v"(F.tid), "+v"(F.lane)); STG0();
            p_attn_sample(F, sw, nsw);
            if (spread && IDLE(128)) { __syncthreads(); conv_job(F, CJ_WO, IGW(128), INGW(128)); conv_job(F, CJ_WUP1, IGW(128), INGW(128)); conv_job(F, CJ_WDN1, IGW(128), INGW(128)); }
            else if (spread && nsw <= 128) { __syncthreads(); conv_job(F, CJ_WO, gwS, NGWS); conv_job(F, CJ_WUP1, gwS, NGWS); conv_job(F, CJ_WDN1, gwS, NGWS); }
            STG(6); sub_barrier(sb, ne); asm volatile("" : "+v"(F.tid), "+v"(F.lane)); STG0();
        }
    } SEAM(4);
    if (IN(5)) {
        pg8::Gemm g{(const bf16*)(args.out + O_PK), (const bf16*)(ws + WS_WOUT), MP, DM, VW}; pg8::StaticOrder S; S.init(MP, DM, F.G, (int)blockIdx.x, WGM_SMALLN);
        pg8::EpiRes E{args.in[I_XP], args.in[I_XP], H, HB, SSQP(1)};
        pg8::gemm_phase<pg8::EpiRes, pg8::StaticOrder, PG8_ALIGN, PG8_SP2>(ring, g, S, E, F.tid);
    } SEAM(5);
    if (IN(6)) {
        pg8::Gemm g{HB, (const bf16*)(ws + WS_WUP0), MP, UPW, DM}; pg8::StaticOrder S; S.init(MP, UPW, F.G, (int)blockIdx.x, WGM_BIGN);
        pg8::EpiBf E{SSQP(1), (bf16*)(ws + WS_UP), UPW, UPW, nullptr, 0, 0, nullptr, 0, 0};
        pg8::gemm_phase<pg8::EpiBf, pg8::StaticOrder, PG8_ALIGN, PG8_SP2>(ring, g, S, E, F.tid);
    } SEAM(6);
#ifndef EXTRA_BAR
#define EXTRA_BAR 0
#endif
#ifdef FFN_REP5
    if (IN(7)) { { int g_ = gwA; asm volatile("" : "+s"(g_)); p_ffnconv(F, 0, 0, MP / 16, g_, NGWA, UPm, ACTm); } { int g_ = gwA; asm volatile("" : "+s"(g_)); p_ffnconv(F, 0, 0, MP / 16, g_, NGWA, UPm, ACTm); } { int g_ = gwA; asm volatile("" : "+s"(g_)); p_ffnconv(F, 0, 0, MP / 16, g_, NGWA, UPm, ACTm); } { int g_ = gwA; asm volatile("" : "+s"(g_)); p_ffnconv(F, 0, 0, MP / 16, g_, NGWA, UPm, ACTm); } { int g_ = gwA; asm volatile("" : "+s"(g_)); p_ffnconv(F, 0, 0, MP / 16, g_, NGWA, UPm, ACTm); } } SEAM(7);
#else
    if (IN(7)) { for (int eb_ = 0; eb_ < EXTRA_BAR; ++eb_) xcd_barrier(bar); REP(7) p_ffnconv(F, 0, 0, MP / 16, gwA, NGWA, UPm, ACTm); } SEAM(7);
#endif
    if (IN(8)) {
        pg8::Gemm g{(const bf16*)(ws + WS_ACT), (const bf16*)(ws + WS_WDN0), MP, DM, DFF}; pg8::StaticOrder S; S.init(MP, DM, F.G, (int)blockIdx.x, WGM_SMALLN);
        pg8::EpiRes E{H, H, H, HB, SSQP(2)};
        pg8::gemm_phase<pg8::EpiRes, pg8::StaticOrder, PG8_ALIGN, PG8_SP2>(ring, g, S, E, F.tid);
    } SEAM(8);
    if (IN(9)) {
        pg8::Gemm g{HB, (const bf16*)(ws + WS_WKVQ), MP, 6144, DM}; pg8::StaticOrder S; S.init(MP, 6144, F.G, (int)blockIdx.x, WGM_BIGN);
        pg8::EpiKVQ E{SSQP(2), args.out, (bf16*)(ws + WS_KB), (WS_VB - WS_KB) / 2, (bf16*)(ws + WS_KC), (WS_VC - WS_KC) / 2};
        static_assert(WS_QB - WS_VB == WS_VB - WS_KB, "K, V, Q bf16 buffers equally spaced");
        pg8::gemm_phase<pg8::EpiKVQ, pg8::StaticOrder, PG8_ALIGN, PG8_SP2>(ring, g, S, E, F.tid);
    } SEAM(9);
    if (IN(10)) {
        const int nsb = F.G < 8 ? F.G : 8;
        if ((int)blockIdx.x < nsb) {
            XcdBarrier sb3 = xcd_barrier_post(F.ctl + CW_BAR3, F.MISC + 14);
            const int spm = MP / 256;
            {
                pg8::Gemm g{ATTs_, (const bf16*)(ws + WS_WO), M, DM, DM}; pg8::SubOrder S{spm, DM / 256, nsb, (int)blockIdx.x};
                pg8::EpiRes E{H, H, H, HB, SSQP(3)};
                pg8::gemm_phase<pg8::EpiRes, pg8::SubOrder, PG8_ALIGN, PG8_SP2>(ring, g, S, E, F.tid); }
            sub_barrier(sb3, (unsigned)nsb); asm volatile("" : "+v"(F.tid), "+v"(F.lane));
            {
                pg8::Gemm g{HB, (const bf16*)(ws + WS_WUP1), M, UPW, DM}; pg8::SubOrder S{spm, UPW / 256, nsb, (int)blockIdx.x};
                pg8::EpiBf E{SSQP(3), UPs_, UPW, UPW, nullptr, 0, 0, nullptr, 0, 0};
                pg8::gemm_phase<pg8::EpiBf, pg8::SubOrder, PG8_ALIGN, PG8_SP2>(ring, g, S, E, F.tid); }
            sub_barrier(sb3, (unsigned)nsb); asm volatile("" : "+v"(F.tid), "+v"(F.lane));
            p_ffnconv(F, 1, MP / 16, MP / 16 + DECB, (int)blockIdx.x * NWAVES + F.wave, nsb * NWAVES, UPs_, ACTs_);
            sub_barrier(sb3, (unsigned)nsb); asm volatile("" : "+v"(F.tid), "+v"(F.lane));
            {
                pg8::Gemm g{ACTs_, (const bf16*)(ws + WS_WDN1), M, DM, DFF}; pg8::SubOrder S{spm, DM / 256, nsb, (int)blockIdx.x};
                pg8::EpiRes E{H, H, H, nullptr, SSQP(4)};
                pg8::gemm_phase<pg8::EpiRes, pg8::SubOrder, PG8_ALIGN, PG8_SP2>(ring, g, S, E, F.tid); }
            sub_barrier(sb3, (unsigned)nsb); asm volatile("" : "+v"(F.tid), "+v"(F.lane));
            p_final(F, MP, M, (int)blockIdx.x * NWAVES + F.wave, nsb * NWAVES);
        }
        p_attn(F);
    } SEAM(10);
    if (IN(11)) {
        pg8::Gemm g{(const bf16*)(ws + WS_ATT), (const bf16*)(ws + WS_WO), MP, DM, DM}; pg8::StaticOrder S; S.init(MP, DM, F.G, (int)blockIdx.x, WGM_SMALLN);
        pg8::EpiRes E{H, H, H, HB, SSQP(3)};
        pg8::gemm_phase<pg8::EpiRes, pg8::StaticOrder, PG8_ALIGN, PG8_SP2>(ring, g, S, E, F.tid);
    } SEAM(11);
    if (IN(12)) {
        pg8::Gemm g{HB, (const bf16*)(ws + WS_WUP1), MP, UPW, DM}; pg8::StaticOrder S; S.init(MP, UPW, F.G, (int)blockIdx.x, WGM_BIGN);
        pg8::EpiBf E{SSQP(3), (bf16*)(ws + WS_UP), UPW, UPW, nullptr, 0, 0, nullptr, 0, 0};
        pg8::gemm_phase<pg8::EpiBf, pg8::StaticOrder, PG8_ALIGN, PG8_SP2>(ring, g, S, E, F.tid);
    } SEAM(12);
    if (IN(13)) { p_ffnconv(F, 1, 0, MP / 16, gwA, NGWA, UPm, ACTm); } SEAM(13);
    if (IN(14)) {
        pg8::Gemm g{(const bf16*)(ws + WS_ACT), (const bf16*)(ws + WS_WDN1), MP, DM, DFF}; pg8::StaticOrder S; S.init(MP, DM, F.G, (int)blockIdx.x, WGM_SMALLN);
        pg8::EpiRes E{H, H, H, nullptr, SSQP(4)};
        pg8::gemm_phase<pg8::EpiRes, pg8::StaticOrder, PG8_ALIGN, PG8_SP2>(ring, g, S, E, F.tid);
    } SEAM(14);
    if (IN(15)) { p_final(F, 0, MP, gwA, NGWA); }
#undef IN
#undef SEAM
}

extern "C" void kernel_launch(void* const* d_in, const int* in_sizes, int n_in, void* d_out, int out_size, void* d_ws, size_t ws_size, hipStream_t stream) {
    static int grid = 0;
    if (grid == 0) {
        if (n_in != N_IN || (size_t)out_size != O_END || ws_size < WS_END) { fprintf(stderr, "kernel_launch: shape mismatch: n_in %d out %d ws %zu (need %zu)\n", n_in, out_size, ws_size, (size_t)WS_END); grid = -1; return; }
        int dev = 0, cus = 0;
        if (hipGetDevice(&dev) != hipSuccess || hipDeviceGetAttribute(&cus, hipDeviceAttributeMultiprocessorCount, dev) != hipSuccess) { grid = -1; return; }
        if (hipFuncSetAttribute((const void*)fwd, hipFuncAttributeMaxDynamicSharedMemorySize, LDS_BYTES) != hipSuccess) { fprintf(stderr, "kernel_launch: hipFuncSetAttribute failed\n"); grid = -1; return; }
        int per_cu = 0;
        if (hipOccupancyMaxActiveBlocksPerMultiprocessor(&per_cu, (const void*)fwd, NWAVES * 64, LDS_BYTES) != hipSuccess || per_cu < 1) fprintf(stderr, "kernel_launch: occupancy query reports %d\n", per_cu);
        (void)hipGetLastError();
        grid = cus;
    }
    if (grid < 0) return;
    (void)hipMemsetAsync((char*)d_ws + WS_CTL, 0, CTL_ZERO_BYTES, stream);
    Args a{};
    for (int i = 0; i < N_IN; ++i) a.in[i] = (const float*)d_in[i];
    a.out = (float*)d_out; a.ws = (unsigned char*)d_ws;
    if (N_LAUNCH_MODE == 1) { a.ph_lo = 0; a.ph_hi = N_PHASES; hipLaunchKernelGGL(fwd, dim3(grid), dim3(NWAVES * 64), LDS_BYTES, stream, a); }
    else for (int p = 0; p < N_PHASES; ++p) { a.ph_lo = p; a.ph_hi = p + 1; hipLaunchKernelGGL(fwd, dim3(grid), dim3(NWAVES * 64), LDS_BYTES, stream, a); }
    const hipError_t le = hipPeekAtLastError();
    if (le != hipSuccess) fprintf(stderr, "kernel_launch: launch failed: %s\n", hipGetErrorName(le));
}
```

```cpp
#include <hip/hip_runtime.h>
#include <cstdio>
#include <cstdint>

constexpr int DM = 2048;
constexpr int SEQ = 8192, NB = 2, MP = NB * SEQ;
constexpr int DECB = 16, DECS = 16, MS = DECB * DECS;
constexpr int PAST = 2048;
constexpr int M = MP + MS;
constexpr int QKVW = 8192, VW = 4096, INW = 12352, INWP = 12544;
constexpr int DFF = 5632, UPW = 11264;
constexpr int NITEM_P = NB * 128 * 32, NITEM = NITEM_P + DECB * 32;
constexpr size_t O_Y = 0, O_PGDN = 34078720, O_PGC = 35127296, O_PFC = 35176448, O_PK = 35266560, O_PV = 68820992,
                 O_SGDN = 102375424, O_SGC = 110764032, O_SFC = 111157248, O_SK = 111878144, O_SV = 112402432, O_END = 112926720;
namespace pg8 {
#define PG8_LAS __attribute__((address_space(3)))
typedef unsigned short bf16_t;
typedef short bf16x8 __attribute__((ext_vector_type(8)));
typedef float f32x4 __attribute__((ext_vector_type(4)));
typedef unsigned u32x4 __attribute__((ext_vector_type(4)));
constexpr int BM = 256, BK = 64, HALF = 128, HTB = HALF * BK * 2  , STAGE_BYTES = 8 * HTB, NXCD = 8, WGM = 4;

__host__ __device__ __forceinline__ int lds_byte(int r, int c) { const int st = (r >> 4) * 2 + (c >> 5), rr = r & 15, cc = c & 31, ob = rr * 64 + cc * 2; return st * 1024 + (ob ^ (((ob >> 9) & 1) << 5)); }
__host__ __device__ __forceinline__ void stage_rc(int b, int& R, int& C) { const int st = b / 1024, sb = b % 1024, swz = sb ^ (((sb >> 9) & 1) << 5); R = (st >> 1) * 16 + swz / 64; C = (st & 1) * 32 + (swz % 64) / 2; }
__host__ __device__ __forceinline__ int perm32(int rho) { const int n = rho >> 4, i = rho & 15; return 8 * (i >> 2) + 4 * n + (i & 3); }

struct Unit { int pm, pn; };
struct Gemm { const bf16_t* A; const bf16_t* Bt; int M, N, K; };

struct StaticOrder {
    int nM, nN, nwg, G, c, wgm;
    __host__ __device__ void init(int M, int N, int G_, int c_, int wgm_ = WGM) { nM = M / BM; nN = N / BM; nwg = nM * nN; G = G_; c = c_; wgm = wgm_; }
    __host__ __device__ bool next(int i, Unit& u) const {
        const long L = (long)i * G + c; if (L >= nwg) return false;
        int wgid = (int)L; { const int q = nwg / NXCD, r = nwg % NXCD, xcd = wgid % NXCD, off = wgid / NXCD; wgid = (xcd < r ? xcd * (q + 1) : r * (q + 1) + (xcd - r) * q) + off; }
        const int nig = wgm * nN, gid = wgid / nig, fm = gid * wgm, gsz = (nM - fm) < wgm ? (nM - fm) : wgm;
        u.pm = fm + ((wgid % nig) % gsz); u.pn = (wgid % nig) / gsz; return true;
    }
    __device__ __forceinline__ void a_ready(const Unit&) const {}
    __device__ __forceinline__ void done(const Unit&) const {}
};

typedef float f32x2 __attribute__((ext_vector_type(2)));
typedef __bf16 bf16v2 __attribute__((ext_vector_type(2)));
typedef unsigned u32x2 __attribute__((ext_vector_type(2)));
__device__ __forceinline__ unsigned cvt_pk_bf16(float lo, float hi) { const f32x2 v = {lo, hi}; return __builtin_bit_cast(unsigned, __builtin_convertvector(v, bf16v2)); }

__device__ __forceinline__ void row_rstd(const float* ssq, int row0, int fq, float (&rs)[2][4]) {
    asm volatile("" : "+v"(row0), "+v"(fq));
#pragma unroll
    for (int ai = 0; ai < 2; ++ai)
#pragma unroll
        for (int m = 0; m < 4; ++m) {
            const float* p = ssq + (size_t)(row0 + ai * HALF + m * 16) * 32 + fq * 8;
            const f32x4 a = *(const f32x4*)p, b = *(const f32x4*)(p + 4);
            float s = ((a[0] + a[1]) + (a[2] + a[3])) + ((b[0] + b[1]) + (b[2] + b[3]));
            s += __shfl_xor(s, 16); s += __shfl_xor(s, 32);
            rs[ai][m] = rsqrtf(s * (1.0f / 2048.0f) + 1e-6f);
        }
}
struct EpiBf {
    static constexpr bool PERM = true, AFTER_DRAIN = false;
    const float* ssq; bf16_t* O0; int ld0, nc0; bf16_t* O1; int ld1, nc1; float* F2; int ld2, nc2;
    __device__ __forceinline__ void operator()(const f32x4 (&acc)[2][2][4][2], const Unit& u, int wr, int wc, int fr, int fq) const {
        asm volatile("" : "+v"(fr), "+v"(fq));
        const int row0 = u.pm * BM + wr * 64 + fr; const int colt = u.pn * BM;
        float rs[2][4]; row_rstd(ssq, row0, fq, rs);
        if (colt < nc0 + nc1) {
            bf16_t* base; int ld;
            if (colt < nc0) { base = O0 + colt; ld = ld0; } else { base = O1 + (colt - nc0); ld = ld1; }
            const int col0 = wc * 32 + 8 * fq;
#pragma unroll
            for (int ai = 0; ai < 2; ++ai)
#pragma unroll
                for (int m = 0; m < 4; ++m) { bf16_t* rowp = base + (size_t)(row0 + ai * HALF + m * 16) * ld + col0; const float r = rs[ai][m];
#pragma unroll
                    for (int bj = 0; bj < 2; ++bj) { const f32x4 v0 = acc[ai][bj][m][0] * r, v1 = acc[ai][bj][m][1] * r;
                        u32x4 w; w.x = cvt_pk_bf16(v0[0], v0[1]); w.y = cvt_pk_bf16(v0[2], v0[3]); w.z = cvt_pk_bf16(v1[0], v1[1]); w.w = cvt_pk_bf16(v1[2], v1[3]);
                        __builtin_nontemporal_store(w, (u32x4*)(rowp + bj * HALF)); } }
        } else if (colt == nc0 + nc1 && F2 != nullptr && wc * 32 < nc2) {
#pragma unroll
            for (int ai = 0; ai < 2; ++ai)
#pragma unroll
                for (int m = 0; m < 4; ++m) { float* rowp = F2 + (size_t)(row0 + ai * HALF + m * 16) * ld2 + wc * 32 + 8 * fq; const float r = rs[ai][m];
                    *(f32x4*)(rowp) = acc[ai][0][m][0] * r; *(f32x4*)(rowp + 4) = acc[ai][0][m][1] * r; }
        }
    }
};
struct EpiRes {
    static constexpr bool PERM = false, AFTER_DRAIN = false;
    const float* base0; const float* base1; float* out; bf16_t* hb; float* ssq;
    __device__ __forceinline__ void operator()(const f32x4 (&acc)[2][2][4][2], const Unit& u, int wr, int wc, int fr, int fq) const {
        asm volatile("" : "+v"(fr), "+v"(fq));
        const int row0 = u.pm * BM + wr * 64 + fr, col0 = u.pn * BM + wc * 32 + 4 * fq;
        const float* bs = (u.pm * BM < MP) ? base0 : base1;
#pragma unroll
        for (int ai = 0; ai < 2; ++ai)
#pragma unroll
            for (int m = 0; m < 4; ++m) { const size_t off = (size_t)(row0 + ai * HALF + m * 16) * DM + col0; float ss = 0.f;
#pragma unroll
                for (int bj = 0; bj < 2; ++bj)
#pragma unroll
                    for (int n = 0; n < 2; ++n) { const size_t o2 = off + bj * HALF + n * 16; const f32x4 o = __builtin_nontemporal_load((const f32x4*)(bs + o2)) + acc[ai][bj][m][n];
                        __builtin_nontemporal_store(o, (f32x4*)(out + o2)); ss += (o[0] * o[0] + o[1] * o[1]) + (o[2] * o[2] + o[3] * o[3]);
                        if (hb) { u32x2 w; w.x = cvt_pk_bf16(o[0], o[1]); w.y = cvt_pk_bf16(o[2], o[3]); *(u32x2*)(hb + o2) = w; } }
                ss += __shfl_xor(ss, 16); ss += __shfl_xor(ss, 32);
                if (fq == 0) ssq[(size_t)(row0 + ai * HALF + m * 16) * 32 + u.pn * 4 + wc] = ss; }
    }
};
struct EpiKVQ {
    static constexpr bool PERM = false, AFTER_DRAIN = false;
    const float* ssq; float* dout; bf16_t* KB; size_t kvq_stride; bf16_t* KC; size_t kc_stride;
    __device__ __forceinline__ void operator()(const f32x4 (&acc)[2][2][4][2], const Unit& u, int wr, int wc, int fr, int fq) const {
        asm volatile("" : "+v"(fr), "+v"(fq));
        const int row0 = u.pm * BM + wr * 64 + fr; const int colt = u.pn * BM, which = colt >> 11, cb = (colt & 2047) + wc * 32 + 4 * fq;
        float rs[2][4]; row_rstd(ssq, row0, fq, rs);
        bf16_t* bb = KB + (size_t)which * kvq_stride;
        float* fo = nullptr;
        if (which < 2) fo = (u.pm * BM < MP) ? dout + O_PK + (size_t)which * (O_PV - O_PK) : dout + O_SK + (size_t)which * (O_SV - O_SK) - (size_t)MP * DM;
#pragma unroll
        for (int ai = 0; ai < 2; ++ai)
#pragma unroll
            for (int m = 0; m < 4; ++m) { const size_t off = (size_t)(row0 + ai * HALF + m * 16) * DM + cb; const float r = rs[ai][m];
#pragma unroll
                for (int bj = 0; bj < 2; ++bj)
#pragma unroll
                    for (int n = 0; n < 2; ++n) { const size_t o2 = off + bj * HALF + n * 16; const f32x4 o = acc[ai][bj][m][n] * r;
                        if (fo) __builtin_nontemporal_store(o, (f32x4*)(fo + o2));
                        u32x2 w; w.x = cvt_pk_bf16(o[0], o[1]); w.y = cvt_pk_bf16(o[2], o[3]); *(u32x2*)(bb + o2) = w;
                        if (which < 2 && u.pm * BM >= MP) { const int ms = row0 + ai * HALF + m * 16 - MP;
                            *(u32x2*)(KC + (size_t)which * kc_stride + ((size_t)(ms >> 4) * (2048 + 16) + 2048 + (ms & 15)) * DM + cb + bj * HALF + n * 16) = w; } } }
    }
};

struct EpiKVQs {
    static constexpr bool PERM = false, AFTER_DRAIN = false;
    const float* ssq; float* dout; bf16_t* KC; size_t kc_stride; bf16_t* Qs;
    __device__ __forceinline__ void operator()(const f32x4 (&acc)[2][2][4][2], const Unit& u, int wr, int wc, int fr, int fq) const {
        asm volatile("" : "+v"(fr), "+v"(fq));
        const int row0 = u.pm * BM + wr * 64 + fr; const int colt = u.pn * BM, which = colt >> 11, cb = (colt & 2047) + wc * 32 + 4 * fq;
        float rs[2][4]; row_rstd(ssq, row0, fq, rs);
        float* fo = (which < 2) ? dout + O_SK + (size_t)which * (O_SV - O_SK) - (size_t)MP * DM : nullptr;
#pragma unroll
        for (int ai = 0; ai < 2; ++ai)
#pragma unroll
            for (int m = 0; m < 4; ++m) { const int row = row0 + ai * HALF + m * 16, ms = row - MP; const size_t off = (size_t)row * DM + cb; const float r = rs[ai][m];
#pragma unroll
                for (int bj = 0; bj < 2; ++bj)
#pragma unroll
                    for (int n = 0; n < 2; ++n) { const size_t o2 = off + bj * HALF + n * 16; const f32x4 o = acc[ai][bj][m][n] * r;
                        u32x2 w; w.x = cvt_pk_bf16(o[0], o[1]); w.y = cvt_pk_bf16(o[2], o[3]);
                        if (which < 2) { *(f32x4*)(fo + o2) = o; *(u32x2*)(KC + (size_t)which * kc_stride + ((size_t)(ms >> 4) * (2048 + 16) + 2048 + (ms & 15)) * DM + cb + bj * HALF + n * 16) = w; }
                        else *(u32x2*)(Qs + o2) = w; } }
    }
};
struct SubOrder {
    int pm, nN, G, c;
    __host__ __device__ bool next(int i, Unit& u) const { const int L = i * G + c; if (L >= nN) return false; u.pm = pm; u.pn = L; return true; }
    __device__ __forceinline__ void a_ready(const Unit&) const {}
    __device__ __forceinline__ void done(const Unit&) const {}
};
template <class Epi, class Sched, bool ALIGN_EPI = false, bool SP2 = false>
__device__ __forceinline__ void gemm_phase(PG8_LAS unsigned char* lds, const Gemm g, const Sched& S, const Epi& E, int tid) {
    asm volatile("" : "+v"(tid));
    const int wid = __builtin_amdgcn_readfirstlane(tid >> 6), lane = tid & 63, wr = wid >> 2, wc = wid & 3, fr = lane & 15, fq = lane >> 4;
    const int K = g.K, nt = K / BK;
    unsigned voffA[2], voffB[2];
#pragma unroll
    for (int i = 0; i < 2; ++i) { int R, C; stage_rc(tid * 16 + i * 8192, R, C); const int Rb = Epi::PERM ? ((R & ~31) + perm32(R & 31)) : R;
        voffA[i] = (unsigned)(R * K + C) * 2u; voffB[i] = (unsigned)(Rb * K + C) * 2u; }
    const size_t kstep = (size_t)(BK * 2);
    const size_t hstep = (size_t)HALF * K * 2;
    const size_t tstep = 2 * hstep;
    const unsigned ldsw = (unsigned)wid * 1024u;
    const int aoff = lds_byte(wr * 64 + fr, fq * 8), boff = lds_byte(wc * 32 + fr, fq * 8);
#define PG8_SA(b, h) (((b) * 2 + (h)) * HTB)
#define PG8_SB(b, h) ((4 + (b) * 2 + (h)) * HTB)
#define PG8_STAGE(bufoff, gbase, voff) do { _Pragma("unroll") for (int _i = 0; _i < 2; ++_i) \
        __builtin_amdgcn_global_load_lds((const unsigned*)((const char*)(gbase) + (voff)[_i]), (PG8_LAS unsigned*)(lds + (bufoff) + ldsw + _i * 8192), 16, 0, 0); } while (0)
#define PG8_LDA(dst, b, h) do { _Pragma("unroll") for (int m = 0; m < 4; ++m) _Pragma("unroll") for (int k = 0; k < 2; ++k) dst[m][k] = *(const PG8_LAS bf16x8*)(lds + PG8_SA(b, h) + aoff + m * 2048 + k * 1024); } while (0)
#define PG8_LDB(dst, b, h) do { _Pragma("unroll") for (int n = 0; n < 2; ++n) _Pragma("unroll") for (int k = 0; k < 2; ++k) dst[n][k] = *(const PG8_LAS bf16x8*)(lds + PG8_SB(b, h) + boff + n * 2048 + k * 1024); } while (0)
#define PG8_MMA(ai, bj, At, Bt) do { __builtin_amdgcn_s_setprio(1); _Pragma("unroll") for (int m = 0; m < 4; ++m) _Pragma("unroll") for (int n = 0; n < 2; ++n) _Pragma("unroll") for (int k = 0; k < 2; ++k) \
        acc[ai][bj][m][n] = __builtin_amdgcn_mfma_f32_16x16x32_bf16(Bt[n][k], At[m][k], acc[ai][bj][m][n], 0, 0, 0); __builtin_amdgcn_s_setprio(0); } while (0)
#define PG8_WAIT_V(n) asm volatile("s_waitcnt vmcnt(" #n ")" ::: "memory")
#define PG8_WAIT_L(n) asm volatile("s_waitcnt lgkmcnt(" #n ")" ::: "memory")
#define PG8_BAR __builtin_amdgcn_s_barrier()
#define PG8_SCHED __builtin_amdgcn_sched_barrier(0)
    Unit cur, nxt; int ui = 0;
    if (!S.next(0, cur)) return;
    f32x4 acc[2][2][4][2];
#pragma unroll
    for (int a = 0; a < 2; ++a)
#pragma unroll
        for (int b = 0; b < 2; ++b)
#pragma unroll
            for (int m = 0; m < 4; ++m)
#pragma unroll
                for (int n = 0; n < 2; ++n) acc[a][b][m][n] = (f32x4){0.f, 0.f, 0.f, 0.f};
    bf16x8 At[4][2], B0[2][2], B1[2][2];
    const char* cA = (const char*)g.A + (size_t)cur.pm * tstep; const char* cB = (const char*)g.Bt + (size_t)cur.pn * tstep;
    S.a_ready(cur);
    if constexpr (SP2) {
        PG8_STAGE(PG8_SB(0, 0), cB, voffB); PG8_STAGE(PG8_SB(0, 1), cB + hstep, voffB); PG8_STAGE(PG8_SA(0, 0), cA, voffA); PG8_STAGE(PG8_SA(0, 1), cA + hstep, voffA);
        if (wr == 1) PG8_BAR;
        PG8_WAIT_V(2); PG8_BAR;
        PG8_STAGE(PG8_SB(1, 0), cB + kstep, voffB); PG8_STAGE(PG8_SA(1, 0), cA + kstep, voffA); PG8_STAGE(PG8_SB(1, 1), cB + hstep + kstep, voffB);
        PG8_WAIT_V(6); PG8_BAR;
    } else {
        PG8_STAGE(PG8_SB(0, 0), cB, voffB); PG8_STAGE(PG8_SA(0, 0), cA, voffA); PG8_STAGE(PG8_SB(0, 1), cB + hstep, voffB); PG8_STAGE(PG8_SA(0, 1), cA + hstep, voffA);
        if (wr == 1) PG8_BAR;
        PG8_WAIT_V(4); PG8_BAR;
        PG8_STAGE(PG8_SB(1, 0), cB + kstep, voffB); PG8_STAGE(PG8_SA(1, 0), cA + kstep, voffA); PG8_STAGE(PG8_SB(1, 1), cB + hstep + kstep, voffB);
        PG8_WAIT_V(6); PG8_BAR;
    }
    for (;;) {
        const bool has_next = S.next(ui + 1, nxt);
        const char* nA = has_next ? (const char*)g.A + (size_t)nxt.pm * tstep : cA; const char* nB = has_next ? (const char*)g.Bt + (size_t)nxt.pn * tstep : cB;
        for (int t = 0; t < nt; t += 2) {
            const bool last = (t == nt - 2);
            const char* a1 = cA + (size_t)(t + 1) * kstep;
            const char* a2 = last ? nA : cA + (size_t)(t + 2) * kstep; const char* b2 = last ? nB : cB + (size_t)(t + 2) * kstep;
            const char* a3 = a2 + kstep; const char* b3 = b2 + kstep;
            if (last && has_next) S.a_ready(nxt);
            if constexpr (SP2) {
            PG8_LDB(B0, 0, 0); PG8_LDB(B1, 0, 1); PG8_SCHED; PG8_LDA(At, 0, 0); PG8_STAGE(PG8_SA(1, 1), a1 + hstep, voffA);
            PG8_WAIT_V(8); PG8_WAIT_L(0); PG8_BAR; PG8_MMA(0, 0, At, B0); PG8_MMA(0, 1, At, B1); PG8_BAR; PG8_SCHED;
            PG8_LDA(At, 0, 1); PG8_STAGE(PG8_SB(0, 0), b2, voffB); PG8_STAGE(PG8_SB(0, 1), b2 + hstep, voffB); PG8_STAGE(PG8_SA(0, 0), a2, voffA);
            PG8_WAIT_V(8); PG8_WAIT_L(0); PG8_BAR; PG8_MMA(1, 0, At, B0); PG8_MMA(1, 1, At, B1); PG8_BAR; PG8_SCHED;
            PG8_LDB(B0, 1, 0); PG8_LDB(B1, 1, 1); PG8_SCHED; PG8_LDA(At, 1, 0); PG8_STAGE(PG8_SA(0, 1), a2 + hstep, voffA);
            PG8_WAIT_V(8); PG8_WAIT_L(0); PG8_BAR; PG8_MMA(0, 0, At, B0); PG8_MMA(0, 1, At, B1); PG8_BAR; PG8_SCHED;
            PG8_LDA(At, 1, 1); PG8_STAGE(PG8_SB(1, 0), b3, voffB); PG8_STAGE(PG8_SB(1, 1), b3 + hstep, voffB); PG8_STAGE(PG8_SA(1, 0), a3, voffA);
            PG8_WAIT_V(8); PG8_WAIT_L(0); PG8_BAR; PG8_MMA(1, 0, At, B0); PG8_MMA(1, 1, At, B1); PG8_BAR; PG8_SCHED;
            } else {
            PG8_LDB(B0, 0, 0); PG8_SCHED; PG8_LDA(At, 0, 0); PG8_STAGE(PG8_SA(1, 1), a1 + hstep, voffA);
            PG8_WAIT_L(8); PG8_BAR; PG8_WAIT_L(0); PG8_MMA(0, 0, At, B0); PG8_BAR; PG8_SCHED;
            PG8_LDB(B1, 0, 1); PG8_STAGE(PG8_SB(0, 0), b2, voffB);
            PG8_BAR; PG8_WAIT_L(0); PG8_MMA(0, 1, At, B1); PG8_BAR;
            PG8_LDA(At, 0, 1); PG8_STAGE(PG8_SA(0, 0), a2, voffA);
            PG8_BAR; PG8_WAIT_L(0); PG8_MMA(1, 0, At, B0); PG8_BAR; PG8_SCHED;
            PG8_STAGE(PG8_SB(0, 1), b2 + hstep, voffB);
            PG8_WAIT_V(6); PG8_BAR; PG8_MMA(1, 1, At, B1); PG8_BAR;
            PG8_LDB(B0, 1, 0); PG8_SCHED; PG8_LDA(At, 1, 0); PG8_STAGE(PG8_SA(0, 1), a2 + hstep, voffA);
            PG8_WAIT_L(8); PG8_BAR; PG8_WAIT_L(0); PG8_MMA(0, 0, At, B0); PG8_BAR; PG8_SCHED;
            PG8_LDB(B1, 1, 1); PG8_STAGE(PG8_SB(1, 0), b3, voffB);
            PG8_BAR; PG8_WAIT_L(0); PG8_MMA(0, 1, At, B1); PG8_BAR;
            PG8_LDA(At, 1, 1); PG8_STAGE(PG8_SA(1, 0), a3, voffA);
            PG8_BAR; PG8_WAIT_L(0); PG8_MMA(1, 0, At, B0); PG8_BAR; PG8_SCHED;
            PG8_STAGE(PG8_SB(1, 1), b3 + hstep, voffB);
            PG8_WAIT_V(6); PG8_BAR; PG8_MMA(1, 1, At, B1); PG8_BAR;
            }
        }
        if constexpr (ALIGN_EPI) { if (wr == 0) PG8_BAR; }
        if constexpr (!Epi::AFTER_DRAIN) { E(acc, cur, wr, wc, fr, fq); S.done(cur); }
        if (!has_next) break;
#pragma unroll
        for (int a = 0; a < 2; ++a)
#pragma unroll
            for (int b = 0; b < 2; ++b)
#pragma unroll
                for (int m = 0; m < 4; ++m)
#pragma unroll
                    for (int n = 0; n < 2; ++n) acc[a][b][m][n] = (f32x4){0.f, 0.f, 0.f, 0.f};
        cur = nxt; cA = nA; cB = nB; ++ui;
        if constexpr (ALIGN_EPI) { if (wr == 1) PG8_BAR; }
    }
    PG8_WAIT_V(0);
    if constexpr (!ALIGN_EPI) { if (wr == 0) PG8_BAR; }
    PG8_BAR;
    if constexpr (Epi::AFTER_DRAIN) { E.fused(acc, cur, wr, wc, fr, fq, lds, wid, lane); S.done(cur); }
#undef PG8_SA
#undef PG8_SB
#undef PG8_STAGE
#undef PG8_LDA
#undef PG8_LDB
#undef PG8_MMA
#undef PG8_WAIT_V
#undef PG8_WAIT_L
#undef PG8_BAR
#undef PG8_SCHED
}
}
#ifndef PG8_SP2
#define PG8_SP2 true
#endif
#ifndef PG8_ALIGN
#define PG8_ALIGN true
#endif

constexpr size_t MiB = 1u << 20;
constexpr size_t WS_CTL = 0, CTL_ZERO_BYTES = 1 * MiB;
constexpr size_t WS_SSQ = 1 * MiB, SSQ_STRIDE = 2359296;
constexpr size_t WS_BA = 13 * MiB;
constexpr size_t WS_EG = 18 * MiB, WS_DL = 21 * MiB, WS_GL = 24 * MiB;
constexpr size_t WS_WIN = 32 * MiB, WS_WOUT = 81 * MiB, WS_WUP0 = 97 * MiB, WS_WDN0 = 141 * MiB, WS_WKVQ = 163 * MiB, WS_WO = 187 * MiB, WS_WUP1 = 195 * MiB, WS_WDN1 = 239 * MiB;
constexpr size_t WS_HB = 261 * MiB;
constexpr size_t WS_RA = 326 * MiB;
constexpr size_t WS_QKV = WS_RA, WS_Z = WS_RA + 260 * MiB, WS_UP = WS_RA;
constexpr size_t WS_KC = WS_RA, WS_VC = WS_RA + 130 * MiB;
static_assert(WS_KC + (size_t)DECB * (PAST + DECS) * DM * 2 <= WS_VC && WS_VC + (size_t)DECB * (PAST + DECS) * DM * 2 <= WS_RA + 390 * MiB, "cache copies");
constexpr size_t WS_RB = 716 * MiB;
constexpr size_t WS_QN = WS_RB, WS_KN = WS_RB + 65 * MiB, WS_VV = WS_RB + 130 * MiB, WS_TP = WS_RB + 260 * MiB, WS_PP = WS_RB + 328 * MiB;
constexpr size_t WS_ACT = WS_RB;
constexpr size_t WS_KB = WS_RB, WS_VB = WS_RB + 65 * MiB, WS_QB = WS_RB + 130 * MiB, WS_ATT = WS_RB + 195 * MiB;
constexpr size_t WS_SUP = 1112 * MiB, WS_SACT = 1118 * MiB, WS_SQB = 1121 * MiB, WS_SATT = 1122 * MiB;
constexpr size_t WS_END = 1123 * MiB;
static_assert(WS_SUP + (size_t)MS * UPW * 2 <= WS_SACT && WS_SACT + (size_t)MS * DFF * 2 <= WS_SQB && WS_SQB + (size_t)MS * DM * 2 <= WS_SATT && WS_SATT + (size_t)MS * DM * 2 <= WS_END, "sample buffers");
static_assert((size_t)M * 32 * 4 <= SSQ_STRIDE && WS_SSQ + 5 * SSQ_STRIDE <= WS_BA && WS_BA + (size_t)M * 64 * 4 <= WS_EG && WS_EG + (size_t)NITEM * 256 <= WS_DL && WS_DL + (size_t)NITEM * 256 <= WS_GL && WS_GL + NITEM * 4 <= WS_WIN, "small buffers");
static_assert(WS_WIN + (size_t)INWP * DM * 2 <= WS_WOUT && WS_WDN1 + (size_t)DM * DFF * 2 <= WS_HB && WS_HB + (size_t)M * DM * 2 <= WS_RA, "weights / HB");
static_assert(WS_QKV + (size_t)M * QKVW * 2 <= WS_Z && WS_Z + (size_t)M * VW * 2 <= WS_RB && WS_UP + (size_t)M * UPW * 2 <= WS_RB, "region A");
static_assert(WS_QN + (size_t)M * DM * 2 <= WS_KN && WS_KN + (size_t)M * DM * 2 <= WS_VV && WS_VV + (size_t)M * VW * 2 <= WS_TP && WS_TP + (size_t)NITEM * 8192 <= WS_PP && WS_PP + (size_t)NITEM * 8192 <= WS_END, "region B (gdn)");
static_assert(WS_ACT + (size_t)M * DFF * 2 <= WS_END && WS_ATT + (size_t)M * DM * 2 <= WS_END, "region B");
static_assert((size_t)M * VW * 2 <= (O_SGDN - O_PK) * 4, "ON scratch");
constexpr int CW_BAR = 4096, CW_BAR2 = 8192, CW_BAR3 = 12288;

constexpr int LDS_BYTES = 159744;
constexpr int LDSCTL_OFF = 158720;
constexpr int NWAVES = 8;

#define GAS __attribute__((address_space(1)))
#define LAS __attribute__((address_space(3)))
#define DI __device__ __forceinline__
typedef unsigned short bf16;
typedef unsigned v4u __attribute__((ext_vector_type(4)));
typedef unsigned v2u __attribute__((ext_vector_type(2)));
typedef float f32x4 __attribute__((ext_vector_type(4)));
typedef float f32x16 __attribute__((ext_vector_type(16)));
typedef short bf16x8 __attribute__((ext_vector_type(8)));
typedef short bf16x4 __attribute__((ext_vector_type(4)));
#define LDS_WAIT() asm volatile("s_waitcnt lgkmcnt(0)" ::: "memory")
#define VM_WAIT() asm volatile("s_waitcnt vmcnt(0)" ::: "memory")
#define MFMA32(a, b, c) __builtin_amdgcn_mfma_f32_32x32x16_bf16((a), (b), (c), 0, 0, 0)
DI unsigned pk2(float lo, float hi) { return pg8::cvt_pk_bf16(lo, hi); }
DI float bf2f(unsigned short b) { return __builtin_bit_cast(float, ((unsigned)b) << 16); }
DI float bflo(unsigned w) { return __builtin_bit_cast(float, w << 16); }
DI float bfhi(unsigned w) { return __builtin_bit_cast(float, w & 0xffff0000u); }
DI void unpack8(const v4u w, float (&f)[8]) { f[0] = bflo(w.x); f[1] = bfhi(w.x); f[2] = bflo(w.y); f[3] = bfhi(w.y); f[4] = bflo(w.z); f[5] = bfhi(w.z); f[6] = bflo(w.w); f[7] = bfhi(w.w); }
DI v4u pack8(const float (&f)[8]) { v4u w; w.x = pk2(f[0], f[1]); w.y = pk2(f[2], f[3]); w.z = pk2(f[4], f[5]); w.w = pk2(f[6], f[7]); return w; }
DI int crow(int r, int hi) { return (r & 3) + 8 * (r >> 2) + 4 * hi; }
DI float wave_sum(float v) {
#pragma unroll
    for (int o = 1; o < 64; o <<= 1) v += __shfl_xor(v, o);
    return v;
}
DI float siluf(float x) { return x * __builtin_amdgcn_rcpf(1.0f + __expf(-x)); }

template <int OFF> DI bf16x4 tr_read(int vb) { bf16x4 r; asm volatile("ds_read_b64_tr_b16 %0, %1 offset:%2" : "=&v"(r) : "v"(vb), "i"(OFF) : "memory"); return r; }
#define XB_TMO      128
#define XB_XCNT(j)  (256  + 64 * (j))
#define XB_XSUB(j)  (1280 + 64 * (j))
#define XB_XGEN(j)  (2304 + 64 * (j))
#define XB_TOP      3328
#define XB_TOPGEN   3392
#define XCD_BAR_WORDS 3456
#define XB_SPIN_CAP (1u << 18)

__device__ __forceinline__ unsigned xb_ld(unsigned* p)              { return __hip_atomic_load(p, __ATOMIC_RELAXED, __HIP_MEMORY_SCOPE_AGENT); }
__device__ __forceinline__ unsigned xb_add(unsigned* p, unsigned v) { return __hip_atomic_fetch_add(p, v, __ATOMIC_RELAXED, __HIP_MEMORY_SCOPE_AGENT); }
__device__ __forceinline__ unsigned xb_xcc_id() { return (unsigned)__builtin_amdgcn_s_getreg((3 << 11) | 20) & 0xFu; }
#define XB_SPIN(cond, bar) do { unsigned _sp = 0; while (cond) { __builtin_amdgcn_s_sleep(1); \
    if ((++_sp & 255u) == 0u) { if (xb_ld(&(bar)[XB_TMO])) break; if (_sp > XB_SPIN_CAP) { atomicAdd(&(bar)[XB_TMO], 1u); break; } } } } while (0)

struct XcdBarrier {
    unsigned* bar; unsigned x;
    volatile LAS unsigned* st;
};

__device__ __forceinline__ XcdBarrier xcd_barrier_post(unsigned* bar, volatile LAS unsigned* st) {
    XcdBarrier b; b.bar = bar; b.x = xb_xcc_id(); b.st = st;
    if (threadIdx.x == 0) (void)xb_add(&bar[XB_XCNT(b.x)], 1u);
    return b;
}
__device__ __forceinline__ void xcd_barrier_complete(unsigned* bar, unsigned x, unsigned& nloc, unsigned& nx) {
    const unsigned G = gridDim.x * gridDim.y * gridDim.z;
    unsigned sum, cnt, mine, sp = 0u;
    for (;;) {
        sum = 0u; cnt = 0u; mine = 0u;
#pragma unroll
        for (unsigned j = 0; j < 16; ++j) { const unsigned c = xb_ld(&bar[XB_XCNT(j)]); sum += c; cnt += (c > 0u) ? 1u : 0u; mine = (j == x) ? c : mine; }
        if (sum == G) break;
        __builtin_amdgcn_s_sleep(1);
        if ((++sp & 255u) == 0u) { if (xb_ld(&bar[XB_TMO])) break; if (sp > XB_SPIN_CAP) { atomicAdd(&bar[XB_TMO], 1u); break; } }
    }
    nloc = mine > 0u ? mine : 1u; nx = cnt > 0u ? cnt : 1u;
}

__device__ __forceinline__ void xcd_barrier(const XcdBarrier& b) {
    asm volatile("s_waitcnt vmcnt(0)" ::: "memory");
    __syncthreads();
    if (threadIdx.x == 0) {
        unsigned* bar = b.bar;
        __builtin_amdgcn_s_waitcnt(0);
        unsigned nloc = b.st[0], nx = b.st[1];
        if (nloc == 0u) { xcd_barrier_complete(bar, b.x, nloc, nx); b.st[0] = nloc; b.st[1] = nx; }
        const unsigned old = xb_add(&bar[XB_XSUB(b.x)], 1u);
        const unsigned gen = old / nloc;
        if (old + 1u == (gen + 1u) * nloc) {
            __builtin_amdgcn_fence(__ATOMIC_RELEASE, "agent");
            asm volatile("s_waitcnt vmcnt(0)" ::: "memory");
            const unsigned og = xb_add(&bar[XB_TOP], 1u);
            const unsigned tg = og / nx;
            if (og + 1u == (tg + 1u) * nx) xb_add(&bar[XB_TOPGEN], 1u);
            else XB_SPIN(xb_ld(&bar[XB_TOPGEN]) == tg, bar);
            __builtin_amdgcn_fence(__ATOMIC_ACQUIRE, "agent");
            xb_add(&bar[XB_XGEN(b.x)], 1u);
            asm volatile("s_waitcnt vmcnt(0)" ::: "memory");
        } else {
            XB_SPIN(xb_ld(&bar[XB_XGEN(b.x)]) == gen, bar);
            __builtin_amdgcn_fence(__ATOMIC_ACQUIRE, "agent");
            asm volatile("s_waitcnt vmcnt(0)" ::: "memory");
        }
    }
    __syncthreads();
}
__device__ __forceinline__ void sub_barrier_complete(unsigned* bar, unsigned x, unsigned& nloc, unsigned& nx, const unsigned expect) {
    unsigned sum, cnt, mine, sp = 0u;
    for (;;) {
        sum = 0u; cnt = 0u; mine = 0u;
#pragma unroll
        for (unsigned j = 0; j < 16; ++j) { const unsigned c = xb_ld(&bar[XB_XCNT(j)]); sum += c; cnt += (c > 0u) ? 1u : 0u; mine = (j == x) ? c : mine; }
        if (sum == expect) break;
        __builtin_amdgcn_s_sleep(1);
        if ((++sp & 255u) == 0u) { if (xb_ld(&bar[XB_TMO])) break; if (sp > XB_SPIN_CAP) { atomicAdd(&bar[XB_TMO], 1u); break; } }
    }
    nloc = mine > 0u ? mine : 1u; nx = cnt > 0u ? cnt : 1u;
}
__device__ __forceinline__ void sub_barrier(const XcdBarrier& b, const unsigned expect) {
    asm volatile("s_waitcnt vmcnt(0)" ::: "memory");
    __syncthreads();
    if (threadIdx.x == 0) {
        unsigned* bar = b.bar;
        __builtin_amdgcn_s_waitcnt(0);
        unsigned nloc = b.st[0], nx = b.st[1];
        if (nloc == 0u) { sub_barrier_complete(bar, b.x, nloc, nx, expect); b.st[0] = nloc; b.st[1] = nx; }
        const unsigned old = xb_add(&bar[XB_XSUB(b.x)], 1u);
        const unsigned gen = old / nloc;
        if (old + 1u == (gen + 1u) * nloc) {
            __builtin_amdgcn_fence(__ATOMIC_RELEASE, "agent");
            asm volatile("s_waitcnt vmcnt(0)" ::: "memory");
            const unsigned og = xb_add(&bar[XB_TOP], 1u);
            const unsigned tg = og / nx;
            if (og + 1u == (tg + 1u) * nx) xb_add(&bar[XB_TOPGEN], 1u);
            else XB_SPIN(xb_ld(&bar[XB_TOPGEN]) == tg, bar);
            __builtin_amdgcn_fence(__ATOMIC_ACQUIRE, "agent");
            xb_add(&bar[XB_XGEN(b.x)], 1u);
            asm volatile("s_waitcnt vmcnt(0)" ::: "memory");
        } else {
            XB_SPIN(xb_ld(&bar[XB_XGEN(b.x)]) == gen, bar);
            __builtin_amdgcn_fence(__ATOMIC_ACQUIRE, "agent");
            asm volatile("s_waitcnt vmcnt(0)" ::: "memory");
        }
    }
    __syncthreads();
}
struct Frame {
    LAS unsigned char* lds;
    volatile LAS unsigned* MISC;
    unsigned* ctl;
    int tid, lane, wave;
    int vcu, G;
    const float* const* in;
    float* out; unsigned char* ws;
};
enum { I_XP = 0, I_XS, I_SGDN, I_SGC, I_SFC, I_CK, I_CV, I_ANORM, I_AWIN, I_AWCONV, I_ALOG, I_ADT, I_AONORM, I_AWOUT, I_KVNORM, I_WKV, I_BNORM, I_BWQ,
       I_LQ1, I_LK1, I_LQ2, I_LK2, I_SUBN, I_BWO, I_RELB, I_FNORM, I_FWUP, I_FWCONV, I_FBCONV, I_FWDN, I_FINAL, N_IN };

constexpr int TR_LDS = 16896;
DI void p0_transpose_item(const float* W, const float* gain, int K, int N, bf16* WT, int row_off, LAS float* scr, int item, int lane) {
    const int nblk = N / 64, kb = item / nblk, nb = item % nblk, k0 = 64 * kb, n0 = 64 * nb;
    const int n4 = lane & 15;
    f32x4 v16[16];
#pragma unroll
    for (int i = 0; i < 16; ++i) v16[i] = __builtin_nontemporal_load((const f32x4*)(W + (size_t)(k0 + 4 * i + (lane >> 4)) * N + n0 + 4 * n4));
#pragma unroll
    for (int i = 0; i < 16; ++i) { const int kk = 4 * i + (lane >> 4); const float gk = gain ? gain[k0 + kk] : 1.0f; const f32x4 v = v16[i];
        LAS float* d = scr + kk * 65 + 4 * n4; d[0] = v[0] * gk; d[1] = v[1] * gk; d[2] = v[2] * gk; d[3] = v[3] * gk; }
    LDS_WAIT(); asm volatile("" ::: "memory");
    const int c = lane & 7;
#pragma unroll
    for (int j = 0; j < 8; ++j) { const int n = (lane >> 3) + 8 * j; const LAS float* s = scr + (8 * c) * 65 + n;
        v4u o; o.x = pk2(s[0 * 65], s[1 * 65]); o.y = pk2(s[2 * 65], s[3 * 65]); o.z = pk2(s[4 * 65], s[5 * 65]); o.w = pk2(s[6 * 65], s[7 * 65]);
        *(v4u*)(WT + (size_t)(row_off + n0 + n) * K + k0 + 8 * c) = o; }
    LDS_WAIT(); asm volatile("" ::: "memory");
}
DI void conv_mat(Frame& F, const float* W, const float* gain, const int K, const int N, bf16* WT, const int row_off, const int gw, const int NGW) {
    LAS float* scr = (LAS float*)(F.lds + F.wave * TR_LDS);
    const int nit = (K / 64) * (N / 64);
    for (int it = gw; it < nit; it += NGW) p0_transpose_item(W, gain, K, N, WT, row_off, scr, it, F.lane);
}
enum { CJ_WOUT = 0, CJ_WUP0, CJ_WDN0, CJ_WKVQ, CJ_WO, CJ_WUP1, CJ_WDN1 };
DI void conv_job(Frame& F, const int job, const int gw, const int NGW) {
    unsigned char* ws = F.ws;
    if (job == CJ_WOUT) conv_mat(F, F.in[I_AWOUT], nullptr, VW, DM, (bf16*)(ws + WS_WOUT), 0, gw, NGW);
    else if (job == CJ_WUP0) conv_mat(F, F.in[I_FWUP], F.in[I_FNORM], DM, UPW, (bf16*)(ws + WS_WUP0), 0, gw, NGW);
    else if (job == CJ_WDN0) conv_mat(F, F.in[I_FWDN], nullptr, DFF, DM, (bf16*)(ws + WS_WDN0), 0, gw, NGW);
    else if (job == CJ_WKVQ) { conv_mat(F, F.in[I_WKV], F.in[I_KVNORM], DM, 4096, (bf16*)(ws + WS_WKVQ), 0, gw, NGW); conv_mat(F, F.in[I_BWQ], F.in[I_BNORM], DM, DM, (bf16*)(ws + WS_WKVQ), 4096, gw, NGW); }
    else if (job == CJ_WO) conv_mat(F, F.in[I_BWO], nullptr, DM, DM, (bf16*)(ws + WS_WO), 0, gw, NGW);
    else if (job == CJ_WUP1) conv_mat(F, F.in[I_FWUP] + (size_t)DM * UPW, F.in[I_FNORM] + DM, DM, UPW, (bf16*)(ws + WS_WUP1), 0, gw, NGW);
    else conv_mat(F, F.in[I_FWDN] + (size_t)DFF * DM, nullptr, DFF, DM, (bf16*)(ws + WS_WDN1), 0, gw, NGW);
}
DI void p0_prologue(Frame& F) {
    LAS float* scr = (LAS float*)(F.lds + F.wave * TR_LDS);
    const int gw = F.vcu * NWAVES + F.wave, NGW = F.G * NWAVES, lane = F.lane;
    unsigned char* ws = F.ws;
    constexpr int I_IN = (DM / 64) * (INW / 64);
    for (int it = F.wave * F.G + F.vcu; it < I_IN; it += NGW) p0_transpose_item(F.in[I_AWIN], F.in[I_ANORM], DM, INW, (bf16*)(ws + WS_WIN), 0, scr, it, lane);
    { v4u* z = (v4u*)(ws + WS_WIN + (size_t)INW * DM * 2); const int nz = (INWP - INW) * DM * 2 / 16; const v4u zero = {0u, 0u, 0u, 0u};
      for (int i = gw * 64 + lane; i < nz; i += NGW * 64) z[i] = zero; }
    float* ssq0 = (float*)(ws + WS_SSQ);
    for (int m0 = NGW - 1 - (F.wave * F.G + F.vcu); m0 < M; m0 += 2 * NGW) {
        const int m1 = m0 + NGW; const bool two = m1 < M; const int mb = two ? m1 : m0;
        const float* xa = (m0 < MP) ? F.in[I_XP] + (size_t)m0 * DM : F.in[I_XS] + (size_t)(m0 - MP) * DM;
        const float* xb = (mb < MP) ? F.in[I_XP] + (size_t)mb * DM : F.in[I_XS] + (size_t)(mb - MP) * DM;
        const f32x4* a4 = (const f32x4*)xa + lane; const f32x4* b4 = (const f32x4*)xb + lane;
        v2u* oa = (v2u*)((bf16*)(ws + WS_HB) + (size_t)m0 * DM) + lane; v2u* ob = (v2u*)((bf16*)(ws + WS_HB) + (size_t)mb * DM) + lane;
        f32x4 va[8], vb[8];
#pragma unroll
        for (int j = 0; j < 8; ++j) va[j] = __builtin_nontemporal_load(a4 + 64 * j);
#pragma unroll
        for (int j = 0; j < 8; ++j) vb[j] = __builtin_nontemporal_load(b4 + 64 * j);
        float sa = 0.f, sb = 0.f;
#pragma unroll
        for (int j = 0; j < 8; ++j) { const f32x4 v = va[j]; sa += (v[0] * v[0] + v[1] * v[1]) + (v[2] * v[2] + v[3] * v[3]); v2u w; w.x = pk2(v[0], v[1]); w.y = pk2(v[2], v[3]); oa[64 * j] = w; }
        sa = wave_sum(sa);
        if (lane < 32) ssq0[(size_t)m0 * 32 + lane] = (lane == 0) ? sa : 0.f;
        if (two) {
#pragma unroll
            for (int j = 0; j < 8; ++j) { const f32x4 v = vb[j]; sb += (v[0] * v[0] + v[1] * v[1]) + (v[2] * v[2] + v[3] * v[3]); v2u w; w.x = pk2(v[0], v[1]); w.y = pk2(v[2], v[3]); ob[64 * j] = w; }
            sb = wave_sum(sb);
            if (lane < 32) ssq0[(size_t)m1 * 32 + lane] = (lane == 0) ? sb : 0.f;
        }
    }
}
#define GC_LOAD(TB, R, H) { const int tb_ = (TB); const int b_ = tb_ >> 9; const int t0_ = (tb_ & 511) * 16; \
        const bf16* p_ = QKV + ((size_t)b_ * SEQ + t0_) * QKVW + c0; \
        _Pragma("unroll") for (int j_ = 0; j_ < 3; ++j_) { if (t0_ > 0) H[j_] = *(const v4u*)(p_ - (3 - j_) * QKVW); else H[j_] = (v4u){0u, 0u, 0u, 0u}; } \
        _Pragma("unroll") for (int tt_ = 0; tt_ < 16; ++tt_) R[tt_] = __builtin_nontemporal_load((const v4u*)(p_ + tt_ * QKVW)); }
#define GC_ROW(ROW, T, MROW, SAMP, B, LEN) { \
            const int t = (T); const size_t m = (MROW); \
            float cur[8]; unpack8(ROW, cur); \
            float y[8]; float ss = 0.f; \
            _Pragma("unroll") for (int e = 0; e < 8; ++e) { const float a = h[0][e] * w[0][e] + h[1][e] * w[1][e] + h[2][e] * w[2][e] + cur[e] * w[3][e]; y[e] = siluf(a); ss += y[e] * y[e]; } \
            if (cc < 8) {     \
                ss += __shfl_xor(ss, 1); ss += __shfl_xor(ss, 2); ss += __shfl_xor(ss, 4); ss += __shfl_xor(ss, 8); \
                const float sc = rsqrtf(ss + 1e-6f) * (cc < 4 ? 0.08838834764831845f : 1.0f); \
                _Pragma("unroll") for (int e = 0; e < 8; ++e) y[e] *= sc; \
                bf16* dst = (cc < 4) ? QN + m * DM + c0 : KN + m * DM + (c0 - 2048); \
                *(v4u*)dst = pack8(y); \
            } else { *(v4u*)(VV + m * VW + (c0 - 4096)) = pack8(y); } \
            if (t >= (LEN) - 3) {     \
                float* so = F.out + ((SAMP) ? O_SGC : O_PGC) + (size_t)((B) * 3 + (t - ((LEN) - 3))) * QKVW + c0; \
                *(f32x4*)so = (f32x4){cur[0], cur[1], cur[2], cur[3]}; *(f32x4*)(so + 4) = (f32x4){cur[4], cur[5], cur[6], cur[7]}; } \
            _Pragma("unroll") for (int e = 0; e < 8; ++e) { h[0][e] = h[1][e]; h[1][e] = h[2][e]; h[2][e] = cur[e]; } }
DI void p_gdnconv(Frame& F) {
    const int gw = F.vcu * NWAVES + F.wave, NGW = F.G * NWAVES, lane = F.lane;
    const bf16* QKV = (const bf16*)(F.ws + WS_QKV);
    bf16* QN = (bf16*)(F.ws + WS_QN); bf16* KN = (bf16*)(F.ws + WS_KN); bf16* VV = (bf16*)(F.ws + WS_VV);
    const float* wconv = F.in[I_AWCONV];
    constexpr int NTBP = MP / 16;
    const int TBS = NGW >> 4;
    const bool act = gw < TBS * 16;
    const int cc = gw & 15, c0 = cc * 512 + lane * 8;
    float w[4][8];
#pragma unroll
    for (int i = 0; i < 4; ++i) { const f32x4 a = *(const f32x4*)(wconv + i * QKVW + c0), bq = *(const f32x4*)(wconv + i * QKVW + c0 + 4);
        w[i][0] = a[0]; w[i][1] = a[1]; w[i][2] = a[2]; w[i][3] = a[3]; w[i][4] = bq[0]; w[i][5] = bq[1]; w[i][6] = bq[2]; w[i][7] = bq[3]; }
    int tb = act ? gw >> 4 : NTBP;
    v4u rows[16], hp[3];
    if (tb < NTBP) GC_LOAD(tb, rows, hp)
    for (; tb < NTBP; tb += TBS) {
        v4u rn[16], hn[3];
#pragma unroll
        for (int tt = 0; tt < 16; ++tt) rn[tt] = rows[tt];
#pragma unroll
        for (int j = 0; j < 3; ++j) hn[j] = hp[j];
        if (tb + TBS < NTBP) GC_LOAD(tb + TBS, rn, hn)
        const int b = tb >> 9; const int t0 = (tb & 511) * 16;
        const size_t mbase = (size_t)b * SEQ;
        float h[3][8];
#pragma unroll
        for (int j = 0; j < 3; ++j) unpack8(hp[j], h[j]);
#pragma unroll
        for (int tt = 0; tt < 16; ++tt) GC_ROW(rows[tt], t0 + tt, mbase + t0 + tt, false, b, SEQ)
#pragma unroll
        for (int tt = 0; tt < 16; ++tt) rows[tt] = rn[tt];
#pragma unroll
        for (int j = 0; j < 3; ++j) hp[j] = hn[j];
    }
    if (act) for (int pc = gw >> 4; pc < DECB * 4; pc += TBS) {
        const int b = pc >> 2, ta = (pc & 3) * 4; const size_t mbase = (size_t)MP + b * 16;
        v4u r4[4];
#pragma unroll
        for (int tt = 0; tt < 4; ++tt) r4[tt] = __builtin_nontemporal_load((const v4u*)(QKV + (mbase + ta + tt) * QKVW + c0));
        float h[3][8];
        if (ta == 0) {
#pragma unroll
            for (int j = 0; j < 3; ++j) { const float* sp = F.in[I_SGC] + (size_t)(b * 3 + j) * QKVW + c0; const f32x4 a = *(const f32x4*)sp, bq = *(const f32x4*)(sp + 4);
                h[j][0] = a[0]; h[j][1] = a[1]; h[j][2] = a[2]; h[j][3] = a[3]; h[j][4] = bq[0]; h[j][5] = bq[1]; h[j][6] = bq[2]; h[j][7] = bq[3]; }
        } else {
#pragma unroll
            for (int j = 0; j < 3; ++j) unpack8(*(const v4u*)(QKV + (mbase + ta - 3 + j) * QKVW + c0), h[j]);
        }
#pragma unroll
        for (int tt = 0; tt < 4; ++tt) GC_ROW(r4[tt], ta + tt, mbase + ta + tt, true, b, DECS)
    }
}
DI void p_prep(Frame& F) {
    const int gw = F.vcu * NWAVES + F.wave, NGW = F.G * NWAVES;
    LAS float* Al = (LAS float*)(F.lds + F.wave * 16384);
    const bf16* QN = (const bf16*)(F.ws + WS_QN); const bf16* KN = (const bf16*)(F.ws + WS_KN);
    const float* BA = (const float*)(F.ws + WS_BA);
    bf16* TP = (bf16*)(F.ws + WS_TP); bf16* PP = (bf16*)(F.ws + WS_PP);
    float* EG = (float*)(F.ws + WS_EG); float* DL = (float*)(F.ws + WS_DL); float* GL = (float*)(F.ws + WS_GL);
    const int gw2 = F.wave * F.G + F.vcu;
    const int npr = (gw < NITEM_P) ? (NITEM_P - gw + NGW - 1) / NGW : 0, nsm = (gw2 < NITEM - NITEM_P) ? (NITEM - NITEM_P - gw2 + NGW - 1) / NGW : 0;
    for (int k = 0; k < npr + nsm; ++k) {
        const int it = (k < npr) ? gw + k * NGW : NITEM_P + gw2 + (k - npr) * NGW;
        int lane = F.lane; asm volatile("" : "+v"(lane));
        const int c = lane & 31, hh = lane >> 5;
        int h, nv; size_t m0;
        if (it < NITEM_P) { h = it & 31; const int bn = it >> 5; m0 = (size_t)(bn >> 7) * SEQ + (size_t)(bn & 127) * 64; nv = 64; }
        else { const int r = it - NITEM_P; h = r & 31; m0 = (size_t)MP + (size_t)(r >> 5) * 16; nv = 16; }
        const int kh = h >> 1;
        float gt = 0.f, bt = 0.f;
        if (lane < nv) { const float bb = BA[(m0 + lane) * 64 + h], aa = BA[(m0 + lane) * 64 + 32 + h];
            bt = 1.0f / (1.0f + __expf(-bb));
            const float xx = aa + F.in[I_ADT][h]; const float sp = fmaxf(xx, 0.f) + log1pf(__expf(-fabsf(xx)));
            gt = -__expf(F.in[I_ALOG][h]) * sp; }
        float G = gt;
#pragma unroll
        for (int o = 1; o < 64; o <<= 1) { const float y = __shfl_up(G, o); if (lane >= o) G += y; }
        const float Glast = __shfl(G, 63);
        if (nv == 64) {
        bf16x8 kf[2][8];
#pragma unroll
        for (int ti = 0; ti < 2; ++ti)
#pragma unroll
            for (int s = 0; s < 8; ++s) { const int row = 32 * ti + c;
                kf[ti][s] = (row < nv) ? *(const bf16x8*)(KN + (m0 + row) * DM + kh * 128 + 16 * s + 8 * hh) : (bf16x8){0, 0, 0, 0, 0, 0, 0, 0}; }
        {
            f32x16 t00 = {}, t10 = {}, t11 = {};
#pragma unroll
            for (int s = 0; s < 8; ++s) { t00 = MFMA32(kf[0][s], kf[0][s], t00); t10 = MFMA32(kf[1][s], kf[0][s], t10); t11 = MFMA32(kf[1][s], kf[1][s], t11); }
#pragma unroll
            for (int i = 0; i < 16; ++i) {
                const int r0 = crow(i, hh), r1 = 32 + r0;
                const float G0 = __shfl(G, r0), G1 = __shfl(G, r1), b0 = __shfl(bt, r0), b1 = __shfl(bt, r1);
                const float Gc0 = __shfl(G, c), Gc1 = __shfl(G, 32 + c);
                Al[r0 * 64 + c] = (r0 > c) ? b0 * t00[i] * __expf(G0 - Gc0) : 0.f;
                Al[r1 * 64 + c] = b1 * t10[i] * __expf(G1 - Gc0);
                Al[r1 * 64 + 32 + c] = (r0 > c) ? b1 * t11[i] * __expf(G1 - Gc1) : 0.f;
            }
        }
        asm volatile("" ::: "memory");
        {
            bf16x8 qf[2][8];
#pragma unroll
            for (int ti = 0; ti < 2; ++ti)
#pragma unroll
                for (int s = 0; s < 8; ++s) { const int row = 32 * ti + c;
                    qf[ti][s] = (row < nv) ? *(const bf16x8*)(QN + (m0 + row) * DM + kh * 128 + 16 * s + 8 * hh) : (bf16x8){0, 0, 0, 0, 0, 0, 0, 0}; }
            f32x16 t00 = {}, t10 = {}, t11 = {};
#pragma unroll
            for (int s = 0; s < 8; ++s) { t00 = MFMA32(qf[0][s], kf[0][s], t00); t10 = MFMA32(qf[1][s], kf[0][s], t10); t11 = MFMA32(qf[1][s], kf[1][s], t11); }
            bf16* pp = PP + (size_t)it * 4096;
#pragma unroll
            for (int i = 0; i < 16; ++i) {
                const int r0 = crow(i, hh), r1 = 32 + r0;
                const float G0 = __shfl(G, r0), G1 = __shfl(G, r1);
                const float Gc0 = __shfl(G, c), Gc1 = __shfl(G, 32 + c);
                const float v00 = (r0 >= c) ? t00[i] * __expf(G0 - Gc0) : 0.f;
                const float v10 = t10[i] * __expf(G1 - Gc0);
                const float v11 = (r0 >= c) ? t11[i] * __expf(G1 - Gc1) : 0.f;
                pp[r0 * 64 + c] = (bf16)(pk2(v00, 0.f) & 0xffffu); pp[r0 * 64 + 32 + c] = 0;
                pp[r1 * 64 + c] = (bf16)(pk2(v10, 0.f) & 0xffffu); pp[r1 * 64 + 32 + c] = (bf16)(pk2(v11, 0.f) & 0xffffu);
            }
        }
        LDS_WAIT(); asm volatile("" ::: "memory");
        float T[64];
#pragma unroll
        for (int i = 0; i < 64; ++i) {
            float a = (lane == i) ? 1.0f : 0.f;
#pragma unroll
            for (int j = 0; j < i; ++j) a -= Al[i * 64 + j] * T[j];
            T[i] = a;
            asm volatile("" ::: "memory");
        }
        bf16* tp = TP + (size_t)it * 4096;
#pragma unroll
        for (int i = 0; i < 64; ++i) tp[i * 64 + lane] = (bf16)(pk2(T[i] * bt, 0.f) & 0xffffu);
        } else {
        bf16x8 kf0[8], qf0[8];
#pragma unroll
        for (int s = 0; s < 8; ++s) { kf0[s] = (c < nv) ? *(const bf16x8*)(KN + (m0 + c) * DM + kh * 128 + 16 * s + 8 * hh) : (bf16x8){0, 0, 0, 0, 0, 0, 0, 0};
            qf0[s] = (c < nv) ? *(const bf16x8*)(QN + (m0 + c) * DM + kh * 128 + 16 * s + 8 * hh) : (bf16x8){0, 0, 0, 0, 0, 0, 0, 0}; }
        f32x16 tk = {}, tq = {};
#pragma unroll
        for (int s = 0; s < 8; ++s) { tk = MFMA32(kf0[s], kf0[s], tk); tq = MFMA32(qf0[s], kf0[s], tq); }
        bf16* pp = PP + (size_t)it * 4096;
#pragma unroll
        for (int i = 0; i < 16; ++i) {
            const int r0 = crow(i, hh), r1 = 32 + r0;
            const float G0 = __shfl(G, r0), b0 = __shfl(bt, r0), Gc0 = __shfl(G, c);
            const float dec = __expf(G0 - Gc0);
            Al[r0 * 64 + c] = (r0 > c) ? b0 * tk[i] * dec : 0.f;
            const float v00 = (r0 >= c) ? tq[i] * dec : 0.f;
            pp[r0 * 64 + c] = (bf16)(pk2(v00, 0.f) & 0xffffu); pp[r0 * 64 + 32 + c] = 0;
            pp[r1 * 64 + c] = 0; pp[r1 * 64 + 32 + c] = 0;
        }
        LDS_WAIT(); asm volatile("" ::: "memory");
        float T[16];
#pragma unroll
        for (int i = 0; i < 16; ++i) {
            float a = (lane == i) ? 1.0f : 0.f;
#pragma unroll
            for (int j = 0; j < i; ++j) a -= Al[i * 64 + j] * T[j];
            T[i] = a;
            asm volatile("" ::: "memory");
        }
        bf16* tp = TP + (size_t)it * 4096;
#pragma unroll
        for (int i = 0; i < 16; ++i) tp[i * 64 + lane] = (bf16)(pk2(T[i] * bt, 0.f) & 0xffffu);
#pragma unroll
        for (int i = 16; i < 64; ++i) tp[i * 64 + lane] = 0;
        }
        EG[(size_t)it * 64 + lane] = __expf(G); DL[(size_t)it * 64 + lane] = __expf(Glast - G);
        if (lane == 0) GL[it] = __expf(Glast);
        LDS_WAIT(); asm volatile("" ::: "memory");
    }
}
constexpr int SB_K = 0, SB_Q = 17408, SB_V = 34816, SB_TP = 52224, SB_PP = 61440, SB_SIZE = 70656, SB_EG = 2 * SB_SIZE;
constexpr int LDK = 272, LDT = 144;
DI bf16x8 frag_perm(const LAS unsigned char* p) {
    const v2u lo = *(const LAS v2u*)p, hi = *(const LAS v2u*)(p + 16); const v4u x = {lo.x, lo.y, hi.x, hi.y}; return __builtin_bit_cast(bf16x8, x); }
DI bf16x8 pack_acc(const f32x16& a, const int s2) {
    v4u x; x.x = pk2(a[8 * s2], a[8 * s2 + 1]); x.y = pk2(a[8 * s2 + 2], a[8 * s2 + 3]); x.z = pk2(a[8 * s2 + 4], a[8 * s2 + 5]); x.w = pk2(a[8 * s2 + 6], a[8 * s2 + 7]); return __builtin_bit_cast(bf16x8, x); }
struct ScanLd { v4u k[4], q[4], v[4], tp[2], pp[2]; float e0, e1; };
DI void scan_issue(ScanLd& L, Frame& F, const int lt, const int item, const size_t m0, const int nv, const int h) {
    const bf16* QN = (const bf16*)(F.ws + WS_QN); const bf16* KN = (const bf16*)(F.ws + WS_KN); const bf16* VV = (const bf16*)(F.ws + WS_VV);
    const bf16* TP = (const bf16*)(F.ws + WS_TP); const bf16* PP = (const bf16*)(F.ws + WS_PP);
    const float* EG = (const float*)(F.ws + WS_EG); const float* DL = (const float*)(F.ws + WS_DL); const float* GL = (const float*)(F.ws + WS_GL);
    const int kh = h >> 1;
#pragma unroll
    for (int i = 0; i < 4; ++i) { const int p = lt + 256 * i, row = p >> 4, cc = p & 15; const v4u z4 = {0u, 0u, 0u, 0u};
        L.k[i] = (row < nv) ? *(const v4u*)(KN + (m0 + row) * DM + kh * 128 + cc * 8) : z4;
        L.q[i] = (row < nv) ? *(const v4u*)(QN + (m0 + row) * DM + kh * 128 + cc * 8) : z4;
        const int vrow = lt >> 2, vcc = (lt & 3) * 4 + i; L.v[i] = (vrow < nv) ? *(const v4u*)(VV + (m0 + vrow) * VW + h * 128 + vcc * 8) : z4; }
#pragma unroll
    for (int i = 0; i < 2; ++i) { const int p = lt + 256 * i, row = p >> 3, cc = p & 7;
        L.tp[i] = *(const v4u*)(TP + (size_t)item * 4096 + row * 64 + cc * 8); L.pp[i] = *(const v4u*)(PP + (size_t)item * 4096 + row * 64 + cc * 8); }
    L.e0 = (lt < 64) ? EG[(size_t)item * 64 + lt] : ((lt < 128) ? DL[(size_t)item * 64 + lt - 64] : GL[item]);
}
DI void st_perm(LAS unsigned char* rowbase, const int cc, const v4u x) {
    LAS unsigned char* g = rowbase + (cc >> 1) * 32 + (cc & 1) * 8;
    *(LAS v2u*)g = (v2u){x.x, x.y}; *(LAS v2u*)(g + 16) = (v2u){x.z, x.w};
}
DI void scan_write(const ScanLd& L, LAS unsigned char* lds, const int buf, const int lt) {
    LAS unsigned char* B = lds + buf * SB_SIZE;
#pragma unroll
    for (int i = 0; i < 4; ++i) { const int p = lt + 256 * i, row = p >> 4, cc = p & 15;
        *(LAS v4u*)(B + SB_K + row * LDK + cc * 16) = L.k[i]; st_perm(B + SB_Q + row * LDK, cc, L.q[i]);
        *(LAS v4u*)(B + SB_V + (lt >> 2) * LDK + ((lt & 3) * 4 + i) * 16) = L.v[i]; }
#pragma unroll
    for (int i = 0; i < 2; ++i) { const int p = lt + 256 * i, row = p >> 3, cc = p & 7;
        st_perm(B + SB_TP + row * LDT, cc, L.tp[i]); st_perm(B + SB_PP + row * LDT, cc, L.pp[i]); }
    if (lt <= 128) *(LAS float*)(lds + SB_EG + buf * 1024 + lt * 4) = L.e0;
}
struct ScanZ { v4u z[4]; };
DI void scan_z_load(ScanZ& N, Frame& F, const int lt, const size_t m0, const int nv, const int h) {
    const bf16* Z = (const bf16*)(F.ws + WS_Z); const int tok = lt >> 2, qd = lt & 3; const size_t off = (m0 + (tok < nv ? tok : 0)) * VW + h * 128 + qd * 32;
#pragma unroll
    for (int i = 0; i < 4; ++i) N.z[i] = *(const v4u*)(Z + off + 8 * i);
}
DI void scan_norm_lds(const ScanZ& N, Frame& F, const int buf, const int lt, const size_t m0, const int nv, const int h) {
    bf16* ON = (bf16*)(F.out + O_PK); const LAS float* gn = (const LAS float*)(F.lds + SB_EG + 2048);
    const int tok = lt >> 2, qd = lt & 3; const size_t off = (m0 + tok) * VW + h * 128 + qd * 32;
    const LAS unsigned char* op = F.lds + buf * SB_SIZE + SB_V + tok * LDK + qd * 64;
    v4u o4[4]; float ss = 0.f;
#pragma unroll
    for (int i = 0; i < 4; ++i) { o4[i] = *(const LAS v4u*)(op + 16 * i); float o8[8]; unpack8(o4[i], o8);
#pragma unroll
        for (int e = 0; e < 8; ++e) ss += o8[e] * o8[e]; }
    ss += __shfl_xor(ss, 1); ss += __shfl_xor(ss, 2);
    const float rstd = rsqrtf(ss * (1.0f / 128.0f) + 1e-6f);
    if (tok < nv) {
#pragma unroll
        for (int i = 0; i < 4; ++i) { float o8[8], z8[8]; unpack8(o4[i], o8); unpack8(N.z[i], z8);
            const f32x4 g0 = *(const LAS f32x4*)(gn + qd * 32 + 8 * i), g1 = *(const LAS f32x4*)(gn + qd * 32 + 8 * i + 4);
#pragma unroll
            for (int e = 0; e < 8; ++e) o8[e] = o8[e] * rstd * (e < 4 ? g0[e & 3] : g1[e & 3]) * siluf(z8[e]);
            *(v4u*)(ON + off + 8 * i) = pack8(o8); }
    }
}
DI void scan_chain(Frame& F, const bool samp, const int b, const int h) {
    const int tid = F.tid, w = F.wave;
    LAS unsigned char* lds = F.lds;
    bf16* ON = (bf16*)(F.out + O_PK);
    const int nsteps = samp ? 1 : 128, nv = samp ? 16 : 64;
    const bool loader = w >= 4; const int lt = tid - 256;
#define SC_ITEM(n) (samp ? NITEM_P + b * 32 + h : (b * 128 + (n)) * 32 + h)
#define SC_M0(n) (samp ? (size_t)MP + b * 16 : (size_t)b * SEQ + (size_t)(n) * 64)
    f32x16 S[4];
    __syncthreads();
    if (tid < 128) *(LAS float*)(lds + SB_EG + 2048 + tid * 4) = F.in[I_AONORM][tid];
    if (samp) {
        const float* s0 = F.in[I_SGDN] + (size_t)(b * 32 + h) * 16384;
#pragma unroll
        for (int i = 0; i < 8; ++i) *(LAS f32x4*)(lds + (tid + 512 * i) * 16) = *(const f32x4*)(s0 + (tid + 512 * i) * 4);
        __syncthreads();
        if (!loader) { const int lane = F.lane, c = lane & 31, hh = lane >> 5, dvb = 32 * w;
#pragma unroll
            for (int i4 = 0; i4 < 4; ++i4)
#pragma unroll
                for (int i = 0; i < 16; ++i) S[i4][i] = *(const LAS float*)(lds + ((32 * i4 + crow(i, hh)) * 128 + dvb + c) * 4); }
        __syncthreads();
    } else {
#pragma unroll
        for (int i4 = 0; i4 < 4; ++i4)
#pragma unroll
            for (int i = 0; i < 16; ++i) S[i4][i] = 0.f;
    }
    if (loader) {
        ScanLd L0, L1; ScanZ Z0;
        { int lv = lt; asm volatile("" : "+v"(lv)); scan_issue(L0, F, lv, SC_ITEM(0), SC_M0(0), nv, h); scan_write(L0, lds, 0, lv);
          if (nsteps > 1) scan_issue(L1, F, lv, SC_ITEM(1), SC_M0(1), nv, h); if (nsteps > 2) scan_issue(L0, F, lv, SC_ITEM(2), SC_M0(2), nv, h);
          scan_z_load(Z0, F, lv, SC_M0(0), nv, h); }
        __syncthreads();
        for (int n = 0; n < nsteps; n += 2) {
            {
                int lv = lt; asm volatile("" : "+v"(lv));
                if (n >= 1) { scan_norm_lds(Z0, F, 1, lv, SC_M0(n - 1), nv, h); scan_z_load(Z0, F, lv, SC_M0(n), nv, h); }
                if (n + 1 < nsteps) scan_write(L1, lds, 1, lv);
                if (n + 3 < nsteps) scan_issue(L1, F, lv, SC_ITEM(n + 3), SC_M0(n + 3), nv, h);
                __syncthreads();
            }
            if (n + 1 < nsteps) {
                int lv = lt; asm volatile("" : "+v"(lv));
                scan_norm_lds(Z0, F, 0, lv, SC_M0(n), nv, h); scan_z_load(Z0, F, lv, SC_M0(n + 1), nv, h);
                if (n + 2 < nsteps) scan_write(L0, lds, 0, lv);
                if (n + 4 < nsteps) scan_issue(L0, F, lv, SC_ITEM(n + 4), SC_M0(n + 4), nv, h);
                __syncthreads();
            }
        }
        __syncthreads();
        { int lv = lt; asm volatile("" : "+v"(lv));
          scan_norm_lds(Z0, F, (nsteps - 1) & 1, lv, SC_M0(nsteps - 1), nv, h); }
        __syncthreads();
    } else {
        __syncthreads();
        for (int n = 0; n < nsteps; ++n) {
            int lane = F.lane; asm volatile("" : "+v"(lane));
            const int c = lane & 31, hh = lane >> 5, dvb = 32 * w;
            const LAS unsigned char* B = lds + (n & 1) * SB_SIZE; const LAS float* egp = (const LAS float*)(lds + SB_EG + (n & 1) * 1024);
            const size_t m0 = SC_M0(n);
            bf16x8 Sb[8];
#pragma unroll
            for (int i4 = 0; i4 < 4; ++i4) { Sb[2 * i4] = pack_acc(S[i4], 0); Sb[2 * i4 + 1] = pack_acc(S[i4], 1); }
            f32x16 ks[2] = {{}, {}}, qs[2] = {{}, {}};
            const LAS unsigned char* pk0 = B + SB_K + c * LDK + 8 * hh; const LAS unsigned char* pq1 = B + SB_Q + c * LDK + 16 * hh;
            bf16x8 fa[4], fb[4], tf[8];
#define LDKQ(dst, s8) do { dst[0] = frag_perm(pk0 + 32 * (s8)); dst[1] = frag_perm(pk0 + 32 * LDK + 32 * (s8)); dst[2] = *(const LAS bf16x8*)(pq1 + 32 * (s8)); dst[3] = *(const LAS bf16x8*)(pq1 + 32 * LDK + 32 * (s8)); } while (0)
#define MMKQ(src, s8) do { ks[0] = MFMA32(src[0], Sb[s8], ks[0]); ks[1] = MFMA32(src[1], Sb[s8], ks[1]); qs[0] = MFMA32(src[2], Sb[s8], qs[0]); qs[1] = MFMA32(src[3], Sb[s8], qs[1]); } while (0)
#define SBAR() __builtin_amdgcn_sched_barrier(0)
            LDKQ(fa, 0); SBAR();
            LDKQ(fb, 1); SBAR(); MMKQ(fa, 0); SBAR();
            LDKQ(fa, 2); SBAR(); MMKQ(fb, 1); SBAR();
            LDKQ(fb, 3); SBAR(); MMKQ(fa, 2); SBAR();
            LDKQ(fa, 4); SBAR(); MMKQ(fb, 3); SBAR();
            LDKQ(fb, 5); SBAR(); MMKQ(fa, 4); SBAR();
            LDKQ(fa, 6); SBAR(); MMKQ(fb, 5); SBAR();
            LDKQ(fb, 7); SBAR(); MMKQ(fa, 6); SBAR();
#pragma unroll
            for (int s4 = 0; s4 < 4; ++s4) { tf[2 * s4] = *(const LAS bf16x8*)(B + SB_TP + c * LDT + 32 * s4 + 16 * hh); tf[2 * s4 + 1] = *(const LAS bf16x8*)(B + SB_TP + (32 + c) * LDT + 32 * s4 + 16 * hh); }
            SBAR(); MMKQ(fb, 7); SBAR();
#undef LDKQ
#undef MMKQ
            bf16x8 rf[4];
            { const int vbv = (int)(unsigned)(size_t)(B + SB_V) + (4 * hh + ((lane >> 2) & 3)) * LDK + ((lane >> 4) & 1) * 32 + (lane & 3) * 8 + dvb * 2;
              const bf16x4 v00 = tr_read<0 * LDK>(vbv), v01 = tr_read<8 * LDK>(vbv), v02 = tr_read<16 * LDK>(vbv), v03 = tr_read<24 * LDK>(vbv);
              const bf16x4 v10 = tr_read<32 * LDK>(vbv), v11 = tr_read<40 * LDK>(vbv), v12 = tr_read<48 * LDK>(vbv), v13 = tr_read<56 * LDK>(vbv);
              asm volatile("s_waitcnt lgkmcnt(0)" ::: "memory"); SBAR();
#define RROW(tt, g4, V) do { const f32x4 e4 = *(const LAS f32x4*)(egp + 32 * (tt) + 8 * (g4) + 4 * hh); \
                  r[4 * (g4)] = bf2f((bf16)V[0]) - e4[0] * ks[tt][4 * (g4)]; r[4 * (g4) + 1] = bf2f((bf16)V[1]) - e4[1] * ks[tt][4 * (g4) + 1]; \
                  r[4 * (g4) + 2] = bf2f((bf16)V[2]) - e4[2] * ks[tt][4 * (g4) + 2]; r[4 * (g4) + 3] = bf2f((bf16)V[3]) - e4[3] * ks[tt][4 * (g4) + 3]; } while (0)
              { f32x16 r; RROW(0, 0, v00); RROW(0, 1, v01); RROW(0, 2, v02); RROW(0, 3, v03); rf[0] = pack_acc(r, 0); rf[1] = pack_acc(r, 1); }
              { f32x16 r; RROW(1, 0, v10); RROW(1, 1, v11); RROW(1, 2, v12); RROW(1, 3, v13); rf[2] = pack_acc(r, 0); rf[3] = pack_acc(r, 1); }
#undef RROW
            }
            SBAR();
            f32x16 u[2] = {{}, {}};
#pragma unroll
            for (int s4 = 0; s4 < 4; ++s4) { u[0] = MFMA32(tf[2 * s4], rf[s4], u[0]); u[1] = MFMA32(tf[2 * s4 + 1], rf[s4], u[1]); }
            SBAR();
            bf16x8 pf[8];
#pragma unroll
            for (int s4 = 0; s4 < 4; ++s4) { pf[2 * s4] = *(const LAS bf16x8*)(B + SB_PP + c * LDT + 32 * s4 + 16 * hh); pf[2 * s4 + 1] = *(const LAS bf16x8*)(B + SB_PP + (32 + c) * LDT + 32 * s4 + 16 * hh); }
            const float gl = egp[128];
            SBAR();
            bf16x8 uf[4], upf[4];
#pragma unroll
            for (int tt = 0; tt < 2; ++tt) { uf[2 * tt] = pack_acc(u[tt], 0); uf[2 * tt + 1] = pack_acc(u[tt], 1); f32x16 up;
#pragma unroll
                for (int g4 = 0; g4 < 4; ++g4) { const f32x4 d4 = *(const LAS f32x4*)(egp + 64 + 32 * tt + 8 * g4 + 4 * hh);
                    up[4 * g4] = u[tt][4 * g4] * d4[0]; up[4 * g4 + 1] = u[tt][4 * g4 + 1] * d4[1]; up[4 * g4 + 2] = u[tt][4 * g4 + 2] * d4[2]; up[4 * g4 + 3] = u[tt][4 * g4 + 3] * d4[3]; }
                upf[2 * tt] = pack_acc(up, 0); upf[2 * tt + 1] = pack_acc(up, 1); }
            f32x16 pu[2] = {{}, {}};
#pragma unroll
            for (int s4 = 0; s4 < 4; ++s4) { pu[0] = MFMA32(pf[2 * s4], uf[s4], pu[0]); pu[1] = MFMA32(pf[2 * s4 + 1], uf[s4], pu[1]); }
            SBAR();
            { const int vb = (int)(unsigned)(size_t)(B + SB_K) + (4 * hh + ((lane >> 2) & 3)) * LDK + ((lane >> 4) & 1) * 32 + (lane & 3) * 8;
#pragma unroll
              for (int i4 = 0; i4 < 4; ++i4) {
#pragma unroll
                  for (int i = 0; i < 16; ++i) S[i4][i] *= gl; }
#define KTPK(L, H) (bf16x8){L[0], L[1], L[2], L[3], H[0], H[1], H[2], H[3]}
#define KTLD(P, s4) const bf16x4 P##l0 = tr_read<16 * (s4) * LDK>(vb), P##h0 = tr_read<(16 * (s4) + 8) * LDK>(vb), P##l1 = tr_read<16 * (s4) * LDK + 64>(vb), P##h1 = tr_read<(16 * (s4) + 8) * LDK + 64>(vb), \
                  P##l2 = tr_read<16 * (s4) * LDK + 128>(vb), P##h2 = tr_read<(16 * (s4) + 8) * LDK + 128>(vb), P##l3 = tr_read<16 * (s4) * LDK + 192>(vb), P##h3 = tr_read<(16 * (s4) + 8) * LDK + 192>(vb)
#define KTMM(P, s4) do { S[0] = MFMA32(KTPK(P##l0, P##h0), upf[s4], S[0]); S[1] = MFMA32(KTPK(P##l1, P##h1), upf[s4], S[1]); S[2] = MFMA32(KTPK(P##l2, P##h2), upf[s4], S[2]); S[3] = MFMA32(KTPK(P##l3, P##h3), upf[s4], S[3]); } while (0)
              KTLD(a, 0); KTLD(b, 1);
              asm volatile("s_waitcnt lgkmcnt(0)" ::: "memory"); SBAR();
              KTMM(a, 0); KTMM(b, 1); SBAR();
              KTLD(d, 2); KTLD(e, 3);
              asm volatile("s_waitcnt lgkmcnt(0)" ::: "memory"); SBAR();
              KTMM(d, 2); KTMM(e, 3); SBAR();
#undef KTLD
#undef KTMM
#undef KTPK
            }
#undef SBAR
            { LAS unsigned char* ob = lds + (n & 1) * SB_SIZE + SB_V + dvb * 2;
#pragma unroll
              for (int ti = 0; ti < 2; ++ti)
#pragma unroll
                for (int g4 = 0; g4 < 4; ++g4) { const int tk = 32 * ti + 8 * g4 + 4 * hh; const f32x4 e4 = *(const LAS f32x4*)(egp + tk);
#pragma unroll
                    for (int j = 0; j < 4; ++j) *(LAS bf16*)(ob + (tk + j) * LDK + c * 2) = (bf16)(pk2(e4[j] * qs[ti][4 * g4 + j] + pu[ti][4 * g4 + j], 0.f) & 0xffffu); }
              LDS_WAIT(); }
            __syncthreads();
        }
        __syncthreads();
        __syncthreads();
        {
            const int lane = F.lane, c = lane & 31, hh = lane >> 5, dvb = 32 * w;
#pragma unroll
            for (int i4 = 0; i4 < 4; ++i4)
#pragma unroll
                for (int i = 0; i < 16; ++i) *(LAS float*)(lds + ((32 * i4 + crow(i, hh)) * 128 + dvb + c) * 4) = S[i4][i];
        }
    }
    __syncthreads();
    { float* so = F.out + (samp ? O_SGDN : O_PGDN) + (size_t)(b * 32 + h) * 16384;
#pragma unroll
      for (int i = 0; i < 8; ++i) *(f32x4*)(so + (tid + 512 * i) * 4) = *(const LAS f32x4*)(lds + (tid + 512 * i) * 16); }
#undef SC_ITEM
#undef SC_M0
}
DI void p_scan(Frame& F) {
    const int nW = F.G, bx = blockIdx.x;
    for (int ch = bx; ch < NB * 32; ch += nW) { const int x = ch & 7, y = (ch >> 3) & 7, kh = x + 8 * (y >> 1);
        scan_chain(F, false, kh >> 4, 2 * (kh & 15) + (y & 1)); }
    int start, stride;
    if (nW > NB * 32) { start = bx - NB * 32; stride = nW - NB * 32; } else { start = bx; stride = nW; }
    if (start >= 0) for (int ch = start; ch < DECB * 32; ch += stride) scan_chain(F, true, ch >> 5, ch & 31);
}
DI void p_ffnconv(Frame& F, const int layer, const int tb_lo, const int tb_hi, const int gw, const int NGW, const bf16* UP, bf16* ACT) {
    const int lane = F.lane;
    const float* wconv = F.in[I_FWCONV] + (size_t)layer * 3 * UPW; const float* bconv = F.in[I_FBCONV] + (size_t)layer * UPW;
    constexpr int NCC = DFF / 512;
    const int NI = (tb_hi - tb_lo) * NCC, R = NI / NGW, rem = NI - R * NGW; const bool halves = 2 * rem <= NGW;
    const int npiece = R + ((halves ? gw < 2 * rem : gw < rem) ? 1 : 0);
    for (int k = 0; k < npiece; ++k) {
        const bool tail = k >= R;
        const int it = !tail ? gw + k * NGW : R * NGW + (halves ? gw >> 1 : gw);
        const int th_lo = (tail && halves) ? (gw & 1) : 0, th_hi = (tail && halves) ? th_lo + 1 : 2;
        const int tb = tb_lo + it / NCC, cc = it % NCC, c0 = cc * 512 + lane * 8;
        const bool samp = tb >= MP / 16; const int b = samp ? tb - MP / 16 : tb >> 9; const int t0 = samp ? 0 : (tb & 511) * 16;
        const size_t mbase = samp ? (size_t)MP + b * 16 : (size_t)b * SEQ; const int L = samp ? DECS : SEQ;
        float wg[3][8], wv[3][8], bg[8], bv[8];
#pragma unroll
        for (int i = 0; i < 3; ++i)
#pragma unroll
            for (int e = 0; e < 8; ++e) { wg[i][e] = wconv[i * UPW + c0 + e]; wv[i][e] = wconv[i * UPW + DFF + c0 + e]; }
#pragma unroll
        for (int e = 0; e < 8; ++e) { bg[e] = bconv[c0 + e]; bv[e] = bconv[DFF + c0 + e]; }
        float hg[2][8], hv[2][8];
#pragma unroll
        for (int j = 0; j < 2; ++j) { const int t = t0 + 8 * th_lo - 2 + j;
            if (t >= 0) { unpack8(*(const v4u*)(UP + (mbase + t) * UPW + c0), hg[j]); unpack8(*(const v4u*)(UP + (mbase + t) * UPW + DFF + c0), hv[j]); }
            else if (samp) { const float* sp = F.in[I_SFC] + ((size_t)(layer * DECB + b) * 2 + (t + 2)) * UPW + c0;
#pragma unroll
                for (int e = 0; e < 8; ++e) { hg[j][e] = sp[e]; hv[j][e] = sp[DFF + e]; } }
            else {
#pragma unroll
                for (int e = 0; e < 8; ++e) { hg[j][e] = 0.f; hv[j][e] = 0.f; } } }
        for (int th = th_lo; th < th_hi; ++th) {
        v4u rg[8], rv[8];
#pragma unroll
        for (int tt = 0; tt < 8; ++tt) { rg[tt] = __builtin_nontemporal_load((const v4u*)(UP + (mbase + t0 + 8 * th + tt) * UPW + c0)); rv[tt] = __builtin_nontemporal_load((const v4u*)(UP + (mbase + t0 + 8 * th + tt) * UPW + DFF + c0)); }
#pragma unroll
        for (int t8 = 0; t8 < 8; ++t8) {
            const int tt = 8 * th + t8; const int t = t0 + tt; const size_t m = mbase + t;
            float cg[8], cv[8]; unpack8(rg[t8], cg); unpack8(rv[t8], cv);
            float y[8];
#pragma unroll
            for (int e = 0; e < 8; ++e) { const float g = hg[0][e] * wg[0][e] + hg[1][e] * wg[1][e] + cg[e] * wg[2][e] + bg[e];
                const float v = hv[0][e] * wv[0][e] + hv[1][e] * wv[1][e] + cv[e] * wv[2][e] + bv[e]; y[e] = siluf(g) * v; }
            *(v4u*)(ACT + m * DFF + c0) = pack8(y);
            if (t >= L - 2) {
                float* so = F.out + (samp ? O_SFC + ((size_t)(layer * DECB + b) * 2 + (t - (L - 2))) * UPW : O_PFC + ((size_t)(layer * NB + b) * 2 + (t - (L - 2))) * UPW) + c0;
#pragma unroll
                for (int e = 0; e < 8; ++e) { so[e] = cg[e]; so[DFF + e] = cv[e]; } }
#pragma unroll
            for (int e = 0; e < 8; ++e) { hg[0][e] = hg[1][e]; hg[1][e] = cg[e]; hv[0][e] = hv[1][e]; hv[1][e] = cv[e]; }
        }
        }
    }
}
DI void p_final(Frame& F, const int m_lo, const int m_hi, const int gw, const int NGW) {
    const int lane = F.lane;
    const float* ssq = (const float*)(F.ws + WS_SSQ + 4 * SSQ_STRIDE); const float* gain = F.in[I_FINAL];
    for (int m0 = m_lo + gw; m0 < m_hi; m0 += 2 * NGW) {
        const int m1 = m0 + NGW; const bool two = m1 < m_hi; const int mb = two ? m1 : m0;
        float s0 = (lane < 32) ? ssq[(size_t)m0 * 32 + lane] : 0.f; float s1 = (lane < 32) ? ssq[(size_t)mb * 32 + lane] : 0.f;
        f32x4* ya = (f32x4*)(F.out + (size_t)m0 * DM) + lane; f32x4* yb = (f32x4*)(F.out + (size_t)mb * DM) + lane; const f32x4* g4 = (const f32x4*)gain + lane;
        f32x4 va[8], vb[8];
#pragma unroll
        for (int j = 0; j < 8; ++j) va[j] = __builtin_nontemporal_load(ya + 64 * j);
#pragma unroll
        for (int j = 0; j < 8; ++j) vb[j] = __builtin_nontemporal_load(yb + 64 * j);
        s0 = wave_sum(s0); s1 = wave_sum(s1);
        const float r0 = rsqrtf(s0 * (1.0f / 2048.0f) + 1e-6f), r1 = rsqrtf(s1 * (1.0f / 2048.0f) + 1e-6f);
#pragma unroll
        for (int j = 0; j < 8; ++j) __builtin_nontemporal_store(va[j] * r0 * g4[64 * j], ya + 64 * j);
        if (two) {
#pragma unroll
            for (int j = 0; j < 8; ++j) __builtin_nontemporal_store(vb[j] * r1 * g4[64 * j], yb + 64 * j);
        }
    }
}
DI void p_cacheconv(Frame& F, const float* src, bf16* dst, const size_t t0, const size_t nthr) {
    constexpr size_t NP = (size_t)DECB * PAST * DM / 8;
    for (size_t p = t0; p < NP; p += nthr) {
        const size_t row = p >> 8, c8 = p & 255, b = row >> 11, key = row & 2047;
        const f32x4 a = __builtin_nontemporal_load((const f32x4*)(src + p * 8)), bq = __builtin_nontemporal_load((const f32x4*)(src + p * 8 + 4));
        v4u o; o.x = pk2(a[0], a[1]); o.y = pk2(a[2], a[3]); o.z = pk2(bq[0], bq[1]); o.w = pk2(bq[2], bq[3]);
        *(v4u*)(dst + (b * (PAST + DECS) + key) * DM + c8 * 8) = o;
    }
}
#ifndef ATT_SKEW
#define ATT_SKEW 0
#endif
constexpr int AT_K = 0, AT_V = 65536, AT_BT = 131072;
constexpr float ATT_C = 0.08838834764831845f * 1.4426950408889634f;
constexpr float LAM_INIT = 0.35550906759718507f;
constexpr float ATT_THR = 6.0f;
constexpr int CW_ATTQ = 64;
struct AttnUnit { const bf16* Kp; const bf16* Vp; const bf16* Qp; bf16* Op; int h, nq, qpos0, nkeys; size_t mq0; };
DI int t5_bucket(int rel) { const int n = rel < 0 ? -rel : rel; int v; if (n < 8) v = n; else { v = 2 + (31 - __builtin_clz((unsigned)(n * n))); v = v > 15 ? 15 : v; } return (rel > 0 ? 16 : 0) + v; }
#define KSWZ(row, colB) ((row) * 256 + ((colB) ^ (((row) & 7) << 4)))
DI int v_st(int k, int c) { return ((k >> 3) * 8 + (c >> 5)) * 512 + ((k & 7) * 32 + (c & 31)) * 2; }
DI int v_rd_base(int lane) { return ((lane & 3) << 3) | (((lane >> 2) & 3) << 6) | (((lane >> 4) & 1) << 5) | (((lane >> 5) & 1) << 8); }
DI void at_dma(LAS unsigned char* lds, const AttnUnit& U, const int kt, const int buf, const int w, int lane) {
    asm volatile("" : "+v"(lane));
#pragma unroll
    for (int i = 0; i < 4; ++i) {
        const int ch = 4 * w + i, map = ch >> 4, row = 4 * (ch & 15) + (lane >> 4), cc = (lane & 15) ^ (row & 7); int kg = kt * 64 + row; kg = kg < U.nkeys ? kg : U.nkeys - 1;
        __builtin_amdgcn_global_load_lds((const unsigned*)(U.Kp + (size_t)kg * DM + (2 * U.h + map) * 128 + cc * 8), (LAS unsigned*)(lds + AT_K + buf * 32768 + ch * 1024), 16, 0, 0); }
#pragma unroll
    for (int i = 0; i < 4; ++i) {
        const int ch = 4 * w + i, key = 8 * (ch >> 2) + ((lane & 31) >> 2), col = 32 * (2 * (ch & 3) + (lane >> 5)) + 8 * (lane & 3); int kg = kt * 64 + key; kg = kg < U.nkeys ? kg : U.nkeys - 1;
        __builtin_amdgcn_global_load_lds((const unsigned*)(U.Vp + (size_t)kg * DM + U.h * 256 + col), (LAS unsigned*)(lds + AT_V + buf * 32768 + ch * 1024), 16, 0, 0); }
}
#define PK(L, H) (bf16x8){L[0], L[1], L[2], L[3], H[0], H[1], H[2], H[3]}
#define VRD(P, D0) const bf16x4 P##l0 = tr_read<(D0) * 512 + 0 * 8192>(vb), P##h0 = tr_read<(D0) * 512 + 0 * 8192 + 4096>(vb), P##l1 = tr_read<(D0) * 512 + 1 * 8192>(vb), P##h1 = tr_read<(D0) * 512 + 1 * 8192 + 4096>(vb), \
    P##l2 = tr_read<(D0) * 512 + 2 * 8192>(vb), P##h2 = tr_read<(D0) * 512 + 2 * 8192 + 4096>(vb), P##l3 = tr_read<(D0) * 512 + 3 * 8192>(vb), P##h3 = tr_read<(D0) * 512 + 3 * 8192 + 4096>(vb)
#define VMM(P, D0) do { O[D0] = MFMA32(pf[0], PK(P##l0, P##h0), O[D0]); O[D0] = MFMA32(pf[1], PK(P##l1, P##h1), O[D0]); O[D0] = MFMA32(pf[2], PK(P##l2, P##h2), O[D0]); O[D0] = MFMA32(pf[3], PK(P##l3, P##h3), O[D0]); } while (0)
#define VW8() do { asm volatile("s_waitcnt lgkmcnt(8)" ::: "memory"); __builtin_amdgcn_sched_barrier(0); } while (0)
DI void at_pv_all(f32x16 (&O)[8], const int vb, const bf16x8 (&pf)[4]) {
    VRD(a, 0); __builtin_amdgcn_sched_barrier(0);
    VRD(b, 1); VW8(); VMM(a, 0); __builtin_amdgcn_sched_barrier(0);
    VRD(c, 2); VW8(); VMM(b, 1); __builtin_amdgcn_sched_barrier(0);
    VRD(d, 3); VW8(); VMM(c, 2); __builtin_amdgcn_sched_barrier(0);
    VRD(e, 4); VW8(); VMM(d, 3); __builtin_amdgcn_sched_barrier(0);
    VRD(f, 5); VW8(); VMM(e, 4); __builtin_amdgcn_sched_barrier(0);
    VRD(g, 6); VW8(); VMM(f, 5); __builtin_amdgcn_sched_barrier(0);
    VRD(h, 7); VW8(); VMM(g, 6); __builtin_amdgcn_sched_barrier(0);
    asm volatile("s_waitcnt lgkmcnt(0)" ::: "memory"); __builtin_amdgcn_sched_barrier(0); VMM(h, 7); __builtin_amdgcn_sched_barrier(0);
}
#undef VRD
#undef VMM
#undef VW8
#undef PK
DI void attn_unit(Frame& F, const AttnUnit& U, const float lam) {
    const int tid = F.tid, w = F.wave, lane = F.lane, rt = w >> 1, mm = w & 1;
    LAS unsigned char* lds = F.lds;
    const bf16* QB = U.Qp; bf16* ATT = U.Op;
    __syncthreads();
    { int tv = tid; asm volatile("" : "+v"(tv)); const int rel = tv - 256; *(LAS float*)(lds + AT_BT + tv * 4) = F.in[I_RELB][t5_bucket(rel) * 8 + U.h] * 1.4426950408889634f; }
    const bool active = 32 * rt < U.nq;
    const int qchunk = (U.qpos0 + 32 * rt) >> 6;
    bf16x8 qf[8];
    { int lq = lane; asm volatile("" : "+v"(lq)); const int c = lq & 31, hh = lq >> 5, qrow = 32 * rt + c;
#pragma unroll
      for (int s = 0; s < 8; ++s) qf[s] = (qrow < U.nq) ? *(const bf16x8*)(QB + (U.mq0 + qrow) * DM + (2 * U.h + mm) * 128 + 16 * s + 8 * hh) : (bf16x8){0, 0, 0, 0, 0, 0, 0, 0}; }
    const int ntiles = (U.nkeys + 63) >> 6;
    float m_run = -1e30f, l_run = 0.f;
    f32x16 O[8];
#pragma unroll
    for (int d = 0; d < 8; ++d) O[d] = (f32x16){};
    at_dma(lds, U, 0, 0, w, lane);
    asm volatile("s_waitcnt vmcnt(0)" ::: "memory");
    __syncthreads();
    for (int kt = 0; kt < ntiles; ++kt) {
        const bool vis = active && kt <= qchunk;
        if (!vis && kt + 1 < ntiles) at_dma(lds, U, kt + 1, (kt + 1) & 1, w, lane);
        if (vis) {
#if ATT_SKEW
            if (w >= 4) __builtin_amdgcn_s_sleep(ATT_SKEW);
#endif
            int lv = lane; asm volatile("" : "+v"(lv)); const int c = lv & 31, hh = lv >> 5; const int qpos_lane = U.qpos0 + 32 * rt + c;
            const int kbase = AT_K + (kt & 1) * 32768 + mm * 16384;
            f32x16 t0 = {}, t1 = {};
            {
                bf16x8 ka[3], kb[3];
#define LDKF(buf, s0) do { ka[buf] = *(const LAS bf16x8*)(lds + kbase + KSWZ(c, 32 * (s0) + 16 * hh)); kb[buf] = *(const LAS bf16x8*)(lds + kbase + KSWZ(32 + c, 32 * (s0) + 16 * hh)); } while (0)
#define MMKF(buf, s0) do { t0 = MFMA32(ka[buf], qf[s0], t0); t1 = MFMA32(kb[buf], qf[s0], t1); } while (0)
#define SB_() __builtin_amdgcn_sched_barrier(0)
                LDKF(0, 0); LDKF(1, 1); SB_();
                LDKF(2, 2); SB_(); MMKF(0, 0); SB_();
                LDKF(0, 3); SB_(); MMKF(1, 1); SB_();
                LDKF(1, 4); SB_(); MMKF(2, 2); SB_();
                LDKF(2, 5); SB_(); MMKF(0, 3); SB_();
                LDKF(0, 6); SB_(); MMKF(1, 4); SB_();
                LDKF(1, 7); SB_(); MMKF(2, 5); SB_();
                MMKF(0, 6); SB_(); MMKF(1, 7); SB_();
#undef SB_
#undef LDKF
#undef MMKF
            }
            const LAS float* bt = (const LAS float*)(lds + AT_BT);
            float mx, bc0 = 0.f; bool far = false;
            if (kt * 64 + 63 - (U.qpos0 + 32 * rt) <= -91 && kt * 64 + 63 < U.nkeys) {
                far = true; bc0 = bt[0];
                float r0 = fmaxf(t0[0], t1[0]);
#pragma unroll
                for (int i = 1; i < 16; i += 1) r0 = __builtin_fmaxf(__builtin_fmaxf(r0, t0[i]), t1[i]);
                mx = r0 * ATT_C + bc0;
            } else {
                const bool part = kt * 64 + 63 >= U.nkeys;
#pragma unroll
                for (int i = 0; i < 16; ++i) { const int kg = kt * 64 + crow(i, hh); int r0 = kg - qpos_lane, r1 = r0 + 32;
                    r0 = r0 < -256 ? -256 : r0; r0 = r0 > 255 ? 255 : r0; r1 = r1 < -256 ? -256 : r1; r1 = r1 > 255 ? 255 : r1;
                    float b0 = bt[r0 + 256], b1 = bt[r1 + 256];
                    if (part) { b0 = (kg < U.nkeys) ? b0 : -1e30f; b1 = (kg + 32 < U.nkeys) ? b1 : -1e30f; }
                    t0[i] = t0[i] * ATT_C + b0; t1[i] = t1[i] * ATT_C + b1; }
                mx = fmaxf(t0[0], t1[0]);
#pragma unroll
                for (int i = 1; i < 16; ++i) mx = __builtin_fmaxf(__builtin_fmaxf(mx, t0[i]), t1[i]);
            }
            mx = fmaxf(mx, __shfl_xor(mx, 32));
            if (__any(mx - m_run > ATT_THR)) {
                const float mn = fmaxf(m_run, mx), al = __builtin_amdgcn_exp2f(m_run - mn);
#pragma unroll
                for (int i = 0; i < 16; ++i) { const float ai = __shfl(al, crow(i, hh));
#pragma unroll
                    for (int d = 0; d < 8; ++d) O[d][i] *= ai; }
                l_run *= al; m_run = mn;
            }
            float ps = 0.f;
            if (far) { const float off = bc0 - m_run;
#pragma unroll
                for (int i = 0; i < 16; ++i) { t0[i] = __builtin_amdgcn_exp2f(__builtin_fmaf(t0[i], ATT_C, off)); t1[i] = __builtin_amdgcn_exp2f(__builtin_fmaf(t1[i], ATT_C, off)); ps += t0[i] + t1[i]; }
            } else {
#pragma unroll
                for (int i = 0; i < 16; ++i) { t0[i] = __builtin_amdgcn_exp2f(t0[i] - m_run); t1[i] = __builtin_amdgcn_exp2f(t1[i] - m_run); ps += t0[i] + t1[i]; }
            }
            l_run += ps;
            bf16x8 pf[4];
            pf[0] = pack_acc(t0, 0); pf[1] = pack_acc(t0, 1); pf[2] = pack_acc(t1, 0); pf[3] = pack_acc(t1, 1);
            if (kt + 1 < ntiles) at_dma(lds, U, kt + 1, (kt + 1) & 1, w, lane);
            const int vb = (int)(unsigned)(size_t)(lds + AT_V + (kt & 1) * 32768) + v_rd_base(lv);
            asm volatile("s_waitcnt lgkmcnt(0)" ::: "memory"); at_pv_all(O, vb, pf);
        }
        asm volatile("s_waitcnt vmcnt(0)" ::: "memory");
        __syncthreads();
    }
    {
        int lv = lane; asm volatile("" : "+v"(lv)); const int c = lv & 31, hh = lv >> 5;
        l_run += __shfl_xor(l_run, 32);
        const float sc_own = (mm ? lam : 1.0f) / l_run;
        LAS float* xo = (LAS float*)lds + rt * 8192;
        if (mm == 1) {
#pragma unroll
            for (int i = 0; i < 16; ++i) { const float si = __shfl(sc_own, crow(i, hh));
#pragma unroll
                for (int d = 0; d < 8; ++d) xo[crow(i, hh) * 256 + 32 * d + c] = O[d][i] * si; }
        }
        __syncthreads();
        if (mm == 0 && active) {
            float ssa[16];
#pragma unroll
            for (int i = 0; i < 16; ++i) { const float si = __shfl(sc_own, crow(i, hh)); float a = 0.f;
#pragma unroll
                for (int d = 0; d < 8; ++d) { const float o = O[d][i] * si - xo[crow(i, hh) * 256 + 32 * d + c]; O[d][i] = o; a += o * o; }
                a += __shfl_xor(a, 1); a += __shfl_xor(a, 2); a += __shfl_xor(a, 4); a += __shfl_xor(a, 8); a += __shfl_xor(a, 16);
                ssa[i] = rsqrtf(a * (1.0f / 256.0f) + 1e-5f) * (1.0f - LAM_INIT); }
#pragma unroll
            for (int d = 0; d < 8; ++d) { const float gn = F.in[I_SUBN][32 * d + c];
#pragma unroll
                for (int i = 0; i < 16; ++i) { const int r = 32 * rt + crow(i, hh);
                    if (r < U.nq) ATT[(U.mq0 + r) * DM + U.h * 256 + 32 * d + c] = (bf16)(pk2(O[d][i] * ssa[i] * gn, 0.f) & 0xffffu); } }
        }
    }
}
DI float attn_lambda(Frame& F) {
    float d1 = 0.f, d2 = 0.f;
    for (int i = 0; i < 128; ++i) { d1 += F.in[I_LQ1][i] * F.in[I_LK1][i]; d2 += F.in[I_LQ2][i] * F.in[I_LK2][i]; }
    return __expf(d1) - __expf(d2) + LAM_INIT;
}
DI void p_attn(Frame& F) {
    const float lam = attn_lambda(F);
    const bf16* KB = (const bf16*)(F.ws + WS_KB); const bf16* VB = (const bf16*)(F.ws + WS_VB);
    constexpr int NPQ = NB * 8 * 64 / 8;
    const int xcc = (int)(xb_xcc_id() & 7u);
    for (int e = 0; e < 8; ++e) {
        const int q = (xcc + e) & 7;
        for (;;) {
            __syncthreads();
            if (F.tid == 0) F.MISC[16] = atomicAdd(F.ctl + CW_ATTQ + 32 * q, 1u);
            __syncthreads();
            const int r = __builtin_amdgcn_readfirstlane((int)F.MISC[16]);
            if (r >= NPQ) break;
            AttnUnit U; const int bh = 2 * q + (r & 1), u = 63 - (r >> 1), b = bh >> 3;
            U.h = bh & 7; U.Kp = KB + (size_t)b * SEQ * DM; U.Vp = VB + (size_t)b * SEQ * DM; U.Qp = (const bf16*)(F.ws + WS_QB); U.Op = (bf16*)(F.ws + WS_ATT);
            U.nq = 128; U.qpos0 = u * 128; U.nkeys = (u + 1) * 128; U.mq0 = (size_t)b * SEQ + (size_t)u * 128;
            attn_unit(F, U, lam);
        }
    }
}
DI void p_attn_sample(Frame& F, const int sw, const int nsw) {
    const float lam = attn_lambda(F);
    const bf16* KC = (const bf16*)(F.ws + WS_KC); const bf16* VC = (const bf16*)(F.ws + WS_VC);
    for (int p = sw; p < DECB * 8; p += nsw) {
        AttnUnit U; const int b = p >> 3; U.h = p & 7; U.Kp = KC + (size_t)b * (PAST + DECS) * DM; U.Vp = VC + (size_t)b * (PAST + DECS) * DM;
        U.Qp = (const bf16*)(F.ws + WS_SQB) - (size_t)MP * DM; U.Op = (bf16*)(F.ws + WS_SATT) - (size_t)MP * DM;
        U.nq = DECS; U.qpos0 = PAST; U.nkeys = PAST + DECS; U.mq0 = (size_t)MP + (size_t)b * DECS;
        attn_unit(F, U, lam);
    }
}
#ifndef WGM_SMALLN
#define WGM_SMALLN 4
#endif
#ifndef WGM_BIGN
#define WGM_BIGN 4
#endif
#ifndef N_LAUNCH_MODE
#define N_LAUNCH_MODE 1
#endif
constexpr int N_PHASES = 16;
struct Args { const float* in[N_IN]; float* out; unsigned char* ws; int ph_lo, ph_hi; };
static_assert(sizeof(Args) == (N_IN + 2) * 8 + 8, "Args has no padding");
__global__ void __launch_bounds__(NWAVES * 64, 2) fwd(Args args) {
    extern __shared__ __attribute__((aligned(16))) unsigned char lds_raw[];
    Frame F;
    F.lds = (LAS unsigned char*)lds_raw;
    F.MISC = (volatile LAS unsigned*)(F.lds + LDSCTL_OFF);
    F.tid = threadIdx.x; F.lane = F.tid & 63; F.wave = __builtin_amdgcn_readfirstlane(F.tid >> 6);
    F.G = gridDim.x; { const int bx = blockIdx.x; F.vcu = (F.G % 8 == 0) ? (bx % 8) * (F.G / 8) + bx / 8 : bx; }
    F.in = args.in; F.out = args.out; F.ws = args.ws; F.ctl = (unsigned*)(args.ws + WS_CTL);
    for (int u = F.tid; u < (LDS_BYTES - LDSCTL_OFF) / 4; u += NWAVES * 64) ((LAS unsigned*)(F.lds + LDSCTL_OFF))[u] = 0u;
    __syncthreads();
    XcdBarrier bar; bar.bar = F.ctl + CW_BAR; bar.x = 0; bar.st = nullptr;
    if (N_LAUNCH_MODE == 1) bar = xcd_barrier_post(F.ctl + CW_BAR, F.MISC + 8);
    const int lo = args.ph_lo, hi = args.ph_hi;
#ifndef PHASE_MASK
#define PHASE_MASK 0xffff
#endif
#define IN(k) (((PHASE_MASK >> (k)) & 1) && lo <= (k) && (k) < hi)
#ifndef TWICE_MASK
#define TWICE_MASK 0
#endif
#ifndef NREP
#define NREP 2
#endif
#ifndef SPIN_MASK
#define SPIN_MASK 0
#endif
#define SEAM(k) do { if (((SPIN_MASK >> (k)) & 1) && IN(k)) { const unsigned long long t1_ = __builtin_amdgcn_s_memrealtime(); while (__builtin_amdgcn_s_memrealtime() - t1_ < t1_ - tph_) __builtin_amdgcn_s_sleep(8); } \
    if (IN(k) && IN((k) + 1)) xcd_barrier(bar); if (SPIN_MASK) tph_ = __builtin_amdgcn_s_memrealtime(); } while (0)
#define REP(k) for (int rep_ = 0; rep_ < (((TWICE_MASK >> (k)) & 1) ? NREP : 1); ++rep_, (((TWICE_MASK >> (k)) & 1) && rep_ < NREP ? xcd_barrier(bar) : (void)0))
    unsigned long long tph_ = SPIN_MASK ? __builtin_amdgcn_s_memrealtime() : 0ull; (void)tph_;
    unsigned char* ws = args.ws;
    PG8_LAS unsigned char* ring = (PG8_LAS unsigned char*)F.lds;
    bf16* HB = (bf16*)(ws + WS_HB);
    float* H = args.out;
#define SSQP(i) ((float*)(ws + WS_SSQ + (size_t)(i) * SSQ_STRIDE))

    const int gwA = F.vcu * NWAVES + F.wave, NGWA = F.G * NWAVES;
    const bf16* UPm = (const bf16*)(ws + WS_UP); bf16* ACTm = (bf16*)(ws + WS_ACT);
    if (IN(0)) { REP(0) p0_prologue(F); } SEAM(0);
    if (IN(1)) {
        pg8::Gemm g{HB, (const bf16*)(ws + WS_WIN), M, INWP, DM}; pg8::StaticOrder S; S.init(M, INWP, F.G, (int)blockIdx.x, WGM_BIGN);
        pg8::EpiBf E{SSQP(0), (bf16*)(ws + WS_QKV), QKVW, QKVW, (bf16*)(ws + WS_Z), VW, VW, (float*)(ws + WS_BA), 64, 64};
        pg8::gemm_phase<pg8::EpiBf, pg8::StaticOrder, PG8_ALIGN, PG8_SP2>(ring, g, S, E, F.tid);
    } SEAM(1);
#ifdef GDN_REP5
    if (IN(2)) { p_gdnconv(F); p_gdnconv(F); p_gdnconv(F); p_gdnconv(F); p_gdnconv(F); } SEAM(2);
#else
    if (IN(2)) { REP(2) p_gdnconv(F); } SEAM(2);
#endif
    if (IN(3)) { REP(3) p_prep(F); } SEAM(3);
    if (IN(4)) {
        p_scan(F);
        const int nW = F.G, bx = blockIdx.x;
        const bool sub = (nW > NB * 32) ? (bx >= NB * 32) : true;
        const int sw = (nW > NB * 32) ? bx - NB * 32 : bx, nsw = (nW > NB * 32) ? nW - NB * 32 : nW;
        if (sub) {
#ifndef SUBSPIN
#define SUBSPIN 0
#endif
            unsigned long long tst_ = SUBSPIN ? __builtin_amdgcn_s_memrealtime() : 0ull; (void)tst_;
#define STG0() do { if (SUBSPIN) tst_ = __builtin_amdgcn_s_memrealtime(); } while (0)
#define STG(i) do { if ((SUBSPIN >> (i)) & 1) { const unsigned long long t1_ = __builtin_amdgcn_s_memrealtime(); while (__builtin_amdgcn_s_memrealtime() - t1_ < t1_ - tst_) __builtin_amdgcn_s_sleep(8); } } while (0)
            XcdBarrier sb = xcd_barrier_post(F.ctl + CW_BAR2, F.MISC + 12);
            const unsigned ne = (unsigned)nsw; const int gwS = sw * NWAVES + F.wave, NGWS = nsw * NWAVES;
#define UPs_ ((bf16*)(ws + WS_SUP) - (size_t)MP * UPW)
#define ACTs_ ((bf16*)(ws + WS_SACT) - (size_t)MP * DFF)
#define QBs_ ((bf16*)(ws + WS_SQB) - (size_t)MP * DM)
#define ATTs_ ((bf16*)(ws + WS_SATT) - (size_t)MP * DM)
            const int spm = MP / 256;
#define IDLE(n) (sw >= (n) && nsw > (n))
#define IGW(n) ((sw - (n)) * NWAVES + F.wave)
#define INGW(n) ((nsw - (n)) * NWAVES)
            __syncthreads();
            conv_job(F, CJ_WOUT, gwS, NGWS);
            if (nsw <= 44) { conv_job(F, CJ_WUP0, gwS, NGWS); conv_job(F, CJ_WDN0, gwS, NGWS); conv_job(F, CJ_WKVQ, gwS, NGWS); conv_job(F, CJ_WO, gwS, NGWS); conv_job(F, CJ_WUP1, gwS, NGWS); conv_job(F, CJ_WDN1, gwS, NGWS);
                p_cacheconv(F, args.in[I_CK], (bf16*)(ws + WS_KC), (size_t)sw * 512 + F.tid, (size_t)nsw * 512); p_cacheconv(F, args.in[I_CV], (bf16*)(ws + WS_VC), (size_t)sw * 512 + F.tid, (size_t)nsw * 512); }
            const bool spread = nsw > 44;
            STG(0); sub_barrier(sb, ne); asm volatile("" : "+v"(F.tid), "+v"(F.lane)); STG0();
            {
                pg8::Gemm g{(const bf16*)(args.out + O_PK), (const bf16*)(ws + WS_WOUT), M, DM, VW}; pg8::SubOrder S{spm, DM / 256, nsw, sw};
                pg8::EpiRes E{args.in[I_XS] - (size_t)MP * DM, args.in[I_XS] - (size_t)MP * DM, H, HB, SSQP(1)};
                pg8::gemm_phase<pg8::EpiRes, pg8::SubOrder, PG8_ALIGN, PG8_SP2>(ring, g, S, E, F.tid); }
            if (spread && IDLE(8)) { __syncthreads(); conv_job(F, CJ_WUP0, IGW(8), INGW(8)); }
            STG(1); sub_barrier(sb, ne); asm volatile("" : "+v"(F.tid), "+v"(F.lane)); STG0();
            {
                pg8::Gemm g{HB, (const bf16*)(ws + WS_WUP0), M, UPW, DM}; pg8::SubOrder S{spm, UPW / 256, nsw, sw};
                pg8::EpiBf E{SSQP(1), UPs_, UPW, UPW, nullptr, 0, 0, nullptr, 0, 0};
                pg8::gemm_phase<pg8::EpiBf, pg8::SubOrder, PG8_ALIGN, PG8_SP2>(ring, g, S, E, F.tid); }
            if (spread && IDLE(44)) { __syncthreads(); conv_job(F, CJ_WDN0, IGW(44), INGW(44)); conv_job(F, CJ_WKVQ, IGW(44), INGW(44)); }
            STG(2); sub_barrier(sb, ne); asm volatile("" : "+v"(F.tid), "+v"(F.lane)); STG0();
            p_ffnconv(F, 0, MP / 16, MP / 16 + DECB, gwS, NGWS, UPs_, ACTs_);
            STG(3); sub_barrier(sb, ne); asm volatile("" : "+v"(F.tid), "+v"(F.lane)); STG0();
            {
                pg8::Gemm g{ACTs_, (const bf16*)(ws + WS_WDN0), M, DM, DFF}; pg8::SubOrder S{spm, DM / 256, nsw, sw};
                pg8::EpiRes E{H, H, H, HB, SSQP(2)};
                pg8::gemm_phase<pg8::EpiRes, pg8::SubOrder, PG8_ALIGN, PG8_SP2>(ring, g, S, E, F.tid); }
            if (spread && IDLE(8)) p_cacheconv(F, args.in[I_CK], (bf16*)(ws + WS_KC), (size_t)(sw - 8) * 512 + F.tid, (size_t)(nsw - 8) * 512);
            STG(4); sub_barrier(sb, ne); asm volatile("" : "+v"(F.tid), "+v"(F.lane)); STG0();
            {
                pg8::Gemm g{HB, (const bf16*)(ws + WS_WKVQ), M, 6144, DM}; pg8::SubOrder S{spm, 6144 / 256, nsw, sw};
                pg8::EpiKVQs E{SSQP(2), args.out, (bf16*)(ws + WS_KC), (WS_VC - WS_KC) / 2, QBs_};
                pg8::gemm_phase<pg8::EpiKVQs, pg8::SubOrder, PG8_ALIGN, PG8_SP2>(ring, g, S, E, F.tid); }
            if (spread && IDLE(24)) p_cacheconv(F, args.in[I_CV], (bf16*)(ws + WS_VC), (size_t)(sw - 24) * 512 + F.tid, (size_t)(nsw - 24) * 512);
            STG(5); sub_barrier(sb, ne); asm volatile("" : "+v"(F.tid), "+v"(F.lane)); STG0();
            p_attn_sample(F, sw, nsw);
            if (spread && IDLE(128)) { __syncthreads(); conv_job(F, CJ_WO, IGW(128), INGW(128)); conv_job(F, CJ_WUP1, IGW(128), INGW(128)); conv_job(F, CJ_WDN1, IGW(128), INGW(128)); }
            else if (spread && nsw <= 128) { __syncthreads(); conv_job(F, CJ_WO, gwS, NGWS); conv_job(F, CJ_WUP1, gwS, NGWS); conv_job(F, CJ_WDN1, gwS, NGWS); }
            STG(6); sub_barrier(sb, ne); asm volatile("" : "+v"(F.tid), "+v"(F.lane)); STG0();
        }
    } SEAM(4);
    if (IN(5)) {
        pg8::Gemm g{(const bf16*)(args.out + O_PK), (const bf16*)(ws + WS_WOUT), MP, DM, VW}; pg8::StaticOrder S; S.init(MP, DM, F.G, (int)blockIdx.x, WGM_SMALLN);
        pg8::EpiRes E{args.in[I_XP], args.in[I_XP], H, HB, SSQP(1)};
        pg8::gemm_phase<pg8::EpiRes, pg8::StaticOrder, PG8_ALIGN, PG8_SP2>(ring, g, S, E, F.tid);
    } SEAM(5);
    if (IN(6)) {
        pg8::Gemm g{HB, (const bf16*)(ws + WS_WUP0), MP, UPW, DM}; pg8::StaticOrder S; S.init(MP, UPW, F.G, (int)blockIdx.x, WGM_BIGN);
        pg8::EpiBf E{SSQP(1), (bf16*)(ws + WS_UP), UPW, UPW, nullptr, 0, 0, nullptr, 0, 0};
        pg8::gemm_phase<pg8::EpiBf, pg8::StaticOrder, PG8_ALIGN, PG8_SP2>(ring, g, S, E, F.tid);
    } SEAM(6);
#ifndef EXTRA_BAR
#define EXTRA_BAR 0
#endif
#ifdef FFN_REP5
    if (IN(7)) { { int g_ = gwA; asm volatile("" : "+s"(g_)); p_ffnconv(F, 0, 0, MP / 16, g_, NGWA, UPm, ACTm); } { int g_ = gwA; asm volatile("" : "+s"(g_)); p_ffnconv(F, 0, 0, MP / 16, g_, NGWA, UPm, ACTm); } { int g_ = gwA; asm volatile("" : "+s"(g_)); p_ffnconv(F, 0, 0, MP / 16, g_, NGWA, UPm, ACTm); } { int g_ = gwA; asm volatile("" : "+s"(g_)); p_ffnconv(F, 0, 0, MP / 16, g_, NGWA, UPm, ACTm); } { int g_ = gwA; asm volatile("" : "+s"(g_)); p_ffnconv(F, 0, 0, MP / 16, g_, NGWA, UPm, ACTm); } } SEAM(7);
#else
    if (IN(7)) { for (int eb_ = 0; eb_ < EXTRA_BAR; ++eb_) xcd_barrier(bar); REP(7) p_ffnconv(F, 0, 0, MP / 16, gwA, NGWA, UPm, ACTm); } SEAM(7);
#endif
    if (IN(8)) {
        pg8::Gemm g{(const bf16*)(ws + WS_ACT), (const bf16*)(ws + WS_WDN0), MP, DM, DFF}; pg8::StaticOrder S; S.init(MP, DM, F.G, (int)blockIdx.x, WGM_SMALLN);
        pg8::EpiRes E{H, H, H, HB, SSQP(2)};
        pg8::gemm_phase<pg8::EpiRes, pg8::StaticOrder, PG8_ALIGN, PG8_SP2>(ring, g, S, E, F.tid);
    } SEAM(8);
    if (IN(9)) {
        pg8::Gemm g{HB, (const bf16*)(ws + WS_WKVQ), MP, 6144, DM}; pg8::StaticOrder S; S.init(MP, 6144, F.G, (int)blockIdx.x, WGM_BIGN);
        pg8::EpiKVQ E{SSQP(2), args.out, (bf16*)(ws + WS_KB), (WS_VB - WS_KB) / 2, (bf16*)(ws + WS_KC), (WS_VC - WS_KC) / 2};
        static_assert(WS_QB - WS_VB == WS_VB - WS_KB, "K, V, Q bf16 buffers equally spaced");
        pg8::gemm_phase<pg8::EpiKVQ, pg8::StaticOrder, PG8_ALIGN, PG8_SP2>(ring, g, S, E, F.tid);
    } SEAM(9);
    if (IN(10)) {
        const int nsb = F.G < 8 ? F.G : 8;
        if ((int)blockIdx.x < nsb) {
            XcdBarrier sb3 = xcd_barrier_post(F.ctl + CW_BAR3, F.MISC + 14);
            const int spm = MP / 256;
            {
                pg8::Gemm g{ATTs_, (const bf16*)(ws + WS_WO), M, DM, DM}; pg8::SubOrder S{spm, DM / 256, nsb, (int)blockIdx.x};
                pg8::EpiRes E{H, H, H, HB, SSQP(3)};
                pg8::gemm_phase<pg8::EpiRes, pg8::SubOrder, PG8_ALIGN, PG8_SP2>(ring, g, S, E, F.tid); }
            sub_barrier(sb3, (unsigned)nsb); asm volatile("" : "+v"(F.tid), "+v"(F.lane));
            {
                pg8::Gemm g{HB, (const bf16*)(ws + WS_WUP1), M, UPW, DM}; pg8::SubOrder S{spm, UPW / 256, nsb, (int)blockIdx.x};
                pg8::EpiBf E{SSQP(3), UPs_, UPW, UPW, nullptr, 0, 0, nullptr, 0, 0};
                pg8::gemm_phase<pg8::EpiBf, pg8::SubOrder, PG8_ALIGN, PG8_SP2>(ring, g, S, E, F.tid); }
            sub_barrier(sb3, (unsigned)nsb); asm volatile("" : "+v"(F.tid), "+v"(F.lane));
            p_ffnconv(F, 1, MP / 16, MP / 16 + DECB, (int)blockIdx.x * NWAVES + F.wave, nsb * NWAVES, UPs_, ACTs_);
            sub_barrier(sb3, (unsigned)nsb); asm volatile("" : "+v"(F.tid), "+v"(F.lane));
            {
                pg8::Gemm g{ACTs_, (const bf16*)(ws + WS_WDN1), M, DM, DFF}; pg8::SubOrder S{spm, DM / 256, nsb, (int)blockIdx.x};
                pg8::EpiRes E{H, H, H, nullptr, SSQP(4)};
                pg8::gemm_phase<pg8::EpiRes, pg8::SubOrder, PG8_ALIGN, PG8_SP2>(ring, g, S, E, F.tid); }
            sub_barrier(sb3, (unsigned)nsb); asm volatile("" : "+v"(F.tid), "+v"(F.lane));
            p_final(F, MP, M, (int)blockIdx.x * NWAVES + F.wave, nsb * NWAVES);
        }
        p_attn(F);
    } SEAM(10);
    if (IN(11)) {
        pg8::Gemm g{(const bf16*)(ws + WS_ATT), (const bf16*)(ws + WS_WO), MP, DM, DM}; pg8::StaticOrder S; S.init(MP, DM, F.G, (int)blockIdx.x, WGM_SMALLN);
        pg8::EpiRes E{H, H, H, HB, SSQP(3)};
        pg8::gemm_phase<pg8::EpiRes, pg8::StaticOrder, PG8_ALIGN, PG8_SP2>(ring, g, S, E, F.tid);
    } SEAM(11);
    if (IN(12)) {
        pg8::Gemm g{HB, (const bf16*)(ws + WS_WUP1), MP, UPW, DM}; pg8::StaticOrder S; S.init(MP, UPW, F.G, (int)blockIdx.x, WGM_BIGN);
        pg8::EpiBf E{SSQP(3), (bf16*)(ws + WS_UP), UPW, UPW, nullptr, 0, 0, nullptr, 0, 0};
        pg8::gemm_phase<pg8::EpiBf, pg8::StaticOrder, PG8_ALIGN, PG8_SP2>(ring, g, S, E, F.tid);
    } SEAM(12);
    if (IN(13)) { p_ffnconv(F, 1, 0, MP / 16, gwA, NGWA, UPm, ACTm); } SEAM(13);
    if (IN(14)) {
        pg8::Gemm g{(const bf16*)(ws + WS_ACT), (const bf16*)(ws + WS_WDN1), MP, DM, DFF}; pg8::StaticOrder S; S.init(MP, DM, F.G, (int)blockIdx.x, WGM_SMALLN);
        pg8::EpiRes E{H, H, H, nullptr, SSQP(4)};
        pg8::gemm_phase<pg8::EpiRes, pg8::StaticOrder, PG8_ALIGN, PG8_SP2>(ring, g, S, E, F.tid);
    } SEAM(14);
    if (IN(15)) { p_final(F, 0, MP, gwA, NGWA); }
#undef IN
#undef SEAM
}

extern "C" void kernel_launch(void* const* d_in, const int* in_sizes, int n_in, void* d_out, int out_size, void* d_ws, size_t ws_size, hipStream_t stream) {
    static int grid = 0;
    if (grid == 0) {
        if (n_in != N_IN || (size_t)out_size != O_END || ws_size < WS_END) { fprintf(stderr, "kernel_launch: shape mismatch: n_in %d out %d ws %zu (need %zu)\n", n_in, out_size, ws_size, (size_t)WS_END); grid = -1; return; }
        int dev = 0, cus = 0;
        if (hipGetDevice(&dev) != hipSuccess || hipDeviceGetAttribute(&cus, hipDeviceAttributeMultiprocessorCount, dev) != hipSuccess) { grid = -1; return; }
        if (hipFuncSetAttribute((const void*)fwd, hipFuncAttributeMaxDynamicSharedMemorySize, LDS_BYTES) != hipSuccess) { fprintf(stderr, "kernel_launch: hipFuncSetAttribute failed\n"); grid = -1; return; }
        int per_cu = 0;
        if (hipOccupancyMaxActiveBlocksPerMultiprocessor(&per_cu, (const void*)fwd, NWAVES * 64, LDS_BYTES) != hipSuccess || per_cu < 1) fprintf(stderr, "kernel_launch: occupancy query reports %d\n", per_cu);
        (void)hipGetLastError();
        grid = cus;
    }
    if (grid < 0) return;
    (void)hipMemsetAsync((char*)d_ws + WS_CTL, 0, CTL_ZERO_BYTES, stream);
    Args a{};
    for (int i = 0; i < N_IN; ++i) a.in[i] = (const float*)d_in[i];
    a.out = (float*)d_out; a.ws = (unsigned char*)d_ws;
    if (N_LAUNCH_MODE == 1) { a.ph_lo = 0; a.ph_hi = N_PHASES; hipLaunchKernelGGL(fwd, dim3(grid), dim3(NWAVES * 64), LDS_BYTES, stream, a); }
    else for (int p = 0; p < N_PHASES; ++p) { a.ph_lo = p; a.ph_hi = p + 1; hipLaunchKernelGGL(fwd, dim3(grid), dim3(NWAVES * 64), LDS_BYTES, stream, a); }
    const hipError_t le = hipPeekAtLastError();
    if (le != hipSuccess) fprintf(stderr, "kernel_launch: launch failed: %s\n", hipGetErrorName(le));
}
```

```cpp
#include <hip/hip_runtime.h>
#include <cstdio>
#include <cstdint>

constexpr int DM = 2048;
constexpr int SEQ = 8192, NB = 2, MP = NB * SEQ;
constexpr int DECB = 16, DECS = 16, MS = DECB * DECS;
constexpr int PAST = 2048;
constexpr int M = MP + MS;
constexpr int QKVW = 8192, VW = 4096, INW = 12352, INWP = 12544;
constexpr int DFF = 5632, UPW = 11264;
constexpr int NITEM_P = NB * 128 * 32, NITEM = NITEM_P + DECB * 32;
constexpr size_t O_Y = 0, O_PGDN = 34078720, O_PGC = 35127296, O_PFC = 35176448, O_PK = 35266560, O_PV = 68820992,
                 O_SGDN = 102375424, O_SGC = 110764032, O_SFC = 111157248, O_SK = 111878144, O_SV = 112402432, O_END = 112926720;
namespace pg8 {
#define PG8_LAS __attribute__((address_space(3)))
typedef unsigned short bf16_t;
typedef short bf16x8 __attribute__((ext_vector_type(8)));
typedef float f32x4 __attribute__((ext_vector_type(4)));
typedef unsigned u32x4 __attribute__((ext_vector_type(4)));
constexpr int BM = 256, BK = 64, HALF = 128, HTB = HALF * BK * 2  , STAGE_BYTES = 8 * HTB, NXCD = 8, WGM = 4;

__host__ __device__ __forceinline__ int lds_byte(int r, int c) { const int st = (r >> 4) * 2 + (c >> 5), rr = r & 15, cc = c & 31, ob = rr * 64 + cc * 2; return st * 1024 + (ob ^ (((ob >> 9) & 1) << 5)); }
__host__ __device__ __forceinline__ void stage_rc(int b, int& R, int& C) { const int st = b / 1024, sb = b % 1024, swz = sb ^ (((sb >> 9) & 1) << 5); R = (st >> 1) * 16 + swz / 64; C = (st & 1) * 32 + (swz % 64) / 2; }
__host__ __device__ __forceinline__ int perm32(int rho) { const int n = rho >> 4, i = rho & 15; return 8 * (i >> 2) + 4 * n + (i & 3); }

struct Unit { int pm, pn; };
struct Gemm { const bf16_t* A; const bf16_t* Bt; int M, N, K; };

struct StaticOrder {
    int nM, nN, nwg, G, c, wgm;
    __host__ __device__ void init(int M, int N, int G_, int c_, int wgm_ = WGM) { nM = M / BM; nN = N / BM; nwg = nM * nN; G = G_; c = c_; wgm = wgm_; }
    __host__ __device__ bool next(int i, Unit& u) const {
        const long L = (long)i * G + c; if (L >= nwg) return false;
        int wgid = (int)L; { const int q = nwg / NXCD, r = nwg % NXCD, xcd = wgid % NXCD, off = wgid / NXCD; wgid = (xcd < r ? xcd * (q + 1) : r * (q + 1) + (xcd - r) * q) + off; }
        const int nig = wgm * nN, gid = wgid / nig, fm = gid * wgm, gsz = (nM - fm) < wgm ? (nM - fm) : wgm;
        u.pm = fm + ((wgid % nig) % gsz); u.pn = (wgid % nig) / gsz; return true;
    }
    __device__ __forceinline__ void a_ready(const Unit&) const {}
    __device__ __forceinline__ void done(const Unit&) const {}
};

typedef float f32x2 __attribute__((ext_vector_type(2)));
typedef __bf16 bf16v2 __attribute__((ext_vector_type(2)));
typedef unsigned u32x2 __attribute__((ext_vector_type(2)));
__device__ __forceinline__ unsigned cvt_pk_bf16(float lo, float hi) { const f32x2 v = {lo, hi}; return __builtin_bit_cast(unsigned, __builtin_convertvector(v, bf16v2)); }

__device__ __forceinline__ void row_rstd(const float* ssq, int row0, int fq, float (&rs)[2][4]) {
    asm volatile("" : "+v"(row0), "+v"(fq));
#pragma unroll
    for (int ai = 0; ai < 2; ++ai)
#pragma unroll
        for (int m = 0; m < 4; ++m) {
            const float* p = ssq + (size_t)(row0 + ai * HALF + m * 16) * 32 + fq * 8;
            const f32x4 a = *(const f32x4*)p, b = *(const f32x4*)(p + 4);
            float s = ((a[0] + a[1]) + (a[2] + a[3])) + ((b[0] + b[1]) + (b[2] + b[3]));
            s += __shfl_xor(s, 16); s += __shfl_xor(s, 32);
            rs[ai][m] = rsqrtf(s * (1.0f / 2048.0f) + 1e-6f);
        }
}
struct EpiBf {
    static constexpr bool PERM = true, AFTER_DRAIN = false;
    const float* ssq; bf16_t* O0; int ld0, nc0; bf16_t* O1; int ld1, nc1; float* F2; int ld2, nc2;
    __device__ __forceinline__ void operator()(const f32x4 (&acc)[2][2][4][2], const Unit& u, int wr, int wc, int fr, int fq) const {
        asm volatile("" : "+v"(fr), "+v"(fq));
        const int row0 = u.pm * BM + wr * 64 + fr; const int colt = u.pn * BM;
        float rs[2][4]; row_rstd(ssq, row0, fq, rs);
        if (colt < nc0 + nc1) {
            bf16_t* base; int ld;
            if (colt < nc0) { base = O0 + colt; ld = ld0; } else { base = O1 + (colt - nc0); ld = ld1; }
            const int col0 = wc * 32 + 8 * fq;
#pragma unroll
            for (int ai = 0; ai < 2; ++ai)
#pragma unroll
                for (int m = 0; m < 4; ++m) { bf16_t* rowp = base + (size_t)(row0 + ai * HALF + m * 16) * ld + col0; const float r = rs[ai][m];
#pragma unroll
                    for (int bj = 0; bj < 2; ++bj) { const f32x4 v0 = acc[ai][bj][m][0] * r, v1 = acc[ai][bj][m][1] * r;
                        u32x4 w; w.x = cvt_pk_bf16(v0[0], v0[1]); w.y = cvt_pk_bf16(v0[2], v0[3]); w.z = cvt_pk_bf16(v1[0], v1[1]); w.w = cvt_pk_bf16(v1[2], v1[3]);
                        __builtin_nontemporal_store(w, (u32x4*)(rowp + bj * HALF)); } }
        } else if (colt == nc0 + nc1 && F2 != nullptr && wc * 32 < nc2) {
#pragma unroll
            for (int ai = 0; ai < 2; ++ai)
#pragma unroll
                for (int m = 0; m < 4; ++m) { float* rowp = F2 + (size_t)(row0 + ai * HALF + m * 16) * ld2 + wc * 32 + 8 * fq; const float r = rs[ai][m];
                    *(f32x4*)(rowp) = acc[ai][0][m][0] * r; *(f32x4*)(rowp + 4) = acc[ai][0][m][1] * r; }
        }
    }
};
struct EpiRes {
    static constexpr bool PERM = false, AFTER_DRAIN = false;
    const float* base0; const float* base1; float* out; bf16_t* hb; float* ssq;
    __device__ __forceinline__ void operator()(const f32x4 (&acc)[2][2][4][2], const Unit& u, int wr, int wc, int fr, int fq) const {
        asm volatile("" : "+v"(fr), "+v"(fq));
        const int row0 = u.pm * BM + wr * 64 + fr, col0 = u.pn * BM + wc * 32 + 4 * fq;
        const float* bs = (u.pm * BM < MP) ? base0 : base1;
#pragma unroll
        for (int ai = 0; ai < 2; ++ai)
#pragma unroll
            for (int m = 0; m < 4; ++m) { const size_t off = (size_t)(row0 + ai * HALF + m * 16) * DM + col0; float ss = 0.f;
#pragma unroll
                for (int bj = 0; bj < 2; ++bj)
#pragma unroll
                    for (int n = 0; n < 2; ++n) { const size_t o2 = off + bj * HALF + n * 16; const f32x4 o = __builtin_nontemporal_load((const f32x4*)(bs + o2)) + acc[ai][bj][m][n];
                        __builtin_nontemporal_store(o, (f32x4*)(out + o2)); ss += (o[0] * o[0] + o[1] * o[1]) + (o[2] * o[2] + o[3] * o[3]);
                        if (hb) { u32x2 w; w.x = cvt_pk_bf16(o[0], o[1]); w.y = cvt_pk_bf16(o[2], o[3]); *(u32x2*)(hb + o2) = w; } }
                ss += __shfl_xor(ss, 16); ss += __shfl_xor(ss, 32);
                if (fq == 0) ssq[(size_t)(row0 + ai * HALF + m * 16) * 32 + u.pn * 4 + wc] = ss; }
    }
};
struct EpiKVQ {
    static constexpr bool PERM = false, AFTER_DRAIN = false;
    const float* ssq; float* dout; bf16_t* KB; size_t kvq_stride; bf16_t* KC; size_t kc_stride;
    __device__ __forceinline__ void operator()(const f32x4 (&acc)[2][2][4][2], const Unit& u, int wr, int wc, int fr, int fq) const {
        asm volatile("" : "+v"(fr), "+v"(fq));
        const int row0 = u.pm * BM + wr * 64 + fr; const int colt = u.pn * BM, which = colt >> 11, cb = (colt & 2047) + wc * 32 + 4 * fq;
        float rs[2][4]; row_rstd(ssq, row0, fq, rs);
        bf16_t* bb = KB + (size_t)which * kvq_stride;
        float* fo = nullptr;
        if (which < 2) fo = (u.pm * BM < MP) ? dout + O_PK + (size_t)which * (O_PV - O_PK) : dout + O_SK + (size_t)which * (O_SV - O_SK) - (size_t)MP * DM;
#pragma unroll
        for (int ai = 0; ai < 2; ++ai)
#pragma unroll
            for (int m = 0; m < 4; ++m) { const size_t off = (size_t)(row0 + ai * HALF + m * 16) * DM + cb; const float r = rs[ai][m];
#pragma unroll
                for (int bj = 0; bj < 2; ++bj)
#pragma unroll
                    for (int n = 0; n < 2; ++n) { const size_t o2 = off + bj * HALF + n * 16; const f32x4 o = acc[ai][bj][m][n] * r;
                        if (fo) __builtin_nontemporal_store(o, (f32x4*)(fo + o2));
                        u32x2 w; w.x = cvt_pk_bf16(o[0], o[1]); w.y = cvt_pk_bf16(o[2], o[3]); *(u32x2*)(bb + o2) = w;
                        if (which < 2 && u.pm * BM >= MP) { const int ms = row0 + ai * HALF + m * 16 - MP;
                            *(u32x2*)(KC + (size_t)which * kc_stride + ((size_t)(ms >> 4) * (2048 + 16) + 2048 + (ms & 15)) * DM + cb + bj * HALF + n * 16) = w; } } }
    }
};

struct EpiKVQs {
    static constexpr bool PERM = false, AFTER_DRAIN = false;
    const float* ssq; float* dout; bf16_t* KC; size_t kc_stride; bf16_t* Qs;
    __device__ __forceinline__ void operator()(const f32x4 (&acc)[2][2][4][2], const Unit& u, int wr, int wc, int fr, int fq) const {
        asm volatile("" : "+v"(fr), "+v"(fq));
        const int row0 = u.pm * BM + wr * 64 + fr; const int colt = u.pn * BM, which = colt >> 11, cb = (colt & 2047) + wc * 32 + 4 * fq;
        float rs[2][4]; row_rstd(ssq, row0, fq, rs);
        float* fo = (which < 2) ? dout + O_SK + (size_t)which * (O_SV - O_SK) - (size_t)MP * DM : nullptr;
#pragma unroll
        for (int ai = 0; ai < 2; ++ai)
#pragma unroll
            for (int m = 0; m < 4; ++m) { const int row = row0 + ai * HALF + m * 16, ms = row - MP; const size_t off = (size_t)row * DM + cb; const float r = rs[ai][m];
#pragma unroll
                for (int bj = 0; bj < 2; ++bj)
#pragma unroll
                    for (int n = 0; n < 2; ++n) { const size_t o2 = off + bj * HALF + n * 16; const f32x4 o = acc[ai][bj][m][n] * r;
                        u32x2 w; w.x = cvt_pk_bf16(o[0], o[1]); w.y = cvt_pk_bf16(o[2], o[3]);
                        if (which < 2) { *(f32x4*)(fo + o2) = o; *(u32x2*)(KC + (size_t)which * kc_stride + ((size_t)(ms >> 4) * (2048 + 16) + 2048 + (ms & 15)) * DM + cb + bj * HALF + n * 16) = w; }
                        else *(u32x2*)(Qs + o2) = w; } }
    }
};
struct SubOrder {
    int pm, nN, G, c;
    __host__ __device__ bool next(int i, Unit& u) const { const int L = i * G + c; if (L >= nN) return false; u.pm = pm; u.pn = L; return true; }
    __device__ __forceinline__ void a_ready(const Unit&) const {}
    __device__ __forceinline__ void done(const Unit&) const {}
};
template <class Epi, class Sched, bool ALIGN_EPI = false, bool SP2 = false>
__device__ __forceinline__ void gemm_phase(PG8_LAS unsigned char* lds, const Gemm g, const Sched& S, const Epi& E, int tid) {
    asm volatile("" : "+v"(tid));
    const int wid = __builtin_amdgcn_readfirstlane(tid >> 6), lane = tid & 63, wr = wid >> 2, wc = wid & 3, fr = lane & 15, fq = lane >> 4;
    const int K = g.K, nt = K / BK;
    unsigned voffA[2], voffB[2];
#pragma unroll
    for (int i = 0; i < 2; ++i) { int R, C; stage_rc(tid * 16 + i * 8192, R, C); const int Rb = Epi::PERM ? ((R & ~31) + perm32(R & 31)) : R;
        voffA[i] = (unsigned)(R * K + C) * 2u; voffB[i] = (unsigned)(Rb * K + C) * 2u; }
    const size_t kstep = (size_t)(BK * 2);
    const size_t hstep = (size_t)HALF * K * 2;
    const size_t tstep = 2 * hstep;
    const unsigned ldsw = (unsigned)wid * 1024u;
    const int aoff = lds_byte(wr * 64 + fr, fq * 8), boff = lds_byte(wc * 32 + fr, fq * 8);
#define PG8_SA(b, h) (((b) * 2 + (h)) * HTB)
#define PG8_SB(b, h) ((4 + (b) * 2 + (h)) * HTB)
#define PG8_STAGE(bufoff, gbase, voff) do { _Pragma("unroll") for (int _i = 0; _i < 2; ++_i) \
        __builtin_amdgcn_global_load_lds((const unsigned*)((const char*)(gbase) + (voff)[_i]), (PG8_LAS unsigned*)(lds + (bufoff) + ldsw + _i * 8192), 16, 0, 0); } while (0)
#define PG8_LDA(dst, b, h) do { _Pragma("unroll") for (int m = 0; m < 4; ++m) _Pragma("unroll") for (int k = 0; k < 2; ++k) dst[m][k] = *(const PG8_LAS bf16x8*)(lds + PG8_SA(b, h) + aoff + m * 2048 + k * 1024); } while (0)
#define PG8_LDB(dst, b, h) do { _Pragma("unroll") for (int n = 0; n < 2; ++n) _Pragma("unroll") for (int k = 0; k < 2; ++k) dst[n][k] = *(const PG8_LAS bf16x8*)(lds + PG8_SB(b, h) + boff + n * 2048 + k * 1024); } while (0)
#define PG8_MMA(ai, bj, At, Bt) do { __builtin_amdgcn_s_setprio(1); _Pragma("unroll") for (int m = 0; m < 4; ++m) _Pragma("unroll") for (int n = 0; n < 2; ++n) _Pragma("unroll") for (int k = 0; k < 2; ++k) \
        acc[ai][bj][m][n] = __builtin_amdgcn_mfma_f32_16x16x32_bf16(Bt[n][k], At[m][k], acc[ai][bj][m][n], 0, 0, 0); __builtin_amdgcn_s_setprio(0); } while (0)
#define PG8_WAIT_V(n) asm volatile("s_waitcnt vmcnt(" #n ")" ::: "memory")
#define PG8_WAIT_L(n) asm volatile("s_waitcnt lgkmcnt(" #n ")" ::: "memory")
#define PG8_BAR __builtin_amdgcn_s_barrier()
#define PG8_SCHED __builtin_amdgcn_sched_barrier(0)
    Unit cur, nxt; int ui = 0;
    if (!S.next(0, cur)) return;
    f32x4 acc[2][2][4][2];
#pragma unroll
    for (int a = 0; a < 2; ++a)
#pragma unroll
        for (int b = 0; b < 2; ++b)
#pragma unroll
            for (int m = 0; m < 4; ++m)
#pragma unroll
                for (int n = 0; n < 2; ++n) acc[a][b][m][n] = (f32x4){0.f, 0.f, 0.f, 0.f};
    bf16x8 At[4][2], B0[2][2], B1[2][2];
    const char* cA = (const char*)g.A + (size_t)cur.pm * tstep; const char* cB = (const char*)g.Bt + (size_t)cur.pn * tstep;
    S.a_ready(cur);
    if constexpr (SP2) {
        PG8_STAGE(PG8_SB(0, 0), cB, voffB); PG8_STAGE(PG8_SB(0, 1), cB + hstep, voffB); PG8_STAGE(PG8_SA(0, 0), cA, voffA); PG8_STAGE(PG8_SA(0, 1), cA + hstep, voffA);
        if (wr == 1) PG8_BAR;
        PG8_WAIT_V(2); PG8_BAR;
        PG8_STAGE(PG8_SB(1, 0), cB + kstep, voffB); PG8_STAGE(PG8_SA(1, 0), cA + kstep, voffA); PG8_STAGE(PG8_SB(1, 1), cB + hstep + kstep, voffB);
        PG8_WAIT_V(6); PG8_BAR;
    } else {
        PG8_STAGE(PG8_SB(0, 0), cB, voffB); PG8_STAGE(PG8_SA(0, 0), cA, voffA); PG8_STAGE(PG8_SB(0, 1), cB + hstep, voffB); PG8_STAGE(PG8_SA(0, 1), cA + hstep, voffA);
        if (wr == 1) PG8_BAR;
        PG8_WAIT_V(4); PG8_BAR;
        PG8_STAGE(PG8_SB(1, 0), cB + kstep, voffB); PG8_STAGE(PG8_SA(1, 0), cA + kstep, voffA); PG8_STAGE(PG8_SB(1, 1), cB + hstep + kstep, voffB);
        PG8_WAIT_V(6); PG8_BAR;
    }
    for (;;) {
        const bool has_next = S.next(ui + 1, nxt);
        const char* nA = has_next ? (const char*)g.A + (size_t)nxt.pm * tstep : cA; const char* nB = has_next ? (const char*)g.Bt + (size_t)nxt.pn * tstep : cB;
        for (int t = 0; t < nt; t += 2) {
            const bool last = (t == nt - 2);
            const char* a1 = cA + (size_t)(t + 1) * kstep;
            const char* a2 = last ? nA : cA + (size_t)(t + 2) * kstep; const char* b2 = last ? nB : cB + (size_t)(t + 2) * kstep;
            const char* a3 = a2 + kstep; const char* b3 = b2 + kstep;
            if (last && has_next) S.a_ready(nxt);
            if constexpr (SP2) {
            PG8_LDB(B0, 0, 0); PG8_LDB(B1, 0, 1); PG8_SCHED; PG8_LDA(At, 0, 0); PG8_STAGE(PG8_SA(1, 1), a1 + hstep, voffA);
            PG8_WAIT_V(8); PG8_WAIT_L(0); PG8_BAR; PG8_MMA(0, 0, At, B0); PG8_MMA(0, 1, At, B1); PG8_BAR; PG8_SCHED;
            PG8_LDA(At, 0, 1); PG8_STAGE(PG8_SB(0, 0), b2, voffB); PG8_STAGE(PG8_SB(0, 1), b2 + hstep, voffB); PG8_STAGE(PG8_SA(0, 0), a2, voffA);
            PG8_WAIT_V(8); PG8_WAIT_L(0); PG8_BAR; PG8_MMA(1, 0, At, B0); PG8_MMA(1, 1, At, B1); PG8_BAR; PG8_SCHED;
            PG8_LDB(B0, 1, 0); PG8_LDB(B1, 1, 1); PG8_SCHED; PG8_LDA(At, 1, 0); PG8_STAGE(PG8_SA(0, 1), a2 + hstep, voffA);
            PG8_WAIT_V(8); PG8_WAIT_L(0); PG8_BAR; PG8_MMA(0, 0, At, B0); PG8_MMA(0, 1, At, B1); PG8_BAR; PG8_SCHED;
            PG8_LDA(At, 1, 1); PG8_STAGE(PG8_SB(1, 0), b3, voffB); PG8_STAGE(PG8_SB(1, 1), b3 + hstep, voffB); PG8_STAGE(PG8_SA(1, 0), a3, voffA);
            PG8_WAIT_V(8); PG8_WAIT_L(0); PG8_BAR; PG8_MMA(1, 0, At, B0); PG8_MMA(1, 1, At, B1); PG8_BAR; PG8_SCHED;
            } else {
            PG8_LDB(B0, 0, 0); PG8_SCHED; PG8_LDA(At, 0, 0); PG8_STAGE(PG8_SA(1, 1), a1 + hstep, voffA);
            PG8_WAIT_L(8); PG8_BAR; PG8_WAIT_L(0); PG8_MMA(0, 0, At, B0); PG8_BAR; PG8_SCHED;
            PG8_LDB(B1, 0, 1); PG8_STAGE(PG8_SB(0, 0), b2, voffB);
            PG8_BAR; PG8_WAIT_L(0); PG8_MMA(0, 1, At, B1); PG8_BAR;
            PG8_LDA(At, 0, 1); PG8_STAGE(PG8_SA(0, 0), a2, voffA);
            PG8_BAR; PG8_WAIT_L(0); PG8_MMA(1, 0, At, B0); PG8_BAR; PG8_SCHED;
            PG8_STAGE(PG8_SB(0, 1), b2 + hstep, voffB);
            PG8_WAIT_V(6); PG8_BAR; PG8_MMA(1, 1, At, B1); PG8_BAR;
            PG8_LDB(B0, 1, 0); PG8_SCHED; PG8_LDA(At, 1, 0); PG8_STAGE(PG8_SA(0, 1), a2 + hstep, voffA);
            PG8_WAIT_L(8); PG8_BAR; PG8_WAIT_L(0); PG8_MMA(0, 0, At, B0); PG8_BAR; PG8_SCHED;
            PG8_LDB(B1, 1, 1); PG8_STAGE(PG8_SB(1, 0), b3, voffB);
            PG8_BAR; PG8_WAIT_L(0); PG8_MMA(0, 1, At, B1); PG8_BAR;
            PG8_LDA(At, 1, 1); PG8_STAGE(PG8_SA(1, 0), a3, voffA);
            PG8_BAR; PG8_WAIT_L(0); PG8_MMA(1, 0, At, B0); PG8_BAR; PG8_SCHED;
            PG8_STAGE(PG8_SB(1, 1), b3 + hstep, voffB);
            PG8_WAIT_V(6); PG8_BAR; PG8_MMA(1, 1, At, B1); PG8_BAR;
            }
        }
        if constexpr (ALIGN_EPI) { if (wr == 0) PG8_BAR; }
        if constexpr (!Epi::AFTER_DRAIN) { E(acc, cur, wr, wc, fr, fq); S.done(cur); }
        if (!has_next) break;
#pragma unroll
        for (int a = 0; a < 2; ++a)
#pragma unroll
            for (int b = 0; b < 2; ++b)
#pragma unroll
                for (int m = 0; m < 4; ++m)
#pragma unroll
                    for (int n = 0; n < 2; ++n) acc[a][b][m][n] = (f32x4){0.f, 0.f, 0.f, 0.f};
        cur = nxt; cA = nA; cB = nB; ++ui;
        if constexpr (ALIGN_EPI) { if (wr == 1) PG8_BAR; }
    }
    PG8_WAIT_V(0);
    if constexpr (!ALIGN_EPI) { if (wr == 0) PG8_BAR; }
    PG8_BAR;
    if constexpr (Epi::AFTER_DRAIN) { E.fused(acc, cur, wr, wc, fr, fq, lds, wid, lane); S.done(cur); }
#undef PG8_SA
#undef PG8_SB
#undef PG8_STAGE
#undef PG8_LDA
#undef PG8_LDB
#undef PG8_MMA
#undef PG8_WAIT_V
#undef PG8_WAIT_L
#undef PG8_BAR
#undef PG8_SCHED
}
}
#ifndef PG8_SP2
#define PG8_SP2 true
#endif
#ifndef PG8_ALIGN
#define PG8_ALIGN true
#endif

constexpr size_t MiB = 1u << 20;
constexpr size_t WS_CTL = 0, CTL_ZERO_BYTES = 1 * MiB;
constexpr size_t WS_SSQ = 1 * MiB, SSQ_STRIDE = 2359296;
constexpr size_t WS_BA = 13 * MiB;
constexpr size_t WS_EG = 18 * MiB, WS_DL = 21 * MiB, WS_GL = 24 * MiB;
constexpr size_t WS_WIN = 32 * MiB, WS_WOUT = 81 * MiB, WS_WUP0 = 97 * MiB, WS_WDN0 = 141 * MiB, WS_WKVQ = 163 * MiB, WS_WO = 187 * MiB, WS_WUP1 = 195 * MiB, WS_WDN1 = 239 * MiB;
constexpr size_t WS_HB = 261 * MiB;
constexpr size_t WS_RA = 326 * MiB;
constexpr size_t WS_QKV = WS_RA, WS_Z = WS_RA + 260 * MiB, WS_UP = WS_RA;
constexpr size_t WS_KC = WS_RA, WS_VC = WS_RA + 130 * MiB;
static_assert(WS_KC + (size_t)DECB * (PAST + DECS) * DM * 2 <= WS_VC && WS_VC + (size_t)DECB * (PAST + DECS) * DM * 2 <= WS_RA + 390 * MiB, "cache copies");
constexpr size_t WS_RB = 716 * MiB;
constexpr size_t WS_QN = WS_RB, WS_KN = WS_RB + 65 * MiB, WS_VV = WS_RB + 130 * MiB, WS_TP = WS_RB + 260 * MiB, WS_PP = WS_RB + 328 * MiB;
constexpr size_t WS_ACT = WS_RB;
constexpr size_t WS_KB = WS_RB, WS_VB = WS_RB + 65 * MiB, WS_QB = WS_RB + 130 * MiB, WS_ATT = WS_RB + 195 * MiB;
constexpr size_t WS_SUP = 1112 * MiB, WS_SACT = 1118 * MiB, WS_SQB = 1121 * MiB, WS_SATT = 1122 * MiB;
constexpr size_t WS_END = 1123 * MiB;
static_assert(WS_SUP + (size_t)MS * UPW * 2 <= WS_SACT && WS_SACT + (size_t)MS * DFF * 2 <= WS_SQB && WS_SQB + (size_t)MS * DM * 2 <= WS_SATT && WS_SATT + (size_t)MS * DM * 2 <= WS_END, "sample buffers");
static_assert((size_t)M * 32 * 4 <= SSQ_STRIDE && WS_SSQ + 5 * SSQ_STRIDE <= WS_BA && WS_BA + (size_t)M * 64 * 4 <= WS_EG && WS_EG + (size_t)NITEM * 256 <= WS_DL && WS_DL + (size_t)NITEM * 256 <= WS_GL && WS_GL + NITEM * 4 <= WS_WIN, "small buffers");
static_assert(WS_WIN + (size_t)INWP * DM * 2 <= WS_WOUT && WS_WDN1 + (size_t)DM * DFF * 2 <= WS_HB && WS_HB + (size_t)M * DM * 2 <= WS_RA, "weights / HB");
static_assert(WS_QKV + (size_t)M * QKVW * 2 <= WS_Z && WS_Z + (size_t)M * VW * 2 <= WS_RB && WS_UP + (size_t)M * UPW * 2 <= WS_RB, "region A");
static_assert(WS_QN + (size_t)M * DM * 2 <= WS_KN && WS_KN + (size_t)M * DM * 2 <= WS_VV && WS_VV + (size_t)M * VW * 2 <= WS_TP && WS_TP + (size_t)NITEM * 8192 <= WS_PP && WS_PP + (size_t)NITEM * 8192 <= WS_END, "region B (gdn)");
static_assert(WS_ACT + (size_t)M * DFF * 2 <= WS_END && WS_ATT + (size_t)M * DM * 2 <= WS_END, "region B");
static_assert((size_t)M * VW * 2 <= (O_SGDN - O_PK) * 4, "ON scratch");
constexpr int CW_BAR = 4096, CW_BAR2 = 8192, CW_BAR3 = 12288;

constexpr int LDS_BYTES = 159744;
constexpr int LDSCTL_OFF = 158720;
constexpr int NWAVES = 8;

#define GAS __attribute__((address_space(1)))
#define LAS __attribute__((address_space(3)))
#define DI __device__ __forceinline__
typedef unsigned short bf16;
typedef unsigned v4u __attribute__((ext_vector_type(4)));
typedef unsigned v2u __attribute__((ext_vector_type(2)));
typedef float f32x4 __attribute__((ext_vector_type(4)));
typedef float f32x16 __attribute__((ext_vector_type(16)));
typedef short bf16x8 __attribute__((ext_vector_type(8)));
typedef short bf16x4 __attribute__((ext_vector_type(4)));
#define LDS_WAIT() asm volatile("s_waitcnt lgkmcnt(0)" ::: "memory")
#define VM_WAIT() asm volatile("s_waitcnt vmcnt(0)" ::: "memory")
#define MFMA32(a, b, c) __builtin_amdgcn_mfma_f32_32x32x16_bf16((a), (b), (c), 0, 0, 0)
DI unsigned pk2(float lo, float hi) { return pg8::cvt_pk_bf16(lo, hi); }
DI float bf2f(unsigned short b) { return __builtin_bit_cast(float, ((unsigned)b) << 16); }
DI float bflo(unsigned w) { return __builtin_bit_cast(float, w << 16); }
DI float bfhi(unsigned w) { return __builtin_bit_cast(float, w & 0xffff0000u); }
DI void unpack8(const v4u w, float (&f)[8]) { f[0] = bflo(w.x); f[1] = bfhi(w.x); f[2] = bflo(w.y); f[3] = bfhi(w.y); f[4] = bflo(w.z); f[5] = bfhi(w.z); f[6] = bflo(w.w); f[7] = bfhi(w.w); }
DI v4u pack8(const float (&f)[8]) { v4u w; w.x = pk2(f[0], f[1]); w.y = pk2(f[2], f[3]); w.z = pk2(f[4], f[5]); w.w = pk2(f[6], f[7]); return w; }
DI int crow(int r, int hi) { return (r & 3) + 8 * (r >> 2) + 4 * hi; }
DI float wave_sum(float v) {
#pragma unroll
    for (int o = 1; o < 64; o <<= 1) v += __shfl_xor(v, o);
    return v;
}
DI float siluf(float x) { return x * __builtin_amdgcn_rcpf(1.0f + __expf(-x)); }

template <int OFF> DI bf16x4 tr_read(int vb) { bf16x4 r; asm volatile("ds_read_b64_tr_b16 %0, %1 offset:%2" : "=&v"(r) : "v"(vb), "i"(OFF) : "memory"); return r; }
#define XB_TMO      128
#define XB_XCNT(j)  (256  + 64 * (j))
#define XB_XSUB(j)  (1280 + 64 * (j))
#define XB_XGEN(j)  (2304 + 64 * (j))
#define XB_TOP      3328
#define XB_TOPGEN   3392
#define XCD_BAR_WORDS 3456
#define XB_SPIN_CAP (1u << 18)

__device__ __forceinline__ unsigned xb_ld(unsigned* p)              { return __hip_atomic_load(p, __ATOMIC_RELAXED, __HIP_MEMORY_SCOPE_AGENT); }
__device__ __forceinline__ unsigned xb_add(unsigned* p, unsigned v) { return __hip_atomic_fetch_add(p, v, __ATOMIC_RELAXED, __HIP_MEMORY_SCOPE_AGENT); }
__device__ __forceinline__ unsigned xb_xcc_id() { return (unsigned)__builtin_amdgcn_s_getreg((3 << 11) | 20) & 0xFu; }
#define XB_SPIN(cond, bar) do { unsigned _sp = 0; while (cond) { __builtin_amdgcn_s_sleep(1); \
    if ((++_sp & 255u) == 0u) { if (xb_ld(&(bar)[XB_TMO])) break; if (_sp > XB_SPIN_CAP) { atomicAdd(&(bar)[XB_TMO], 1u); break; } } } } while (0)

struct XcdBarrier {
    unsigned* bar; unsigned x;
    volatile LAS unsigned* st;
};

__device__ __forceinline__ XcdBarrier xcd_barrier_post(unsigned* bar, volatile LAS unsigned* st) {
    XcdBarrier b; b.bar = bar; b.x = xb_xcc_id(); b.st = st;
    if (threadIdx.x == 0) (void)xb_add(&bar[XB_XCNT(b.x)], 1u);
    return b;
}
__device__ __forceinline__ void xcd_barrier_complete(unsigned* bar, unsigned x, unsigned& nloc, unsigned& nx) {
    const unsigned G = gridDim.x * gridDim.y * gridDim.z;
    unsigned sum, cnt, mine, sp = 0u;
    for (;;) {
        sum = 0u; cnt = 0u; mine = 0u;
#pragma unroll
        for (unsigned j = 0; j < 16; ++j) { const unsigned c = xb_ld(&bar[XB_XCNT(j)]); sum += c; cnt += (c > 0u) ? 1u : 0u; mine = (j == x) ? c : mine; }
        if (sum == G) break;
        __builtin_amdgcn_s_sleep(1);
        if ((++sp & 255u) == 0u) { if (xb_ld(&bar[XB_TMO])) break; if (sp > XB_SPIN_CAP) { atomicAdd(&bar[XB_TMO], 1u); break; } }
    }
    nloc = mine > 0u ? mine : 1u; nx = cnt > 0u ? cnt : 1u;
}

__device__ __forceinline__ void xcd_barrier(const XcdBarrier& b) {
    asm volatile("s_waitcnt vmcnt(0)" ::: "memory");
    __syncthreads();
    if (threadIdx.x == 0) {
        unsigned* bar = b.bar;
        __builtin_amdgcn_s_waitcnt(0);
        unsigned nloc = b.st[0], nx = b.st[1];
        if (nloc == 0u) { xcd_barrier_complete(bar, b.x, nloc, nx); b.st[0] = nloc; b.st[1] = nx; }
        const unsigned old = xb_add(&bar[XB_XSUB(b.x)], 1u);
        const unsigned gen = old / nloc;
        if (old + 1u == (gen + 1u) * nloc) {
            __builtin_amdgcn_fence(__ATOMIC_RELEASE, "agent");
            asm volatile("s_waitcnt vmcnt(0)" ::: "memory");
            const unsigned og = xb_add(&bar[XB_TOP], 1u);
            const unsigned tg = og / nx;
            if (og + 1u == (tg + 1u) * nx) xb_add(&bar[XB_TOPGEN], 1u);
            else XB_SPIN(xb_ld(&bar[XB_TOPGEN]) == tg, bar);
            __builtin_amdgcn_fence(__ATOMIC_ACQUIRE, "agent");
            xb_add(&bar[XB_XGEN(b.x)], 1u);
            asm volatile("s_waitcnt vmcnt(0)" ::: "memory");
        } else {
            XB_SPIN(xb_ld(&bar[XB_XGEN(b.x)]) == gen, bar);
            __builtin_amdgcn_fence(__ATOMIC_ACQUIRE, "agent");
            asm volatile("s_waitcnt vmcnt(0)" ::: "memory");
        }
    }
    __syncthreads();
}
__device__ __forceinline__ void sub_barrier_complete(unsigned* bar, unsigned x, unsigned& nloc, unsigned& nx, const unsigned expect) {
    unsigned sum, cnt, mine, sp = 0u;
    for (;;) {
        sum = 0u; cnt = 0u; mine = 0u;
#pragma unroll
        for (unsigned j = 0; j < 16; ++j) { const unsigned c = xb_ld(&bar[XB_XCNT(j)]); sum += c; cnt += (c > 0u) ? 1u : 0u; mine = (j == x) ? c : mine; }
        if (sum == expect) break;
        __builtin_amdgcn_s_sleep(1);
        if ((++sp & 255u) == 0u) { if (xb_ld(&bar[XB_TMO])) break; if (sp > XB_SPIN_CAP) { atomicAdd(&bar[XB_TMO], 1u); break; } }
    }
    nloc = mine > 0u ? mine : 1u; nx = cnt > 0u ? cnt : 1u;
}
__device__ __forceinline__ void sub_barrier(const XcdBarrier& b, const unsigned expect) {
    asm volatile("s_waitcnt vmcnt(0)" ::: "memory");
    __syncthreads();
    if (threadIdx.x == 0) {
        unsigned* bar = b.bar;
        __builtin_amdgcn_s_waitcnt(0);
        unsigned nloc = b.st[0], nx = b.st[1];
        if (nloc == 0u) { sub_barrier_complete(bar, b.x, nloc, nx, expect); b.st[0] = nloc; b.st[1] = nx; }
        const unsigned old = xb_add(&bar[XB_XSUB(b.x)], 1u);
        const unsigned gen = old / nloc;
        if (old + 1u == (gen + 1u) * nloc) {
            __builtin_amdgcn_fence(__ATOMIC_RELEASE, "agent");
            asm volatile("s_waitcnt vmcnt(0)" ::: "memory");
            const unsigned og = xb_add(&bar[XB_TOP], 1u);
            const unsigned tg = og / nx;
            if (og + 1u == (tg + 1u) * nx) xb_add(&bar[XB_TOPGEN], 1u);
            else XB_SPIN(xb_ld(&bar[XB_TOPGEN]) == tg, bar);
            __builtin_amdgcn_fence(__ATOMIC_ACQUIRE, "agent");
            xb_add(&bar[XB_XGEN(b.x)], 1u);
            asm volatile("s_waitcnt vmcnt(0)" ::: "memory");
        } else {
            XB_SPIN(xb_ld(&bar[XB_XGEN(b.x)]) == gen, bar);
            __builtin_amdgcn_fence(__ATOMIC_ACQUIRE, "agent");
            asm volatile("s_waitcnt vmcnt(0)" ::: "memory");
        }
    }
    __syncthreads();
}
struct Frame {
    LAS unsigned char* lds;
    volatile LAS unsigned* MISC;
    unsigned* ctl;
    int tid, lane, wave;
    int vcu, G;
    const float* const* in;
    float* out; unsigned char* ws;
};
enum { I_XP = 0, I_XS, I_SGDN, I_SGC, I_SFC, I_CK, I_CV, I_ANORM, I_AWIN, I_AWCONV, I_ALOG, I_ADT, I_AONORM, I_AWOUT, I_KVNORM, I_WKV, I_BNORM, I_BWQ,
       I_LQ1, I_LK1, I_LQ2, I_LK2, I_SUBN, I_BWO, I_RELB, I_FNORM, I_FWUP, I_FWCONV, I_FBCONV, I_FWDN, I_FINAL, N_IN };

constexpr int TR_LDS = 16896;
DI void p0_transpose_item(const float* W, const float* gain, int K, int N, bf16* WT, int row_off, LAS float* scr, int item, int lane) {
    const int nblk = N / 64, kb = item / nblk, nb = item % nblk, k0 = 64 * kb, n0 = 64 * nb;
    const int n4 = lane & 15;
#pragma unroll 8
    for (int i = 0; i < 16; ++i) { const int kk = 4 * i + (lane >> 4); const float gk = gain ? gain[k0 + kk] : 1.0f;
        const f32x4 v = __builtin_nontemporal_load((const f32x4*)(W + (size_t)(k0 + kk) * N + n0 + 4 * n4));
        LAS float* d = scr + kk * 65 + 4 * n4; d[0] = v[0] * gk; d[1] = v[1] * gk; d[2] = v[2] * gk; d[3] = v[3] * gk; }
    LDS_WAIT(); asm volatile("" ::: "memory");
    const int c = lane & 7;
#pragma unroll
    for (int j = 0; j < 8; ++j) { const int n = (lane >> 3) + 8 * j; const LAS float* s = scr + (8 * c) * 65 + n;
        v4u o; o.x = pk2(s[0 * 65], s[1 * 65]); o.y = pk2(s[2 * 65], s[3 * 65]); o.z = pk2(s[4 * 65], s[5 * 65]); o.w = pk2(s[6 * 65], s[7 * 65]);
        *(v4u*)(WT + (size_t)(row_off + n0 + n) * K + k0 + 8 * c) = o; }
    LDS_WAIT(); asm volatile("" ::: "memory");
}
DI void conv_mat(Frame& F, const float* W, const float* gain, const int K, const int N, bf16* WT, const int row_off, const int gw, const int NGW) {
    LAS float* scr = (LAS float*)(F.lds + F.wave * TR_LDS);
    const int nit = (K / 64) * (N / 64);
    for (int it = gw; it < nit; it += NGW) p0_transpose_item(W, gain, K, N, WT, row_off, scr, it, F.lane);
}
enum { CJ_WOUT = 0, CJ_WUP0, CJ_WDN0, CJ_WKVQ, CJ_WO, CJ_WUP1, CJ_WDN1 };
DI void conv_job(Frame& F, const int job, const int gw, const int NGW) {
    unsigned char* ws = F.ws;
    if (job == CJ_WOUT) conv_mat(F, F.in[I_AWOUT], nullptr, VW, DM, (bf16*)(ws + WS_WOUT), 0, gw, NGW);
    else if (job == CJ_WUP0) conv_mat(F, F.in[I_FWUP], F.in[I_FNORM], DM, UPW, (bf16*)(ws + WS_WUP0), 0, gw, NGW);
    else if (job == CJ_WDN0) conv_mat(F, F.in[I_FWDN], nullptr, DFF, DM, (bf16*)(ws + WS_WDN0), 0, gw, NGW);
    else if (job == CJ_WKVQ) { conv_mat(F, F.in[I_WKV], F.in[I_KVNORM], DM, 4096, (bf16*)(ws + WS_WKVQ), 0, gw, NGW); conv_mat(F, F.in[I_BWQ], F.in[I_BNORM], DM, DM, (bf16*)(ws + WS_WKVQ), 4096, gw, NGW); }
    else if (job == CJ_WO) conv_mat(F, F.in[I_BWO], nullptr, DM, DM, (bf16*)(ws + WS_WO), 0, gw, NGW);
    else if (job == CJ_WUP1) conv_mat(F, F.in[I_FWUP] + (size_t)DM * UPW, F.in[I_FNORM] + DM, DM, UPW, (bf16*)(ws + WS_WUP1), 0, gw, NGW);
    else conv_mat(F, F.in[I_FWDN] + (size_t)DFF * DM, nullptr, DFF, DM, (bf16*)(ws + WS_WDN1), 0, gw, NGW);
}
DI void p0_prologue(Frame& F) {
    LAS float* scr = (LAS float*)(F.lds + F.wave * TR_LDS);
    const int gw = F.vcu * NWAVES + F.wave, NGW = F.G * NWAVES, lane = F.lane;
    unsigned char* ws = F.ws;
    constexpr int I_IN = (DM / 64) * (INW / 64);
    for (int it = F.wave * F.G + F.vcu; it < I_IN; it += NGW) p0_transpose_item(F.in[I_AWIN], F.in[I_ANORM], DM, INW, (bf16*)(ws + WS_WIN), 0, scr, it, lane);
    { v4u* z = (v4u*)(ws + WS_WIN + (size_t)INW * DM * 2); const int nz = (INWP - INW) * DM * 2 / 16; const v4u zero = {0u, 0u, 0u, 0u};
      for (int i = gw * 64 + lane; i < nz; i += NGW * 64) z[i] = zero; }
    float* ssq0 = (float*)(ws + WS_SSQ);
    for (int m0 = NGW - 1 - (F.wave * F.G + F.vcu); m0 < M; m0 += 2 * NGW) {
        const int m1 = m0 + NGW; const bool two = m1 < M; const int mb = two ? m1 : m0;
        const float* xa = (m0 < MP) ? F.in[I_XP] + (size_t)m0 * DM : F.in[I_XS] + (size_t)(m0 - MP) * DM;
        const float* xb = (mb < MP) ? F.in[I_XP] + (size_t)mb * DM : F.in[I_XS] + (size_t)(mb - MP) * DM;
        const f32x4* a4 = (const f32x4*)xa + lane; const f32x4* b4 = (const f32x4*)xb + lane;
        v2u* oa = (v2u*)((bf16*)(ws + WS_HB) + (size_t)m0 * DM) + lane; v2u* ob = (v2u*)((bf16*)(ws + WS_HB) + (size_t)mb * DM) + lane;
        f32x4 va[8], vb[8];
#pragma unroll
        for (int j = 0; j < 8; ++j) va[j] = __builtin_nontemporal_load(a4 + 64 * j);
#pragma unroll
        for (int j = 0; j < 8; ++j) vb[j] = __builtin_nontemporal_load(b4 + 64 * j);
        float sa = 0.f, sb = 0.f;
#pragma unroll
        for (int j = 0; j < 8; ++j) { const f32x4 v = va[j]; sa += (v[0] * v[0] + v[1] * v[1]) + (v[2] * v[2] + v[3] * v[3]); v2u w; w.x = pk2(v[0], v[1]); w.y = pk2(v[2], v[3]); oa[64 * j] = w; }
        sa = wave_sum(sa);
        if (lane < 32) ssq0[(size_t)m0 * 32 + lane] = (lane == 0) ? sa : 0.f;
        if (two) {
#pragma unroll
            for (int j = 0; j < 8; ++j) { const f32x4 v = vb[j]; sb += (v[0] * v[0] + v[1] * v[1]) + (v[2] * v[2] + v[3] * v[3]); v2u w; w.x = pk2(v[0], v[1]); w.y = pk2(v[2], v[3]); ob[64 * j] = w; }
            sb = wave_sum(sb);
            if (lane < 32) ssq0[(size_t)m1 * 32 + lane] = (lane == 0) ? sb : 0.f;
        }
    }
}
#define GC_LOAD(TB, R, H) { const int tb_ = (TB); const int b_ = tb_ >> 9; const int t0_ = (tb_ & 511) * 16; \
        const bf16* p_ = QKV + ((size_t)b_ * SEQ + t0_) * QKVW + c0; \
        _Pragma("unroll") for (int j_ = 0; j_ < 3; ++j_) { if (t0_ > 0) H[j_] = *(const v4u*)(p_ - (3 - j_) * QKVW); else H[j_] = (v4u){0u, 0u, 0u, 0u}; } \
        _Pragma("unroll") for (int tt_ = 0; tt_ < 16; ++tt_) R[tt_] = __builtin_nontemporal_load((const v4u*)(p_ + tt_ * QKVW)); }
#define GC_ROW(ROW, T, MROW, SAMP, B, LEN) { \
            const int t = (T); const size_t m = (MROW); \
            float cur[8]; unpack8(ROW, cur); \
            float y[8]; float ss = 0.f; \
            _Pragma("unroll") for (int e = 0; e < 8; ++e) { const float a = h[0][e] * w[0][e] + h[1][e] * w[1][e] + h[2][e] * w[2][e] + cur[e] * w[3][e]; y[e] = siluf(a); ss += y[e] * y[e]; } \
            if (cc < 8) {     \
                ss += __shfl_xor(ss, 1); ss += __shfl_xor(ss, 2); ss += __shfl_xor(ss, 4); ss += __shfl_xor(ss, 8); \
                const float sc = rsqrtf(ss + 1e-6f) * (cc < 4 ? 0.08838834764831845f : 1.0f); \
                _Pragma("unroll") for (int e = 0; e < 8; ++e) y[e] *= sc; \
                bf16* dst = (cc < 4) ? QN + m * DM + c0 : KN + m * DM + (c0 - 2048); \
                *(v4u*)dst = pack8(y); \
            } else { *(v4u*)(VV + m * VW + (c0 - 4096)) = pack8(y); } \
            if (t >= (LEN) - 3) {     \
                float* so = F.out + ((SAMP) ? O_SGC : O_PGC) + (size_t)((B) * 3 + (t - ((LEN) - 3))) * QKVW + c0; \
                *(f32x4*)so = (f32x4){cur[0], cur[1], cur[2], cur[3]}; *(f32x4*)(so + 4) = (f32x4){cur[4], cur[5], cur[6], cur[7]}; } \
            _Pragma("unroll") for (int e = 0; e < 8; ++e) { h[0][e] = h[1][e]; h[1][e] = h[2][e]; h[2][e] = cur[e]; } }
DI void p_gdnconv(Frame& F) {
    const int gw = F.vcu * NWAVES + F.wave, NGW = F.G * NWAVES, lane = F.lane;
    const bf16* QKV = (const bf16*)(F.ws + WS_QKV);
    bf16* QN = (bf16*)(F.ws + WS_QN); bf16* KN = (bf16*)(F.ws + WS_KN); bf16* VV = (bf16*)(F.ws + WS_VV);
    const float* wconv = F.in[I_AWCONV];
    constexpr int NTBP = MP / 16;
    const int TBS = NGW >> 4;
    const bool act = gw < TBS * 16;
    const int cc = gw & 15, c0 = cc * 512 + lane * 8;
    float w[4][8];
#pragma unroll
    for (int i = 0; i < 4; ++i) { const f32x4 a = *(const f32x4*)(wconv + i * QKVW + c0), bq = *(const f32x4*)(wconv + i * QKVW + c0 + 4);
        w[i][0] = a[0]; w[i][1] = a[1]; w[i][2] = a[2]; w[i][3] = a[3]; w[i][4] = bq[0]; w[i][5] = bq[1]; w[i][6] = bq[2]; w[i][7] = bq[3]; }
    int tb = act ? gw >> 4 : NTBP;
    v4u rows[16], hp[3];
    if (tb < NTBP) GC_LOAD(tb, rows, hp)
    for (; tb < NTBP; tb += TBS) {
        v4u rn[16], hn[3];
#pragma unroll
        for (int tt = 0; tt < 16; ++tt) rn[tt] = rows[tt];
#pragma unroll
        for (int j = 0; j < 3; ++j) hn[j] = hp[j];
        if (tb + TBS < NTBP) GC_LOAD(tb + TBS, rn, hn)
        const int b = tb >> 9; const int t0 = (tb & 511) * 16;
        const size_t mbase = (size_t)b * SEQ;
        float h[3][8];
#pragma unroll
        for (int j = 0; j < 3; ++j) unpack8(hp[j], h[j]);
#pragma unroll
        for (int tt = 0; tt < 16; ++tt) GC_ROW(rows[tt], t0 + tt, mbase + t0 + tt, false, b, SEQ)
#pragma unroll
        for (int tt = 0; tt < 16; ++tt) rows[tt] = rn[tt];
#pragma unroll
        for (int j = 0; j < 3; ++j) hp[j] = hn[j];
    }
    if (act) for (int pc = gw >> 4; pc < DECB * 4; pc += TBS) {
        const int b = pc >> 2, ta = (pc & 3) * 4; const size_t mbase = (size_t)MP + b * 16;
        v4u r4[4];
#pragma unroll
        for (int tt = 0; tt < 4; ++tt) r4[tt] = __builtin_nontemporal_load((const v4u*)(QKV + (mbase + ta + tt) * QKVW + c0));
        float h[3][8];
        if (ta == 0) {
#pragma unroll
            for (int j = 0; j < 3; ++j) { const float* sp = F.in[I_SGC] + (size_t)(b * 3 + j) * QKVW + c0; const f32x4 a = *(const f32x4*)sp, bq = *(const f32x4*)(sp + 4);
                h[j][0] = a[0]; h[j][1] = a[1]; h[j][2] = a[2]; h[j][3] = a[3]; h[j][4] = bq[0]; h[j][5] = bq[1]; h[j][6] = bq[2]; h[j][7] = bq[3]; }
        } else {
#pragma unroll
            for (int j = 0; j < 3; ++j) unpack8(*(const v4u*)(QKV + (mbase + ta - 3 + j) * QKVW + c0), h[j]);
        }
#pragma unroll
        for (int tt = 0; tt < 4; ++tt) GC_ROW(r4[tt], ta + tt, mbase + ta + tt, true, b, DECS)
    }
}
DI void p_prep(Frame& F) {
    const int gw = F.vcu * NWAVES + F.wave, NGW = F.G * NWAVES;
    LAS float* Al = (LAS float*)(F.lds + F.wave * 16384);
    const bf16* QN = (const bf16*)(F.ws + WS_QN); const bf16* KN = (const bf16*)(F.ws + WS_KN);
    const float* BA = (const float*)(F.ws + WS_BA);
    bf16* TP = (bf16*)(F.ws + WS_TP); bf16* PP = (bf16*)(F.ws + WS_PP);
    float* EG = (float*)(F.ws + WS_EG); float* DL = (float*)(F.ws + WS_DL); float* GL = (float*)(F.ws + WS_GL);
    const int gw2 = F.wave * F.G + F.vcu;
    const int npr = (gw < NITEM_P) ? (NITEM_P - gw + NGW - 1) / NGW : 0, nsm = (gw2 < NITEM - NITEM_P) ? (NITEM - NITEM_P - gw2 + NGW - 1) / NGW : 0;
    for (int k = 0; k < npr + nsm; ++k) {
        const int it = (k < npr) ? gw + k * NGW : NITEM_P + gw2 + (k - npr) * NGW;
        int lane = F.lane; asm volatile("" : "+v"(lane));
        const int c = lane & 31, hh = lane >> 5;
        int h, nv; size_t m0;
        if (it < NITEM_P) { h = it & 31; const int bn = it >> 5; m0 = (size_t)(bn >> 7) * SEQ + (size_t)(bn & 127) * 64; nv = 64; }
        else { const int r = it - NITEM_P; h = r & 31; m0 = (size_t)MP + (size_t)(r >> 5) * 16; nv = 16; }
        const int kh = h >> 1;
        float gt = 0.f, bt = 0.f;
        if (lane < nv) { const float bb = BA[(m0 + lane) * 64 + h], aa = BA[(m0 + lane) * 64 + 32 + h];
            bt = 1.0f / (1.0f + __expf(-bb));
            const float xx = aa + F.in[I_ADT][h]; const float sp = fmaxf(xx, 0.f) + log1pf(__expf(-fabsf(xx)));
            gt = -__expf(F.in[I_ALOG][h]) * sp; }
        float G = gt;
#pragma unroll
        for (int o = 1; o < 64; o <<= 1) { const float y = __shfl_up(G, o); if (lane >= o) G += y; }
        const float Glast = __shfl(G, 63);
        if (nv == 64) {
        bf16x8 kf[2][8];
#pragma unroll
        for (int ti = 0; ti < 2; ++ti)
#pragma unroll
            for (int s = 0; s < 8; ++s) { const int row = 32 * ti + c;
                kf[ti][s] = (row < nv) ? *(const bf16x8*)(KN + (m0 + row) * DM + kh * 128 + 16 * s + 8 * hh) : (bf16x8){0, 0, 0, 0, 0, 0, 0, 0}; }
        {
            f32x16 t00 = {}, t10 = {}, t11 = {};
#pragma unroll
            for (int s = 0; s < 8; ++s) { t00 = MFMA32(kf[0][s], kf[0][s], t00); t10 = MFMA32(kf[1][s], kf[0][s], t10); t11 = MFMA32(kf[1][s], kf[1][s], t11); }
#pragma unroll
            for (int i = 0; i < 16; ++i) {
                const int r0 = crow(i, hh), r1 = 32 + r0;
                const float G0 = __shfl(G, r0), G1 = __shfl(G, r1), b0 = __shfl(bt, r0), b1 = __shfl(bt, r1);
                const float Gc0 = __shfl(G, c), Gc1 = __shfl(G, 32 + c);
                Al[r0 * 64 + c] = (r0 > c) ? b0 * t00[i] * __expf(G0 - Gc0) : 0.f;
                Al[r1 * 64 + c] = b1 * t10[i] * __expf(G1 - Gc0);
                Al[r1 * 64 + 32 + c] = (r0 > c) ? b1 * t11[i] * __expf(G1 - Gc1) : 0.f;
            }
        }
        asm volatile("" ::: "memory");
        {
            bf16x8 qf[2][8];
#pragma unroll
            for (int ti = 0; ti < 2; ++ti)
#pragma unroll
                for (int s = 0; s < 8; ++s) { const int row = 32 * ti + c;
                    qf[ti][s] = (row < nv) ? *(const bf16x8*)(QN + (m0 + row) * DM + kh * 128 + 16 * s + 8 * hh) : (bf16x8){0, 0, 0, 0, 0, 0, 0, 0}; }
            f32x16 t00 = {}, t10 = {}, t11 = {};
#pragma unroll
            for (int s = 0; s < 8; ++s) { t00 = MFMA32(qf[0][s], kf[0][s], t00); t10 = MFMA32(qf[1][s], kf[0][s], t10); t11 = MFMA32(qf[1][s], kf[1][s], t11); }
            bf16* pp = PP + (size_t)it * 4096;
#pragma unroll
            for (int i = 0; i < 16; ++i) {
                const int r0 = crow(i, hh), r1 = 32 + r0;
                const float G0 = __shfl(G, r0), G1 = __shfl(G, r1);
                const float Gc0 = __shfl(G, c), Gc1 = __shfl(G, 32 + c);
                const float v00 = (r0 >= c) ? t00[i] * __expf(G0 - Gc0) : 0.f;
                const float v10 = t10[i] * __expf(G1 - Gc0);
                const float v11 = (r0 >= c) ? t11[i] * __expf(G1 - Gc1) : 0.f;
                pp[r0 * 64 + c] = (bf16)(pk2(v00, 0.f) & 0xffffu); pp[r0 * 64 + 32 + c] = 0;
                pp[r1 * 64 + c] = (bf16)(pk2(v10, 0.f) & 0xffffu); pp[r1 * 64 + 32 + c] = (bf16)(pk2(v11, 0.f) & 0xffffu);
            }
        }
        LDS_WAIT(); asm volatile("" ::: "memory");
        float T[64];
#pragma unroll
        for (int i = 0; i < 64; ++i) {
            float a = (lane == i) ? 1.0f : 0.f;
#pragma unroll
            for (int j = 0; j < i; ++j) a -= Al[i * 64 + j] * T[j];
            T[i] = a;
            asm volatile("" ::: "memory");
        }
        bf16* tp = TP + (size_t)it * 4096;
#pragma unroll
        for (int i = 0; i < 64; ++i) tp[i * 64 + lane] = (bf16)(pk2(T[i] * bt, 0.f) & 0xffffu);
        } else {
        bf16x8 kf0[8], qf0[8];
#pragma unroll
        for (int s = 0; s < 8; ++s) { kf0[s] = (c < nv) ? *(const bf16x8*)(KN + (m0 + c) * DM + kh * 128 + 16 * s + 8 * hh) : (bf16x8){0, 0, 0, 0, 0, 0, 0, 0};
            qf0[s] = (c < nv) ? *(const bf16x8*)(QN + (m0 + c) * DM + kh * 128 + 16 * s + 8 * hh) : (bf16x8){0, 0, 0, 0, 0, 0, 0, 0}; }
        f32x16 tk = {}, tq = {};
#pragma unroll
        for (int s = 0; s < 8; ++s) { tk = MFMA32(kf0[s], kf0[s], tk); tq = MFMA32(qf0[s], kf0[s], tq); }
        bf16* pp = PP + (size_t)it * 4096;
#pragma unroll
        for (int i = 0; i < 16; ++i) {
            const int r0 = crow(i, hh), r1 = 32 + r0;
            const float G0 = __shfl(G, r0), b0 = __shfl(bt, r0), Gc0 = __shfl(G, c);
            const float dec = __expf(G0 - Gc0);
            Al[r0 * 64 + c] = (r0 > c) ? b0 * tk[i] * dec : 0.f;
            const float v00 = (r0 >= c) ? tq[i] * dec : 0.f;
            pp[r0 * 64 + c] = (bf16)(pk2(v00, 0.f) & 0xffffu); pp[r0 * 64 + 32 + c] = 0;
            pp[r1 * 64 + c] = 0; pp[r1 * 64 + 32 + c] = 0;
        }
        LDS_WAIT(); asm volatile("" ::: "memory");
        float T[16];
#pragma unroll
        for (int i = 0; i < 16; ++i) {
            float a = (lane == i) ? 1.0f : 0.f;
#pragma unroll
            for (int j = 0; j < i; ++j) a -= Al[i * 64 + j] * T[j];
            T[i] = a;
            asm volatile("" ::: "memory");
        }
        bf16* tp = TP + (size_t)it * 4096;
#pragma unroll
        for (int i = 0; i < 16; ++i) tp[i * 64 + lane] = (bf16)(pk2(T[i] * bt, 0.f) & 0xffffu);
#pragma unroll
        for (int i = 16; i < 64; ++i) tp[i * 64 + lane] = 0;
        }
        EG[(size_t)it * 64 + lane] = __expf(G); DL[(size_t)it * 64 + lane] = __expf(Glast - G);
        if (lane == 0) GL[it] = __expf(Glast);
        LDS_WAIT(); asm volatile("" ::: "memory");
    }
}
constexpr int SB_K = 0, SB_Q = 17408, SB_V = 34816, SB_TP = 52224, SB_PP = 61440, SB_SIZE = 70656, SB_EG = 2 * SB_SIZE;
constexpr int LDK = 272, LDT = 144;
DI bf16x8 frag_perm(const LAS unsigned char* p) {
    const v2u lo = *(const LAS v2u*)p, hi = *(const LAS v2u*)(p + 16); const v4u x = {lo.x, lo.y, hi.x, hi.y}; return __builtin_bit_cast(bf16x8, x); }
DI bf16x8 pack_acc(const f32x16& a, const int s2) {
    v4u x; x.x = pk2(a[8 * s2], a[8 * s2 + 1]); x.y = pk2(a[8 * s2 + 2], a[8 * s2 + 3]); x.z = pk2(a[8 * s2 + 4], a[8 * s2 + 5]); x.w = pk2(a[8 * s2 + 6], a[8 * s2 + 7]); return __builtin_bit_cast(bf16x8, x); }
struct ScanLd { v4u k[4], q[4], v[4], tp[2], pp[2]; float e0, e1; };
DI void scan_issue(ScanLd& L, Frame& F, const int lt, const int item, const size_t m0, const int nv, const int h) {
    const bf16* QN = (const bf16*)(F.ws + WS_QN); const bf16* KN = (const bf16*)(F.ws + WS_KN); const bf16* VV = (const bf16*)(F.ws + WS_VV);
    const bf16* TP = (const bf16*)(F.ws + WS_TP); const bf16* PP = (const bf16*)(F.ws + WS_PP);
    const float* EG = (const float*)(F.ws + WS_EG); const float* DL = (const float*)(F.ws + WS_DL); const float* GL = (const float*)(F.ws + WS_GL);
    const int kh = h >> 1;
#pragma unroll
    for (int i = 0; i < 4; ++i) { const int p = lt + 256 * i, row = p >> 4, cc = p & 15; const v4u z4 = {0u, 0u, 0u, 0u};
        L.k[i] = (row < nv) ? *(const v4u*)(KN + (m0 + row) * DM + kh * 128 + cc * 8) : z4;
        L.q[i] = (row < nv) ? *(const v4u*)(QN + (m0 + row) * DM + kh * 128 + cc * 8) : z4;
        const int vrow = lt >> 2, vcc = (lt & 3) * 4 + i; L.v[i] = (vrow < nv) ? *(const v4u*)(VV + (m0 + vrow) * VW + h * 128 + vcc * 8) : z4; }
#pragma unroll
    for (int i = 0; i < 2; ++i) { const int p = lt + 256 * i, row = p >> 3, cc = p & 7;
        L.tp[i] = *(const v4u*)(TP + (size_t)item * 4096 + row * 64 + cc * 8); L.pp[i] = *(const v4u*)(PP + (size_t)item * 4096 + row * 64 + cc * 8); }
    L.e0 = (lt < 64) ? EG[(size_t)item * 64 + lt] : ((lt < 128) ? DL[(size_t)item * 64 + lt - 64] : GL[item]);
}
DI void st_perm(LAS unsigned char* rowbase, const int cc, const v4u x) {
    LAS unsigned char* g = rowbase + (cc >> 1) * 32 + (cc & 1) * 8;
    *(LAS v2u*)g = (v2u){x.x, x.y}; *(LAS v2u*)(g + 16) = (v2u){x.z, x.w};
}
DI void scan_write(const ScanLd& L, LAS unsigned char* lds, const int buf, const int lt) {
    LAS unsigned char* B = lds + buf * SB_SIZE;
#pragma unroll
    for (int i = 0; i < 4; ++i) { const int p = lt + 256 * i, row = p >> 4, cc = p & 15;
        *(LAS v4u*)(B + SB_K + row * LDK + cc * 16) = L.k[i]; st_perm(B + SB_Q + row * LDK, cc, L.q[i]);
        *(LAS v4u*)(B + SB_V + (lt >> 2) * LDK + ((lt & 3) * 4 + i) * 16) = L.v[i]; }
#pragma unroll
    for (int i = 0; i < 2; ++i) { const int p = lt + 256 * i, row = p >> 3, cc = p & 7;
        st_perm(B + SB_TP + row * LDT, cc, L.tp[i]); st_perm(B + SB_PP + row * LDT, cc, L.pp[i]); }
    if (lt <= 128) *(LAS float*)(lds + SB_EG + buf * 1024 + lt * 4) = L.e0;
}
struct ScanZ { v4u z[4]; };
DI void scan_z_load(ScanZ& N, Frame& F, const int lt, const size_t m0, const int nv, const int h) {
    const bf16* Z = (const bf16*)(F.ws + WS_Z); const int tok = lt >> 2, qd = lt & 3; const size_t off = (m0 + (tok < nv ? tok : 0)) * VW + h * 128 + qd * 32;
#pragma unroll
    for (int i = 0; i < 4; ++i) N.z[i] = *(const v4u*)(Z + off + 8 * i);
}
DI void scan_norm_lds(const ScanZ& N, Frame& F, const int buf, const int lt, const size_t m0, const int nv, const int h) {
    bf16* ON = (bf16*)(F.out + O_PK); const LAS float* gn = (const LAS float*)(F.lds + SB_EG + 2048);
    const int tok = lt >> 2, qd = lt & 3; const size_t off = (m0 + tok) * VW + h * 128 + qd * 32;
    const LAS unsigned char* op = F.lds + buf * SB_SIZE + SB_V + tok * LDK + qd * 64;
    v4u o4[4]; float ss = 0.f;
#pragma unroll
    for (int i = 0; i < 4; ++i) { o4[i] = *(const LAS v4u*)(op + 16 * i); float o8[8]; unpack8(o4[i], o8);
#pragma unroll
        for (int e = 0; e < 8; ++e) ss += o8[e] * o8[e]; }
    ss += __shfl_xor(ss, 1); ss += __shfl_xor(ss, 2);
    const float rstd = rsqrtf(ss * (1.0f / 128.0f) + 1e-6f);
    if (tok < nv) {
#pragma unroll
        for (int i = 0; i < 4; ++i) { float o8[8], z8[8]; unpack8(o4[i], o8); unpack8(N.z[i], z8);
            const f32x4 g0 = *(const LAS f32x4*)(gn + qd * 32 + 8 * i), g1 = *(const LAS f32x4*)(gn + qd * 32 + 8 * i + 4);
#pragma unroll
            for (int e = 0; e < 8; ++e) o8[e] = o8[e] * rstd * (e < 4 ? g0[e & 3] : g1[e & 3]) * siluf(z8[e]);
            *(v4u*)(ON + off + 8 * i) = pack8(o8); }
    }
}
DI void scan_chain(Frame& F, const bool samp, const int b, const int h) {
    const int tid = F.tid, w = F.wave;
    LAS unsigned char* lds = F.lds;
    bf16* ON = (bf16*)(F.out + O_PK);
    const int nsteps = samp ? 1 : 128, nv = samp ? 16 : 64;
    const bool loader = w >= 4; const int lt = tid - 256;
#define SC_ITEM(n) (samp ? NITEM_P + b * 32 + h : (b * 128 + (n)) * 32 + h)
#define SC_M0(n) (samp ? (size_t)MP + b * 16 : (size_t)b * SEQ + (size_t)(n) * 64)
    f32x16 S[4];
    __syncthreads();
    if (tid < 128) *(LAS float*)(lds + SB_EG + 2048 + tid * 4) = F.in[I_AONORM][tid];
    if (samp) {
        const float* s0 = F.in[I_SGDN] + (size_t)(b * 32 + h) * 16384;
#pragma unroll
        for (int i = 0; i < 8; ++i) *(LAS f32x4*)(lds + (tid + 512 * i) * 16) = *(const f32x4*)(s0 + (tid + 512 * i) * 4);
        __syncthreads();
        if (!loader) { const int lane = F.lane, c = lane & 31, hh = lane >> 5, dvb = 32 * w;
#pragma unroll
            for (int i4 = 0; i4 < 4; ++i4)
#pragma unroll
                for (int i = 0; i < 16; ++i) S[i4][i] = *(const LAS float*)(lds + ((32 * i4 + crow(i, hh)) * 128 + dvb + c) * 4); }
        __syncthreads();
    } else {
#pragma unroll
        for (int i4 = 0; i4 < 4; ++i4)
#pragma unroll
            for (int i = 0; i < 16; ++i) S[i4][i] = 0.f;
    }
    if (loader) {
        ScanLd L0, L1; ScanZ Z0;
        { int lv = lt; asm volatile("" : "+v"(lv)); scan_issue(L0, F, lv, SC_ITEM(0), SC_M0(0), nv, h); scan_write(L0, lds, 0, lv);
          if (nsteps > 1) scan_issue(L1, F, lv, SC_ITEM(1), SC_M0(1), nv, h); if (nsteps > 2) scan_issue(L0, F, lv, SC_ITEM(2), SC_M0(2), nv, h);
          scan_z_load(Z0, F, lv, SC_M0(0), nv, h); }
        __syncthreads();
        for (int n = 0; n < nsteps; n += 2) {
            {
                int lv = lt; asm volatile("" : "+v"(lv));
                if (n >= 1) { scan_norm_lds(Z0, F, 1, lv, SC_M0(n - 1), nv, h); scan_z_load(Z0, F, lv, SC_M0(n), nv, h); }
                if (n + 1 < nsteps) scan_write(L1, lds, 1, lv);
                if (n + 3 < nsteps) scan_issue(L1, F, lv, SC_ITEM(n + 3), SC_M0(n + 3), nv, h);
                __syncthreads();
            }
            if (n + 1 < nsteps) {
                int lv = lt; asm volatile("" : "+v"(lv));
                scan_norm_lds(Z0, F, 0, lv, SC_M0(n), nv, h); scan_z_load(Z0, F, lv, SC_M0(n + 1), nv, h);
                if (n + 2 < nsteps) scan_write(L0, lds, 0, lv);
                if (n + 4 < nsteps) scan_issue(L0, F, lv, SC_ITEM(n + 4), SC_M0(n + 4), nv, h);
                __syncthreads();
            }
        }
        __syncthreads();
        { int lv = lt; asm volatile("" : "+v"(lv));
          scan_norm_lds(Z0, F, (nsteps - 1) & 1, lv, SC_M0(nsteps - 1), nv, h); }
        __syncthreads();
    } else {
        __syncthreads();
        __builtin_amdgcn_s_setprio(3);
        for (int n = 0; n < nsteps; ++n) {
            int lane = F.lane; asm volatile("" : "+v"(lane));
            const int c = lane & 31, hh = lane >> 5, dvb = 32 * w;
            const LAS unsigned char* B = lds + (n & 1) * SB_SIZE; const LAS float* egp = (const LAS float*)(lds + SB_EG + (n & 1) * 1024);
            const size_t m0 = SC_M0(n);
            bf16x8 Sb[8];
#pragma unroll
            for (int i4 = 0; i4 < 4; ++i4) { Sb[2 * i4] = pack_acc(S[i4], 0); Sb[2 * i4 + 1] = pack_acc(S[i4], 1); }
            f32x16 ks[2] = {{}, {}}, qs[2] = {{}, {}};
            const LAS unsigned char* pk0 = B + SB_K + c * LDK + 8 * hh; const LAS unsigned char* pq1 = B + SB_Q + c * LDK + 16 * hh;
            bf16x8 fa[4], fb[4], tf[8];
#define LDKQ(dst, s8) do { dst[0] = frag_perm(pk0 + 32 * (s8)); dst[1] = frag_perm(pk0 + 32 * LDK + 32 * (s8)); dst[2] = *(const LAS bf16x8*)(pq1 + 32 * (s8)); dst[3] = *(const LAS bf16x8*)(pq1 + 32 * LDK + 32 * (s8)); } while (0)
#define MMKQ(src, s8) do { ks[0] = MFMA32(src[0], Sb[s8], ks[0]); ks[1] = MFMA32(src[1], Sb[s8], ks[1]); qs[0] = MFMA32(src[2], Sb[s8], qs[0]); qs[1] = MFMA32(src[3], Sb[s8], qs[1]); } while (0)
#define SBAR() __builtin_amdgcn_sched_barrier(0)
            LDKQ(fa, 0); SBAR();
            LDKQ(fb, 1); SBAR(); MMKQ(fa, 0); SBAR();
            LDKQ(fa, 2); SBAR(); MMKQ(fb, 1); SBAR();
            LDKQ(fb, 3); SBAR(); MMKQ(fa, 2); SBAR();
            LDKQ(fa, 4); SBAR(); MMKQ(fb, 3); SBAR();
            LDKQ(fb, 5); SBAR(); MMKQ(fa, 4); SBAR();
            LDKQ(fa, 6); SBAR(); MMKQ(fb, 5); SBAR();
            LDKQ(fb, 7); SBAR(); MMKQ(fa, 6); SBAR();
#pragma unroll
            for (int s4 = 0; s4 < 4; ++s4) { tf[2 * s4] = *(const LAS bf16x8*)(B + SB_TP + c * LDT + 32 * s4 + 16 * hh); tf[2 * s4 + 1] = *(const LAS bf16x8*)(B + SB_TP + (32 + c) * LDT + 32 * s4 + 16 * hh); }
            SBAR(); MMKQ(fb, 7); SBAR();
#undef LDKQ
#undef MMKQ
            bf16x8 rf[4];
            { const int vbv = (int)(unsigned)(size_t)(B + SB_V) + (4 * hh + ((lane >> 2) & 3)) * LDK + ((lane >> 4) & 1) * 32 + (lane & 3) * 8 + dvb * 2;
              const bf16x4 v00 = tr_read<0 * LDK>(vbv), v01 = tr_read<8 * LDK>(vbv), v02 = tr_read<16 * LDK>(vbv), v03 = tr_read<24 * LDK>(vbv);
              const bf16x4 v10 = tr_read<32 * LDK>(vbv), v11 = tr_read<40 * LDK>(vbv), v12 = tr_read<48 * LDK>(vbv), v13 = tr_read<56 * LDK>(vbv);
              asm volatile("s_waitcnt lgkmcnt(0)" ::: "memory"); SBAR();
#define RROW(tt, g4, V) do { const f32x4 e4 = *(const LAS f32x4*)(egp + 32 * (tt) + 8 * (g4) + 4 * hh); \
                  r[4 * (g4)] = bf2f((bf16)V[0]) - e4[0] * ks[tt][4 * (g4)]; r[4 * (g4) + 1] = bf2f((bf16)V[1]) - e4[1] * ks[tt][4 * (g4) + 1]; \
                  r[4 * (g4) + 2] = bf2f((bf16)V[2]) - e4[2] * ks[tt][4 * (g4) + 2]; r[4 * (g4) + 3] = bf2f((bf16)V[3]) - e4[3] * ks[tt][4 * (g4) + 3]; } while (0)
              { f32x16 r; RROW(0, 0, v00); RROW(0, 1, v01); RROW(0, 2, v02); RROW(0, 3, v03); rf[0] = pack_acc(r, 0); rf[1] = pack_acc(r, 1); }
              { f32x16 r; RROW(1, 0, v10); RROW(1, 1, v11); RROW(1, 2, v12); RROW(1, 3, v13); rf[2] = pack_acc(r, 0); rf[3] = pack_acc(r, 1); }
#undef RROW
            }
            SBAR();
            f32x16 u[2] = {{}, {}};
#pragma unroll
            for (int s4 = 0; s4 < 4; ++s4) { u[0] = MFMA32(tf[2 * s4], rf[s4], u[0]); u[1] = MFMA32(tf[2 * s4 + 1], rf[s4], u[1]); }
            SBAR();
            bf16x8 pf[8];
#pragma unroll
            for (int s4 = 0; s4 < 4; ++s4) { pf[2 * s4] = *(const LAS bf16x8*)(B + SB_PP + c * LDT + 32 * s4 + 16 * hh); pf[2 * s4 + 1] = *(const LAS bf16x8*)(B + SB_PP + (32 + c) * LDT + 32 * s4 + 16 * hh); }
            const float gl = egp[128];
            SBAR();
            bf16x8 uf[4], upf[4];
#pragma unroll
            for (int tt = 0; tt < 2; ++tt) { uf[2 * tt] = pack_acc(u[tt], 0); uf[2 * tt + 1] = pack_acc(u[tt], 1); f32x16 up;
#pragma unroll
                for (int g4 = 0; g4 < 4; ++g4) { const f32x4 d4 = *(const LAS f32x4*)(egp + 64 + 32 * tt + 8 * g4 + 4 * hh);
                    up[4 * g4] = u[tt][4 * g4] * d4[0]; up[4 * g4 + 1] = u[tt][4 * g4 + 1] * d4[1]; up[4 * g4 + 2] = u[tt][4 * g4 + 2] * d4[2]; up[4 * g4 + 3] = u[tt][4 * g4 + 3] * d4[3]; }
                upf[2 * tt] = pack_acc(up, 0); upf[2 * tt + 1] = pack_acc(up, 1); }
            f32x16 pu[2] = {{}, {}};
#pragma unroll
            for (int s4 = 0; s4 < 4; ++s4) { pu[0] = MFMA32(pf[2 * s4], uf[s4], pu[0]); pu[1] = MFMA32(pf[2 * s4 + 1], uf[s4], pu[1]); }
            SBAR();
            { const int vb = (int)(unsigned)(size_t)(B + SB_K) + (4 * hh + ((lane >> 2) & 3)) * LDK + ((lane >> 4) & 1) * 32 + (lane & 3) * 8;
#pragma unroll
              for (int i4 = 0; i4 < 4; ++i4) {
#pragma unroll
                  for (int i = 0; i < 16; ++i) S[i4][i] *= gl; }
#define KTPK(L, H) (bf16x8){L[0], L[1], L[2], L[3], H[0], H[1], H[2], H[3]}
#define KTLD(P, s4) const bf16x4 P##l0 = tr_read<16 * (s4) * LDK>(vb), P##h0 = tr_read<(16 * (s4) + 8) * LDK>(vb), P##l1 = tr_read<16 * (s4) * LDK + 64>(vb), P##h1 = tr_read<(16 * (s4) + 8) * LDK + 64>(vb), \
                  P##l2 = tr_read<16 * (s4) * LDK + 128>(vb), P##h2 = tr_read<(16 * (s4) + 8) * LDK + 128>(vb), P##l3 = tr_read<16 * (s4) * LDK + 192>(vb), P##h3 = tr_read<(16 * (s4) + 8) * LDK + 192>(vb)
#define KTMM(P, s4) do { S[0] = MFMA32(KTPK(P##l0, P##h0), upf[s4], S[0]); S[1] = MFMA32(KTPK(P##l1, P##h1), upf[s4], S[1]); S[2] = MFMA32(KTPK(P##l2, P##h2), upf[s4], S[2]); S[3] = MFMA32(KTPK(P##l3, P##h3), upf[s4], S[3]); } while (0)
              KTLD(a, 0); KTLD(b, 1);
              asm volatile("s_waitcnt lgkmcnt(0)" ::: "memory"); SBAR();
              KTMM(a, 0); KTMM(b, 1); SBAR();
              KTLD(d, 2); KTLD(e, 3);
              asm volatile("s_waitcnt lgkmcnt(0)" ::: "memory"); SBAR();
              KTMM(d, 2); KTMM(e, 3); SBAR();
#undef KTLD
#undef KTMM
#undef KTPK
            }
#undef SBAR
            { LAS unsigned char* ob = lds + (n & 1) * SB_SIZE + SB_V + dvb * 2;
#pragma unroll
              for (int ti = 0; ti < 2; ++ti)
#pragma unroll
                for (int g4 = 0; g4 < 4; ++g4) { const int tk = 32 * ti + 8 * g4 + 4 * hh; const f32x4 e4 = *(const LAS f32x4*)(egp + tk);
#pragma unroll
                    for (int j = 0; j < 4; ++j) *(LAS bf16*)(ob + (tk + j) * LDK + c * 2) = (bf16)(pk2(e4[j] * qs[ti][4 * g4 + j] + pu[ti][4 * g4 + j], 0.f) & 0xffffu); }
              LDS_WAIT(); }
            __syncthreads();
        }
        __builtin_amdgcn_s_setprio(0);
        __syncthreads();
        __syncthreads();
        {
            const int lane = F.lane, c = lane & 31, hh = lane >> 5, dvb = 32 * w;
#pragma unroll
            for (int i4 = 0; i4 < 4; ++i4)
#pragma unroll
                for (int i = 0; i < 16; ++i) *(LAS float*)(lds + ((32 * i4 + crow(i, hh)) * 128 + dvb + c) * 4) = S[i4][i];
        }
    }
    __syncthreads();
    { float* so = F.out + (samp ? O_SGDN : O_PGDN) + (size_t)(b * 32 + h) * 16384;
#pragma unroll
      for (int i = 0; i < 8; ++i) *(f32x4*)(so + (tid + 512 * i) * 4) = *(const LAS f32x4*)(lds + (tid + 512 * i) * 16); }
#undef SC_ITEM
#undef SC_M0
}
DI void p_scan(Frame& F) {
    const int nW = F.G, bx = blockIdx.x;
    for (int ch = bx; ch < NB * 32; ch += nW) { const int x = ch & 7, y = (ch >> 3) & 7, kh = x + 8 * (y >> 1);
        scan_chain(F, false, kh >> 4, 2 * (kh & 15) + (y & 1)); }
    int start, stride;
    if (nW > NB * 32) { start = bx - NB * 32; stride = nW - NB * 32; } else { start = bx; stride = nW; }
    if (start >= 0) for (int ch = start; ch < DECB * 32; ch += stride) scan_chain(F, true, ch >> 5, ch & 31);
}
DI void p_ffnconv(Frame& F, const int layer, const int tb_lo, const int tb_hi, const int gw, const int NGW, const bf16* UP, bf16* ACT) {
    const int lane = F.lane;
    const float* wconv = F.in[I_FWCONV] + (size_t)layer * 3 * UPW; const float* bconv = F.in[I_FBCONV] + (size_t)layer * UPW;
    constexpr int NCC = DFF / 512;
    const int NI = (tb_hi - tb_lo) * NCC, R = NI / NGW, rem = NI - R * NGW; const bool halves = 2 * rem <= NGW;
    const int npiece = R + ((halves ? gw < 2 * rem : gw < rem) ? 1 : 0);
    for (int k = 0; k < npiece; ++k) {
        const bool tail = k >= R;
        const int it = !tail ? gw + k * NGW : R * NGW + (halves ? gw >> 1 : gw);
        const int th_lo = (tail && halves) ? (gw & 1) : 0, th_hi = (tail && halves) ? th_lo + 1 : 2;
        const int tb = tb_lo + it / NCC, cc = it % NCC, c0 = cc * 512 + lane * 8;
        const bool samp = tb >= MP / 16; const int b = samp ? tb - MP / 16 : tb >> 9; const int t0 = samp ? 0 : (tb & 511) * 16;
        const size_t mbase = samp ? (size_t)MP + b * 16 : (size_t)b * SEQ; const int L = samp ? DECS : SEQ;
        float wg[3][8], wv[3][8], bg[8], bv[8];
#pragma unroll
        for (int i = 0; i < 3; ++i)
#pragma unroll
            for (int e = 0; e < 8; ++e) { wg[i][e] = wconv[i * UPW + c0 + e]; wv[i][e] = wconv[i * UPW + DFF + c0 + e]; }
#pragma unroll
        for (int e = 0; e < 8; ++e) { bg[e] = bconv[c0 + e]; bv[e] = bconv[DFF + c0 + e]; }
        float hg[2][8], hv[2][8];
#pragma unroll
        for (int j = 0; j < 2; ++j) { const int t = t0 + 8 * th_lo - 2 + j;
            if (t >= 0) { unpack8(*(const v4u*)(UP + (mbase + t) * UPW + c0), hg[j]); unpack8(*(const v4u*)(UP + (mbase + t) * UPW + DFF + c0), hv[j]); }
            else if (samp) { const float* sp = F.in[I_SFC] + ((size_t)(layer * DECB + b) * 2 + (t + 2)) * UPW + c0;
#pragma unroll
                for (int e = 0; e < 8; ++e) { hg[j][e] = sp[e]; hv[j][e] = sp[DFF + e]; } }
            else {
#pragma unroll
                for (int e = 0; e < 8; ++e) { hg[j][e] = 0.f; hv[j][e] = 0.f; } } }
        for (int th = th_lo; th < th_hi; ++th) {
        v4u rg[8], rv[8];
#pragma unroll
        for (int tt = 0; tt < 8; ++tt) { rg[tt] = __builtin_nontemporal_load((const v4u*)(UP + (mbase + t0 + 8 * th + tt) * UPW + c0)); rv[tt] = __builtin_nontemporal_load((const v4u*)(UP + (mbase + t0 + 8 * th + tt) * UPW + DFF + c0)); }
#pragma unroll
        for (int t8 = 0; t8 < 8; ++t8) {
            const int tt = 8 * th + t8; const int t = t0 + tt; const size_t m = mbase + t;
            float cg[8], cv[8]; unpack8(rg[t8], cg); unpack8(rv[t8], cv);
            float y[8];
#pragma unroll
            for (int e = 0; e < 8; ++e) { const float g = hg[0][e] * wg[0][e] + hg[1][e] * wg[1][e] + cg[e] * wg[2][e] + bg[e];
                const float v = hv[0][e] * wv[0][e] + hv[1][e] * wv[1][e] + cv[e] * wv[2][e] + bv[e]; y[e] = siluf(g) * v; }
            *(v4u*)(ACT + m * DFF + c0) = pack8(y);
            if (t >= L - 2) {
                float* so = F.out + (samp ? O_SFC + ((size_t)(layer * DECB + b) * 2 + (t - (L - 2))) * UPW : O_PFC + ((size_t)(layer * NB + b) * 2 + (t - (L - 2))) * UPW) + c0;
#pragma unroll
                for (int e = 0; e < 8; ++e) { so[e] = cg[e]; so[DFF + e] = cv[e]; } }
#pragma unroll
            for (int e = 0; e < 8; ++e) { hg[0][e] = hg[1][e]; hg[1][e] = cg[e]; hv[0][e] = hv[1][e]; hv[1][e] = cv[e]; }
        }
        }
    }
}
DI void p_final(Frame& F, const int m_lo, const int m_hi, const int gw, const int NGW) {
    const int lane = F.lane;
    const float* ssq = (const float*)(F.ws + WS_SSQ + 4 * SSQ_STRIDE); const float* gain = F.in[I_FINAL];
    for (int m0 = m_lo + gw; m0 < m_hi; m0 += 2 * NGW) {
        const int m1 = m0 + NGW; const bool two = m1 < m_hi; const int mb = two ? m1 : m0;
        float s0 = (lane < 32) ? ssq[(size_t)m0 * 32 + lane] : 0.f; float s1 = (lane < 32) ? ssq[(size_t)mb * 32 + lane] : 0.f;
        f32x4* ya = (f32x4*)(F.out + (size_t)m0 * DM) + lane; f32x4* yb = (f32x4*)(F.out + (size_t)mb * DM) + lane; const f32x4* g4 = (const f32x4*)gain + lane;
        f32x4 va[8], vb[8];
#pragma unroll
        for (int j = 0; j < 8; ++j) va[j] = __builtin_nontemporal_load(ya + 64 * j);
#pragma unroll
        for (int j = 0; j < 8; ++j) vb[j] = __builtin_nontemporal_load(yb + 64 * j);
        s0 = wave_sum(s0); s1 = wave_sum(s1);
        const float r0 = rsqrtf(s0 * (1.0f / 2048.0f) + 1e-6f), r1 = rsqrtf(s1 * (1.0f / 2048.0f) + 1e-6f);
#pragma unroll
        for (int j = 0; j < 8; ++j) __builtin_nontemporal_store(va[j] * r0 * g4[64 * j], ya + 64 * j);
        if (two) {
#pragma unroll
            for (int j = 0; j < 8; ++j) __builtin_nontemporal_store(vb[j] * r1 * g4[64 * j], yb + 64 * j);
        }
    }
}
DI void p_cacheconv(Frame& F, const float* src, bf16* dst, const size_t t0, const size_t nthr) {
    constexpr size_t NP = (size_t)DECB * PAST * DM / 8;
    for (size_t p = t0; p < NP; p += nthr) {
        const size_t row = p >> 8, c8 = p & 255, b = row >> 11, key = row & 2047;
        const f32x4 a = __builtin_nontemporal_load((const f32x4*)(src + p * 8)), bq = __builtin_nontemporal_load((const f32x4*)(src + p * 8 + 4));
        v4u o; o.x = pk2(a[0], a[1]); o.y = pk2(a[2], a[3]); o.z = pk2(bq[0], bq[1]); o.w = pk2(bq[2], bq[3]);
        *(v4u*)(dst + (b * (PAST + DECS) + key) * DM + c8 * 8) = o;
    }
}
#ifndef ATT_SKEW
#define ATT_SKEW 0
#endif
constexpr int AT_K = 0, AT_V = 65536, AT_BT = 131072;
constexpr float ATT_C = 0.08838834764831845f * 1.4426950408889634f;
constexpr float LAM_INIT = 0.35550906759718507f;
constexpr float ATT_THR = 6.0f;
constexpr int CW_ATTQ = 64;
struct AttnUnit { const bf16* Kp; const bf16* Vp; const bf16* Qp; bf16* Op; int h, nq, qpos0, nkeys; size_t mq0; };
DI int t5_bucket(int rel) { const int n = rel < 0 ? -rel : rel; int v; if (n < 8) v = n; else { v = 2 + (31 - __builtin_clz((unsigned)(n * n))); v = v > 15 ? 15 : v; } return (rel > 0 ? 16 : 0) + v; }
#define KSWZ(row, colB) ((row) * 256 + ((colB) ^ (((row) & 7) << 4)))
DI int v_st(int k, int c) { return ((k >> 3) * 8 + (c >> 5)) * 512 + ((k & 7) * 32 + (c & 31)) * 2; }
DI int v_rd_base(int lane) { return ((lane & 3) << 3) | (((lane >> 2) & 3) << 6) | (((lane >> 4) & 1) << 5) | (((lane >> 5) & 1) << 8); }
DI void at_dma(LAS unsigned char* lds, const AttnUnit& U, const int kt, const int buf, const int w, int lane) {
    asm volatile("" : "+v"(lane));
#pragma unroll
    for (int i = 0; i < 4; ++i) {
        const int ch = 4 * w + i, map = ch >> 4, row = 4 * (ch & 15) + (lane >> 4), cc = (lane & 15) ^ (row & 7); int kg = kt * 64 + row; kg = kg < U.nkeys ? kg : U.nkeys - 1;
        __builtin_amdgcn_global_load_lds((const unsigned*)(U.Kp + (size_t)kg * DM + (2 * U.h + map) * 128 + cc * 8), (LAS unsigned*)(lds + AT_K + buf * 32768 + ch * 1024), 16, 0, 0); }
#pragma unroll
    for (int i = 0; i < 4; ++i) {
        const int ch = 4 * w + i, key = 8 * (ch >> 2) + ((lane & 31) >> 2), col = 32 * (2 * (ch & 3) + (lane >> 5)) + 8 * (lane & 3); int kg = kt * 64 + key; kg = kg < U.nkeys ? kg : U.nkeys - 1;
        __builtin_amdgcn_global_load_lds((const unsigned*)(U.Vp + (size_t)kg * DM + U.h * 256 + col), (LAS unsigned*)(lds + AT_V + buf * 32768 + ch * 1024), 16, 0, 0); }
}
#define PK(L, H) (bf16x8){L[0], L[1], L[2], L[3], H[0], H[1], H[2], H[3]}
#define VRD(P, D0) const bf16x4 P##l0 = tr_read<(D0) * 512 + 0 * 8192>(vb), P##h0 = tr_read<(D0) * 512 + 0 * 8192 + 4096>(vb), P##l1 = tr_read<(D0) * 512 + 1 * 8192>(vb), P##h1 = tr_read<(D0) * 512 + 1 * 8192 + 4096>(vb), \
    P##l2 = tr_read<(D0) * 512 + 2 * 8192>(vb), P##h2 = tr_read<(D0) * 512 + 2 * 8192 + 4096>(vb), P##l3 = tr_read<(D0) * 512 + 3 * 8192>(vb), P##h3 = tr_read<(D0) * 512 + 3 * 8192 + 4096>(vb)
#define VMM(P, D0) do { O[D0] = MFMA32(pf[0], PK(P##l0, P##h0), O[D0]); O[D0] = MFMA32(pf[1], PK(P##l1, P##h1), O[D0]); O[D0] = MFMA32(pf[2], PK(P##l2, P##h2), O[D0]); O[D0] = MFMA32(pf[3], PK(P##l3, P##h3), O[D0]); } while (0)
#define VW8() do { asm volatile("s_waitcnt lgkmcnt(8)" ::: "memory"); __builtin_amdgcn_sched_barrier(0); } while (0)
DI void at_pv_all(f32x16 (&O)[8], const int vb, const bf16x8 (&pf)[4]) {
    VRD(a, 0); __builtin_amdgcn_sched_barrier(0);
    VRD(b, 1); VW8(); VMM(a, 0); __builtin_amdgcn_sched_barrier(0);
    VRD(c, 2); VW8(); VMM(b, 1); __builtin_amdgcn_sched_barrier(0);
    VRD(d, 3); VW8(); VMM(c, 2); __builtin_amdgcn_sched_barrier(0);
    VRD(e, 4); VW8(); VMM(d, 3); __builtin_amdgcn_sched_barrier(0);
    VRD(f, 5); VW8(); VMM(e, 4); __builtin_amdgcn_sched_barrier(0);
    VRD(g, 6); VW8(); VMM(f, 5); __builtin_amdgcn_sched_barrier(0);
    VRD(h, 7); VW8(); VMM(g, 6); __builtin_amdgcn_sched_barrier(0);
    asm volatile("s_waitcnt lgkmcnt(0)" ::: "memory"); __builtin_amdgcn_sched_barrier(0); VMM(h, 7); __builtin_amdgcn_sched_barrier(0);
}
#undef VRD
#undef VMM
#undef VW8
#undef PK
DI void attn_unit(Frame& F, const AttnUnit& U, const float lam) {
    const int tid = F.tid, w = F.wave, lane = F.lane, rt = w >> 1, mm = w & 1;
    LAS unsigned char* lds = F.lds;
    const bf16* QB = U.Qp; bf16* ATT = U.Op;
    __syncthreads();
    { int tv = tid; asm volatile("" : "+v"(tv)); const int rel = tv - 256; *(LAS float*)(lds + AT_BT + tv * 4) = F.in[I_RELB][t5_bucket(rel) * 8 + U.h] * 1.4426950408889634f; }
    const bool active = 32 * rt < U.nq;
    const int qchunk = (U.qpos0 + 32 * rt) >> 6;
    bf16x8 qf[8];
    { int lq = lane; asm volatile("" : "+v"(lq)); const int c = lq & 31, hh = lq >> 5, qrow = 32 * rt + c;
#pragma unroll
      for (int s = 0; s < 8; ++s) qf[s] = (qrow < U.nq) ? *(const bf16x8*)(QB + (U.mq0 + qrow) * DM + (2 * U.h + mm) * 128 + 16 * s + 8 * hh) : (bf16x8){0, 0, 0, 0, 0, 0, 0, 0}; }
    const int ntiles = (U.nkeys + 63) >> 6;
    float m_run = -1e30f, l_run = 0.f;
    f32x16 O[8];
#pragma unroll
    for (int d = 0; d < 8; ++d) O[d] = (f32x16){};
    at_dma(lds, U, 0, 0, w, lane);
    asm volatile("s_waitcnt vmcnt(0)" ::: "memory");
    __syncthreads();
    for (int kt = 0; kt < ntiles; ++kt) {
        const bool vis = active && kt <= qchunk;
        if (!vis && kt + 1 < ntiles) at_dma(lds, U, kt + 1, (kt + 1) & 1, w, lane);
        if (vis) {
#if ATT_SKEW
            if (w >= 4) __builtin_amdgcn_s_sleep(ATT_SKEW);
#endif
            int lv = lane; asm volatile("" : "+v"(lv)); const int c = lv & 31, hh = lv >> 5; const int qpos_lane = U.qpos0 + 32 * rt + c;
            const int kbase = AT_K + (kt & 1) * 32768 + mm * 16384;
            f32x16 t0 = {}, t1 = {};
            {
                bf16x8 ka[3], kb[3];
#define LDKF(buf, s0) do { ka[buf] = *(const LAS bf16x8*)(lds + kbase + KSWZ(c, 32 * (s0) + 16 * hh)); kb[buf] = *(const LAS bf16x8*)(lds + kbase + KSWZ(32 + c, 32 * (s0) + 16 * hh)); } while (0)
#define MMKF(buf, s0) do { t0 = MFMA32(ka[buf], qf[s0], t0); t1 = MFMA32(kb[buf], qf[s0], t1); } while (0)
#define SB_() __builtin_amdgcn_sched_barrier(0)
                LDKF(0, 0); LDKF(1, 1); SB_();
                LDKF(2, 2); SB_(); MMKF(0, 0); SB_();
                LDKF(0, 3); SB_(); MMKF(1, 1); SB_();
                LDKF(1, 4); SB_(); MMKF(2, 2); SB_();
                LDKF(2, 5); SB_(); MMKF(0, 3); SB_();
                LDKF(0, 6); SB_(); MMKF(1, 4); SB_();
                LDKF(1, 7); SB_(); MMKF(2, 5); SB_();
                MMKF(0, 6); SB_(); MMKF(1, 7); SB_();
#undef SB_
#undef LDKF
#undef MMKF
            }
            const LAS float* bt = (const LAS float*)(lds + AT_BT);
            float mx, bc0 = 0.f; bool far = false;
            if (kt * 64 + 63 - (U.qpos0 + 32 * rt) <= -91 && kt * 64 + 63 < U.nkeys) {
                far = true; bc0 = bt[0];
                float r0 = fmaxf(t0[0], t1[0]);
#pragma unroll
                for (int i = 1; i < 16; i += 1) r0 = __builtin_fmaxf(__builtin_fmaxf(r0, t0[i]), t1[i]);
                mx = r0 * ATT_C + bc0;
            } else {
                const bool part = kt * 64 + 63 >= U.nkeys;
#pragma unroll
                for (int i = 0; i < 16; ++i) { const int kg = kt * 64 + crow(i, hh); int r0 = kg - qpos_lane, r1 = r0 + 32;
                    r0 = r0 < -256 ? -256 : r0; r0 = r0 > 255 ? 255 : r0; r1 = r1 < -256 ? -256 : r1; r1 = r1 > 255 ? 255 : r1;
                    float b0 = bt[r0 + 256], b1 = bt[r1 + 256];
                    if (part) { b0 = (kg < U.nkeys) ? b0 : -1e30f; b1 = (kg + 32 < U.nkeys) ? b1 : -1e30f; }
                    t0[i] = t0[i] * ATT_C + b0; t1[i] = t1[i] * ATT_C + b1; }
                mx = fmaxf(t0[0], t1[0]);
#pragma unroll
                for (int i = 1; i < 16; ++i) mx = __builtin_fmaxf(__builtin_fmaxf(mx, t0[i]), t1[i]);
            }
            mx = fmaxf(mx, __shfl_xor(mx, 32));
            if (__any(mx - m_run > ATT_THR)) {
                const float mn = fmaxf(m_run, mx), al = __builtin_amdgcn_exp2f(m_run - mn);
#pragma unroll
                for (int i = 0; i < 16; ++i) { const float ai = __shfl(al, crow(i, hh));
#pragma unroll
                    for (int d = 0; d < 8; ++d) O[d][i] *= ai; }
                l_run *= al; m_run = mn;
            }
            float ps = 0.f;
            if (far) { const float off = bc0 - m_run;
#pragma unroll
                for (int i = 0; i < 16; ++i) { t0[i] = __builtin_amdgcn_exp2f(__builtin_fmaf(t0[i], ATT_C, off)); t1[i] = __builtin_amdgcn_exp2f(__builtin_fmaf(t1[i], ATT_C, off)); ps += t0[i] + t1[i]; }
            } else {
#pragma unroll
                for (int i = 0; i < 16; ++i) { t0[i] = __builtin_amdgcn_exp2f(t0[i] - m_run); t1[i] = __builtin_amdgcn_exp2f(t1[i] - m_run); ps += t0[i] + t1[i]; }
            }
            l_run += ps;
            bf16x8 pf[4];
            pf[0] = pack_acc(t0, 0); pf[1] = pack_acc(t0, 1); pf[2] = pack_acc(t1, 0); pf[3] = pack_acc(t1, 1);
            if (kt + 1 < ntiles) at_dma(lds, U, kt + 1, (kt + 1) & 1, w, lane);
            const int vb = (int)(unsigned)(size_t)(lds + AT_V + (kt & 1) * 32768) + v_rd_base(lv);
            asm volatile("s_waitcnt lgkmcnt(0)" ::: "memory"); at_pv_all(O, vb, pf);
        }
        asm volatile("s_waitcnt vmcnt(0)" ::: "memory");
        __syncthreads();
    }
    {
        int lv = lane; asm volatile("" : "+v"(lv)); const int c = lv & 31, hh = lv >> 5;
        l_run += __shfl_xor(l_run, 32);
        const float sc_own = (mm ? lam : 1.0f) / l_run;
        LAS float* xo = (LAS float*)lds + rt * 8192;
        if (mm == 1) {
#pragma unroll
            for (int i = 0; i < 16; ++i) { const float si = __shfl(sc_own, crow(i, hh));
#pragma unroll
                for (int d = 0; d < 8; ++d) xo[crow(i, hh) * 256 + 32 * d + c] = O[d][i] * si; }
        }
        __syncthreads();
        if (mm == 0 && active) {
            float ssa[16];
#pragma unroll
            for (int i = 0; i < 16; ++i) { const float si = __shfl(sc_own, crow(i, hh)); float a = 0.f;
#pragma unroll
                for (int d = 0; d < 8; ++d) { const float o = O[d][i] * si - xo[crow(i, hh) * 256 + 32 * d + c]; O[d][i] = o; a += o * o; }
                a += __shfl_xor(a, 1); a += __shfl_xor(a, 2); a += __shfl_xor(a, 4); a += __shfl_xor(a, 8); a += __shfl_xor(a, 16);
                ssa[i] = rsqrtf(a * (1.0f / 256.0f) + 1e-5f) * (1.0f - LAM_INIT); }
#pragma unroll
            for (int d = 0; d < 8; ++d) { const float gn = F.in[I_SUBN][32 * d + c];
#pragma unroll
                for (int i = 0; i < 16; ++i) { const int r = 32 * rt + crow(i, hh);
                    if (r < U.nq) ATT[(U.mq0 + r) * DM + U.h * 256 + 32 * d + c] = (bf16)(pk2(O[d][i] * ssa[i] * gn, 0.f) & 0xffffu); } }
        }
    }
}
DI float attn_lambda(Frame& F) {
    float d1 = 0.f, d2 = 0.f;
    for (int i = 0; i < 128; ++i) { d1 += F.in[I_LQ1][i] * F.in[I_LK1][i]; d2 += F.in[I_LQ2][i] * F.in[I_LK2][i]; }
    return __expf(d1) - __expf(d2) + LAM_INIT;
}
DI void p_attn(Frame& F) {
    const float lam = attn_lambda(F);
    const bf16* KB = (const bf16*)(F.ws + WS_KB); const bf16* VB = (const bf16*)(F.ws + WS_VB);
    constexpr int NPQ = NB * 8 * 64 / 8;
    const int xcc = (int)(xb_xcc_id() & 7u);
    for (int e = 0; e < 8; ++e) {
        const int q = (xcc + e) & 7;
        for (;;) {
            __syncthreads();
            if (F.tid == 0) F.MISC[16] = atomicAdd(F.ctl + CW_ATTQ + 32 * q, 1u);
            __syncthreads();
            const int r = __builtin_amdgcn_readfirstlane((int)F.MISC[16]);
            if (r >= NPQ) break;
            AttnUnit U; const int bh = 2 * q + (r & 1), u = 63 - (r >> 1), b = bh >> 3;
            U.h = bh & 7; U.Kp = KB + (size_t)b * SEQ * DM; U.Vp = VB + (size_t)b * SEQ * DM; U.Qp = (const bf16*)(F.ws + WS_QB); U.Op = (bf16*)(F.ws + WS_ATT);
            U.nq = 128; U.qpos0 = u * 128; U.nkeys = (u + 1) * 128; U.mq0 = (size_t)b * SEQ + (size_t)u * 128;
            attn_unit(F, U, lam);
        }
    }
}
DI void p_attn_sample(Frame& F, const int sw, const int nsw) {
    const float lam = attn_lambda(F);
    const bf16* KC = (const bf16*)(F.ws + WS_KC); const bf16* VC = (const bf16*)(F.ws + WS_VC);
    for (int p = sw; p < DECB * 8; p += nsw) {
        AttnUnit U; const int b = p >> 3; U.h = p & 7; U.Kp = KC + (size_t)b * (PAST + DECS) * DM; U.Vp = VC + (size_t)b * (PAST + DECS) * DM;
        U.Qp = (const bf16*)(F.ws + WS_SQB) - (size_t)MP * DM; U.Op = (bf16*)(F.ws + WS_SATT) - (size_t)MP * DM;
        U.nq = DECS; U.qpos0 = PAST; U.nkeys = PAST + DECS; U.mq0 = (size_t)MP + (size_t)b * DECS;
        attn_unit(F, U, lam);
    }
}
#ifndef WGM_SMALLN
#define WGM_SMALLN 4
#endif
#ifndef WGM_BIGN
#define WGM_BIGN 4
#endif
#ifndef N_LAUNCH_MODE
#define N_LAUNCH_MODE 1
#endif
constexpr int N_PHASES = 16;
struct Args { const float* in[N_IN]; float* out; unsigned char* ws; int ph_lo, ph_hi; };
static_assert(sizeof(Args) == (N_IN + 2) * 8 + 8, "Args has no padding");
__global__ void __launch_bounds__(NWAVES * 64, 2) fwd(Args args) {
    extern __shared__ __attribute__((aligned(16))) unsigned char lds_raw[];
    Frame F;
    F.lds = (LAS unsigned char*)lds_raw;
    F.MISC = (volatile LAS unsigned*)(F.lds + LDSCTL_OFF);
    F.tid = threadIdx.x; F.lane = F.tid & 63; F.wave = __builtin_amdgcn_readfirstlane(F.tid >> 6);
    F.G = gridDim.x; { const int bx = blockIdx.x; F.vcu = (F.G % 8 == 0) ? (bx % 8) * (F.G / 8) + bx / 8 : bx; }
    F.in = args.in; F.out = args.out; F.ws = args.ws; F.ctl = (unsigned*)(args.ws + WS_CTL);
    for (int u = F.tid; u < (LDS_BYTES - LDSCTL_OFF) / 4; u += NWAVES * 64) ((LAS unsigned*)(F.lds + LDSCTL_OFF))[u] = 0u;
    __syncthreads();
    XcdBarrier bar; bar.bar = F.ctl + CW_BAR; bar.x = 0; bar.st = nullptr;
    if (N_LAUNCH_MODE == 1) bar = xcd_barrier_post(F.ctl + CW_BAR, F.MISC + 8);
    const int lo = args.ph_lo, hi = args.ph_hi;
#ifndef PHASE_MASK
#define PHASE_MASK 0xffff
#endif
#define IN(k) (((PHASE_MASK >> (k)) & 1) && lo <= (k) && (k) < hi)
#ifndef TWICE_MASK
#define TWICE_MASK 0
#endif
#ifndef NREP
#define NREP 2
#endif
#ifndef SPIN_MASK
#define SPIN_MASK 0
#endif
#define SEAM(k) do { if (((SPIN_MASK >> (k)) & 1) && IN(k)) { const unsigned long long t1_ = __builtin_amdgcn_s_memrealtime(); while (__builtin_amdgcn_s_memrealtime() - t1_ < t1_ - tph_) __builtin_amdgcn_s_sleep(8); } \
    if (IN(k) && IN((k) + 1)) xcd_barrier(bar); if (SPIN_MASK) tph_ = __builtin_amdgcn_s_memrealtime(); } while (0)
#define REP(k) for (int rep_ = 0; rep_ < (((TWICE_MASK >> (k)) & 1) ? NREP : 1); ++rep_, (((TWICE_MASK >> (k)) & 1) && rep_ < NREP ? xcd_barrier(bar) : (void)0))
    unsigned long long tph_ = SPIN_MASK ? __builtin_amdgcn_s_memrealtime() : 0ull; (void)tph_;
    unsigned char* ws = args.ws;
    PG8_LAS unsigned char* ring = (PG8_LAS unsigned char*)F.lds;
    bf16* HB = (bf16*)(ws + WS_HB);
    float* H = args.out;
#define SSQP(i) ((float*)(ws + WS_SSQ + (size_t)(i) * SSQ_STRIDE))

    const int gwA = F.vcu * NWAVES + F.wave, NGWA = F.G * NWAVES;
    const bf16* UPm = (const bf16*)(ws + WS_UP); bf16* ACTm = (bf16*)(ws + WS_ACT);
    if (IN(0)) { REP(0) p0_prologue(F); } SEAM(0);
    if (IN(1)) {
        pg8::Gemm g{HB, (const bf16*)(ws + WS_WIN), M, INWP, DM}; pg8::StaticOrder S; S.init(M, INWP, F.G, (int)blockIdx.x, WGM_BIGN);
        pg8::EpiBf E{SSQP(0), (bf16*)(ws + WS_QKV), QKVW, QKVW, (bf16*)(ws + WS_Z), VW, VW, (float*)(ws + WS_BA), 64, 64};
        pg8::gemm_phase<pg8::EpiBf, pg8::StaticOrder, PG8_ALIGN, PG8_SP2>(ring, g, S, E, F.tid);
    } SEAM(1);
#ifdef GDN_REP5
    if (IN(2)) { p_gdnconv(F); p_gdnconv(F); p_gdnconv(F); p_gdnconv(F); p_gdnconv(F); } SEAM(2);
#else
    if (IN(2)) { REP(2) p_gdnconv(F); } SEAM(2);
#endif
    if (IN(3)) { REP(3) p_prep(F); } SEAM(3);
    if (IN(4)) {
        p_scan(F);
        const int nW = F.G, bx = blockIdx.x;
        const bool sub = (nW > NB * 32) ? (bx >= NB * 32) : true;
        const int sw = (nW > NB * 32) ? bx - NB * 32 : bx, nsw = (nW > NB * 32) ? nW - NB * 32 : nW;
        if (sub) {
#ifndef SUBSPIN
#define SUBSPIN 0
#endif
            unsigned long long tst_ = SUBSPIN ? __builtin_amdgcn_s_memrealtime() : 0ull; (void)tst_;
#define STG0() do { if (SUBSPIN) tst_ = __builtin_amdgcn_s_memrealtime(); } while (0)
#define STG(i) do { if ((SUBSPIN >> (i)) & 1) { const unsigned long long t1_ = __builtin_amdgcn_s_memrealtime(); while (__builtin_amdgcn_s_memrealtime() - t1_ < t1_ - tst_) __builtin_amdgcn_s_sleep(8); } } while (0)
            XcdBarrier sb = xcd_barrier_post(F.ctl + CW_BAR2, F.MISC + 12);
            const unsigned ne = (unsigned)nsw; const int gwS = sw * NWAVES + F.wave, NGWS = nsw * NWAVES;
#define UPs_ ((bf16*)(ws + WS_SUP) - (size_t)MP * UPW)
#define ACTs_ ((bf16*)(ws + WS_SACT) - (size_t)MP * DFF)
#define QBs_ ((bf16*)(ws + WS_SQB) - (size_t)MP * DM)
#define ATTs_ ((bf16*)(ws + WS_SATT) - (size_t)MP * DM)
            const int spm = MP / 256;
#define IDLE(n) (sw >= (n) && nsw > (n))
#define IGW(n) ((sw - (n)) * NWAVES + F.wave)
#define INGW(n) ((nsw - (n)) * NWAVES)
            __syncthreads();
            conv_job(F, CJ_WOUT, gwS, NGWS);
            if (nsw <= 44) { conv_job(F, CJ_WUP0, gwS, NGWS); conv_job(F, CJ_WDN0, gwS, NGWS); conv_job(F, CJ_WKVQ, gwS, NGWS); conv_job(F, CJ_WO, gwS, NGWS); conv_job(F, CJ_WUP1, gwS, NGWS); conv_job(F, CJ_WDN1, gwS, NGWS);
                p_cacheconv(F, args.in[I_CK], (bf16*)(ws + WS_KC), (size_t)sw * 512 + F.tid, (size_t)nsw * 512); p_cacheconv(F, args.in[I_CV], (bf16*)(ws + WS_VC), (size_t)sw * 512 + F.tid, (size_t)nsw * 512); }
            const bool spread = nsw > 44;
            STG(0); sub_barrier(sb, ne); asm volatile("" : "+v"(F.tid), "+v"(F.lane)); STG0();
            {
                pg8::Gemm g{(const bf16*)(args.out + O_PK), (const bf16*)(ws + WS_WOUT), M, DM, VW}; pg8::SubOrder S{spm, DM / 256, nsw, sw};
                pg8::EpiRes E{args.in[I_XS] - (size_t)MP * DM, args.in[I_XS] - (size_t)MP * DM, H, HB, SSQP(1)};
                pg8::gemm_phase<pg8::EpiRes, pg8::SubOrder, PG8_ALIGN, PG8_SP2>(ring, g, S, E, F.tid); }
            if (spread && IDLE(8)) { __syncthreads(); conv_job(F, CJ_WUP0, IGW(8), INGW(8)); }
            STG(1); sub_barrier(sb, ne); asm volatile("" : "+v"(F.tid), "+v"(F.lane)); STG0();
            {
                pg8::Gemm g{HB, (const bf16*)(ws + WS_WUP0), M, UPW, DM}; pg8::SubOrder S{spm, UPW / 256, nsw, sw};
                pg8::EpiBf E{SSQP(1), UPs_, UPW, UPW, nullptr, 0, 0, nullptr, 0, 0};
                pg8::gemm_phase<pg8::EpiBf, pg8::SubOrder, PG8_ALIGN, PG8_SP2>(ring, g, S, E, F.tid); }
            if (spread && IDLE(44)) { __syncthreads(); conv_job(F, CJ_WDN0, IGW(44), INGW(44)); conv_job(F, CJ_WKVQ, IGW(44), INGW(44)); }
            STG(2); sub_barrier(sb, ne); asm volatile("" : "+v"(F.tid), "+v"(F.lane)); STG0();
            p_ffnconv(F, 0, MP / 16, MP / 16 + DECB, gwS, NGWS, UPs_, ACTs_);
            STG(3); sub_barrier(sb, ne); asm volatile("" : "+v"(F.tid), "+v"(F.lane)); STG0();
            {
                pg8::Gemm g{ACTs_, (const bf16*)(ws + WS_WDN0), M, DM, DFF}; pg8::SubOrder S{spm, DM / 256, nsw, sw};
                pg8::EpiRes E{H, H, H, HB, SSQP(2)};
                pg8::gemm_phase<pg8::EpiRes, pg8::SubOrder, PG8_ALIGN, PG8_SP2>(ring, g, S, E, F.tid); }
            if (spread && IDLE(8)) p_cacheconv(F, args.in[I_CK], (bf16*)(ws + WS_KC), (size_t)(sw - 8) * 512 + F.tid, (size_t)(nsw - 8) * 512);
            STG(4); sub_barrier(sb, ne); asm volatile("" : "+v"(F.tid), "+v"(F.lane)); STG0();
            {
                pg8::Gemm g{HB, (const bf16*)(ws + WS_WKVQ), M, 6144, DM}; pg8::SubOrder S{spm, 6144 / 256, nsw, sw};
                pg8::EpiKVQs E{SSQP(2), args.out, (bf16*)(ws + WS_KC), (WS_VC - WS_KC) / 2, QBs_};
                pg8::gemm_phase<pg8::EpiKVQs, pg8::SubOrder, PG8_ALIGN, PG8_SP2>(ring, g, S, E, F.tid); }
            if (spread && IDLE(24)) p_cacheconv(F, args.in[I_CV], (bf16*)(ws + WS_VC), (size_t)(sw - 24) * 512 + F.tid, (size_t)(nsw - 24) * 512);
            STG(5); sub_barrier(sb, ne); asm volatile("" : "+v"(F.tid), "+v"(F.lane)); STG0();
            p_attn_sample(F, sw, nsw);
            if (spread && IDLE(128)) { __syncthreads(); conv_job(F, CJ_WO, IGW(128), INGW(128)); conv_job(F, CJ_WUP1, IGW(128), INGW(128)); conv_job(F, CJ_WDN1, IGW(128), INGW(128)); }
            else if (spread && nsw <= 128) { __syncthreads(); conv_job(F, CJ_WO, gwS, NGWS); conv_job(F, CJ_WUP1, gwS, NGWS); conv_job(F, CJ_WDN1, gwS, NGWS); }
            STG(6); sub_barrier(sb, ne); asm volatile("" : "+v"(F.tid), "+v"(F.lane)); STG0();
        }
    } SEAM(4);
    if (IN(5)) {
        pg8::Gemm g{(const bf16*)(args.out + O_PK), (const bf16*)(ws + WS_WOUT), MP, DM, VW}; pg8::StaticOrder S; S.init(MP, DM, F.G, (int)blockIdx.x, WGM_SMALLN);
        pg8::EpiRes E{args.in[I_XP], args.in[I_XP], H, HB, SSQP(1)};
        pg8::gemm_phase<pg8::EpiRes, pg8::StaticOrder, PG8_ALIGN, PG8_SP2>(ring, g, S, E, F.tid);
    } SEAM(5);
    if (IN(6)) {
        pg8::Gemm g{HB, (const bf16*)(ws + WS_WUP0), MP, UPW, DM}; pg8::StaticOrder S; S.init(MP, UPW, F.G, (int)blockIdx.x, WGM_BIGN);
        pg8::EpiBf E{SSQP(1), (bf16*)(ws + WS_UP), UPW, UPW, nullptr, 0, 0, nullptr, 0, 0};
        pg8::gemm_phase<pg8::EpiBf, pg8::StaticOrder, PG8_ALIGN, PG8_SP2>(ring, g, S, E, F.tid);
    } SEAM(6);
#ifndef EXTRA_BAR
#define EXTRA_BAR 0
#endif
#ifdef FFN_REP5
    if (IN(7)) { { int g_ = gwA; asm volatile("" : "+s"(g_)); p_ffnconv(F, 0, 0, MP / 16, g_, NGWA, UPm, ACTm); } { int g_ = gwA; asm volatile("" : "+s"(g_)); p_ffnconv(F, 0, 0, MP / 16, g_, NGWA, UPm, ACTm); } { int g_ = gwA; asm volatile("" : "+s"(g_)); p_ffnconv(F, 0, 0, MP / 16, g_, NGWA, UPm, ACTm); } { int g_ = gwA; asm volatile("" : "+s"(g_)); p_ffnconv(F, 0, 0, MP / 16, g_, NGWA, UPm, ACTm); } { int g_ = gwA; asm volatile("" : "+s"(g_)); p_ffnconv(F, 0, 0, MP / 16, g_, NGWA, UPm, ACTm); } } SEAM(7);
#else
    if (IN(7)) { for (int eb_ = 0; eb_ < EXTRA_BAR; ++eb_) xcd_barrier(bar); REP(7) p_ffnconv(F, 0, 0, MP / 16, gwA, NGWA, UPm, ACTm); } SEAM(7);
#endif
    if (IN(8)) {
        pg8::Gemm g{(const bf16*)(ws + WS_ACT), (const bf16*)(ws + WS_WDN0), MP, DM, DFF}; pg8::StaticOrder S; S.init(MP, DM, F.G, (int)blockIdx.x, WGM_SMALLN);
        pg8::EpiRes E{H, H, H, HB, SSQP(2)};
        pg8::gemm_phase<pg8::EpiRes, pg8::StaticOrder, PG8_ALIGN, PG8_SP2>(ring, g, S, E, F.tid);
    } SEAM(8);
    if (IN(9)) {
        pg8::Gemm g{HB, (const bf16*)(ws + WS_WKVQ), MP, 6144, DM}; pg8::StaticOrder S; S.init(MP, 6144, F.G, (int)blockIdx.x, WGM_BIGN);
        pg8::EpiKVQ E{SSQP(2), args.out, (bf16*)(ws + WS_KB), (WS_VB - WS_KB) / 2, (bf16*)(ws + WS_KC), (WS_VC - WS_KC) / 2};
        static_assert(WS_QB - WS_VB == WS_VB - WS_KB, "K, V, Q bf16 buffers equally spaced");
        pg8::gemm_phase<pg8::EpiKVQ, pg8::StaticOrder, PG8_ALIGN, PG8_SP2>(ring, g, S, E, F.tid);
    } SEAM(9);
    if (IN(10)) {
        const int nsb = F.G < 8 ? F.G : 8;
        if ((int)blockIdx.x < nsb) {
            XcdBarrier sb3 = xcd_barrier_post(F.ctl + CW_BAR3, F.MISC + 14);
            const int spm = MP / 256;
            {
                pg8::Gemm g{ATTs_, (const bf16*)(ws + WS_WO), M, DM, DM}; pg8::SubOrder S{spm, DM / 256, nsb, (int)blockIdx.x};
                pg8::EpiRes E{H, H, H, HB, SSQP(3)};
                pg8::gemm_phase<pg8::EpiRes, pg8::SubOrder, PG8_ALIGN, PG8_SP2>(ring, g, S, E, F.tid); }
            sub_barrier(sb3, (unsigned)nsb); asm volatile("" : "+v"(F.tid), "+v"(F.lane));
            {
                pg8::Gemm g{HB, (const bf16*)(ws + WS_WUP1), M, UPW, DM}; pg8::SubOrder S{spm, UPW / 256, nsb, (int)blockIdx.x};
                pg8::EpiBf E{SSQP(3), UPs_, UPW, UPW, nullptr, 0, 0, nullptr, 0, 0};
                pg8::gemm_phase<pg8::EpiBf, pg8::SubOrder, PG8_ALIGN, PG8_SP2>(ring, g, S, E, F.tid); }
            sub_barrier(sb3, (unsigned)nsb); asm volatile("" : "+v"(F.tid), "+v"(F.lane));
            p_ffnconv(F, 1, MP / 16, MP / 16 + DECB, (int)blockIdx.x * NWAVES + F.wave, nsb * NWAVES, UPs_, ACTs_);
            sub_barrier(sb3, (unsigned)nsb); asm volatile("" : "+v"(F.tid), "+v"(F.lane));
            {
                pg8::Gemm g{ACTs_, (const bf16*)(ws + WS_WDN1), M, DM, DFF}; pg8::SubOrder S{spm, DM / 256, nsb, (int)blockIdx.x};
                pg8::EpiRes E{H, H, H, nullptr, SSQP(4)};
                pg8::gemm_phase<pg8::EpiRes, pg8::SubOrder, PG8_ALIGN, PG8_SP2>(ring, g, S, E, F.tid); }
            sub_barrier(sb3, (unsigned)nsb); asm volatile("" : "+v"(F.tid), "+v"(F.lane));
            p_final(F, MP, M, (int)blockIdx.x * NWAVES + F.wave, nsb * NWAVES);
        }
        p_attn(F);
    } SEAM(10);
    if (IN(11)) {
        pg8::Gemm g{(const bf16*)(ws + WS_ATT), (const bf16*)(ws + WS_WO), MP, DM, DM}; pg8::StaticOrder S; S.init(MP, DM, F.G, (int)blockIdx.x, WGM_SMALLN);
        pg8::EpiRes E{H, H, H, HB, SSQP(3)};
        pg8::gemm_phase<pg8::EpiRes, pg8::StaticOrder, PG8_ALIGN, PG8_SP2>(ring, g, S, E, F.tid);
    } SEAM(11);
    if (IN(12)) {
        pg8::Gemm g{HB, (const bf16*)(ws + WS_WUP1), MP, UPW, DM}; pg8::StaticOrder S; S.init(MP, UPW, F.G, (int)blockIdx.x, WGM_BIGN);
        pg8::EpiBf E{SSQP(3), (bf16*)(ws + WS_UP), UPW, UPW, nullptr, 0, 0, nullptr, 0, 0};
        pg8::gemm_phase<pg8::EpiBf, pg8::StaticOrder, PG8_ALIGN, PG8_SP2>(ring, g, S, E, F.tid);
    } SEAM(12);
    if (IN(13)) { p_ffnconv(F, 1, 0, MP / 16, gwA, NGWA, UPm, ACTm); } SEAM(13);
    if (IN(14)) {
        pg8::Gemm g{(const bf16*)(ws + WS_ACT), (const bf16*)(ws + WS_WDN1), MP, DM, DFF}; pg8::StaticOrder S; S.init(MP, DM, F.G, (int)blockIdx.x, WGM_SMALLN);
        pg8::EpiRes E{H, H, H, nullptr, SSQP(4)};
        pg8::gemm_phase<pg8::EpiRes, pg8::StaticOrder, PG8_ALIGN, PG8_SP2>(ring, g, S, E, F.tid);
    } SEAM(14);
    if (IN(15)) { p_final(F, 0, MP, gwA, NGWA); }
#undef IN
#undef SEAM
}

extern "C" void kernel_launch(void* const* d_in, const int* in_sizes, int n_in, void* d_out, int out_size, void* d_ws, size_t ws_size, hipStream_t stream) {
    static int grid = 0;
    if (grid == 0) {
        if (n_in != N_IN || (size_t)out_size != O_END || ws_size < WS_END) { fprintf(stderr, "kernel_launch: shape mismatch: n_in %d out %d ws %zu (need %zu)\n", n_in, out_size, ws_size, (size_t)WS_END); grid = -1; return; }
        int dev = 0, cus = 0;
        if (hipGetDevice(&dev) != hipSuccess || hipDeviceGetAttribute(&cus, hipDeviceAttributeMultiprocessorCount, dev) != hipSuccess) { grid = -1; return; }
        if (hipFuncSetAttribute((const void*)fwd, hipFuncAttributeMaxDynamicSharedMemorySize, LDS_BYTES) != hipSuccess) { fprintf(stderr, "kernel_launch: hipFuncSetAttribute failed\n"); grid = -1; return; }
        int per_cu = 0;
        if (hipOccupancyMaxActiveBlocksPerMultiprocessor(&per_cu, (const void*)fwd, NWAVES * 64, LDS_BYTES) != hipSuccess || per_cu < 1) fprintf(stderr, "kernel_launch: occupancy query reports %d\n", per_cu);
        (void)hipGetLastError();
        grid = cus;
    }
    if (grid < 0) return;
    (void)hipMemsetAsync((char*)d_ws + WS_CTL, 0, CTL_ZERO_BYTES, stream);
    Args a{};
    for (int i = 0; i < N_IN; ++i) a.in[i] = (const float*)d_in[i];
    a.out = (float*)d_out; a.ws = (unsigned char*)d_ws;
    if (N_LAUNCH_MODE == 1) { a.ph_lo = 0; a.ph_hi = N_PHASES; hipLaunchKernelGGL(fwd, dim3(grid), dim3(NWAVES * 64), LDS_BYTES, stream, a); }
    else for (int p = 0; p < N_PHASES; ++p) { a.ph_lo = p; a.ph_hi = p + 1; hipLaunchKernelGGL(fwd, dim3(grid), dim3(NWAVES * 64), LDS_BYTES, stream, a); }
    const hipError_t le = hipPeekAtLastError();
    if (le != hipSuccess) fprintf(stderr, "kernel_launch: launch failed: %s\n", hipGetErrorName(le));
}
```

```cpp
#include <hip/hip_runtime.h>
#include <cstdio>
#include <cstdint>

constexpr int DM = 2048;
constexpr int SEQ = 8192, NB = 2, MP = NB * SEQ;
constexpr int DECB = 16, DECS = 16, MS = DECB * DECS;
constexpr int PAST = 2048;
constexpr int M = MP + MS;
constexpr int QKVW = 8192, VW = 4096, INW = 12352, INWP = 12544;
constexpr int DFF = 5632, UPW = 11264;
constexpr int NITEM_P = NB * 128 * 32, NITEM = NITEM_P + DECB * 32;
constexpr size_t O_Y = 0, O_PGDN = 34078720, O_PGC = 35127296, O_PFC = 35176448, O_PK = 35266560, O_PV = 68820992,
                 O_SGDN = 102375424, O_SGC = 110764032, O_SFC = 111157248, O_SK = 111878144, O_SV = 112402432, O_END = 112926720;
namespace pg8 {
#define PG8_LAS __attribute__((address_space(3)))
typedef unsigned short bf16_t;
typedef short bf16x8 __attribute__((ext_vector_type(8)));
typedef float f32x4 __attribute__((ext_vector_type(4)));
typedef unsigned u32x4 __attribute__((ext_vector_type(4)));
constexpr int BM = 256, BK = 64, HALF = 128, HTB = HALF * BK * 2  , STAGE_BYTES = 8 * HTB, NXCD = 8, WGM = 4;

__host__ __device__ __forceinline__ int lds_byte(int r, int c) { const int st = (r >> 4) * 2 + (c >> 5), rr = r & 15, cc = c & 31, ob = rr * 64 + cc * 2; return st * 1024 + (ob ^ (((ob >> 9) & 1) << 5)); }
__host__ __device__ __forceinline__ void stage_rc(int b, int& R, int& C) { const int st = b / 1024, sb = b % 1024, swz = sb ^ (((sb >> 9) & 1) << 5); R = (st >> 1) * 16 + swz / 64; C = (st & 1) * 32 + (swz % 64) / 2; }
__host__ __device__ __forceinline__ int perm32(int rho) { const int n = rho >> 4, i = rho & 15; return 8 * (i >> 2) + 4 * n + (i & 3); }

struct Unit { int pm, pn; };
struct Gemm { const bf16_t* A; const bf16_t* Bt; int M, N, K; };

struct StaticOrder {
    int nM, nN, nwg, G, c, wgm;
    __host__ __device__ void init(int M, int N, int G_, int c_, int wgm_ = WGM) { nM = M / BM; nN = N / BM; nwg = nM * nN; G = G_; c = c_; wgm = wgm_; }
    __host__ __device__ bool next(int i, Unit& u) const {
        const long L = (long)i * G + c; if (L >= nwg) return false;
        int wgid = (int)L; { const int q = nwg / NXCD, r = nwg % NXCD, xcd = wgid % NXCD, off = wgid / NXCD; wgid = (xcd < r ? xcd * (q + 1) : r * (q + 1) + (xcd - r) * q) + off; }
        const int nig = wgm * nN, gid = wgid / nig, fm = gid * wgm, gsz = (nM - fm) < wgm ? (nM - fm) : wgm;
        u.pm = fm + ((wgid % nig) % gsz); u.pn = (wgid % nig) / gsz; return true;
    }
    __device__ __forceinline__ void a_ready(const Unit&) const {}
    __device__ __forceinline__ void done(const Unit&) const {}
};

typedef float f32x2 __attribute__((ext_vector_type(2)));
typedef __bf16 bf16v2 __attribute__((ext_vector_type(2)));
typedef unsigned u32x2 __attribute__((ext_vector_type(2)));
__device__ __forceinline__ unsigned cvt_pk_bf16(float lo, float hi) { const f32x2 v = {lo, hi}; return __builtin_bit_cast(unsigned, __builtin_convertvector(v, bf16v2)); }

__device__ __forceinline__ void row_rstd(const float* ssq, int row0, int fq, float (&rs)[2][4]) {
    asm volatile("" : "+v"(row0), "+v"(fq));
#pragma unroll
    for (int ai = 0; ai < 2; ++ai)
#pragma unroll
        for (int m = 0; m < 4; ++m) {
            const float* p = ssq + (size_t)(row0 + ai * HALF + m * 16) * 32 + fq * 8;
            const f32x4 a = *(const f32x4*)p, b = *(const f32x4*)(p + 4);
            float s = ((a[0] + a[1]) + (a[2] + a[3])) + ((b[0] + b[1]) + (b[2] + b[3]));
            s += __shfl_xor(s, 16); s += __shfl_xor(s, 32);
            rs[ai][m] = rsqrtf(s * (1.0f / 2048.0f) + 1e-6f);
        }
}
struct EpiBf {
    static constexpr bool PERM = true, AFTER_DRAIN = false;
    const float* ssq; bf16_t* O0; int ld0, nc0; bf16_t* O1; int ld1, nc1; float* F2; int ld2, nc2;
    __device__ __forceinline__ void operator()(const f32x4 (&acc)[2][2][4][2], const Unit& u, int wr, int wc, int fr, int fq) const {
        asm volatile("" : "+v"(fr), "+v"(fq));
        const int row0 = u.pm * BM + wr * 64 + fr; const int colt = u.pn * BM;
        float rs[2][4]; row_rstd(ssq, row0, fq, rs);
        if (colt < nc0 + nc1) {
            bf16_t* base; int ld;
            if (colt < nc0) { base = O0 + colt; ld = ld0; } else { base = O1 + (colt - nc0); ld = ld1; }
            const int col0 = wc * 32 + 8 * fq;
#pragma unroll
            for (int ai = 0; ai < 2; ++ai)
#pragma unroll
                for (int m = 0; m < 4; ++m) { bf16_t* rowp = base + (size_t)(row0 + ai * HALF + m * 16) * ld + col0; const float r = rs[ai][m];
#pragma unroll
                    for (int bj = 0; bj < 2; ++bj) { const f32x4 v0 = acc[ai][bj][m][0] * r, v1 = acc[ai][bj][m][1] * r;
                        u32x4 w; w.x = cvt_pk_bf16(v0[0], v0[1]); w.y = cvt_pk_bf16(v0[2], v0[3]); w.z = cvt_pk_bf16(v1[0], v1[1]); w.w = cvt_pk_bf16(v1[2], v1[3]);
                        __builtin_nontemporal_store(w, (u32x4*)(rowp + bj * HALF)); } }
        } else if (colt == nc0 + nc1 && F2 != nullptr && wc * 32 < nc2) {
#pragma unroll
            for (int ai = 0; ai < 2; ++ai)
#pragma unroll
                for (int m = 0; m < 4; ++m) { float* rowp = F2 + (size_t)(row0 + ai * HALF + m * 16) * ld2 + wc * 32 + 8 * fq; const float r = rs[ai][m];
                    *(f32x4*)(rowp) = acc[ai][0][m][0] * r; *(f32x4*)(rowp + 4) = acc[ai][0][m][1] * r; }
        }
    }
};
struct EpiRes {
    static constexpr bool PERM = false, AFTER_DRAIN = false;
    const float* base0; const float* base1; float* out; bf16_t* hb; float* ssq;
    __device__ __forceinline__ void operator()(const f32x4 (&acc)[2][2][4][2], const Unit& u, int wr, int wc, int fr, int fq) const {
        asm volatile("" : "+v"(fr), "+v"(fq));
        const int row0 = u.pm * BM + wr * 64 + fr, col0 = u.pn * BM + wc * 32 + 4 * fq;
        const float* bs = (u.pm * BM < MP) ? base0 : base1;
#pragma unroll
        for (int ai = 0; ai < 2; ++ai)
#pragma unroll
            for (int m = 0; m < 4; ++m) { const size_t off = (size_t)(row0 + ai * HALF + m * 16) * DM + col0; float ss = 0.f;
#pragma unroll
                for (int bj = 0; bj < 2; ++bj)
#pragma unroll
                    for (int n = 0; n < 2; ++n) { const size_t o2 = off + bj * HALF + n * 16; const f32x4 o = __builtin_nontemporal_load((const f32x4*)(bs + o2)) + acc[ai][bj][m][n];
                        __builtin_nontemporal_store(o, (f32x4*)(out + o2)); ss += (o[0] * o[0] + o[1] * o[1]) + (o[2] * o[2] + o[3] * o[3]);
                        if (hb) { u32x2 w; w.x = cvt_pk_bf16(o[0], o[1]); w.y = cvt_pk_bf16(o[2], o[3]); *(u32x2*)(hb + o2) = w; } }
                ss += __shfl_xor(ss, 16); ss += __shfl_xor(ss, 32);
                if (fq == 0) ssq[(size_t)(row0 + ai * HALF + m * 16) * 32 + u.pn * 4 + wc] = ss; }
    }
};
struct EpiResNorm {
    static constexpr bool PERM = false, AFTER_DRAIN = false;
    const float* base; float* out; float* ssq; const float* gain; unsigned* cnt;
    __device__ __forceinline__ void operator()(f32x4 (&acc)[2][2][4][2], const Unit& u, int wr, int wc, int fr, int fq) const {
        asm volatile("" : "+v"(fr), "+v"(fq));
        const int row0 = u.pm * BM + wr * 64 + fr, col0 = u.pn * BM + wc * 32 + 4 * fq;
#pragma unroll
        for (int ai = 0; ai < 2; ++ai)
#pragma unroll
            for (int m = 0; m < 4; ++m) { const size_t off = (size_t)(row0 + ai * HALF + m * 16) * DM + col0; float ss = 0.f;
#pragma unroll
                for (int bj = 0; bj < 2; ++bj)
#pragma unroll
                    for (int n = 0; n < 2; ++n) { const f32x4 o = __builtin_nontemporal_load((const f32x4*)(base + off + bj * HALF + n * 16)) + acc[ai][bj][m][n];
                        acc[ai][bj][m][n] = o; ss += (o[0] * o[0] + o[1] * o[1]) + (o[2] * o[2] + o[3] * o[3]); }
                ss += __shfl_xor(ss, 16); ss += __shfl_xor(ss, 32);
                if (fq == 0) __hip_atomic_store(ssq + (size_t)(row0 + ai * HALF + m * 16) * 32 + u.pn * 4 + wc, ss, __ATOMIC_RELAXED, __HIP_MEMORY_SCOPE_AGENT); }
        asm volatile("s_waitcnt vmcnt(0)" ::: "memory");
        __syncthreads();
        if (threadIdx.x == 0) {
            __hip_atomic_fetch_add(cnt + u.pm, 1u, __ATOMIC_RELAXED, __HIP_MEMORY_SCOPE_AGENT);
            unsigned sp = 0;
            while (__hip_atomic_load(cnt + u.pm, __ATOMIC_RELAXED, __HIP_MEMORY_SCOPE_AGENT) < 8u) { __builtin_amdgcn_s_sleep(2); if (++sp > 4000000u) break; }
        }
        __syncthreads();
        float rs[2][4]; row_rstd(ssq, row0, fq, rs);
        f32x4 g4[2][2];
#pragma unroll
        for (int bj = 0; bj < 2; ++bj)
#pragma unroll
            for (int n = 0; n < 2; ++n) g4[bj][n] = *(const f32x4*)(gain + col0 + bj * HALF + n * 16);
#pragma unroll
        for (int ai = 0; ai < 2; ++ai)
#pragma unroll
            for (int m = 0; m < 4; ++m) { const size_t off = (size_t)(row0 + ai * HALF + m * 16) * DM + col0;
#pragma unroll
                for (int bj = 0; bj < 2; ++bj)
#pragma unroll
                    for (int n = 0; n < 2; ++n) __builtin_nontemporal_store(acc[ai][bj][m][n] * rs[ai][m] * g4[bj][n], (f32x4*)(out + off + bj * HALF + n * 16)); }
    }
};
struct EpiKVQ {
    static constexpr bool PERM = false, AFTER_DRAIN = false;
    const float* ssq; float* dout; bf16_t* KB; size_t kvq_stride; bf16_t* KC; size_t kc_stride;
    __device__ __forceinline__ void operator()(const f32x4 (&acc)[2][2][4][2], const Unit& u, int wr, int wc, int fr, int fq) const {
        asm volatile("" : "+v"(fr), "+v"(fq));
        const int row0 = u.pm * BM + wr * 64 + fr; const int colt = u.pn * BM, which = colt >> 11, cb = (colt & 2047) + wc * 32 + 4 * fq;
        float rs[2][4]; row_rstd(ssq, row0, fq, rs);
        bf16_t* bb = KB + (size_t)which * kvq_stride;
        float* fo = nullptr;
        if (which < 2) fo = (u.pm * BM < MP) ? dout + O_PK + (size_t)which * (O_PV - O_PK) : dout + O_SK + (size_t)which * (O_SV - O_SK) - (size_t)MP * DM;
#pragma unroll
        for (int ai = 0; ai < 2; ++ai)
#pragma unroll
            for (int m = 0; m < 4; ++m) { const size_t off = (size_t)(row0 + ai * HALF + m * 16) * DM + cb; const float r = rs[ai][m];
#pragma unroll
                for (int bj = 0; bj < 2; ++bj)
#pragma unroll
                    for (int n = 0; n < 2; ++n) { const size_t o2 = off + bj * HALF + n * 16; const f32x4 o = acc[ai][bj][m][n] * r;
                        if (fo) __builtin_nontemporal_store(o, (f32x4*)(fo + o2));
                        u32x2 w; w.x = cvt_pk_bf16(o[0], o[1]); w.y = cvt_pk_bf16(o[2], o[3]); *(u32x2*)(bb + o2) = w;
                        if (which < 2 && u.pm * BM >= MP) { const int ms = row0 + ai * HALF + m * 16 - MP;
                            *(u32x2*)(KC + (size_t)which * kc_stride + ((size_t)(ms >> 4) * (2048 + 16) + 2048 + (ms & 15)) * DM + cb + bj * HALF + n * 16) = w; } } }
    }
};

struct EpiKVQs {
    static constexpr bool PERM = false, AFTER_DRAIN = false;
    const float* ssq; float* dout; bf16_t* KC; size_t kc_stride; bf16_t* Qs;
    __device__ __forceinline__ void operator()(const f32x4 (&acc)[2][2][4][2], const Unit& u, int wr, int wc, int fr, int fq) const {
        asm volatile("" : "+v"(fr), "+v"(fq));
        const int row0 = u.pm * BM + wr * 64 + fr; const int colt = u.pn * BM, which = colt >> 11, cb = (colt & 2047) + wc * 32 + 4 * fq;
        float rs[2][4]; row_rstd(ssq, row0, fq, rs);
        float* fo = (which < 2) ? dout + O_SK + (size_t)which * (O_SV - O_SK) - (size_t)MP * DM : nullptr;
#pragma unroll
        for (int ai = 0; ai < 2; ++ai)
#pragma unroll
            for (int m = 0; m < 4; ++m) { const int row = row0 + ai * HALF + m * 16, ms = row - MP; const size_t off = (size_t)row * DM + cb; const float r = rs[ai][m];
#pragma unroll
                for (int bj = 0; bj < 2; ++bj)
#pragma unroll
                    for (int n = 0; n < 2; ++n) { const size_t o2 = off + bj * HALF + n * 16; const f32x4 o = acc[ai][bj][m][n] * r;
                        u32x2 w; w.x = cvt_pk_bf16(o[0], o[1]); w.y = cvt_pk_bf16(o[2], o[3]);
                        if (which < 2) { *(f32x4*)(fo + o2) = o; *(u32x2*)(KC + (size_t)which * kc_stride + ((size_t)(ms >> 4) * (2048 + 16) + 2048 + (ms & 15)) * DM + cb + bj * HALF + n * 16) = w; }
                        else *(u32x2*)(Qs + o2) = w; } }
    }
};
struct SubOrder {
    int pm, nN, G, c;
    __host__ __device__ bool next(int i, Unit& u) const { const int L = i * G + c; if (L >= nN) return false; u.pm = pm; u.pn = L; return true; }
    __device__ __forceinline__ void a_ready(const Unit&) const {}
    __device__ __forceinline__ void done(const Unit&) const {}
};
template <class Epi, class Sched, bool ALIGN_EPI = false, bool SP2 = false>
__device__ __forceinline__ void gemm_phase(PG8_LAS unsigned char* lds, const Gemm g, const Sched& S, const Epi& E, int tid) {
    asm volatile("" : "+v"(tid));
    const int wid = __builtin_amdgcn_readfirstlane(tid >> 6), lane = tid & 63, wr = wid >> 2, wc = wid & 3, fr = lane & 15, fq = lane >> 4;
    const int K = g.K, nt = K / BK;
    unsigned voffA[2], voffB[2];
#pragma unroll
    for (int i = 0; i < 2; ++i) { int R, C; stage_rc(tid * 16 + i * 8192, R, C); const int Rb = Epi::PERM ? ((R & ~31) + perm32(R & 31)) : R;
        voffA[i] = (unsigned)(R * K + C) * 2u; voffB[i] = (unsigned)(Rb * K + C) * 2u; }
    const size_t kstep = (size_t)(BK * 2);
    const size_t hstep = (size_t)HALF * K * 2;
    const size_t tstep = 2 * hstep;
    const unsigned ldsw = (unsigned)wid * 1024u;
    const int aoff = lds_byte(wr * 64 + fr, fq * 8), boff = lds_byte(wc * 32 + fr, fq * 8);
#define PG8_SA(b, h) (((b) * 2 + (h)) * HTB)
#define PG8_SB(b, h) ((4 + (b) * 2 + (h)) * HTB)
#define PG8_STAGE(bufoff, gbase, voff) do { _Pragma("unroll") for (int _i = 0; _i < 2; ++_i) \
        __builtin_amdgcn_global_load_lds((const unsigned*)((const char*)(gbase) + (voff)[_i]), (PG8_LAS unsigned*)(lds + (bufoff) + ldsw + _i * 8192), 16, 0, 0); } while (0)
#define PG8_LDA(dst, b, h) do { _Pragma("unroll") for (int m = 0; m < 4; ++m) _Pragma("unroll") for (int k = 0; k < 2; ++k) dst[m][k] = *(const PG8_LAS bf16x8*)(lds + PG8_SA(b, h) + aoff + m * 2048 + k * 1024); } while (0)
#define PG8_LDB(dst, b, h) do { _Pragma("unroll") for (int n = 0; n < 2; ++n) _Pragma("unroll") for (int k = 0; k < 2; ++k) dst[n][k] = *(const PG8_LAS bf16x8*)(lds + PG8_SB(b, h) + boff + n * 2048 + k * 1024); } while (0)
#define PG8_MMA(ai, bj, At, Bt) do { __builtin_amdgcn_s_setprio(1); _Pragma("unroll") for (int m = 0; m < 4; ++m) _Pragma("unroll") for (int n = 0; n < 2; ++n) _Pragma("unroll") for (int k = 0; k < 2; ++k) \
        acc[ai][bj][m][n] = __builtin_amdgcn_mfma_f32_16x16x32_bf16(Bt[n][k], At[m][k], acc[ai][bj][m][n], 0, 0, 0); __builtin_amdgcn_s_setprio(0); } while (0)
#define PG8_WAIT_V(n) asm volatile("s_waitcnt vmcnt(" #n ")" ::: "memory")
#define PG8_WAIT_L(n) asm volatile("s_waitcnt lgkmcnt(" #n ")" ::: "memory")
#define PG8_BAR __builtin_amdgcn_s_barrier()
#define PG8_SCHED __builtin_amdgcn_sched_barrier(0)
    Unit cur, nxt; int ui = 0;
    if (!S.next(0, cur)) return;
    f32x4 acc[2][2][4][2];
#pragma unroll
    for (int a = 0; a < 2; ++a)
#pragma unroll
        for (int b = 0; b < 2; ++b)
#pragma unroll
            for (int m = 0; m < 4; ++m)
#pragma unroll
                for (int n = 0; n < 2; ++n) acc[a][b][m][n] = (f32x4){0.f, 0.f, 0.f, 0.f};
    bf16x8 At[4][2], B0[2][2], B1[2][2];
    const char* cA = (const char*)g.A + (size_t)cur.pm * tstep; const char* cB = (const char*)g.Bt + (size_t)cur.pn * tstep;
    S.a_ready(cur);
    if constexpr (SP2) {
        PG8_STAGE(PG8_SB(0, 0), cB, voffB); PG8_STAGE(PG8_SB(0, 1), cB + hstep, voffB); PG8_STAGE(PG8_SA(0, 0), cA, voffA); PG8_STAGE(PG8_SA(0, 1), cA + hstep, voffA);
        if (wr == 1) PG8_BAR;
        PG8_WAIT_V(2); PG8_BAR;
        PG8_STAGE(PG8_SB(1, 0), cB + kstep, voffB); PG8_STAGE(PG8_SA(1, 0), cA + kstep, voffA); PG8_STAGE(PG8_SB(1, 1), cB + hstep + kstep, voffB);
        PG8_WAIT_V(6); PG8_BAR;
    } else {
        PG8_STAGE(PG8_SB(0, 0), cB, voffB); PG8_STAGE(PG8_SA(0, 0), cA, voffA); PG8_STAGE(PG8_SB(0, 1), cB + hstep, voffB); PG8_STAGE(PG8_SA(0, 1), cA + hstep, voffA);
        if (wr == 1) PG8_BAR;
        PG8_WAIT_V(4); PG8_BAR;
        PG8_STAGE(PG8_SB(1, 0), cB + kstep, voffB); PG8_STAGE(PG8_SA(1, 0), cA + kstep, voffA); PG8_STAGE(PG8_SB(1, 1), cB + hstep + kstep, voffB);
        PG8_WAIT_V(6); PG8_BAR;
    }
    for (;;) {
        const bool has_next = S.next(ui + 1, nxt);
        const char* nA = has_next ? (const char*)g.A + (size_t)nxt.pm * tstep : cA; const char* nB = has_next ? (const char*)g.Bt + (size_t)nxt.pn * tstep : cB;
        for (int t = 0; t < nt; t += 2) {
            const bool last = (t == nt - 2);
            const char* a1 = cA + (size_t)(t + 1) * kstep;
            const char* a2 = last ? nA : cA + (size_t)(t + 2) * kstep; const char* b2 = last ? nB : cB + (size_t)(t + 2) * kstep;
            const char* a3 = a2 + kstep; const char* b3 = b2 + kstep;
            if (last && has_next) S.a_ready(nxt);
            if constexpr (SP2) {
            PG8_LDB(B0, 0, 0); PG8_LDB(B1, 0, 1); PG8_SCHED; PG8_LDA(At, 0, 0); PG8_STAGE(PG8_SA(1, 1), a1 + hstep, voffA);
            PG8_WAIT_V(8); PG8_WAIT_L(0); PG8_BAR; PG8_MMA(0, 0, At, B0); PG8_MMA(0, 1, At, B1); PG8_BAR; PG8_SCHED;
            PG8_LDA(At, 0, 1); PG8_STAGE(PG8_SB(0, 0), b2, voffB); PG8_STAGE(PG8_SB(0, 1), b2 + hstep, voffB); PG8_STAGE(PG8_SA(0, 0), a2, voffA);
            PG8_WAIT_V(8); PG8_WAIT_L(0); PG8_BAR; PG8_MMA(1, 0, At, B0); PG8_MMA(1, 1, At, B1); PG8_BAR; PG8_SCHED;
            PG8_LDB(B0, 1, 0); PG8_LDB(B1, 1, 1); PG8_SCHED; PG8_LDA(At, 1, 0); PG8_STAGE(PG8_SA(0, 1), a2 + hstep, voffA);
            PG8_WAIT_V(8); PG8_WAIT_L(0); PG8_BAR; PG8_MMA(0, 0, At, B0); PG8_MMA(0, 1, At, B1); PG8_BAR; PG8_SCHED;
            PG8_LDA(At, 1, 1); PG8_STAGE(PG8_SB(1, 0), b3, voffB); PG8_STAGE(PG8_SB(1, 1), b3 + hstep, voffB); PG8_STAGE(PG8_SA(1, 0), a3, voffA);
            PG8_WAIT_V(8); PG8_WAIT_L(0); PG8_BAR; PG8_MMA(1, 0, At, B0); PG8_MMA(1, 1, At, B1); PG8_BAR; PG8_SCHED;
            } else {
            PG8_LDB(B0, 0, 0); PG8_SCHED; PG8_LDA(At, 0, 0); PG8_STAGE(PG8_SA(1, 1), a1 + hstep, voffA);
            PG8_WAIT_L(8); PG8_BAR; PG8_WAIT_L(0); PG8_MMA(0, 0, At, B0); PG8_BAR; PG8_SCHED;
            PG8_LDB(B1, 0, 1); PG8_STAGE(PG8_SB(0, 0), b2, voffB);
            PG8_BAR; PG8_WAIT_L(0); PG8_MMA(0, 1, At, B1); PG8_BAR;
            PG8_LDA(At, 0, 1); PG8_STAGE(PG8_SA(0, 0), a2, voffA);
            PG8_BAR; PG8_WAIT_L(0); PG8_MMA(1, 0, At, B0); PG8_BAR; PG8_SCHED;
            PG8_STAGE(PG8_SB(0, 1), b2 + hstep, voffB);
            PG8_WAIT_V(6); PG8_BAR; PG8_MMA(1, 1, At, B1); PG8_BAR;
            PG8_LDB(B0, 1, 0); PG8_SCHED; PG8_LDA(At, 1, 0); PG8_STAGE(PG8_SA(0, 1), a2 + hstep, voffA);
            PG8_WAIT_L(8); PG8_BAR; PG8_WAIT_L(0); PG8_MMA(0, 0, At, B0); PG8_BAR; PG8_SCHED;
            PG8_LDB(B1, 1, 1); PG8_STAGE(PG8_SB(1, 0), b3, voffB);
            PG8_BAR; PG8_WAIT_L(0); PG8_MMA(0, 1, At, B1); PG8_BAR;
            PG8_LDA(At, 1, 1); PG8_STAGE(PG8_SA(1, 0), a3, voffA);
            PG8_BAR; PG8_WAIT_L(0); PG8_MMA(1, 0, At, B0); PG8_BAR; PG8_SCHED;
            PG8_STAGE(PG8_SB(1, 1), b3 + hstep, voffB);
            PG8_WAIT_V(6); PG8_BAR; PG8_MMA(1, 1, At, B1); PG8_BAR;
            }
        }
        if constexpr (ALIGN_EPI) { if (wr == 0) PG8_BAR; }
        if constexpr (!Epi::AFTER_DRAIN) { E(acc, cur, wr, wc, fr, fq); S.done(cur); }
        if (!has_next) break;
#pragma unroll
        for (int a = 0; a < 2; ++a)
#pragma unroll
            for (int b = 0; b < 2; ++b)
#pragma unroll
                for (int m = 0; m < 4; ++m)
#pragma unroll
                    for (int n = 0; n < 2; ++n) acc[a][b][m][n] = (f32x4){0.f, 0.f, 0.f, 0.f};
        cur = nxt; cA = nA; cB = nB; ++ui;
        if constexpr (ALIGN_EPI) { if (wr == 1) PG8_BAR; }
    }
    PG8_WAIT_V(0);
    if constexpr (!ALIGN_EPI) { if (wr == 0) PG8_BAR; }
    PG8_BAR;
    if constexpr (Epi::AFTER_DRAIN) { E.fused(acc, cur, wr, wc, fr, fq, lds, wid, lane); S.done(cur); }
#undef PG8_SA
#undef PG8_SB
#undef PG8_STAGE
#undef PG8_LDA
#undef PG8_LDB
#undef PG8_MMA
#undef PG8_WAIT_V
#undef PG8_WAIT_L
#undef PG8_BAR
#undef PG8_SCHED
}
}
#ifndef PG8_SP2
#define PG8_SP2 true
#endif
#ifndef PG8_ALIGN
#define PG8_ALIGN true
#endif

constexpr size_t MiB = 1u << 20;
constexpr size_t WS_CTL = 0, CTL_ZERO_BYTES = 1 * MiB;
constexpr size_t WS_SSQ = 1 * MiB, SSQ_STRIDE = 2359296;
constexpr size_t WS_BA = 13 * MiB;
constexpr size_t WS_EG = 18 * MiB, WS_DL = 21 * MiB, WS_GL = 24 * MiB;
constexpr size_t WS_WIN = 32 * MiB, WS_WOUT = 81 * MiB, WS_WUP0 = 97 * MiB, WS_WDN0 = 141 * MiB, WS_WKVQ = 163 * MiB, WS_WO = 187 * MiB, WS_WUP1 = 195 * MiB, WS_WDN1 = 239 * MiB;
constexpr size_t WS_HB = 261 * MiB;
constexpr size_t WS_RA = 326 * MiB;
constexpr size_t WS_QKV = WS_RA, WS_Z = WS_RA + 260 * MiB, WS_UP = WS_RA;
constexpr size_t WS_KC = WS_RA, WS_VC = WS_RA + 130 * MiB;
static_assert(WS_KC + (size_t)DECB * (PAST + DECS) * DM * 2 <= WS_VC && WS_VC + (size_t)DECB * (PAST + DECS) * DM * 2 <= WS_RA + 390 * MiB, "cache copies");
constexpr size_t WS_RB = 716 * MiB;
constexpr size_t WS_QN = WS_RB, WS_KN = WS_RB + 65 * MiB, WS_VV = WS_RB + 130 * MiB, WS_TP = WS_RB + 260 * MiB, WS_PP = WS_RB + 328 * MiB;
constexpr size_t WS_ACT = WS_RB;
constexpr size_t WS_KB = WS_RB, WS_VB = WS_RB + 65 * MiB, WS_QB = WS_RB + 130 * MiB, WS_ATT = WS_RB + 195 * MiB;
constexpr size_t WS_SUP = 1112 * MiB, WS_SACT = 1118 * MiB, WS_SQB = 1121 * MiB, WS_SATT = 1122 * MiB;
constexpr size_t WS_END = 1123 * MiB;
static_assert(WS_SUP + (size_t)MS * UPW * 2 <= WS_SACT && WS_SACT + (size_t)MS * DFF * 2 <= WS_SQB && WS_SQB + (size_t)MS * DM * 2 <= WS_SATT && WS_SATT + (size_t)MS * DM * 2 <= WS_END, "sample buffers");
static_assert((size_t)M * 32 * 4 <= SSQ_STRIDE && WS_SSQ + 5 * SSQ_STRIDE <= WS_BA && WS_BA + (size_t)M * 64 * 4 <= WS_EG && WS_EG + (size_t)NITEM * 256 <= WS_DL && WS_DL + (size_t)NITEM * 256 <= WS_GL && WS_GL + NITEM * 4 <= WS_WIN, "small buffers");
static_assert(WS_WIN + (size_t)INWP * DM * 2 <= WS_WOUT && WS_WDN1 + (size_t)DM * DFF * 2 <= WS_HB && WS_HB + (size_t)M * DM * 2 <= WS_RA, "weights / HB");
static_assert(WS_QKV + (size_t)M * QKVW * 2 <= WS_Z && WS_Z + (size_t)M * VW * 2 <= WS_RB && WS_UP + (size_t)M * UPW * 2 <= WS_RB, "region A");
static_assert(WS_QN + (size_t)M * DM * 2 <= WS_KN && WS_KN + (size_t)M * DM * 2 <= WS_VV && WS_VV + (size_t)M * VW * 2 <= WS_TP && WS_TP + (size_t)NITEM * 8192 <= WS_PP && WS_PP + (size_t)NITEM * 8192 <= WS_END, "region B (gdn)");
static_assert(WS_ACT + (size_t)M * DFF * 2 <= WS_END && WS_ATT + (size_t)M * DM * 2 <= WS_END, "region B");
static_assert((size_t)M * VW * 2 <= (O_SGDN - O_PK) * 4, "ON scratch");
constexpr int CW_FNORM = 1024;
constexpr int CW_BAR = 4096, CW_BAR2 = 8192, CW_BAR3 = 12288;

constexpr int LDS_BYTES = 159744;
constexpr int LDSCTL_OFF = 158720;
constexpr int NWAVES = 8;

#define GAS __attribute__((address_space(1)))
#define LAS __attribute__((address_space(3)))
#define DI __device__ __forceinline__
typedef unsigned short bf16;
typedef unsigned v4u __attribute__((ext_vector_type(4)));
typedef unsigned v2u __attribute__((ext_vector_type(2)));
typedef float f32x4 __attribute__((ext_vector_type(4)));
typedef float f32x16 __attribute__((ext_vector_type(16)));
typedef short bf16x8 __attribute__((ext_vector_type(8)));
typedef short bf16x4 __attribute__((ext_vector_type(4)));
#define LDS_WAIT() asm volatile("s_waitcnt lgkmcnt(0)" ::: "memory")
#define VM_WAIT() asm volatile("s_waitcnt vmcnt(0)" ::: "memory")
#define MFMA32(a, b, c) __builtin_amdgcn_mfma_f32_32x32x16_bf16((a), (b), (c), 0, 0, 0)
DI unsigned pk2(float lo, float hi) { return pg8::cvt_pk_bf16(lo, hi); }
DI float bf2f(unsigned short b) { return __builtin_bit_cast(float, ((unsigned)b) << 16); }
DI float bflo(unsigned w) { return __builtin_bit_cast(float, w << 16); }
DI float bfhi(unsigned w) { return __builtin_bit_cast(float, w & 0xffff0000u); }
DI void unpack8(const v4u w, float (&f)[8]) { f[0] = bflo(w.x); f[1] = bfhi(w.x); f[2] = bflo(w.y); f[3] = bfhi(w.y); f[4] = bflo(w.z); f[5] = bfhi(w.z); f[6] = bflo(w.w); f[7] = bfhi(w.w); }
DI v4u pack8(const float (&f)[8]) { v4u w; w.x = pk2(f[0], f[1]); w.y = pk2(f[2], f[3]); w.z = pk2(f[4], f[5]); w.w = pk2(f[6], f[7]); return w; }
DI int crow(int r, int hi) { return (r & 3) + 8 * (r >> 2) + 4 * hi; }
DI float wave_sum(float v) {
#pragma unroll
    for (int o = 1; o < 64; o <<= 1) v += __shfl_xor(v, o);
    return v;
}
DI float siluf(float x) { return x * __builtin_amdgcn_rcpf(1.0f + __expf(-x)); }

template <int OFF> DI bf16x4 tr_read(int vb) { bf16x4 r; asm volatile("ds_read_b64_tr_b16 %0, %1 offset:%2" : "=&v"(r) : "v"(vb), "i"(OFF) : "memory"); return r; }
#define XB_TMO      128
#define XB_XCNT(j)  (256  + 64 * (j))
#define XB_XSUB(j)  (1280 + 64 * (j))
#define XB_XGEN(j)  (2304 + 64 * (j))
#define XB_TOP      3328
#define XB_TOPGEN   3392
#define XCD_BAR_WORDS 3456
#define XB_SPIN_CAP (1u << 18)

__device__ __forceinline__ unsigned xb_ld(unsigned* p)              { return __hip_atomic_load(p, __ATOMIC_RELAXED, __HIP_MEMORY_SCOPE_AGENT); }
__device__ __forceinline__ unsigned xb_add(unsigned* p, unsigned v) { return __hip_atomic_fetch_add(p, v, __ATOMIC_RELAXED, __HIP_MEMORY_SCOPE_AGENT); }
__device__ __forceinline__ unsigned xb_xcc_id() { return (unsigned)__builtin_amdgcn_s_getreg((3 << 11) | 20) & 0xFu; }
#define XB_SPIN(cond, bar) do { unsigned _sp = 0; while (cond) { __builtin_amdgcn_s_sleep(1); \
    if ((++_sp & 255u) == 0u) { if (xb_ld(&(bar)[XB_TMO])) break; if (_sp > XB_SPIN_CAP) { atomicAdd(&(bar)[XB_TMO], 1u); break; } } } } while (0)

struct XcdBarrier {
    unsigned* bar; unsigned x;
    volatile LAS unsigned* st;
};

__device__ __forceinline__ XcdBarrier xcd_barrier_post(unsigned* bar, volatile LAS unsigned* st) {
    XcdBarrier b; b.bar = bar; b.x = xb_xcc_id(); b.st = st;
    if (threadIdx.x == 0) (void)xb_add(&bar[XB_XCNT(b.x)], 1u);
    return b;
}
__device__ __forceinline__ void xcd_barrier_complete(unsigned* bar, unsigned x, unsigned& nloc, unsigned& nx) {
    const unsigned G = gridDim.x * gridDim.y * gridDim.z;
    unsigned sum, cnt, mine, sp = 0u;
    for (;;) {
        sum = 0u; cnt = 0u; mine = 0u;
#pragma unroll
        for (unsigned j = 0; j < 16; ++j) { const unsigned c = xb_ld(&bar[XB_XCNT(j)]); sum += c; cnt += (c > 0u) ? 1u : 0u; mine = (j == x) ? c : mine; }
        if (sum == G) break;
        __builtin_amdgcn_s_sleep(1);
        if ((++sp & 255u) == 0u) { if (xb_ld(&bar[XB_TMO])) break; if (sp > XB_SPIN_CAP) { atomicAdd(&bar[XB_TMO], 1u); break; } }
    }
    nloc = mine > 0u ? mine : 1u; nx = cnt > 0u ? cnt : 1u;
}

__device__ __forceinline__ void xcd_barrier(const XcdBarrier& b) {
    asm volatile("s_waitcnt vmcnt(0)" ::: "memory");
    __syncthreads();
    if (threadIdx.x == 0) {
        unsigned* bar = b.bar;
        __builtin_amdgcn_s_waitcnt(0);
        unsigned nloc = b.st[0], nx = b.st[1];
        if (nloc == 0u) { xcd_barrier_complete(bar, b.x, nloc, nx); b.st[0] = nloc; b.st[1] = nx; }
        const unsigned old = xb_add(&bar[XB_XSUB(b.x)], 1u);
        const unsigned gen = old / nloc;
        if (old + 1u == (gen + 1u) * nloc) {
            __builtin_amdgcn_fence(__ATOMIC_RELEASE, "agent");
            asm volatile("s_waitcnt vmcnt(0)" ::: "memory");
            const unsigned og = xb_add(&bar[XB_TOP], 1u);
            const unsigned tg = og / nx;
            if (og + 1u == (tg + 1u) * nx) xb_add(&bar[XB_TOPGEN], 1u);
            else XB_SPIN(xb_ld(&bar[XB_TOPGEN]) == tg, bar);
            __builtin_amdgcn_fence(__ATOMIC_ACQUIRE, "agent");
            xb_add(&bar[XB_XGEN(b.x)], 1u);
            asm volatile("s_waitcnt vmcnt(0)" ::: "memory");
        } else {
            XB_SPIN(xb_ld(&bar[XB_XGEN(b.x)]) == gen, bar);
            __builtin_amdgcn_fence(__ATOMIC_ACQUIRE, "agent");
            asm volatile("s_waitcnt vmcnt(0)" ::: "memory");
        }
    }
    __syncthreads();
}
__device__ __forceinline__ void sub_barrier_complete(unsigned* bar, unsigned x, unsigned& nloc, unsigned& nx, const unsigned expect) {
    unsigned sum, cnt, mine, sp = 0u;
    for (;;) {
        sum = 0u; cnt = 0u; mine = 0u;
#pragma unroll
        for (unsigned j = 0; j < 16; ++j) { const unsigned c = xb_ld(&bar[XB_XCNT(j)]); sum += c; cnt += (c > 0u) ? 1u : 0u; mine = (j == x) ? c : mine; }
        if (sum == expect) break;
        __builtin_amdgcn_s_sleep(1);
        if ((++sp & 255u) == 0u) { if (xb_ld(&bar[XB_TMO])) break; if (sp > XB_SPIN_CAP) { atomicAdd(&bar[XB_TMO], 1u); break; } }
    }
    nloc = mine > 0u ? mine : 1u; nx = cnt > 0u ? cnt : 1u;
}
__device__ __forceinline__ void sub_barrier(const XcdBarrier& b, const unsigned expect) {
    asm volatile("s_waitcnt vmcnt(0)" ::: "memory");
    __syncthreads();
    if (threadIdx.x == 0) {
        unsigned* bar = b.bar;
        __builtin_amdgcn_s_waitcnt(0);
        unsigned nloc = b.st[0], nx = b.st[1];
        if (nloc == 0u) { sub_barrier_complete(bar, b.x, nloc, nx, expect); b.st[0] = nloc; b.st[1] = nx; }
        const unsigned old = xb_add(&bar[XB_XSUB(b.x)], 1u);
        const unsigned gen = old / nloc;
        if (old + 1u == (gen + 1u) * nloc) {
            __builtin_amdgcn_fence(__ATOMIC_RELEASE, "agent");
            asm volatile("s_waitcnt vmcnt(0)" ::: "memory");
            const unsigned og = xb_add(&bar[XB_TOP], 1u);
            const unsigned tg = og / nx;
            if (og + 1u == (tg + 1u) * nx) xb_add(&bar[XB_TOPGEN], 1u);
            else XB_SPIN(xb_ld(&bar[XB_TOPGEN]) == tg, bar);
            __builtin_amdgcn_fence(__ATOMIC_ACQUIRE, "agent");
            xb_add(&bar[XB_XGEN(b.x)], 1u);
            asm volatile("s_waitcnt vmcnt(0)" ::: "memory");
        } else {
            XB_SPIN(xb_ld(&bar[XB_XGEN(b.x)]) == gen, bar);
            __builtin_amdgcn_fence(__ATOMIC_ACQUIRE, "agent");
            asm volatile("s_waitcnt vmcnt(0)" ::: "memory");
        }
    }
    __syncthreads();
}
struct Frame {
    LAS unsigned char* lds;
    volatile LAS unsigned* MISC;
    unsigned* ctl;
    int tid, lane, wave;
    int vcu, G;
    const float* const* in;
    float* out; unsigned char* ws;
};
enum { I_XP = 0, I_XS, I_SGDN, I_SGC, I_SFC, I_CK, I_CV, I_ANORM, I_AWIN, I_AWCONV, I_ALOG, I_ADT, I_AONORM, I_AWOUT, I_KVNORM, I_WKV, I_BNORM, I_BWQ,
       I_LQ1, I_LK1, I_LQ2, I_LK2, I_SUBN, I_BWO, I_RELB, I_FNORM, I_FWUP, I_FWCONV, I_FBCONV, I_FWDN, I_FINAL, N_IN };

constexpr int TR_LDS = 16896;
DI void p0_transpose_item(const float* W, const float* gain, int K, int N, bf16* WT, int row_off, LAS float* scr, int item, int lane) {
    const int nblk = N / 64, kb = item / nblk, nb = item % nblk, k0 = 64 * kb, n0 = 64 * nb;
    const int n4 = lane & 15;
#pragma unroll 8
    for (int i = 0; i < 16; ++i) { const int kk = 4 * i + (lane >> 4); const float gk = gain ? gain[k0 + kk] : 1.0f;
        const f32x4 v = __builtin_nontemporal_load((const f32x4*)(W + (size_t)(k0 + kk) * N + n0 + 4 * n4));
        LAS float* d = scr + kk * 65 + 4 * n4; d[0] = v[0] * gk; d[1] = v[1] * gk; d[2] = v[2] * gk; d[3] = v[3] * gk; }
    LDS_WAIT(); asm volatile("" ::: "memory");
    const int c = lane & 7;
#pragma unroll
    for (int j = 0; j < 8; ++j) { const int n = (lane >> 3) + 8 * j; const LAS float* s = scr + (8 * c) * 65 + n;
        v4u o; o.x = pk2(s[0 * 65], s[1 * 65]); o.y = pk2(s[2 * 65], s[3 * 65]); o.z = pk2(s[4 * 65], s[5 * 65]); o.w = pk2(s[6 * 65], s[7 * 65]);
        *(v4u*)(WT + (size_t)(row_off + n0 + n) * K + k0 + 8 * c) = o; }
    LDS_WAIT(); asm volatile("" ::: "memory");
}
DI void conv_mat(Frame& F, const float* W, const float* gain, const int K, const int N, bf16* WT, const int row_off, const int gw, const int NGW) {
    LAS float* scr = (LAS float*)(F.lds + F.wave * TR_LDS);
    const int nit = (K / 64) * (N / 64);
    for (int it = gw; it < nit; it += NGW) p0_transpose_item(W, gain, K, N, WT, row_off, scr, it, F.lane);
}
enum { CJ_WOUT = 0, CJ_WUP0, CJ_WDN0, CJ_WKVQ, CJ_WO, CJ_WUP1, CJ_WDN1 };
DI void conv_job(Frame& F, const int job, const int gw, const int NGW) {
    unsigned char* ws = F.ws;
    if (job == CJ_WOUT) conv_mat(F, F.in[I_AWOUT], nullptr, VW, DM, (bf16*)(ws + WS_WOUT), 0, gw, NGW);
    else if (job == CJ_WUP0) conv_mat(F, F.in[I_FWUP], F.in[I_FNORM], DM, UPW, (bf16*)(ws + WS_WUP0), 0, gw, NGW);
    else if (job == CJ_WDN0) conv_mat(F, F.in[I_FWDN], nullptr, DFF, DM, (bf16*)(ws + WS_WDN0), 0, gw, NGW);
    else if (job == CJ_WKVQ) { conv_mat(F, F.in[I_WKV], F.in[I_KVNORM], DM, 4096, (bf16*)(ws + WS_WKVQ), 0, gw, NGW); conv_mat(F, F.in[I_BWQ], F.in[I_BNORM], DM, DM, (bf16*)(ws + WS_WKVQ), 4096, gw, NGW); }
    else if (job == CJ_WO) conv_mat(F, F.in[I_BWO], nullptr, DM, DM, (bf16*)(ws + WS_WO), 0, gw, NGW);
    else if (job == CJ_WUP1) conv_mat(F, F.in[I_FWUP] + (size_t)DM * UPW, F.in[I_FNORM] + DM, DM, UPW, (bf16*)(ws + WS_WUP1), 0, gw, NGW);
    else conv_mat(F, F.in[I_FWDN] + (size_t)DFF * DM, nullptr, DFF, DM, (bf16*)(ws + WS_WDN1), 0, gw, NGW);
}
DI void p0_prologue(Frame& F) {
    LAS float* scr = (LAS float*)(F.lds + F.wave * TR_LDS);
    const int gw = F.vcu * NWAVES + F.wave, NGW = F.G * NWAVES, lane = F.lane;
    unsigned char* ws = F.ws;
    constexpr int I_IN = (DM / 64) * (INW / 64);
    for (int it = F.wave * F.G + F.vcu; it < I_IN; it += NGW) p0_transpose_item(F.in[I_AWIN], F.in[I_ANORM], DM, INW, (bf16*)(ws + WS_WIN), 0, scr, it, lane);
    { v4u* z = (v4u*)(ws + WS_WIN + (size_t)INW * DM * 2); const int nz = (INWP - INW) * DM * 2 / 16; const v4u zero = {0u, 0u, 0u, 0u};
      for (int i = gw * 64 + lane; i < nz; i += NGW * 64) z[i] = zero; }
    float* ssq0 = (float*)(ws + WS_SSQ);
    for (int m0 = NGW - 1 - (F.wave * F.G + F.vcu); m0 < M; m0 += 2 * NGW) {
        const int m1 = m0 + NGW; const bool two = m1 < M; const int mb = two ? m1 : m0;
        const float* xa = (m0 < MP) ? F.in[I_XP] + (size_t)m0 * DM : F.in[I_XS] + (size_t)(m0 - MP) * DM;
        const float* xb = (mb < MP) ? F.in[I_XP] + (size_t)mb * DM : F.in[I_XS] + (size_t)(mb - MP) * DM;
        const f32x4* a4 = (const f32x4*)xa + lane; const f32x4* b4 = (const f32x4*)xb + lane;
        v2u* oa = (v2u*)((bf16*)(ws + WS_HB) + (size_t)m0 * DM) + lane; v2u* ob = (v2u*)((bf16*)(ws + WS_HB) + (size_t)mb * DM) + lane;
        f32x4 va[8], vb[8];
#pragma unroll
        for (int j = 0; j < 8; ++j) va[j] = __builtin_nontemporal_load(a4 + 64 * j);
#pragma unroll
        for (int j = 0; j < 8; ++j) vb[j] = __builtin_nontemporal_load(b4 + 64 * j);
        float sa = 0.f, sb = 0.f;
#pragma unroll
        for (int j = 0; j < 8; ++j) { const f32x4 v = va[j]; sa += (v[0] * v[0] + v[1] * v[1]) + (v[2] * v[2] + v[3] * v[3]); v2u w; w.x = pk2(v[0], v[1]); w.y = pk2(v[2], v[3]); oa[64 * j] = w; }
        sa = wave_sum(sa);
        if (lane < 32) ssq0[(size_t)m0 * 32 + lane] = (lane == 0) ? sa : 0.f;
        if (two) {
#pragma unroll
            for (int j = 0; j < 8; ++j) { const f32x4 v = vb[j]; sb += (v[0] * v[0] + v[1] * v[1]) + (v[2] * v[2] + v[3] * v[3]); v2u w; w.x = pk2(v[0], v[1]); w.y = pk2(v[2], v[3]); ob[64 * j] = w; }
            sb = wave_sum(sb);
            if (lane < 32) ssq0[(size_t)m1 * 32 + lane] = (lane == 0) ? sb : 0.f;
        }
    }
}
#define GC_LOAD(TB, R, H) { const int tb_ = (TB); const int b_ = tb_ >> 9; const int t0_ = (tb_ & 511) * 16; \
        const bf16* p_ = QKV + ((size_t)b_ * SEQ + t0_) * QKVW + c0; \
        _Pragma("unroll") for (int j_ = 0; j_ < 3; ++j_) { if (t0_ > 0) H[j_] = *(const v4u*)(p_ - (3 - j_) * QKVW); else H[j_] = (v4u){0u, 0u, 0u, 0u}; } \
        _Pragma("unroll") for (int tt_ = 0; tt_ < 16; ++tt_) R[tt_] = __builtin_nontemporal_load((const v4u*)(p_ + tt_ * QKVW)); }
#define GC_ROW(ROW, T, MROW, SAMP, B, LEN) { \
            const int t = (T); const size_t m = (MROW); \
            float cur[8]; unpack8(ROW, cur); \
            float y[8]; float ss = 0.f; \
            _Pragma("unroll") for (int e = 0; e < 8; ++e) { const float a = h[0][e] * w[0][e] + h[1][e] * w[1][e] + h[2][e] * w[2][e] + cur[e] * w[3][e]; y[e] = siluf(a); ss += y[e] * y[e]; } \
            if (cc < 8) {     \
                ss += __shfl_xor(ss, 1); ss += __shfl_xor(ss, 2); ss += __shfl_xor(ss, 4); ss += __shfl_xor(ss, 8); \
                const float sc = rsqrtf(ss + 1e-6f) * (cc < 4 ? 0.08838834764831845f : 1.0f); \
                _Pragma("unroll") for (int e = 0; e < 8; ++e) y[e] *= sc; \
                bf16* dst = (cc < 4) ? QN + m * DM + c0 : KN + m * DM + (c0 - 2048); \
                *(v4u*)dst = pack8(y); \
            } else { *(v4u*)(VV + m * VW + (c0 - 4096)) = pack8(y); } \
            if (t >= (LEN) - 3) {     \
                float* so = F.out + ((SAMP) ? O_SGC : O_PGC) + (size_t)((B) * 3 + (t - ((LEN) - 3))) * QKVW + c0; \
                *(f32x4*)so = (f32x4){cur[0], cur[1], cur[2], cur[3]}; *(f32x4*)(so + 4) = (f32x4){cur[4], cur[5], cur[6], cur[7]}; } \
            _Pragma("unroll") for (int e = 0; e < 8; ++e) { h[0][e] = h[1][e]; h[1][e] = h[2][e]; h[2][e] = cur[e]; } }
DI void p_gdnconv(Frame& F) {
    const int gw = F.vcu * NWAVES + F.wave, NGW = F.G * NWAVES, lane = F.lane;
    const bf16* QKV = (const bf16*)(F.ws + WS_QKV);
    bf16* QN = (bf16*)(F.ws + WS_QN); bf16* KN = (bf16*)(F.ws + WS_KN); bf16* VV = (bf16*)(F.ws + WS_VV);
    const float* wconv = F.in[I_AWCONV];
    constexpr int NTBP = MP / 16;
    const int TBS = NGW >> 4;
    const bool act = gw < TBS * 16;
    const int cc = gw & 15, c0 = cc * 512 + lane * 8;
    float w[4][8];
#pragma unroll
    for (int i = 0; i < 4; ++i) { const f32x4 a = *(const f32x4*)(wconv + i * QKVW + c0), bq = *(const f32x4*)(wconv + i * QKVW + c0 + 4);
        w[i][0] = a[0]; w[i][1] = a[1]; w[i][2] = a[2]; w[i][3] = a[3]; w[i][4] = bq[0]; w[i][5] = bq[1]; w[i][6] = bq[2]; w[i][7] = bq[3]; }
    int tb = act ? gw >> 4 : NTBP;
    v4u rows[16], hp[3];
    if (tb < NTBP) GC_LOAD(tb, rows, hp)
    for (; tb < NTBP; tb += TBS) {
        v4u rn[16], hn[3];
#pragma unroll
        for (int tt = 0; tt < 16; ++tt) rn[tt] = rows[tt];
#pragma unroll
        for (int j = 0; j < 3; ++j) hn[j] = hp[j];
        if (tb + TBS < NTBP) GC_LOAD(tb + TBS, rn, hn)
        const int b = tb >> 9; const int t0 = (tb & 511) * 16;
        const size_t mbase = (size_t)b * SEQ;
        float h[3][8];
#pragma unroll
        for (int j = 0; j < 3; ++j) unpack8(hp[j], h[j]);
#pragma unroll
        for (int tt = 0; tt < 16; ++tt) GC_ROW(rows[tt], t0 + tt, mbase + t0 + tt, false, b, SEQ)
#pragma unroll
        for (int tt = 0; tt < 16; ++tt) rows[tt] = rn[tt];
#pragma unroll
        for (int j = 0; j < 3; ++j) hp[j] = hn[j];
    }
    if (act) for (int pc = gw >> 4; pc < DECB * 4; pc += TBS) {
        const int b = pc >> 2, ta = (pc & 3) * 4; const size_t mbase = (size_t)MP + b * 16;
        v4u r4[4];
#pragma unroll
        for (int tt = 0; tt < 4; ++tt) r4[tt] = __builtin_nontemporal_load((const v4u*)(QKV + (mbase + ta + tt) * QKVW + c0));
        float h[3][8];
        if (ta == 0) {
#pragma unroll
            for (int j = 0; j < 3; ++j) { const float* sp = F.in[I_SGC] + (size_t)(b * 3 + j) * QKVW + c0; const f32x4 a = *(const f32x4*)sp, bq = *(const f32x4*)(sp + 4);
                h[j][0] = a[0]; h[j][1] = a[1]; h[j][2] = a[2]; h[j][3] = a[3]; h[j][4] = bq[0]; h[j][5] = bq[1]; h[j][6] = bq[2]; h[j][7] = bq[3]; }
        } else {
#pragma unroll
            for (int j = 0; j < 3; ++j) unpack8(*(const v4u*)(QKV + (mbase + ta - 3 + j) * QKVW + c0), h[j]);
        }
#pragma unroll
        for (int tt = 0; tt < 4; ++tt) GC_ROW(r4[tt], ta + tt, mbase + ta + tt, true, b, DECS)
    }
}
DI void p_prep(Frame& F) {
    const int gw = F.vcu * NWAVES + F.wave, NGW = F.G * NWAVES;
    LAS float* Al = (LAS float*)(F.lds + F.wave * 16384);
    const bf16* QN = (const bf16*)(F.ws + WS_QN); const bf16* KN = (const bf16*)(F.ws + WS_KN);
    const float* BA = (const float*)(F.ws + WS_BA);
    bf16* TP = (bf16*)(F.ws + WS_TP); bf16* PP = (bf16*)(F.ws + WS_PP);
    float* EG = (float*)(F.ws + WS_EG); float* DL = (float*)(F.ws + WS_DL); float* GL = (float*)(F.ws + WS_GL);
    const int gw2 = F.wave * F.G + F.vcu;
    const int npr = (gw < NITEM_P) ? (NITEM_P - gw + NGW - 1) / NGW : 0, nsm = (gw2 < NITEM - NITEM_P) ? (NITEM - NITEM_P - gw2 + NGW - 1) / NGW : 0;
    for (int k = 0; k < npr + nsm; ++k) {
        const int it = (k < npr) ? gw + k * NGW : NITEM_P + gw2 + (k - npr) * NGW;
        int lane = F.lane; asm volatile("" : "+v"(lane));
        const int c = lane & 31, hh = lane >> 5;
        int h, nv; size_t m0;
        if (it < NITEM_P) { h = it & 31; const int bn = it >> 5; m0 = (size_t)(bn >> 7) * SEQ + (size_t)(bn & 127) * 64; nv = 64; }
        else { const int r = it - NITEM_P; h = r & 31; m0 = (size_t)MP + (size_t)(r >> 5) * 16; nv = 16; }
        const int kh = h >> 1;
        float gt = 0.f, bt = 0.f;
        if (lane < nv) { const float bb = BA[(m0 + lane) * 64 + h], aa = BA[(m0 + lane) * 64 + 32 + h];
            bt = 1.0f / (1.0f + __expf(-bb));
            const float xx = aa + F.in[I_ADT][h]; const float sp = fmaxf(xx, 0.f) + log1pf(__expf(-fabsf(xx)));
            gt = -__expf(F.in[I_ALOG][h]) * sp; }
        float G = gt;
#pragma unroll
        for (int o = 1; o < 64; o <<= 1) { const float y = __shfl_up(G, o); if (lane >= o) G += y; }
        const float Glast = __shfl(G, 63);
        if (nv == 64) {
        bf16x8 kf[2][8];
#pragma unroll
        for (int ti = 0; ti < 2; ++ti)
#pragma unroll
            for (int s = 0; s < 8; ++s) { const int row = 32 * ti + c;
                kf[ti][s] = (row < nv) ? *(const bf16x8*)(KN + (m0 + row) * DM + kh * 128 + 16 * s + 8 * hh) : (bf16x8){0, 0, 0, 0, 0, 0, 0, 0}; }
        {
            f32x16 t00 = {}, t10 = {}, t11 = {};
#pragma unroll
            for (int s = 0; s < 8; ++s) { t00 = MFMA32(kf[0][s], kf[0][s], t00); t10 = MFMA32(kf[1][s], kf[0][s], t10); t11 = MFMA32(kf[1][s], kf[1][s], t11); }
#pragma unroll
            for (int i = 0; i < 16; ++i) {
                const int r0 = crow(i, hh), r1 = 32 + r0;
                const float G0 = __shfl(G, r0), G1 = __shfl(G, r1), b0 = __shfl(bt, r0), b1 = __shfl(bt, r1);
                const float Gc0 = __shfl(G, c), Gc1 = __shfl(G, 32 + c);
                Al[r0 * 64 + c] = (r0 > c) ? b0 * t00[i] * __expf(G0 - Gc0) : 0.f;
                Al[r1 * 64 + c] = b1 * t10[i] * __expf(G1 - Gc0);
                Al[r1 * 64 + 32 + c] = (r0 > c) ? b1 * t11[i] * __expf(G1 - Gc1) : 0.f;
            }
        }
        asm volatile("" ::: "memory");
        {
            bf16x8 qf[2][8];
#pragma unroll
            for (int ti = 0; ti < 2; ++ti)
#pragma unroll
                for (int s = 0; s < 8; ++s) { const int row = 32 * ti + c;
                    qf[ti][s] = (row < nv) ? *(const bf16x8*)(QN + (m0 + row) * DM + kh * 128 + 16 * s + 8 * hh) : (bf16x8){0, 0, 0, 0, 0, 0, 0, 0}; }
            f32x16 t00 = {}, t10 = {}, t11 = {};
#pragma unroll
            for (int s = 0; s < 8; ++s) { t00 = MFMA32(qf[0][s], kf[0][s], t00); t10 = MFMA32(qf[1][s], kf[0][s], t10); t11 = MFMA32(qf[1][s], kf[1][s], t11); }
            bf16* pp = PP + (size_t)it * 4096;
#pragma unroll
            for (int i = 0; i < 16; ++i) {
                const int r0 = crow(i, hh), r1 = 32 + r0;
                const float G0 = __shfl(G, r0), G1 = __shfl(G, r1);
                const float Gc0 = __shfl(G, c), Gc1 = __shfl(G, 32 + c);
                const float v00 = (r0 >= c) ? t00[i] * __expf(G0 - Gc0) : 0.f;
                const float v10 = t10[i] * __expf(G1 - Gc0);
                const float v11 = (r0 >= c) ? t11[i] * __expf(G1 - Gc1) : 0.f;
                pp[r0 * 64 + c] = (bf16)(pk2(v00, 0.f) & 0xffffu); pp[r0 * 64 + 32 + c] = 0;
                pp[r1 * 64 + c] = (bf16)(pk2(v10, 0.f) & 0xffffu); pp[r1 * 64 + 32 + c] = (bf16)(pk2(v11, 0.f) & 0xffffu);
            }
        }
        LDS_WAIT(); asm volatile("" ::: "memory");
        float T[64];
#pragma unroll
        for (int i = 0; i < 64; ++i) {
            float a = (lane == i) ? 1.0f : 0.f;
#pragma unroll
            for (int j = 0; j < i; ++j) a -= Al[i * 64 + j] * T[j];
            T[i] = a;
            asm volatile("" ::: "memory");
        }
        bf16* tp = TP + (size_t)it * 4096;
#pragma unroll
        for (int i = 0; i < 64; ++i) tp[i * 64 + lane] = (bf16)(pk2(T[i] * bt, 0.f) & 0xffffu);
        } else {
        bf16x8 kf0[8], qf0[8];
#pragma unroll
        for (int s = 0; s < 8; ++s) { kf0[s] = (c < nv) ? *(const bf16x8*)(KN + (m0 + c) * DM + kh * 128 + 16 * s + 8 * hh) : (bf16x8){0, 0, 0, 0, 0, 0, 0, 0};
            qf0[s] = (c < nv) ? *(const bf16x8*)(QN + (m0 + c) * DM + kh * 128 + 16 * s + 8 * hh) : (bf16x8){0, 0, 0, 0, 0, 0, 0, 0}; }
        f32x16 tk = {}, tq = {};
#pragma unroll
        for (int s = 0; s < 8; ++s) { tk = MFMA32(kf0[s], kf0[s], tk); tq = MFMA32(qf0[s], kf0[s], tq); }
        bf16* pp = PP + (size_t)it * 4096;
#pragma unroll
        for (int i = 0; i < 16; ++i) {
            const int r0 = crow(i, hh), r1 = 32 + r0;
            const float G0 = __shfl(G, r0), b0 = __shfl(bt, r0), Gc0 = __shfl(G, c);
            const float dec = __expf(G0 - Gc0);
            Al[r0 * 64 + c] = (r0 > c) ? b0 * tk[i] * dec : 0.f;
            const float v00 = (r0 >= c) ? tq[i] * dec : 0.f;
            pp[r0 * 64 + c] = (bf16)(pk2(v00, 0.f) & 0xffffu); pp[r0 * 64 + 32 + c] = 0;
            pp[r1 * 64 + c] = 0; pp[r1 * 64 + 32 + c] = 0;
        }
        LDS_WAIT(); asm volatile("" ::: "memory");
        float T[16];
#pragma unroll
        for (int i = 0; i < 16; ++i) {
            float a = (lane == i) ? 1.0f : 0.f;
#pragma unroll
            for (int j = 0; j < i; ++j) a -= Al[i * 64 + j] * T[j];
            T[i] = a;
            asm volatile("" ::: "memory");
        }
        bf16* tp = TP + (size_t)it * 4096;
#pragma unroll
        for (int i = 0; i < 16; ++i) tp[i * 64 + lane] = (bf16)(pk2(T[i] * bt, 0.f) & 0xffffu);
#pragma unroll
        for (int i = 16; i < 64; ++i) tp[i * 64 + lane] = 0;
        }
        EG[(size_t)it * 64 + lane] = __expf(G); DL[(size_t)it * 64 + lane] = __expf(Glast - G);
        if (lane == 0) GL[it] = __expf(Glast);
        LDS_WAIT(); asm volatile("" ::: "memory");
    }
}
constexpr int SB_K = 0, SB_Q = 17408, SB_V = 34816, SB_TP = 52224, SB_PP = 61440, SB_SIZE = 70656, SB_EG = 2 * SB_SIZE;
constexpr int LDK = 272, LDT = 144;
DI bf16x8 frag_perm(const LAS unsigned char* p) {
    const v2u lo = *(const LAS v2u*)p, hi = *(const LAS v2u*)(p + 16); const v4u x = {lo.x, lo.y, hi.x, hi.y}; return __builtin_bit_cast(bf16x8, x); }
DI bf16x8 pack_acc(const f32x16& a, const int s2) {
    v4u x; x.x = pk2(a[8 * s2], a[8 * s2 + 1]); x.y = pk2(a[8 * s2 + 2], a[8 * s2 + 3]); x.z = pk2(a[8 * s2 + 4], a[8 * s2 + 5]); x.w = pk2(a[8 * s2 + 6], a[8 * s2 + 7]); return __builtin_bit_cast(bf16x8, x); }
struct ScanLd { v4u k[4], q[4], v[4], tp[2], pp[2]; float e0, e1; };
DI void scan_issue(ScanLd& L, Frame& F, const int lt, const int item, const size_t m0, const int nv, const int h) {
    const bf16* QN = (const bf16*)(F.ws + WS_QN); const bf16* KN = (const bf16*)(F.ws + WS_KN); const bf16* VV = (const bf16*)(F.ws + WS_VV);
    const bf16* TP = (const bf16*)(F.ws + WS_TP); const bf16* PP = (const bf16*)(F.ws + WS_PP);
    const float* EG = (const float*)(F.ws + WS_EG); const float* DL = (const float*)(F.ws + WS_DL); const float* GL = (const float*)(F.ws + WS_GL);
    const int kh = h >> 1;
#pragma unroll
    for (int i = 0; i < 4; ++i) { const int p = lt + 256 * i, row = p >> 4, cc = p & 15; const v4u z4 = {0u, 0u, 0u, 0u};
        L.k[i] = (row < nv) ? *(const v4u*)(KN + (m0 + row) * DM + kh * 128 + cc * 8) : z4;
        L.q[i] = (row < nv) ? *(const v4u*)(QN + (m0 + row) * DM + kh * 128 + cc * 8) : z4;
        const int vrow = lt >> 2, vcc = (lt & 3) * 4 + i; L.v[i] = (vrow < nv) ? *(const v4u*)(VV + (m0 + vrow) * VW + h * 128 + vcc * 8) : z4; }
#pragma unroll
    for (int i = 0; i < 2; ++i) { const int p = lt + 256 * i, row = p >> 3, cc = p & 7;
        L.tp[i] = *(const v4u*)(TP + (size_t)item * 4096 + row * 64 + cc * 8); L.pp[i] = *(const v4u*)(PP + (size_t)item * 4096 + row * 64 + cc * 8); }
    L.e0 = (lt < 64) ? EG[(size_t)item * 64 + lt] : ((lt < 128) ? DL[(size_t)item * 64 + lt - 64] : GL[item]);
}
DI void st_perm(LAS unsigned char* rowbase, const int cc, const v4u x) {
    LAS unsigned char* g = rowbase + (cc >> 1) * 32 + (cc & 1) * 8;
    *(LAS v2u*)g = (v2u){x.x, x.y}; *(LAS v2u*)(g + 16) = (v2u){x.z, x.w};
}
DI void scan_write(const ScanLd& L, LAS unsigned char* lds, const int buf, const int lt) {
    LAS unsigned char* B = lds + buf * SB_SIZE;
#pragma unroll
    for (int i = 0; i < 4; ++i) { const int p = lt + 256 * i, row = p >> 4, cc = p & 15;
        *(LAS v4u*)(B + SB_K + row * LDK + cc * 16) = L.k[i]; st_perm(B + SB_Q + row * LDK, cc, L.q[i]);
        *(LAS v4u*)(B + SB_V + (lt >> 2) * LDK + ((lt & 3) * 4 + i) * 16) = L.v[i]; }
#pragma unroll
    for (int i = 0; i < 2; ++i) { const int p = lt + 256 * i, row = p >> 3, cc = p & 7;
        st_perm(B + SB_TP + row * LDT, cc, L.tp[i]); st_perm(B + SB_PP + row * LDT, cc, L.pp[i]); }
    if (lt <= 128) *(LAS float*)(lds + SB_EG + buf * 1024 + lt * 4) = L.e0;
}
struct ScanZ { v4u z[4]; };
DI void scan_z_load(ScanZ& N, Frame& F, const int lt, const size_t m0, const int nv, const int h) {
    const bf16* Z = (const bf16*)(F.ws + WS_Z); const int tok = lt >> 2, qd = lt & 3; const size_t off = (m0 + (tok < nv ? tok : 0)) * VW + h * 128 + qd * 32;
#pragma unroll
    for (int i = 0; i < 4; ++i) N.z[i] = *(const v4u*)(Z + off + 8 * i);
}
DI void scan_norm_lds(const ScanZ& N, Frame& F, const int buf, const int lt, const size_t m0, const int nv, const int h) {
    bf16* ON = (bf16*)(F.out + O_PK); const LAS float* gn = (const LAS float*)(F.lds + SB_EG + 2048);
    const int tok = lt >> 2, qd = lt & 3; const size_t off = (m0 + tok) * VW + h * 128 + qd * 32;
    const LAS unsigned char* op = F.lds + buf * SB_SIZE + SB_V + tok * LDK + qd * 64;
    v4u o4[4]; float ss = 0.f;
#pragma unroll
    for (int i = 0; i < 4; ++i) { o4[i] = *(const LAS v4u*)(op + 16 * i); float o8[8]; unpack8(o4[i], o8);
#pragma unroll
        for (int e = 0; e < 8; ++e) ss += o8[e] * o8[e]; }
    ss += __shfl_xor(ss, 1); ss += __shfl_xor(ss, 2);
    const float rstd = rsqrtf(ss * (1.0f / 128.0f) + 1e-6f);
    if (tok < nv) {
#pragma unroll
        for (int i = 0; i < 4; ++i) { float o8[8], z8[8]; unpack8(o4[i], o8); unpack8(N.z[i], z8);
            const f32x4 g0 = *(const LAS f32x4*)(gn + qd * 32 + 8 * i), g1 = *(const LAS f32x4*)(gn + qd * 32 + 8 * i + 4);
#pragma unroll
            for (int e = 0; e < 8; ++e) o8[e] = o8[e] * rstd * (e < 4 ? g0[e & 3] : g1[e & 3]) * siluf(z8[e]);
            *(v4u*)(ON + off + 8 * i) = pack8(o8); }
    }
}
DI void scan_chain(Frame& F, const bool samp, const int b, const int h) {
    const int tid = F.tid, w = F.wave;
    LAS unsigned char* lds = F.lds;
    bf16* ON = (bf16*)(F.out + O_PK);
    const int nsteps = samp ? 1 : 128, nv = samp ? 16 : 64;
    const bool loader = w >= 4; const int lt = tid - 256;
#define SC_ITEM(n) (samp ? NITEM_P + b * 32 + h : (b * 128 + (n)) * 32 + h)
#define SC_M0(n) (samp ? (size_t)MP + b * 16 : (size_t)b * SEQ + (size_t)(n) * 64)
    f32x16 S[4];
    __syncthreads();
    if (tid < 128) *(LAS float*)(lds + SB_EG + 2048 + tid * 4) = F.in[I_AONORM][tid];
    if (samp) {
        const float* s0 = F.in[I_SGDN] + (size_t)(b * 32 + h) * 16384;
#pragma unroll
        for (int i = 0; i < 8; ++i) *(LAS f32x4*)(lds + (tid + 512 * i) * 16) = *(const f32x4*)(s0 + (tid + 512 * i) * 4);
        __syncthreads();
        if (!loader) { const int lane = F.lane, c = lane & 31, hh = lane >> 5, dvb = 32 * w;
#pragma unroll
            for (int i4 = 0; i4 < 4; ++i4)
#pragma unroll
                for (int i = 0; i < 16; ++i) S[i4][i] = *(const LAS float*)(lds + ((32 * i4 + crow(i, hh)) * 128 + dvb + c) * 4); }
        __syncthreads();
    } else {
#pragma unroll
        for (int i4 = 0; i4 < 4; ++i4)
#pragma unroll
            for (int i = 0; i < 16; ++i) S[i4][i] = 0.f;
    }
    if (loader) {
        ScanLd L0, L1; ScanZ Z0;
        { int lv = lt; asm volatile("" : "+v"(lv)); scan_issue(L0, F, lv, SC_ITEM(0), SC_M0(0), nv, h); scan_write(L0, lds, 0, lv);
          if (nsteps > 1) scan_issue(L1, F, lv, SC_ITEM(1), SC_M0(1), nv, h); if (nsteps > 2) scan_issue(L0, F, lv, SC_ITEM(2), SC_M0(2), nv, h);
          scan_z_load(Z0, F, lv, SC_M0(0), nv, h); }
        __syncthreads();
        for (int n = 0; n < nsteps; n += 2) {
            {
                int lv = lt; asm volatile("" : "+v"(lv));
                if (n >= 1) { scan_norm_lds(Z0, F, 1, lv, SC_M0(n - 1), nv, h); scan_z_load(Z0, F, lv, SC_M0(n), nv, h); }
                if (n + 1 < nsteps) scan_write(L1, lds, 1, lv);
                if (n + 3 < nsteps) scan_issue(L1, F, lv, SC_ITEM(n + 3), SC_M0(n + 3), nv, h);
                __syncthreads();
            }
            if (n + 1 < nsteps) {
                int lv = lt; asm volatile("" : "+v"(lv));
                scan_norm_lds(Z0, F, 0, lv, SC_M0(n), nv, h); scan_z_load(Z0, F, lv, SC_M0(n + 1), nv, h);
                if (n + 2 < nsteps) scan_write(L0, lds, 0, lv);
                if (n + 4 < nsteps) scan_issue(L0, F, lv, SC_ITEM(n + 4), SC_M0(n + 4), nv, h);
                __syncthreads();
            }
        }
        __syncthreads();
        { int lv = lt; asm volatile("" : "+v"(lv));
          scan_norm_lds(Z0, F, (nsteps - 1) & 1, lv, SC_M0(nsteps - 1), nv, h); }
        __syncthreads();
    } else {
        __syncthreads();
        for (int n = 0; n < nsteps; ++n) {
            int lane = F.lane; asm volatile("" : "+v"(lane));
            const int c = lane & 31, hh = lane >> 5, dvb = 32 * w;
            const LAS unsigned char* B = lds + (n & 1) * SB_SIZE; const LAS float* egp = (const LAS float*)(lds + SB_EG + (n & 1) * 1024);
            const size_t m0 = SC_M0(n);
            bf16x8 Sb[8];
#pragma unroll
            for (int i4 = 0; i4 < 4; ++i4) { Sb[2 * i4] = pack_acc(S[i4], 0); Sb[2 * i4 + 1] = pack_acc(S[i4], 1); }
            f32x16 ks[2] = {{}, {}}, qs[2] = {{}, {}};
            const LAS unsigned char* pk0 = B + SB_K + c * LDK + 8 * hh; const LAS unsigned char* pq1 = B + SB_Q + c * LDK + 16 * hh;
            bf16x8 fa[4], fb[4], tf[8];
#define LDKQ(dst, s8) do { dst[0] = frag_perm(pk0 + 32 * (s8)); dst[1] = frag_perm(pk0 + 32 * LDK + 32 * (s8)); dst[2] = *(const LAS bf16x8*)(pq1 + 32 * (s8)); dst[3] = *(const LAS bf16x8*)(pq1 + 32 * LDK + 32 * (s8)); } while (0)
#define MMKQ(src, s8) do { ks[0] = MFMA32(src[0], Sb[s8], ks[0]); ks[1] = MFMA32(src[1], Sb[s8], ks[1]); qs[0] = MFMA32(src[2], Sb[s8], qs[0]); qs[1] = MFMA32(src[3], Sb[s8], qs[1]); } while (0)
#define SBAR() __builtin_amdgcn_sched_barrier(0)
            LDKQ(fa, 0); SBAR();
            LDKQ(fb, 1); SBAR(); MMKQ(fa, 0); SBAR();
            LDKQ(fa, 2); SBAR(); MMKQ(fb, 1); SBAR();
            LDKQ(fb, 3); SBAR(); MMKQ(fa, 2); SBAR();
            LDKQ(fa, 4); SBAR(); MMKQ(fb, 3); SBAR();
            LDKQ(fb, 5); SBAR(); MMKQ(fa, 4); SBAR();
            LDKQ(fa, 6); SBAR(); MMKQ(fb, 5); SBAR();
            LDKQ(fb, 7); SBAR(); MMKQ(fa, 6); SBAR();
#pragma unroll
            for (int s4 = 0; s4 < 4; ++s4) { tf[2 * s4] = *(const LAS bf16x8*)(B + SB_TP + c * LDT + 32 * s4 + 16 * hh); tf[2 * s4 + 1] = *(const LAS bf16x8*)(B + SB_TP + (32 + c) * LDT + 32 * s4 + 16 * hh); }
            SBAR(); MMKQ(fb, 7); SBAR();
#undef LDKQ
#undef MMKQ
            bf16x8 rf[4];
            { const int vbv = (int)(unsigned)(size_t)(B + SB_V) + (4 * hh + ((lane >> 2) & 3)) * LDK + ((lane >> 4) & 1) * 32 + (lane & 3) * 8 + dvb * 2;
              const bf16x4 v00 = tr_read<0 * LDK>(vbv), v01 = tr_read<8 * LDK>(vbv), v02 = tr_read<16 * LDK>(vbv), v03 = tr_read<24 * LDK>(vbv);
              const bf16x4 v10 = tr_read<32 * LDK>(vbv), v11 = tr_read<40 * LDK>(vbv), v12 = tr_read<48 * LDK>(vbv), v13 = tr_read<56 * LDK>(vbv);
              asm volatile("s_waitcnt lgkmcnt(0)" ::: "memory"); SBAR();
#define RROW(tt, g4, V) do { const f32x4 e4 = *(const LAS f32x4*)(egp + 32 * (tt) + 8 * (g4) + 4 * hh); \
                  r[4 * (g4)] = bf2f((bf16)V[0]) - e4[0] * ks[tt][4 * (g4)]; r[4 * (g4) + 1] = bf2f((bf16)V[1]) - e4[1] * ks[tt][4 * (g4) + 1]; \
                  r[4 * (g4) + 2] = bf2f((bf16)V[2]) - e4[2] * ks[tt][4 * (g4) + 2]; r[4 * (g4) + 3] = bf2f((bf16)V[3]) - e4[3] * ks[tt][4 * (g4) + 3]; } while (0)
              { f32x16 r; RROW(0, 0, v00); RROW(0, 1, v01); RROW(0, 2, v02); RROW(0, 3, v03); rf[0] = pack_acc(r, 0); rf[1] = pack_acc(r, 1); }
              { f32x16 r; RROW(1, 0, v10); RROW(1, 1, v11); RROW(1, 2, v12); RROW(1, 3, v13); rf[2] = pack_acc(r, 0); rf[3] = pack_acc(r, 1); }
#undef RROW
            }
            SBAR();
            f32x16 u[2] = {{}, {}};
#pragma unroll
            for (int s4 = 0; s4 < 4; ++s4) { u[0] = MFMA32(tf[2 * s4], rf[s4], u[0]); u[1] = MFMA32(tf[2 * s4 + 1], rf[s4], u[1]); }
            SBAR();
            bf16x8 pf[8];
#pragma unroll
            for (int s4 = 0; s4 < 4; ++s4) { pf[2 * s4] = *(const LAS bf16x8*)(B + SB_PP + c * LDT + 32 * s4 + 16 * hh); pf[2 * s4 + 1] = *(const LAS bf16x8*)(B + SB_PP + (32 + c) * LDT + 32 * s4 + 16 * hh); }
            const float gl = egp[128];
            SBAR();
            bf16x8 uf[4], upf[4];
#pragma unroll
            for (int tt = 0; tt < 2; ++tt) { uf[2 * tt] = pack_acc(u[tt], 0); uf[2 * tt + 1] = pack_acc(u[tt], 1); f32x16 up;
#pragma unroll
                for (int g4 = 0; g4 < 4; ++g4) { const f32x4 d4 = *(const LAS f32x4*)(egp + 64 + 32 * tt + 8 * g4 + 4 * hh);
                    up[4 * g4] = u[tt][4 * g4] * d4[0]; up[4 * g4 + 1] = u[tt][4 * g4 + 1] * d4[1]; up[4 * g4 + 2] = u[tt][4 * g4 + 2] * d4[2]; up[4 * g4 + 3] = u[tt][4 * g4 + 3] * d4[3]; }
                upf[2 * tt] = pack_acc(up, 0); upf[2 * tt + 1] = pack_acc(up, 1); }
            f32x16 pu[2] = {{}, {}};
#pragma unroll
            for (int s4 = 0; s4 < 4; ++s4) { pu[0] = MFMA32(pf[2 * s4], uf[s4], pu[0]); pu[1] = MFMA32(pf[2 * s4 + 1], uf[s4], pu[1]); }
            SBAR();
            { const int vb = (int)(unsigned)(size_t)(B + SB_K) + (4 * hh + ((lane >> 2) & 3)) * LDK + ((lane >> 4) & 1) * 32 + (lane & 3) * 8;
#pragma unroll
              for (int i4 = 0; i4 < 4; ++i4) {
#pragma unroll
                  for (int i = 0; i < 16; ++i) S[i4][i] *= gl; }
#define KTPK(L, H) (bf16x8){L[0], L[1], L[2], L[3], H[0], H[1], H[2], H[3]}
#define KTLD(P, s4) const bf16x4 P##l0 = tr_read<16 * (s4) * LDK>(vb), P##h0 = tr_read<(16 * (s4) + 8) * LDK>(vb), P##l1 = tr_read<16 * (s4) * LDK + 64>(vb), P##h1 = tr_read<(16 * (s4) + 8) * LDK + 64>(vb), \
                  P##l2 = tr_read<16 * (s4) * LDK + 128>(vb), P##h2 = tr_read<(16 * (s4) + 8) * LDK + 128>(vb), P##l3 = tr_read<16 * (s4) * LDK + 192>(vb), P##h3 = tr_read<(16 * (s4) + 8) * LDK + 192>(vb)
#define KTMM(P, s4) do { S[0] = MFMA32(KTPK(P##l0, P##h0), upf[s4], S[0]); S[1] = MFMA32(KTPK(P##l1, P##h1), upf[s4], S[1]); S[2] = MFMA32(KTPK(P##l2, P##h2), upf[s4], S[2]); S[3] = MFMA32(KTPK(P##l3, P##h3), upf[s4], S[3]); } while (0)
              KTLD(a, 0); KTLD(b, 1);
              asm volatile("s_waitcnt lgkmcnt(0)" ::: "memory"); SBAR();
              KTMM(a, 0); KTMM(b, 1); SBAR();
              KTLD(d, 2); KTLD(e, 3);
              asm volatile("s_waitcnt lgkmcnt(0)" ::: "memory"); SBAR();
              KTMM(d, 2); KTMM(e, 3); SBAR();
#undef KTLD
#undef KTMM
#undef KTPK
            }
#undef SBAR
            { LAS unsigned char* ob = lds + (n & 1) * SB_SIZE + SB_V + dvb * 2;
#pragma unroll
              for (int ti = 0; ti < 2; ++ti)
#pragma unroll
                for (int g4 = 0; g4 < 4; ++g4) { const int tk = 32 * ti + 8 * g4 + 4 * hh; const f32x4 e4 = *(const LAS f32x4*)(egp + tk);
#pragma unroll
                    for (int j = 0; j < 4; ++j) *(LAS bf16*)(ob + (tk + j) * LDK + c * 2) = (bf16)(pk2(e4[j] * qs[ti][4 * g4 + j] + pu[ti][4 * g4 + j], 0.f) & 0xffffu); }
              LDS_WAIT(); }
            __syncthreads();
        }
        __syncthreads();
        __syncthreads();
        {
            const int lane = F.lane, c = lane & 31, hh = lane >> 5, dvb = 32 * w;
#pragma unroll
            for (int i4 = 0; i4 < 4; ++i4)
#pragma unroll
                for (int i = 0; i < 16; ++i) *(LAS float*)(lds + ((32 * i4 + crow(i, hh)) * 128 + dvb + c) * 4) = S[i4][i];
        }
    }
    __syncthreads();
    { float* so = F.out + (samp ? O_SGDN : O_PGDN) + (size_t)(b * 32 + h) * 16384;
#pragma unroll
      for (int i = 0; i < 8; ++i) *(f32x4*)(so + (tid + 512 * i) * 4) = *(const LAS f32x4*)(lds + (tid + 512 * i) * 16); }
#undef SC_ITEM
#undef SC_M0
}
DI void p_scan(Frame& F) {
    const int nW = F.G, bx = blockIdx.x;
    for (int ch = bx; ch < NB * 32; ch += nW) { const int x = ch & 7, y = (ch >> 3) & 7, kh = x + 8 * (y >> 1);
        scan_chain(F, false, kh >> 4, 2 * (kh & 15) + (y & 1)); }
    int start, stride;
    if (nW > NB * 32) { start = bx - NB * 32; stride = nW - NB * 32; } else { start = bx; stride = nW; }
    if (start >= 0) for (int ch = start; ch < DECB * 32; ch += stride) scan_chain(F, true, ch >> 5, ch & 31);
}
DI void p_ffnconv(Frame& F, const int layer, const int tb_lo, const int tb_hi, const int gw, const int NGW, const bf16* UP, bf16* ACT) {
    const int lane = F.lane;
    const float* wconv = F.in[I_FWCONV] + (size_t)layer * 3 * UPW; const float* bconv = F.in[I_FBCONV] + (size_t)layer * UPW;
    constexpr int NCC = DFF / 512;
    const int NI = (tb_hi - tb_lo) * NCC, R = NI / NGW, rem = NI - R * NGW; const bool halves = 2 * rem <= NGW;
    const int npiece = R + ((halves ? gw < 2 * rem : gw < rem) ? 1 : 0);
    for (int k = 0; k < npiece; ++k) {
        const bool tail = k >= R;
        const int it = !tail ? gw + k * NGW : R * NGW + (halves ? gw >> 1 : gw);
        const int th_lo = (tail && halves) ? (gw & 1) : 0, th_hi = (tail && halves) ? th_lo + 1 : 2;
        const int tb = tb_lo + it / NCC, cc = it % NCC, c0 = cc * 512 + lane * 8;
        const bool samp = tb >= MP / 16; const int b = samp ? tb - MP / 16 : tb >> 9; const int t0 = samp ? 0 : (tb & 511) * 16;
        const size_t mbase = samp ? (size_t)MP + b * 16 : (size_t)b * SEQ; const int L = samp ? DECS : SEQ;
        float wg[3][8], wv[3][8], bg[8], bv[8];
#pragma unroll
        for (int i = 0; i < 3; ++i)
#pragma unroll
            for (int e = 0; e < 8; ++e) { wg[i][e] = wconv[i * UPW + c0 + e]; wv[i][e] = wconv[i * UPW + DFF + c0 + e]; }
#pragma unroll
        for (int e = 0; e < 8; ++e) { bg[e] = bconv[c0 + e]; bv[e] = bconv[DFF + c0 + e]; }
        float hg[2][8], hv[2][8];
#pragma unroll
        for (int j = 0; j < 2; ++j) { const int t = t0 + 8 * th_lo - 2 + j;
            if (t >= 0) { unpack8(*(const v4u*)(UP + (mbase + t) * UPW + c0), hg[j]); unpack8(*(const v4u*)(UP + (mbase + t) * UPW + DFF + c0), hv[j]); }
            else if (samp) { const float* sp = F.in[I_SFC] + ((size_t)(layer * DECB + b) * 2 + (t + 2)) * UPW + c0;
#pragma unroll
                for (int e = 0; e < 8; ++e) { hg[j][e] = sp[e]; hv[j][e] = sp[DFF + e]; } }
            else {
#pragma unroll
                for (int e = 0; e < 8; ++e) { hg[j][e] = 0.f; hv[j][e] = 0.f; } } }
        for (int th = th_lo; th < th_hi; ++th) {
        v4u rg[8], rv[8];
#pragma unroll
        for (int tt = 0; tt < 8; ++tt) { rg[tt] = __builtin_nontemporal_load((const v4u*)(UP + (mbase + t0 + 8 * th + tt) * UPW + c0)); rv[tt] = __builtin_nontemporal_load((const v4u*)(UP + (mbase + t0 + 8 * th + tt) * UPW + DFF + c0)); }
#pragma unroll
        for (int t8 = 0; t8 < 8; ++t8) {
            const int tt = 8 * th + t8; const int t = t0 + tt; const size_t m = mbase + t;
            float cg[8], cv[8]; unpack8(rg[t8], cg); unpack8(rv[t8], cv);
            float y[8];
#pragma unroll
            for (int e = 0; e < 8; ++e) { const float g = hg[0][e] * wg[0][e] + hg[1][e] * wg[1][e] + cg[e] * wg[2][e] + bg[e];
                const float v = hv[0][e] * wv[0][e] + hv[1][e] * wv[1][e] + cv[e] * wv[2][e] + bv[e]; y[e] = siluf(g) * v; }
            *(v4u*)(ACT + m * DFF + c0) = pack8(y);
            if (t >= L - 2) {
                float* so = F.out + (samp ? O_SFC + ((size_t)(layer * DECB + b) * 2 + (t - (L - 2))) * UPW : O_PFC + ((size_t)(layer * NB + b) * 2 + (t - (L - 2))) * UPW) + c0;
#pragma unroll
                for (int e = 0; e < 8; ++e) { so[e] = cg[e]; so[DFF + e] = cv[e]; } }
#pragma unroll
            for (int e = 0; e < 8; ++e) { hg[0][e] = hg[1][e]; hg[1][e] = cg[e]; hv[0][e] = hv[1][e]; hv[1][e] = cv[e]; }
        }
        }
    }
}
DI void p_final(Frame& F, const int m_lo, const int m_hi, const int gw, const int NGW) {
    const int lane = F.lane;
    const float* ssq = (const float*)(F.ws + WS_SSQ + 4 * SSQ_STRIDE); const float* gain = F.in[I_FINAL];
    for (int m0 = m_lo + gw; m0 < m_hi; m0 += 2 * NGW) {
        const int m1 = m0 + NGW; const bool two = m1 < m_hi; const int mb = two ? m1 : m0;
        float s0 = (lane < 32) ? ssq[(size_t)m0 * 32 + lane] : 0.f; float s1 = (lane < 32) ? ssq[(size_t)mb * 32 + lane] : 0.f;
        f32x4* ya = (f32x4*)(F.out + (size_t)m0 * DM) + lane; f32x4* yb = (f32x4*)(F.out + (size_t)mb * DM) + lane; const f32x4* g4 = (const f32x4*)gain + lane;
        f32x4 va[8], vb[8];
#pragma unroll
        for (int j = 0; j < 8; ++j) va[j] = __builtin_nontemporal_load(ya + 64 * j);
#pragma unroll
        for (int j = 0; j < 8; ++j) vb[j] = __builtin_nontemporal_load(yb + 64 * j);
        s0 = wave_sum(s0); s1 = wave_sum(s1);
        const float r0 = rsqrtf(s0 * (1.0f / 2048.0f) + 1e-6f), r1 = rsqrtf(s1 * (1.0f / 2048.0f) + 1e-6f);
#pragma unroll
        for (int j = 0; j < 8; ++j) __builtin_nontemporal_store(va[j] * r0 * g4[64 * j], ya + 64 * j);
        if (two) {
#pragma unroll
            for (int j = 0; j < 8; ++j) __builtin_nontemporal_store(vb[j] * r1 * g4[64 * j], yb + 64 * j);
        }
    }
}
DI void p_cacheconv(Frame& F, const float* src, bf16* dst, const size_t t0, const size_t nthr) {
    constexpr size_t NP = (size_t)DECB * PAST * DM / 8;
    for (size_t p = t0; p < NP; p += nthr) {
        const size_t row = p >> 8, c8 = p & 255, b = row >> 11, key = row & 2047;
        const f32x4 a = __builtin_nontemporal_load((const f32x4*)(src + p * 8)), bq = __builtin_nontemporal_load((const f32x4*)(src + p * 8 + 4));
        v4u o; o.x = pk2(a[0], a[1]); o.y = pk2(a[2], a[3]); o.z = pk2(bq[0], bq[1]); o.w = pk2(bq[2], bq[3]);
        *(v4u*)(dst + (b * (PAST + DECS) + key) * DM + c8 * 8) = o;
    }
}
#ifndef ATT_SKEW
#define ATT_SKEW 0
#endif
constexpr int AT_K = 0, AT_V = 65536, AT_BT = 131072;
constexpr float ATT_C = 0.08838834764831845f * 1.4426950408889634f;
constexpr float LAM_INIT = 0.35550906759718507f;
constexpr float ATT_THR = 6.0f;
constexpr int CW_ATTQ = 64;
struct AttnUnit { const bf16* Kp; const bf16* Vp; const bf16* Qp; bf16* Op; int h, nq, qpos0, nkeys; size_t mq0; };
DI int t5_bucket(int rel) { const int n = rel < 0 ? -rel : rel; int v; if (n < 8) v = n; else { v = 2 + (31 - __builtin_clz((unsigned)(n * n))); v = v > 15 ? 15 : v; } return (rel > 0 ? 16 : 0) + v; }
#define KSWZ(row, colB) ((row) * 256 + ((colB) ^ (((row) & 7) << 4)))
DI int v_st(int k, int c) { return ((k >> 3) * 8 + (c >> 5)) * 512 + ((k & 7) * 32 + (c & 31)) * 2; }
DI int v_rd_base(int lane) { return ((lane & 3) << 3) | (((lane >> 2) & 3) << 6) | (((lane >> 4) & 1) << 5) | (((lane >> 5) & 1) << 8); }
DI void at_dma(LAS unsigned char* lds, const AttnUnit& U, const int kt, const int buf, const int w, int lane) {
    asm volatile("" : "+v"(lane));
#pragma unroll
    for (int i = 0; i < 4; ++i) {
        const int ch = 4 * w + i, map = ch >> 4, row = 4 * (ch & 15) + (lane >> 4), cc = (lane & 15) ^ (row & 7); int kg = kt * 64 + row; kg = kg < U.nkeys ? kg : U.nkeys - 1;
        __builtin_amdgcn_global_load_lds((const unsigned*)(U.Kp + (size_t)kg * DM + (2 * U.h + map) * 128 + cc * 8), (LAS unsigned*)(lds + AT_K + buf * 32768 + ch * 1024), 16, 0, 0); }
#pragma unroll
    for (int i = 0; i < 4; ++i) {
        const int ch = 4 * w + i, key = 8 * (ch >> 2) + ((lane & 31) >> 2), col = 32 * (2 * (ch & 3) + (lane >> 5)) + 8 * (lane & 3); int kg = kt * 64 + key; kg = kg < U.nkeys ? kg : U.nkeys - 1;
        __builtin_amdgcn_global_load_lds((const unsigned*)(U.Vp + (size_t)kg * DM + U.h * 256 + col), (LAS unsigned*)(lds + AT_V + buf * 32768 + ch * 1024), 16, 0, 0); }
}
#define PK(L, H) (bf16x8){L[0], L[1], L[2], L[3], H[0], H[1], H[2], H[3]}
#define VRD(P, D0) const bf16x4 P##l0 = tr_read<(D0) * 512 + 0 * 8192>(vb), P##h0 = tr_read<(D0) * 512 + 0 * 8192 + 4096>(vb), P##l1 = tr_read<(D0) * 512 + 1 * 8192>(vb), P##h1 = tr_read<(D0) * 512 + 1 * 8192 + 4096>(vb), \
    P##l2 = tr_read<(D0) * 512 + 2 * 8192>(vb), P##h2 = tr_read<(D0) * 512 + 2 * 8192 + 4096>(vb), P##l3 = tr_read<(D0) * 512 + 3 * 8192>(vb), P##h3 = tr_read<(D0) * 512 + 3 * 8192 + 4096>(vb)
#define VMM(P, D0) do { O[D0] = MFMA32(pf[0], PK(P##l0, P##h0), O[D0]); O[D0] = MFMA32(pf[1], PK(P##l1, P##h1), O[D0]); O[D0] = MFMA32(pf[2], PK(P##l2, P##h2), O[D0]); O[D0] = MFMA32(pf[3], PK(P##l3, P##h3), O[D0]); } while (0)
#define VW8() do { asm volatile("s_waitcnt lgkmcnt(8)" ::: "memory"); __builtin_amdgcn_sched_barrier(0); } while (0)
DI void at_pv_all(f32x16 (&O)[8], const int vb, const bf16x8 (&pf)[4]) {
    VRD(a, 0); __builtin_amdgcn_sched_barrier(0);
    VRD(b, 1); VW8(); VMM(a, 0); __builtin_amdgcn_sched_barrier(0);
    VRD(c, 2); VW8(); VMM(b, 1); __builtin_amdgcn_sched_barrier(0);
    VRD(d, 3); VW8(); VMM(c, 2); __builtin_amdgcn_sched_barrier(0);
    VRD(e, 4); VW8(); VMM(d, 3); __builtin_amdgcn_sched_barrier(0);
    VRD(f, 5); VW8(); VMM(e, 4); __builtin_amdgcn_sched_barrier(0);
    VRD(g, 6); VW8(); VMM(f, 5); __builtin_amdgcn_sched_barrier(0);
    VRD(h, 7); VW8(); VMM(g, 6); __builtin_amdgcn_sched_barrier(0);
    asm volatile("s_waitcnt lgkmcnt(0)" ::: "memory"); __builtin_amdgcn_sched_barrier(0); VMM(h, 7); __builtin_amdgcn_sched_barrier(0);
}
#undef VRD
#undef VMM
#undef VW8
#undef PK
DI void attn_unit(Frame& F, const AttnUnit& U, const float lam) {
    const int tid = F.tid, w = F.wave, lane = F.lane, rt = w >> 1, mm = w & 1;
    LAS unsigned char* lds = F.lds;
    const bf16* QB = U.Qp; bf16* ATT = U.Op;
    __syncthreads();
    { int tv = tid; asm volatile("" : "+v"(tv)); const int rel = tv - 256; *(LAS float*)(lds + AT_BT + tv * 4) = F.in[I_RELB][t5_bucket(rel) * 8 + U.h] * 1.4426950408889634f; }
    const bool active = 32 * rt < U.nq;
    const int qchunk = (U.qpos0 + 32 * rt) >> 6;
    bf16x8 qf[8];
    { int lq = lane; asm volatile("" : "+v"(lq)); const int c = lq & 31, hh = lq >> 5, qrow = 32 * rt + c;
#pragma unroll
      for (int s = 0; s < 8; ++s) qf[s] = (qrow < U.nq) ? *(const bf16x8*)(QB + (U.mq0 + qrow) * DM + (2 * U.h + mm) * 128 + 16 * s + 8 * hh) : (bf16x8){0, 0, 0, 0, 0, 0, 0, 0}; }
    const int ntiles = (U.nkeys + 63) >> 6;
    float m_run = -1e30f, l_run = 0.f;
    f32x16 O[8];
#pragma unroll
    for (int d = 0; d < 8; ++d) O[d] = (f32x16){};
    at_dma(lds, U, 0, 0, w, lane);
    asm volatile("s_waitcnt vmcnt(0)" ::: "memory");
    __syncthreads();
    for (int kt = 0; kt < ntiles; ++kt) {
        const bool vis = active && kt <= qchunk;
        if (!vis && kt + 1 < ntiles) at_dma(lds, U, kt + 1, (kt + 1) & 1, w, lane);
        if (vis) {
#if ATT_SKEW
            if (w >= 4) __builtin_amdgcn_s_sleep(ATT_SKEW);
#endif
            int lv = lane; asm volatile("" : "+v"(lv)); const int c = lv & 31, hh = lv >> 5; const int qpos_lane = U.qpos0 + 32 * rt + c;
            const int kbase = AT_K + (kt & 1) * 32768 + mm * 16384;
            f32x16 t0 = {}, t1 = {};
            {
                bf16x8 ka[3], kb[3];
#define LDKF(buf, s0) do { ka[buf] = *(const LAS bf16x8*)(lds + kbase + KSWZ(c, 32 * (s0) + 16 * hh)); kb[buf] = *(const LAS bf16x8*)(lds + kbase + KSWZ(32 + c, 32 * (s0) + 16 * hh)); } while (0)
#define MMKF(buf, s0) do { t0 = MFMA32(ka[buf], qf[s0], t0); t1 = MFMA32(kb[buf], qf[s0], t1); } while (0)
#define SB_() __builtin_amdgcn_sched_barrier(0)
                LDKF(0, 0); LDKF(1, 1); SB_();
                LDKF(2, 2); SB_(); MMKF(0, 0); SB_();
                LDKF(0, 3); SB_(); MMKF(1, 1); SB_();
                LDKF(1, 4); SB_(); MMKF(2, 2); SB_();
                LDKF(2, 5); SB_(); MMKF(0, 3); SB_();
                LDKF(0, 6); SB_(); MMKF(1, 4); SB_();
                LDKF(1, 7); SB_(); MMKF(2, 5); SB_();
                MMKF(0, 6); SB_(); MMKF(1, 7); SB_();
#undef SB_
#undef LDKF
#undef MMKF
            }
            const LAS float* bt = (const LAS float*)(lds + AT_BT);
            float mx, bc0 = 0.f; bool far = false;
            if (kt * 64 + 63 - (U.qpos0 + 32 * rt) <= -91 && kt * 64 + 63 < U.nkeys) {
                far = true; bc0 = bt[0];
                float r0 = fmaxf(t0[0], t1[0]);
#pragma unroll
                for (int i = 1; i < 16; i += 1) r0 = __builtin_fmaxf(__builtin_fmaxf(r0, t0[i]), t1[i]);
                mx = r0 * ATT_C + bc0;
            } else {
                const bool part = kt * 64 + 63 >= U.nkeys;
#pragma unroll
                for (int i = 0; i < 16; ++i) { const int kg = kt * 64 + crow(i, hh); int r0 = kg - qpos_lane, r1 = r0 + 32;
                    r0 = r0 < -256 ? -256 : r0; r0 = r0 > 255 ? 255 : r0; r1 = r1 < -256 ? -256 : r1; r1 = r1 > 255 ? 255 : r1;
                    float b0 = bt[r0 + 256], b1 = bt[r1 + 256];
                    if (part) { b0 = (kg < U.nkeys) ? b0 : -1e30f; b1 = (kg + 32 < U.nkeys) ? b1 : -1e30f; }
                    t0[i] = t0[i] * ATT_C + b0; t1[i] = t1[i] * ATT_C + b1; }
                mx = fmaxf(t0[0], t1[0]);
#pragma unroll
                for (int i = 1; i < 16; ++i) mx = __builtin_fmaxf(__builtin_fmaxf(mx, t0[i]), t1[i]);
            }
            mx = fmaxf(mx, __shfl_xor(mx, 32));
            if (__any(mx - m_run > ATT_THR)) {
                const float mn = fmaxf(m_run, mx), al = __builtin_amdgcn_exp2f(m_run - mn);
#pragma unroll
                for (int i = 0; i < 16; ++i) { const float ai = __shfl(al, crow(i, hh));
#pragma unroll
                    for (int d = 0; d < 8; ++d) O[d][i] *= ai; }
                l_run *= al; m_run = mn;
            }
            float ps = 0.f;
            if (far) { const float off = bc0 - m_run;
#pragma unroll
                for (int i = 0; i < 16; ++i) { t0[i] = __builtin_amdgcn_exp2f(__builtin_fmaf(t0[i], ATT_C, off)); t1[i] = __builtin_amdgcn_exp2f(__builtin_fmaf(t1[i], ATT_C, off)); ps += t0[i] + t1[i]; }
            } else {
#pragma unroll
                for (int i = 0; i < 16; ++i) { t0[i] = __builtin_amdgcn_exp2f(t0[i] - m_run); t1[i] = __builtin_amdgcn_exp2f(t1[i] - m_run); ps += t0[i] + t1[i]; }
            }
            l_run += ps;
            bf16x8 pf[4];
            pf[0] = pack_acc(t0, 0); pf[1] = pack_acc(t0, 1); pf[2] = pack_acc(t1, 0); pf[3] = pack_acc(t1, 1);
            if (kt + 1 < ntiles) at_dma(lds, U, kt + 1, (kt + 1) & 1, w, lane);
            const int vb = (int)(unsigned)(size_t)(lds + AT_V + (kt & 1) * 32768) + v_rd_base(lv);
            asm volatile("s_waitcnt lgkmcnt(0)" ::: "memory"); at_pv_all(O, vb, pf);
        }
        asm volatile("s_waitcnt vmcnt(0)" ::: "memory");
        __syncthreads();
    }
    {
        int lv = lane; asm volatile("" : "+v"(lv)); const int c = lv & 31, hh = lv >> 5;
        l_run += __shfl_xor(l_run, 32);
        const float sc_own = (mm ? lam : 1.0f) / l_run;
        LAS float* xo = (LAS float*)lds + rt * 8192;
        if (mm == 1) {
#pragma unroll
            for (int i = 0; i < 16; ++i) { const float si = __shfl(sc_own, crow(i, hh));
#pragma unroll
                for (int d = 0; d < 8; ++d) xo[crow(i, hh) * 256 + 32 * d + c] = O[d][i] * si; }
        }
        __syncthreads();
        if (mm == 0 && active) {
            float ssa[16];
#pragma unroll
            for (int i = 0; i < 16; ++i) { const float si = __shfl(sc_own, crow(i, hh)); float a = 0.f;
#pragma unroll
                for (int d = 0; d < 8; ++d) { const float o = O[d][i] * si - xo[crow(i, hh) * 256 + 32 * d + c]; O[d][i] = o; a += o * o; }
                a += __shfl_xor(a, 1); a += __shfl_xor(a, 2); a += __shfl_xor(a, 4); a += __shfl_xor(a, 8); a += __shfl_xor(a, 16);
                ssa[i] = rsqrtf(a * (1.0f / 256.0f) + 1e-5f) * (1.0f - LAM_INIT); }
#pragma unroll
            for (int d = 0; d < 8; ++d) { const float gn = F.in[I_SUBN][32 * d + c];
#pragma unroll
                for (int i = 0; i < 16; ++i) { const int r = 32 * rt + crow(i, hh);
                    if (r < U.nq) ATT[(U.mq0 + r) * DM + U.h * 256 + 32 * d + c] = (bf16)(pk2(O[d][i] * ssa[i] * gn, 0.f) & 0xffffu); } }
        }
    }
}
DI float attn_lambda(Frame& F) {
    float d1 = 0.f, d2 = 0.f;
    for (int i = 0; i < 128; ++i) { d1 += F.in[I_LQ1][i] * F.in[I_LK1][i]; d2 += F.in[I_LQ2][i] * F.in[I_LK2][i]; }
    return __expf(d1) - __expf(d2) + LAM_INIT;
}
DI void p_attn(Frame& F) {
    const float lam = attn_lambda(F);
    const bf16* KB = (const bf16*)(F.ws + WS_KB); const bf16* VB = (const bf16*)(F.ws + WS_VB);
    constexpr int NPQ = NB * 8 * 64 / 8;
    const int xcc = (int)(xb_xcc_id() & 7u);
    for (int e = 0; e < 8; ++e) {
        const int q = (xcc + e) & 7;
        for (;;) {
            __syncthreads();
            if (F.tid == 0) F.MISC[16] = atomicAdd(F.ctl + CW_ATTQ + 32 * q, 1u);
            __syncthreads();
            const int r = __builtin_amdgcn_readfirstlane((int)F.MISC[16]);
            if (r >= NPQ) break;
            AttnUnit U; const int bh = 2 * q + (r & 1), u = 63 - (r >> 1), b = bh >> 3;
            U.h = bh & 7; U.Kp = KB + (size_t)b * SEQ * DM; U.Vp = VB + (size_t)b * SEQ * DM; U.Qp = (const bf16*)(F.ws + WS_QB); U.Op = (bf16*)(F.ws + WS_ATT);
            U.nq = 128; U.qpos0 = u * 128; U.nkeys = (u + 1) * 128; U.mq0 = (size_t)b * SEQ + (size_t)u * 128;
            attn_unit(F, U, lam);
        }
    }
}
DI void p_attn_sample(Frame& F, const int sw, const int nsw) {
    const float lam = attn_lambda(F);
    const bf16* KC = (const bf16*)(F.ws + WS_KC); const bf16* VC = (const bf16*)(F.ws + WS_VC);
    for (int p = sw; p < DECB * 8; p += nsw) {
        AttnUnit U; const int b = p >> 3; U.h = p & 7; U.Kp = KC + (size_t)b * (PAST + DECS) * DM; U.Vp = VC + (size_t)b * (PAST + DECS) * DM;
        U.Qp = (const bf16*)(F.ws + WS_SQB) - (size_t)MP * DM; U.Op = (bf16*)(F.ws + WS_SATT) - (size_t)MP * DM;
        U.nq = DECS; U.qpos0 = PAST; U.nkeys = PAST + DECS; U.mq0 = (size_t)MP + (size_t)b * DECS;
        attn_unit(F, U, lam);
    }
}
#ifndef WGM_SMALLN
#define WGM_SMALLN 4
#endif
#ifndef WGM_BIGN
#define WGM_BIGN 4
#endif
#ifndef N_LAUNCH_MODE
#define N_LAUNCH_MODE 1
#endif
constexpr int N_PHASES = 16;
struct Args { const float* in[N_IN]; float* out; unsigned char* ws; int ph_lo, ph_hi; };
static_assert(sizeof(Args) == (N_IN + 2) * 8 + 8, "Args has no padding");
__global__ void __launch_bounds__(NWAVES * 64, 2) fwd(Args args) {
    extern __shared__ __attribute__((aligned(16))) unsigned char lds_raw[];
    Frame F;
    F.lds = (LAS unsigned char*)lds_raw;
    F.MISC = (volatile LAS unsigned*)(F.lds + LDSCTL_OFF);
    F.tid = threadIdx.x; F.lane = F.tid & 63; F.wave = __builtin_amdgcn_readfirstlane(F.tid >> 6);
    F.G = gridDim.x; { const int bx = blockIdx.x; F.vcu = (F.G % 8 == 0) ? (bx % 8) * (F.G / 8) + bx / 8 : bx; }
    F.in = args.in; F.out = args.out; F.ws = args.ws; F.ctl = (unsigned*)(args.ws + WS_CTL);
    for (int u = F.tid; u < (LDS_BYTES - LDSCTL_OFF) / 4; u += NWAVES * 64) ((LAS unsigned*)(F.lds + LDSCTL_OFF))[u] = 0u;
    __syncthreads();
    XcdBarrier bar; bar.bar = F.ctl + CW_BAR; bar.x = 0; bar.st = nullptr;
    if (N_LAUNCH_MODE == 1) bar = xcd_barrier_post(F.ctl + CW_BAR, F.MISC + 8);
    const int lo = args.ph_lo, hi = args.ph_hi;
#ifndef PHASE_MASK
#define PHASE_MASK 0xffff
#endif
#define IN(k) (((PHASE_MASK >> (k)) & 1) && lo <= (k) && (k) < hi)
#ifndef TWICE_MASK
#define TWICE_MASK 0
#endif
#ifndef NREP
#define NREP 2
#endif
#ifndef SPIN_MASK
#define SPIN_MASK 0
#endif
#define SEAM(k) do { if (((SPIN_MASK >> (k)) & 1) && IN(k)) { const unsigned long long t1_ = __builtin_amdgcn_s_memrealtime(); while (__builtin_amdgcn_s_memrealtime() - t1_ < t1_ - tph_) __builtin_amdgcn_s_sleep(8); } \
    if (IN(k) && IN((k) + 1)) xcd_barrier(bar); if (SPIN_MASK) tph_ = __builtin_amdgcn_s_memrealtime(); } while (0)
#define REP(k) for (int rep_ = 0; rep_ < (((TWICE_MASK >> (k)) & 1) ? NREP : 1); ++rep_, (((TWICE_MASK >> (k)) & 1) && rep_ < NREP ? xcd_barrier(bar) : (void)0))
    unsigned long long tph_ = SPIN_MASK ? __builtin_amdgcn_s_memrealtime() : 0ull; (void)tph_;
    unsigned char* ws = args.ws;
    PG8_LAS unsigned char* ring = (PG8_LAS unsigned char*)F.lds;
    bf16* HB = (bf16*)(ws + WS_HB);
    float* H = args.out;
#define SSQP(i) ((float*)(ws + WS_SSQ + (size_t)(i) * SSQ_STRIDE))

    const int gwA = F.vcu * NWAVES + F.wave, NGWA = F.G * NWAVES;
    const bf16* UPm = (const bf16*)(ws + WS_UP); bf16* ACTm = (bf16*)(ws + WS_ACT);
    if (IN(0)) { REP(0) p0_prologue(F); } SEAM(0);
    if (IN(1)) {
        pg8::Gemm g{HB, (const bf16*)(ws + WS_WIN), M, INWP, DM}; pg8::StaticOrder S; S.init(M, INWP, F.G, (int)blockIdx.x, WGM_BIGN);
        pg8::EpiBf E{SSQP(0), (bf16*)(ws + WS_QKV), QKVW, QKVW, (bf16*)(ws + WS_Z), VW, VW, (float*)(ws + WS_BA), 64, 64};
        pg8::gemm_phase<pg8::EpiBf, pg8::StaticOrder, PG8_ALIGN, PG8_SP2>(ring, g, S, E, F.tid);
    } SEAM(1);
#ifdef GDN_REP5
    if (IN(2)) { p_gdnconv(F); p_gdnconv(F); p_gdnconv(F); p_gdnconv(F); p_gdnconv(F); } SEAM(2);
#else
    if (IN(2)) { REP(2) p_gdnconv(F); } SEAM(2);
#endif
    if (IN(3)) { REP(3) p_prep(F); } SEAM(3);
    if (IN(4)) {
        p_scan(F);
        const int nW = F.G, bx = blockIdx.x;
        const bool sub = (nW > NB * 32) ? (bx >= NB * 32) : true;
        const int sw = (nW > NB * 32) ? bx - NB * 32 : bx, nsw = (nW > NB * 32) ? nW - NB * 32 : nW;
        if (sub) {
#ifndef SUBSPIN
#define SUBSPIN 0
#endif
            unsigned long long tst_ = SUBSPIN ? __builtin_amdgcn_s_memrealtime() : 0ull; (void)tst_;
#define STG0() do { if (SUBSPIN) tst_ = __builtin_amdgcn_s_memrealtime(); } while (0)
#define STG(i) do { if ((SUBSPIN >> (i)) & 1) { const unsigned long long t1_ = __builtin_amdgcn_s_memrealtime(); while (__builtin_amdgcn_s_memrealtime() - t1_ < t1_ - tst_) __builtin_amdgcn_s_sleep(8); } } while (0)
            XcdBarrier sb = xcd_barrier_post(F.ctl + CW_BAR2, F.MISC + 12);
            const unsigned ne = (unsigned)nsw; const int gwS = sw * NWAVES + F.wave, NGWS = nsw * NWAVES;
#define UPs_ ((bf16*)(ws + WS_SUP) - (size_t)MP * UPW)
#define ACTs_ ((bf16*)(ws + WS_SACT) - (size_t)MP * DFF)
#define QBs_ ((bf16*)(ws + WS_SQB) - (size_t)MP * DM)
#define ATTs_ ((bf16*)(ws + WS_SATT) - (size_t)MP * DM)
            const int spm = MP / 256;
#define IDLE(n) (sw >= (n) && nsw > (n))
#define IGW(n) ((sw - (n)) * NWAVES + F.wave)
#define INGW(n) ((nsw - (n)) * NWAVES)
            __syncthreads();
            conv_job(F, CJ_WOUT, gwS, NGWS);
            if (nsw <= 44) { conv_job(F, CJ_WUP0, gwS, NGWS); conv_job(F, CJ_WDN0, gwS, NGWS); conv_job(F, CJ_WKVQ, gwS, NGWS); conv_job(F, CJ_WO, gwS, NGWS); conv_job(F, CJ_WUP1, gwS, NGWS); conv_job(F, CJ_WDN1, gwS, NGWS);
                p_cacheconv(F, args.in[I_CK], (bf16*)(ws + WS_KC), (size_t)sw * 512 + F.tid, (size_t)nsw * 512); p_cacheconv(F, args.in[I_CV], (bf16*)(ws + WS_VC), (size_t)sw * 512 + F.tid, (size_t)nsw * 512); }
            const bool spread = nsw > 44;
            STG(0); sub_barrier(sb, ne); asm volatile("" : "+v"(F.tid), "+v"(F.lane)); STG0();
            {
                pg8::Gemm g{(const bf16*)(args.out + O_PK), (const bf16*)(ws + WS_WOUT), M, DM, VW}; pg8::SubOrder S{spm, DM / 256, nsw, sw};
                pg8::EpiRes E{args.in[I_XS] - (size_t)MP * DM, args.in[I_XS] - (size_t)MP * DM, H, HB, SSQP(1)};
                pg8::gemm_phase<pg8::EpiRes, pg8::SubOrder, PG8_ALIGN, PG8_SP2>(ring, g, S, E, F.tid); }
            if (spread && IDLE(8)) { __syncthreads(); conv_job(F, CJ_WUP0, IGW(8), INGW(8)); }
            STG(1); sub_barrier(sb, ne); asm volatile("" : "+v"(F.tid), "+v"(F.lane)); STG0();
            {
                pg8::Gemm g{HB, (const bf16*)(ws + WS_WUP0), M, UPW, DM}; pg8::SubOrder S{spm, UPW / 256, nsw, sw};
                pg8::EpiBf E{SSQP(1), UPs_, UPW, UPW, nullptr, 0, 0, nullptr, 0, 0};
                pg8::gemm_phase<pg8::EpiBf, pg8::SubOrder, PG8_ALIGN, PG8_SP2>(ring, g, S, E, F.tid); }
            if (spread && IDLE(44)) { __syncthreads(); conv_job(F, CJ_WDN0, IGW(44), INGW(44)); conv_job(F, CJ_WKVQ, IGW(44), INGW(44)); }
            STG(2); sub_barrier(sb, ne); asm volatile("" : "+v"(F.tid), "+v"(F.lane)); STG0();
            p_ffnconv(F, 0, MP / 16, MP / 16 + DECB, gwS, NGWS, UPs_, ACTs_);
            STG(3); sub_barrier(sb, ne); asm volatile("" : "+v"(F.tid), "+v"(F.lane)); STG0();
            {
                pg8::Gemm g{ACTs_, (const bf16*)(ws + WS_WDN0), M, DM, DFF}; pg8::SubOrder S{spm, DM / 256, nsw, sw};
                pg8::EpiRes E{H, H, H, HB, SSQP(2)};
                pg8::gemm_phase<pg8::EpiRes, pg8::SubOrder, PG8_ALIGN, PG8_SP2>(ring, g, S, E, F.tid); }
            if (spread && IDLE(8)) p_cacheconv(F, args.in[I_CK], (bf16*)(ws + WS_KC), (size_t)(sw - 8) * 512 + F.tid, (size_t)(nsw - 8) * 512);
            STG(4); sub_barrier(sb, ne); asm volatile("" : "+v"(F.tid), "+v"(F.lane)); STG0();
            {
                pg8::Gemm g{HB, (const bf16*)(ws + WS_WKVQ), M, 6144, DM}; pg8::SubOrder S{spm, 6144 / 256, nsw, sw};
                pg8::EpiKVQs E{SSQP(2), args.out, (bf16*)(ws + WS_KC), (WS_VC - WS_KC) / 2, QBs_};
                pg8::gemm_phase<pg8::EpiKVQs, pg8::SubOrder, PG8_ALIGN, PG8_SP2>(ring, g, S, E, F.tid); }
            if (spread && IDLE(24)) p_cacheconv(F, args.in[I_CV], (bf16*)(ws + WS_VC), (size_t)(sw - 24) * 512 + F.tid, (size_t)(nsw - 24) * 512);
            STG(5); sub_barrier(sb, ne); asm volatile("" : "+v"(F.tid), "+v"(F.lane)); STG0();
            p_attn_sample(F, sw, nsw);
            if (spread && IDLE(128)) { __syncthreads(); conv_job(F, CJ_WO, IGW(128), INGW(128)); conv_job(F, CJ_WUP1, IGW(128), INGW(128)); conv_job(F, CJ_WDN1, IGW(128), INGW(128)); }
            else if (spread && nsw <= 128) { __syncthreads(); conv_job(F, CJ_WO, gwS, NGWS); conv_job(F, CJ_WUP1, gwS, NGWS); conv_job(F, CJ_WDN1, gwS, NGWS); }
            STG(6); sub_barrier(sb, ne); asm volatile("" : "+v"(F.tid), "+v"(F.lane)); STG0();
        }
    } SEAM(4);
    if (IN(5)) {
        pg8::Gemm g{(const bf16*)(args.out + O_PK), (const bf16*)(ws + WS_WOUT), MP, DM, VW}; pg8::StaticOrder S; S.init(MP, DM, F.G, (int)blockIdx.x, WGM_SMALLN);
        pg8::EpiRes E{args.in[I_XP], args.in[I_XP], H, HB, SSQP(1)};
        pg8::gemm_phase<pg8::EpiRes, pg8::StaticOrder, PG8_ALIGN, PG8_SP2>(ring, g, S, E, F.tid);
    } SEAM(5);
    if (IN(6)) {
        pg8::Gemm g{HB, (const bf16*)(ws + WS_WUP0), MP, UPW, DM}; pg8::StaticOrder S; S.init(MP, UPW, F.G, (int)blockIdx.x, WGM_BIGN);
        pg8::EpiBf E{SSQP(1), (bf16*)(ws + WS_UP), UPW, UPW, nullptr, 0, 0, nullptr, 0, 0};
        pg8::gemm_phase<pg8::EpiBf, pg8::StaticOrder, PG8_ALIGN, PG8_SP2>(ring, g, S, E, F.tid);
    } SEAM(6);
#ifndef EXTRA_BAR
#define EXTRA_BAR 0
#endif
#ifdef FFN_REP5
    if (IN(7)) { { int g_ = gwA; asm volatile("" : "+s"(g_)); p_ffnconv(F, 0, 0, MP / 16, g_, NGWA, UPm, ACTm); } { int g_ = gwA; asm volatile("" : "+s"(g_)); p_ffnconv(F, 0, 0, MP / 16, g_, NGWA, UPm, ACTm); } { int g_ = gwA; asm volatile("" : "+s"(g_)); p_ffnconv(F, 0, 0, MP / 16, g_, NGWA, UPm, ACTm); } { int g_ = gwA; asm volatile("" : "+s"(g_)); p_ffnconv(F, 0, 0, MP / 16, g_, NGWA, UPm, ACTm); } { int g_ = gwA; asm volatile("" : "+s"(g_)); p_ffnconv(F, 0, 0, MP / 16, g_, NGWA, UPm, ACTm); } } SEAM(7);
#else
    if (IN(7)) { for (int eb_ = 0; eb_ < EXTRA_BAR; ++eb_) xcd_barrier(bar); REP(7) p_ffnconv(F, 0, 0, MP / 16, gwA, NGWA, UPm, ACTm); } SEAM(7);
#endif
    if (IN(8)) {
        pg8::Gemm g{(const bf16*)(ws + WS_ACT), (const bf16*)(ws + WS_WDN0), MP, DM, DFF}; pg8::StaticOrder S; S.init(MP, DM, F.G, (int)blockIdx.x, WGM_SMALLN);
        pg8::EpiRes E{H, H, H, HB, SSQP(2)};
        pg8::gemm_phase<pg8::EpiRes, pg8::StaticOrder, PG8_ALIGN, PG8_SP2>(ring, g, S, E, F.tid);
    } SEAM(8);
    if (IN(9)) {
        pg8::Gemm g{HB, (const bf16*)(ws + WS_WKVQ), MP, 6144, DM}; pg8::StaticOrder S; S.init(MP, 6144, F.G, (int)blockIdx.x, WGM_BIGN);
        pg8::EpiKVQ E{SSQP(2), args.out, (bf16*)(ws + WS_KB), (WS_VB - WS_KB) / 2, (bf16*)(ws + WS_KC), (WS_VC - WS_KC) / 2};
        static_assert(WS_QB - WS_VB == WS_VB - WS_KB, "K, V, Q bf16 buffers equally spaced");
        pg8::gemm_phase<pg8::EpiKVQ, pg8::StaticOrder, PG8_ALIGN, PG8_SP2>(ring, g, S, E, F.tid);
    } SEAM(9);
    if (IN(10)) {
        const int nsb = F.G < 8 ? F.G : 8;
        if ((int)blockIdx.x < nsb) {
            XcdBarrier sb3 = xcd_barrier_post(F.ctl + CW_BAR3, F.MISC + 14);
            const int spm = MP / 256;
            {
                pg8::Gemm g{ATTs_, (const bf16*)(ws + WS_WO), M, DM, DM}; pg8::SubOrder S{spm, DM / 256, nsb, (int)blockIdx.x};
                pg8::EpiRes E{H, H, H, HB, SSQP(3)};
                pg8::gemm_phase<pg8::EpiRes, pg8::SubOrder, PG8_ALIGN, PG8_SP2>(ring, g, S, E, F.tid); }
            sub_barrier(sb3, (unsigned)nsb); asm volatile("" : "+v"(F.tid), "+v"(F.lane));
            {
                pg8::Gemm g{HB, (const bf16*)(ws + WS_WUP1), M, UPW, DM}; pg8::SubOrder S{spm, UPW / 256, nsb, (int)blockIdx.x};
                pg8::EpiBf E{SSQP(3), UPs_, UPW, UPW, nullptr, 0, 0, nullptr, 0, 0};
                pg8::gemm_phase<pg8::EpiBf, pg8::SubOrder, PG8_ALIGN, PG8_SP2>(ring, g, S, E, F.tid); }
            sub_barrier(sb3, (unsigned)nsb); asm volatile("" : "+v"(F.tid), "+v"(F.lane));
            p_ffnconv(F, 1, MP / 16, MP / 16 + DECB, (int)blockIdx.x * NWAVES + F.wave, nsb * NWAVES, UPs_, ACTs_);
            sub_barrier(sb3, (unsigned)nsb); asm volatile("" : "+v"(F.tid), "+v"(F.lane));
            {
                pg8::Gemm g{ACTs_, (const bf16*)(ws + WS_WDN1), M, DM, DFF}; pg8::SubOrder S{spm, DM / 256, nsb, (int)blockIdx.x};
                pg8::EpiRes E{H, H, H, nullptr, SSQP(4)};
                pg8::gemm_phase<pg8::EpiRes, pg8::SubOrder, PG8_ALIGN, PG8_SP2>(ring, g, S, E, F.tid); }
            sub_barrier(sb3, (unsigned)nsb); asm volatile("" : "+v"(F.tid), "+v"(F.lane));
            p_final(F, MP, M, (int)blockIdx.x * NWAVES + F.wave, nsb * NWAVES);
        }
        p_attn(F);
    } SEAM(10);
    if (IN(11)) {
        pg8::Gemm g{(const bf16*)(ws + WS_ATT), (const bf16*)(ws + WS_WO), MP, DM, DM}; pg8::StaticOrder S; S.init(MP, DM, F.G, (int)blockIdx.x, WGM_SMALLN);
        pg8::EpiRes E{H, H, H, HB, SSQP(3)};
        pg8::gemm_phase<pg8::EpiRes, pg8::StaticOrder, PG8_ALIGN, PG8_SP2>(ring, g, S, E, F.tid);
    } SEAM(11);
    if (IN(12)) {
        pg8::Gemm g{HB, (const bf16*)(ws + WS_WUP1), MP, UPW, DM}; pg8::StaticOrder S; S.init(MP, UPW, F.G, (int)blockIdx.x, WGM_BIGN);
        pg8::EpiBf E{SSQP(3), (bf16*)(ws + WS_UP), UPW, UPW, nullptr, 0, 0, nullptr, 0, 0};
        pg8::gemm_phase<pg8::EpiBf, pg8::StaticOrder, PG8_ALIGN, PG8_SP2>(ring, g, S, E, F.tid);
    } SEAM(12);
    if (IN(13)) { p_ffnconv(F, 1, 0, MP / 16, gwA, NGWA, UPm, ACTm); } SEAM(13);
    if (IN(14)) {
        pg8::Gemm g{(const bf16*)(ws + WS_ACT), (const bf16*)(ws + WS_WDN1), MP, DM, DFF}; pg8::StaticOrder S; S.init(MP, DM, F.G, (int)blockIdx.x, WGM_SMALLN);
        if (F.G == 256) {
            pg8::EpiResNorm E{H, H, SSQP(4), args.in[I_FINAL], F.ctl + CW_FNORM};
            pg8::gemm_phase<pg8::EpiResNorm, pg8::StaticOrder, PG8_ALIGN, PG8_SP2>(ring, g, S, E, F.tid);
        } else {
            pg8::EpiRes E{H, H, H, nullptr, SSQP(4)};
            pg8::gemm_phase<pg8::EpiRes, pg8::StaticOrder, PG8_ALIGN, PG8_SP2>(ring, g, S, E, F.tid);
        }
    }
    if (F.G != 256) { SEAM(14);
    if (IN(15)) { p_final(F, 0, MP, gwA, NGWA); } }
#undef IN
#undef SEAM
}

extern "C" void kernel_launch(void* const* d_in, const int* in_sizes, int n_in, void* d_out, int out_size, void* d_ws, size_t ws_size, hipStream_t stream) {
    static int grid = 0;
    if (grid == 0) {
        if (n_in != N_IN || (size_t)out_size != O_END || ws_size < WS_END) { fprintf(stderr, "kernel_launch: shape mismatch: n_in %d out %d ws %zu (need %zu)\n", n_in, out_size, ws_size, (size_t)WS_END); grid = -1; return; }
        int dev = 0, cus = 0;
        if (hipGetDevice(&dev) != hipSuccess || hipDeviceGetAttribute(&cus, hipDeviceAttributeMultiprocessorCount, dev) != hipSuccess) { grid = -1; return; }
        if (hipFuncSetAttribute((const void*)fwd, hipFuncAttributeMaxDynamicSharedMemorySize, LDS_BYTES) != hipSuccess) { fprintf(stderr, "kernel_launch: hipFuncSetAttribute failed\n"); grid = -1; return; }
        int per_cu = 0;
        if (hipOccupancyMaxActiveBlocksPerMultiprocessor(&per_cu, (const void*)fwd, NWAVES * 64, LDS_BYTES) != hipSuccess || per_cu < 1) fprintf(stderr, "kernel_launch: occupancy query reports %d\n", per_cu);
        (void)hipGetLastError();
        grid = cus;
    }
    if (grid < 0) return;
    (void)hipMemsetAsync((char*)d_ws + WS_CTL, 0, CTL_ZERO_BYTES, stream);
    Args a{};
    for (int i = 0; i < N_IN; ++i) a.in[i] = (const float*)d_in[i];
    a.out = (float*)d_out; a.ws = (unsigned char*)d_ws;
    if (N_LAUNCH_MODE == 1) { a.ph_lo = 0; a.ph_hi = N_PHASES; hipLaunchKernelGGL(fwd, dim3(grid), dim3(NWAVES * 64), LDS_BYTES, stream, a); }
    else for (int p = 0; p < N_PHASES; ++p) { a.ph_lo = p; a.ph_hi = p + 1; hipLaunchKernelGGL(fwd, dim3(grid), dim3(NWAVES * 64), LDS_BYTES, stream, a); }
    const hipError_t le = hipPeekAtLastError();
    if (le != hipSuccess) fprintf(stderr, "kernel_launch: launch failed: %s\n", hipGetErrorName(le));
}
```
